# Optimizing an MI355X kernel written in HIP

```python
import jax, jax.numpy as jnp
from jax import lax
import numpy as np

D_MODEL = 1024
BATCH = 4
SEQ = 4096
DEPTH = 2

HEAD_DIM = 64
W_SSM = 512
W_NA = 512
W_DIL = 512
MIX_WIDTH = W_SSM + W_NA + W_DIL
SSM_GROUP = 16
SSM_GROUPS = W_SSM // SSM_GROUP
SSM_STATE = 64
N_DIRS = 2
NA_HEADS = W_NA // HEAD_DIM
DIL_HEADS = W_DIL // HEAD_DIM
GRID_W = 64
NA_MAX_ROWS = 8
NA_COLS = 16
DIL_PATTERNS = ((128, 1), (512, 4), (2048, 16))
DIL_PAD = 1024
Q_BLOCK = 128
T5_BUCKETS = 32
T5_MAX_DIST = 1024
DT_MIN = 1e-3
DT_MAX = 1e-1
RMS_EPS = 1e-6
NEG_INF = -1e30
IN_COLS = 2 * W_SSM + 4 * W_NA + 4 * W_DIL
SPLIT_SIZES = (W_SSM, W_SSM, W_NA, W_NA, W_NA, W_NA, W_DIL, W_DIL, W_DIL, W_DIL)

kernel_name = "hybrid_s5_natten_dilated_encoder"


def rmsnorm(x, g):
    xf = x.astype(jnp.float32)
    y = xf * lax.rsqrt(jnp.mean(xf * xf, axis=-1, keepdims=True) + RMS_EPS)
    return (y * g.astype(jnp.float32)).astype(x.dtype)


def _t5_bucket(rel):
    nb = T5_BUCKETS // 2
    max_exact = nb // 2
    n = np.abs(rel)
    large = max_exact + (np.log(np.maximum(n, 1) / max_exact) / np.log(T5_MAX_DIST / max_exact)
                         * (nb - max_exact)).astype(np.int32)
    large = np.minimum(large, nb - 1)
    return (np.where(rel > 0, nb, 0) + np.where(n < max_exact, n, large)).astype(np.int32)


def _ssm_combine(left, right):
    a_l, b_l = left
    a_r, b_r = right
    return a_r * a_l, a_r * b_l + b_r


def ssm_branch(xa, lam_re, lam_im, log_dt, b_re, b_im, c_re, c_im, d_skip, glu_w, glu_b):
    f32 = jnp.float32
    bsz, s, _ = xa.shape
    u = xa.astype(f32).reshape(bsz, s, SSM_GROUPS, SSM_GROUP)
    y = d_skip.astype(f32).reshape(SSM_GROUPS, SSM_GROUP) * u
    for direction in range(N_DIRS):
        lam = lax.complex(lam_re[direction].astype(f32), lam_im[direction].astype(f32))
        dt = jnp.exp(log_dt[direction].astype(f32))[:, None]
        lam_bar = jnp.exp(lam * dt)
        b = lax.complex(b_re[direction].astype(f32), b_im[direction].astype(f32))
        b_bar = ((lam_bar - 1.0) / lam)[..., None] * b
        bu = jnp.einsum('gpc,bsgc->bsgp', b_bar, u)
        decay = jnp.broadcast_to(lam_bar, bu.shape)
        _, h = lax.associative_scan(_ssm_combine, (decay, bu), axis=1, reverse=(direction == 1))
        c = lax.complex(c_re[direction].astype(f32), c_im[direction].astype(f32))
        y = y + jnp.einsum('gcp,bsgp->bsgc', c, h).real
    y = y.reshape(bsz, s, W_SSM)
    g = jax.nn.gelu(y)
    out = g * jax.nn.sigmoid(g @ glu_w.astype(f32) + glu_b.astype(f32))
    return out.astype(xa.dtype)


def na_branch(q, k, v, rpb):
    bsz, s, _ = q.shape
    rows = s // GRID_W
    wr = min(NA_MAX_ROWS, rows)

    def heads(t):
        return t.reshape(bsz, rows, GRID_W, NA_HEADS, HEAD_DIM).transpose(0, 3, 1, 2, 4)

    q5 = heads(q) * (HEAD_DIM ** -0.5)
    k5 = heads(k)
    v5 = heads(v)
    j = np.arange(GRID_W)
    col_start = np.clip(j - NA_COLS // 2, 0, GRID_W - NA_COLS)
    col_idx = col_start[:, None] + np.arange(NA_COLS)[None, :]
    col_rel = col_idx - j[:, None] + (NA_COLS - 1)
    rpb_cols = rpb[:, :, col_rel]

    def row_fn(r):
        rs = jnp.clip(r - wr // 2, 0, rows - wr)
        qr = lax.dynamic_index_in_dim(q5, r, axis=2, keepdims=False)
        kr = lax.dynamic_slice_in_dim(k5, rs, wr, axis=2)[:, :, :, col_idx]
        vr = lax.dynamic_slice_in_dim(v5, rs, wr, axis=2)[:, :, :, col_idx]
        row_rel = rs + jnp.arange(wr) - r + (NA_MAX_ROWS - 1)
        bias = jnp.take(rpb_cols, row_rel, axis=1).transpose(0, 2, 1, 3)
        logits = jnp.einsum('bhjd,bhrjcd->bhjrc', qr, kr).astype(jnp.float32) + bias.astype(jnp.float32)
        p = jax.nn.softmax(logits.reshape(bsz, NA_HEADS, GRID_W, wr * NA_COLS), axis=-1)
        p = p.reshape(logits.shape).astype(v.dtype)
        return jnp.einsum('bhjrc,bhrjcd->bhjd', p, vr)

    out = lax.map(row_fn, jnp.arange(rows))
    return out.transpose(1, 0, 3, 2, 4).reshape(bsz, s, W_NA)


def dilated_branch(q, k, v, t5_bias):
    bsz, s, _ = q.shape

    def heads(t):
        return t.reshape(bsz, s, DIL_HEADS, HEAD_DIM).transpose(0, 2, 1, 3)

    pad = ((0, 0), (0, 0), (DIL_PAD, DIL_PAD), (0, 0))
    qh = heads(q) * (HEAD_DIM ** -0.5)
    kp = jnp.pad(heads(k), pad)
    vp = jnp.pad(heads(v), pad)
    qi = np.arange(Q_BLOCK)
    patterns = []
    for w, d in DIL_PATTERNS:
        half = (w // 2) // d
        steps = np.arange(-half, half + 1)
        rel = d * steps
        bias = t5_bias[_t5_bucket(rel)].T
        idx = qi[:, None] + d * (steps + half)[None, :]
        patterns.append((d, half, rel, idx, bias))

    def block_fn(s0):
        qb = lax.dynamic_slice_in_dim(qh, s0, Q_BLOCK, axis=2)
        lses, outs = [], []
        for d, half, rel, idx, bias in patterns:
            seg_len = Q_BLOCK + 2 * half * d
            start = s0 + DIL_PAD - half * d
            kg = lax.dynamic_slice_in_dim(kp, start, seg_len, axis=2)[:, :, idx]
            vg = lax.dynamic_slice_in_dim(vp, start, seg_len, axis=2)[:, :, idx]
            logits = jnp.einsum('bhqd,bhqkd->bhqk', qb, kg).astype(jnp.float32) + bias[:, None, :].astype(jnp.float32)
            pos = s0 + qi[:, None] + rel[None, :]
            logits = jnp.where((pos >= 0) & (pos < s), logits, NEG_INF)
            m = jnp.max(logits, axis=-1, keepdims=True)
            p = jnp.exp(logits - m)
            den = jnp.sum(p, axis=-1, keepdims=True)
            outs.append(jnp.einsum('bhqk,bhqkd->bhqd', p, vg.astype(jnp.float32)) / den)
            lses.append(m + jnp.log(den))
        wts = jax.nn.softmax(jnp.stack(lses), axis=0)
        return jnp.sum(wts * jnp.stack(outs), axis=0).astype(q.dtype)

    out = lax.map(block_fn, jnp.arange(s // Q_BLOCK) * Q_BLOCK)
    return out.transpose(1, 0, 3, 2, 4).reshape(bsz, s, W_DIL)


def setup_inputs(seed: int = 0) -> dict:
    key = jax.random.key(seed)
    ks = jax.random.split(key, 20)
    f32 = jnp.float32
    G, P, C = SSM_GROUPS, SSM_STATE, SSM_GROUP
    nrm = lambda k, shape, sc: jax.random.normal(k, shape, f32) * sc
    lam_im_base = jnp.pi * jnp.arange(P, dtype=f32)
    return {
        "x": nrm(ks[0], (BATCH, SEQ, D_MODEL), 1.0),
        "norm_g": 1.0 + nrm(ks[1], (DEPTH, D_MODEL), 0.02),
        "w_in": nrm(ks[2], (DEPTH, D_MODEL, IN_COLS), D_MODEL ** -0.5),
        "w_out": nrm(ks[3], (DEPTH, MIX_WIDTH, D_MODEL), MIX_WIDTH ** -0.5),
        "ssm_lam_re": -0.5 + nrm(ks[4], (DEPTH, N_DIRS, G, P), 0.01),
        "ssm_lam_im": lam_im_base + nrm(ks[5], (DEPTH, N_DIRS, G, P), 0.01),
        "ssm_log_dt": jax.random.uniform(ks[6], (DEPTH, N_DIRS, G), f32, np.log(DT_MIN), np.log(DT_MAX)),
        "ssm_b_re": nrm(ks[7], (DEPTH, N_DIRS, G, P, C), (2 * C) ** -0.5),
        "ssm_b_im": nrm(ks[8], (DEPTH, N_DIRS, G, P, C), (2 * C) ** -0.5),
        "ssm_c_re": nrm(ks[9], (DEPTH, N_DIRS, G, C, P), P ** -0.5),
        "ssm_c_im": nrm(ks[10], (DEPTH, N_DIRS, G, C, P), P ** -0.5),
        "ssm_d": nrm(ks[11], (DEPTH, W_SSM), 1.0),
        "glu_w": nrm(ks[12], (DEPTH, W_SSM, W_SSM), W_SSM ** -0.5),
        "glu_b": nrm(ks[13], (DEPTH, W_SSM), 0.01),
        "na_rpb": nrm(ks[14], (DEPTH, NA_HEADS, 2 * NA_MAX_ROWS - 1, 2 * NA_COLS - 1), 0.1),
        "t5_bias": nrm(ks[15], (T5_BUCKETS, DIL_HEADS), 0.1),
        "final_g": 1.0 + nrm(ks[16], (D_MODEL,), 0.02),
    }


def reference(x, norm_g, w_in, w_out, ssm_lam_re, ssm_lam_im, ssm_log_dt, ssm_b_re, ssm_b_im,
              ssm_c_re, ssm_c_im, ssm_d, glu_w, glu_b, na_rpb, t5_bias, final_g):
    split_points = [int(v) for v in np.cumsum(SPLIT_SIZES)[:-1]]
    for l in range(DEPTH):
        h = rmsnorm(x, norm_g[l])
        proj = h @ w_in[l]
        xa, za, qb, kb, vb, zb, qc, kc, vc, zc = jnp.split(proj, split_points, axis=-1)
        ya = ssm_branch(xa, ssm_lam_re[l], ssm_lam_im[l], ssm_log_dt[l], ssm_b_re[l], ssm_b_im[l],
                        ssm_c_re[l], ssm_c_im[l], ssm_d[l], glu_w[l], glu_b[l]) * jax.nn.silu(za)
        yb = na_branch(qb, kb, vb, na_rpb[l]) * jax.nn.silu(zb)
        yc = dilated_branch(qc, kc, vc, t5_bias) * jax.nn.silu(zc)
        x = x + jnp.concatenate([ya, yb, yc], axis=-1) @ w_out[l]
    return rmsnorm(x, final_g)
```

```cpp
#include <hip/hip_runtime.h>
#include <cstdio>
#include <cstdint>
#include <cmath>

typedef unsigned short bf16_t;

constexpr int NB = 4, SEQ = 4096, DM = 1024, NTOK = NB * SEQ, DEPTH = 2;
constexpr int IN_COLS = 5120, MIXW = 1536;
constexpr float RMS_EPS = 1e-6f;
constexpr int LCH = 16;
constexpr int NCHUNK = SEQ / LCH;
constexpr int NCHUNK_TOT = NB * NCHUNK;
constexpr int PLD = 4608;
constexpr int PC_ZA = 0, PC_QB = 512, PC_QC = 1024, PC_KB = 1536, PC_VB = 2048, PC_ZB = 2560, PC_KC = 3072, PC_VC = 3584, PC_ZC = 4096;
__host__ __device__ __forceinline__ int inproj_src_col(int n) {
    if (n < 512) return n;
    const int pc = n - 512, s = pc >> 9;
    const int seg = (s == 0) ? 1 : (s == 1) ? 2 : (s == 2) ? 6 : (s == 3) ? 3 : (s == 4) ? 4 : (s == 5) ? 5 : (s == 6) ? 7 : (s == 7) ? 8 : 9;
    return seg * 512 + (pc & 511);
}

constexpr size_t OFF_CTL = 0;
constexpr size_t OFF_SS = 1u << 20;
constexpr size_t OFF_PROJ = 2u << 20;
constexpr size_t SZ_PROJ = (size_t)NTOK * PLD * 2;
constexpr size_t OFF_XAG = OFF_PROJ + SZ_PROJ;
constexpr size_t SZ_XAG = (size_t)32 * NCHUNK_TOT * 512 * 2;
constexpr size_t OFF_XB = OFF_XAG + SZ_XAG;
constexpr size_t SZ_XB = (size_t)NTOK * DM * 2;
constexpr size_t OFF_G = OFF_XB + SZ_XB;
constexpr size_t SZ_G = (size_t)NTOK * 512 * 2;
constexpr size_t OFF_W = OFF_G + SZ_G;
constexpr size_t WS_NEED_NAIVE = OFF_W;

__host__ __device__ __forceinline__ unsigned f2bf(float f) { unsigned u = __builtin_bit_cast(unsigned, f); return (u + 0x7fffu + ((u >> 16) & 1u)) >> 16; }
__host__ __device__ __forceinline__ float bf2f(bf16_t b) { return __builtin_bit_cast(float, (unsigned)b << 16); }
namespace nv {

__device__ __forceinline__ float wave_sum(float v) {
#pragma unroll
    for (int o = 1; o < 64; o <<= 1) v += __shfl_xor(v, o);
    return v;
}

__global__ void __launch_bounds__(256) k_prep_x(const float* __restrict__ x, bf16_t* __restrict__ xb, float* __restrict__ sspart) {
    const int row = blockIdx.x * 4 + (threadIdx.x >> 6), lane = threadIdx.x & 63;
    const float* xr = x + (size_t)row * DM;
    float s = 0.f;
    for (int j = 0; j < 16; ++j) { const float v = xr[lane + 64 * j]; s += v * v; xb[(size_t)row * DM + lane + 64 * j] = (bf16_t)f2bf(v); }
    s = wave_sum(s);
    if (lane < 16) sspart[(size_t)row * 16 + lane] = lane == 0 ? s : 0.f;
}

template <class BF, class EP>
__global__ void __launch_bounds__(256) k_gemm(const bf16_t* __restrict__ A, int lda, int K, BF bf, EP ep) {
    __shared__ float As[16][65];
    __shared__ float Bs[16][65];
    const int tid = threadIdx.x, tx = tid & 15, ty = tid >> 4;
    const int row0 = blockIdx.y * 64, col0 = blockIdx.x * 64;
    float acc[4][4];
#pragma unroll
    for (int i = 0; i < 4; ++i)
#pragma unroll
        for (int j = 0; j < 4; ++j) acc[i][j] = 0.f;
    for (int k0 = 0; k0 < K; k0 += 16) {
        {
            const int r = tid >> 2, kk = (tid & 3) * 4;
#pragma unroll
            for (int q = 0; q < 4; ++q) As[kk + q][r] = bf2f(A[(size_t)(row0 + r) * lda + k0 + kk + q]);
            const int kb = tid >> 4, cb = (tid & 15) * 4;
#pragma unroll
            for (int q = 0; q < 4; ++q) Bs[kb][cb + q] = bf(k0 + kb, col0 + cb + q);
        }
        __syncthreads();
#pragma unroll
        for (int kk = 0; kk < 16; ++kk) {
            float a[4], b[4];
#pragma unroll
            for (int i = 0; i < 4; ++i) a[i] = As[kk][ty * 4 + i];
#pragma unroll
            for (int j = 0; j < 4; ++j) b[j] = Bs[kk][tx * 4 + j];
#pragma unroll
            for (int i = 0; i < 4; ++i)
#pragma unroll
                for (int j = 0; j < 4; ++j) acc[i][j] += a[i] * b[j];
        }
        __syncthreads();
    }
#pragma unroll
    for (int i = 0; i < 4; ++i)
#pragma unroll
        for (int j = 0; j < 4; ++j) ep(row0 + ty * 4 + i, col0 + tx * 4 + j, acc[i][j]);
}

struct BInProj { const float* W; const float* g; __device__ float operator()(int k, int n) const { return g[k] * W[(size_t)k * IN_COLS + inproj_src_col(n)]; } };
struct BPlain { const float* W; int ldn; __device__ float operator()(int k, int n) const { return W[(size_t)k * ldn + n]; } };

struct EpInProj {
    const float* sspart; bf16_t* proj; bf16_t* xag;
    __device__ void operator()(int row, int n, float v) const {
        float ss = 0.f;
        for (int i = 0; i < 16; ++i) ss += sspart[(size_t)row * 16 + i];
        v *= rsqrtf(ss * (1.0f / DM) + RMS_EPS);
        if (n < 512) { const int g = n >> 4, c = n & 15; xag[((size_t)g * NCHUNK_TOT + (row >> 4)) * 512 + (row & 15) * 16 + c] = (bf16_t)f2bf(v); }
        else proj[(size_t)row * PLD + (n - 512)] = (bf16_t)f2bf(v);
    }
};
struct EpGlu {
    const bf16_t* G; const float* bias; bf16_t* proj;
    __device__ void operator()(int row, int n, float v) const {
        const float gg = bf2f(G[(size_t)row * 512 + n]); const float s = 1.f / (1.f + expf(-(v + bias[n])));
        const float z = bf2f(proj[(size_t)row * PLD + PC_ZA + n]); const float sz = z / (1.f + expf(-z));
        proj[(size_t)row * PLD + PC_ZA + n] = (bf16_t)f2bf(gg * s * sz);
    }
};
struct EpOut {
    const float* xold; float* xout;
    __device__ void operator()(int row, int n, float v) const { xout[(size_t)row * DM + n] = xold[(size_t)row * DM + n] + v; }
};

__global__ void __launch_bounds__(64) k_ssm(const bf16_t* __restrict__ xag, const float* lam_re, const float* lam_im, const float* log_dt,
                                              const float* b_re, const float* b_im, const float* c_re, const float* c_im, const float* dskip,
                                              float* __restrict__ ytmp, bf16_t* __restrict__ G, int layer) {
    __shared__ float sh[2][16][64];
    const int b = blockIdx.x >> 5, g = blockIdx.x & 31, p = threadIdx.x;
    for (int dir = 0; dir < 2; ++dir) {
        const int pg = (layer * 2 + dir) * 32 + g;
        const float lre = lam_re[pg * 64 + p], lim = lam_im[pg * 64 + p], dt = expf(log_dt[pg]);
        const float er = expf(lre * dt), lbr = er * cosf(lim * dt), lbi = er * sinf(lim * dt);
        const float nr = lbr - 1.f, ni = lbi, den = lre * lre + lim * lim;
        const float fr = (nr * lre + ni * lim) / den, fi = (ni * lre - nr * lim) / den;
        float bbr[16], bbi[16], cr[16], ci[16];
#pragma unroll
        for (int c = 0; c < 16; ++c) {
            const float br = b_re[((size_t)pg * 64 + p) * 16 + c], bi = b_im[((size_t)pg * 64 + p) * 16 + c];
            bbr[c] = fr * br - fi * bi; bbi[c] = fr * bi + fi * br;
            cr[c] = c_re[((size_t)pg * 16 + c) * 64 + p]; ci[c] = c_im[((size_t)pg * 16 + c) * 64 + p];
        }
        float hr = 0.f, hi = 0.f;
        for (int step = 0; step < SEQ; ++step) {
            const int t = dir == 0 ? step : SEQ - 1 - step;
            const int n = b * NCHUNK + (t >> 4);
            float uu = 0.f;
            if (p < 16) uu = bf2f(xag[((size_t)g * NCHUNK_TOT + n) * 512 + (t & 15) * 16 + p]);
            float bur = 0.f, bui = 0.f;
#pragma unroll
            for (int c = 0; c < 16; ++c) { const float u = __shfl(uu, c); bur += bbr[c] * u; bui += bbi[c] * u; }
            const float nhr = lbr * hr - lbi * hi + bur, nhi = lbr * hi + lbi * hr + bui;
            hr = nhr; hi = nhi;
#pragma unroll
            for (int c = 0; c < 16; ++c) sh[step & 1][c][p] = cr[c] * hr - ci[c] * hi;
            __syncthreads();
            const int c = p & 15, q = p >> 4;
            float s = 0.f;
#pragma unroll
            for (int i = 0; i < 16; ++i) s += sh[step & 1][c][q * 16 + i];
            s += __shfl_xor(s, 16); s += __shfl_xor(s, 32);
            const size_t tok = (size_t)b * SEQ + t;
            if (p < 16) {
                if (dir == 0) ytmp[tok * 512 + g * 16 + p] = s;
                else {
                    const float y = dskip[layer * 512 + g * 16 + p] * uu + ytmp[tok * 512 + g * 16 + p] + s;
                    const float ge = 0.5f * y * (1.f + tanhf(0.7978845608028654f * (y + 0.044715f * y * y * y)));
                    G[tok * 512 + g * 16 + p] = (bf16_t)f2bf(ge);
                }
            }
        }
        __syncthreads();
    }
}

__global__ void __launch_bounds__(256) k_na(bf16_t* __restrict__ proj, const float* __restrict__ rpb, int layer) {
    const int wv = blockIdx.x * 4 + (threadIdx.x >> 6), lane = threadIdx.x & 63;
    const int tok = wv >> 3, h = wv & 7;
    const int b = tok >> 12, r = (tok >> 6) & 63, j = tok & 63;
    int rs = r - 4; rs = rs < 0 ? 0 : (rs > 56 ? 56 : rs);
    int cs = j - 8; cs = cs < 0 ? 0 : (cs > 48 ? 48 : cs);
    const float q = bf2f(proj[(size_t)tok * PLD + PC_QB + h * 64 + lane]) * 0.125f;
    float m = -INFINITY, l = 0.f, o = 0.f;
    for (int i = 0; i < 8; ++i)
        for (int c = 0; c < 16; ++c) {
            const size_t kt = (size_t)b * SEQ + (rs + i) * 64 + cs + c;
            float s = wave_sum(q * bf2f(proj[kt * PLD + PC_KB + h * 64 + lane]));
            s += rpb[(((size_t)layer * 8 + h) * 15 + (rs + i - r + 7)) * 31 + (cs + c - j + 15)];
            const float mn = fmaxf(m, s), al = expf(m - mn), pp = expf(s - mn);
            l = l * al + pp; o = o * al + pp * bf2f(proj[kt * PLD + PC_VB + h * 64 + lane]); m = mn;
        }
    const float z = bf2f(proj[(size_t)tok * PLD + PC_ZB + h * 64 + lane]);
    proj[(size_t)tok * PLD + PC_QB + h * 64 + lane] = (bf16_t)f2bf(o / l * (z / (1.f + expf(-z))));
}

__device__ __forceinline__ int t5_bucket_dev(int rel) {
    const int n = rel < 0 ? -rel : rel;
    int large = 8 + (int)(log((double)(n < 1 ? 1 : n) / 8.0) / log(128.0) * 8.0);
    if (n < 8) large = n;
    large = large > 15 ? 15 : large;
    return (rel > 0 ? 16 : 0) + (n < 8 ? n : large);
}
__global__ void __launch_bounds__(256) k_dil(bf16_t* __restrict__ proj, const float* __restrict__ t5) {
    const int wv = blockIdx.x * 4 + (threadIdx.x >> 6), lane = threadIdx.x & 63;
    const int tok = wv >> 3, h = wv & 7;
    const int b = tok >> 12, t = tok & 4095;
    const float q = bf2f(proj[(size_t)tok * PLD + PC_QC + h * 64 + lane]) * 0.125f;
    float lse[3], outp[3];
    for (int pi = 0; pi < 3; ++pi) {
        const int d = pi == 0 ? 1 : (pi == 1 ? 4 : 16);
        float m = -INFINITY, l = 0.f, o = 0.f;
        for (int s = -64; s <= 64; ++s) {
            const int pos = t + d * s;
            if (pos < 0 || pos >= SEQ) continue;
            const size_t kt = (size_t)b * SEQ + pos;
            float sc = wave_sum(q * bf2f(proj[kt * PLD + PC_KC + h * 64 + lane]));
            sc += t5[t5_bucket_dev(d * s) * 8 + h];
            const float mn = fmaxf(m, sc), al = expf(m - mn), pp = expf(sc - mn);
            l = l * al + pp; o = o * al + pp * bf2f(proj[kt * PLD + PC_VC + h * 64 + lane]); m = mn;
        }
        lse[pi] = m + logf(l); outp[pi] = o / l;
    }
    const float mm = fmaxf(lse[0], fmaxf(lse[1], lse[2]));
    const float w0 = expf(lse[0] - mm), w1 = expf(lse[1] - mm), w2 = expf(lse[2] - mm);
    const float res = (w0 * outp[0] + w1 * outp[1] + w2 * outp[2]) / (w0 + w1 + w2);
    const float z = bf2f(proj[(size_t)tok * PLD + PC_ZC + h * 64 + lane]);
    proj[(size_t)tok * PLD + PC_QC + h * 64 + lane] = (bf16_t)f2bf(res * (z / (1.f + expf(-z))));
}

__global__ void __launch_bounds__(256) k_final(float* __restrict__ x, const float* __restrict__ g) {
    const int row = blockIdx.x * 4 + (threadIdx.x >> 6), lane = threadIdx.x & 63;
    float* xr = x + (size_t)row * DM;
    float v[16]; float s = 0.f;
#pragma unroll
    for (int j = 0; j < 16; ++j) { v[j] = xr[lane + 64 * j]; s += v[j] * v[j]; }
    s = wave_sum(s);
    const float r = rsqrtf(s * (1.0f / DM) + RMS_EPS);
#pragma unroll
    for (int j = 0; j < 16; ++j) xr[lane + 64 * j] = v[j] * r * g[lane + 64 * j];
}

static void run_naive(void* const* d_in, float* out, unsigned char* ws, hipStream_t st) {
    const float* x = (const float*)d_in[0]; const float* norm_g = (const float*)d_in[1]; const float* w_in = (const float*)d_in[2]; const float* w_out = (const float*)d_in[3];
    const float* lam_re = (const float*)d_in[4]; const float* lam_im = (const float*)d_in[5]; const float* log_dt = (const float*)d_in[6];
    const float* b_re = (const float*)d_in[7]; const float* b_im = (const float*)d_in[8]; const float* c_re = (const float*)d_in[9]; const float* c_im = (const float*)d_in[10];
    const float* ssm_d = (const float*)d_in[11]; const float* glu_w = (const float*)d_in[12]; const float* glu_b = (const float*)d_in[13];
    const float* rpb = (const float*)d_in[14]; const float* t5 = (const float*)d_in[15]; const float* final_g = (const float*)d_in[16];
    bf16_t* proj = (bf16_t*)(ws + OFF_PROJ); bf16_t* xag = (bf16_t*)(ws + OFF_XAG); bf16_t* xb = (bf16_t*)(ws + OFF_XB); float* ytmp = (float*)(ws + OFF_XB);
    bf16_t* G = (bf16_t*)(ws + OFF_G); float* sspart = (float*)(ws + OFF_SS);
    for (int l = 0; l < 2; ++l) {
        const float* xcur = l == 0 ? x : out;
        k_prep_x<<<NTOK / 4, 256, 0, st>>>(xcur, xb, sspart);
        k_gemm<<<dim3(IN_COLS / 64, NTOK / 64), 256, 0, st>>>(xb, DM, DM, BInProj{w_in + (size_t)l * DM * IN_COLS, norm_g + l * DM}, EpInProj{sspart, proj, xag});
        k_ssm<<<NB * 32, 64, 0, st>>>(xag, lam_re, lam_im, log_dt, b_re, b_im, c_re, c_im, ssm_d, ytmp, G, l);
        k_gemm<<<dim3(512 / 64, NTOK / 64), 256, 0, st>>>(G, 512, 512, BPlain{glu_w + (size_t)l * 512 * 512, 512}, EpGlu{G, glu_b + l * 512, proj});
        k_na<<<NTOK * 8 / 4, 256, 0, st>>>(proj, rpb, l);
        k_dil<<<NTOK * 8 / 4, 256, 0, st>>>(proj, t5);
        k_gemm<<<dim3(DM / 64, NTOK / 64), 256, 0, st>>>(proj, PLD, 1536, BPlain{w_out + (size_t)l * 1536 * DM, DM}, EpOut{xcur, out});
    }
    k_final<<<NTOK / 4, 256, 0, st>>>(out, final_g);
}
}
extern "C" void kernel_launch(void* const* d_in, const int* in_sizes, int n_in, void* d_out, int out_size, void* d_ws, size_t ws_size, hipStream_t stream) {
    if (n_in != 17 || in_sizes[0] != NTOK * DM || out_size != NTOK * DM || ws_size < WS_NEED_NAIVE) { fprintf(stderr, "kernel_launch: unexpected shapes (n_in %d in0 %d out %d ws %zu)\n", n_in, n_in > 0 ? in_sizes[0] : -1, out_size, ws_size); return; }
    nv::run_naive(d_in, (float*)d_out, (unsigned char*)d_ws, stream);
}
```

```cpp
#include <hip/hip_runtime.h>
#include <cstdio>
#include <cstdint>
#include <cmath>

typedef unsigned short bf16_t;

constexpr int NB = 4, SEQ = 4096, DM = 1024, NTOK = NB * SEQ, DEPTH = 2;
constexpr int IN_COLS = 5120, MIXW = 1536;
constexpr float RMS_EPS = 1e-6f;
constexpr int LCH = 16;
constexpr int NCHUNK = SEQ / LCH;
constexpr int NCHUNK_TOT = NB * NCHUNK;
constexpr int PLD = 4608;
constexpr int PC_ZA = 0, PC_QB = 512, PC_QC = 1024, PC_KB = 1536, PC_VB = 2048, PC_ZB = 2560, PC_KC = 3072, PC_VC = 3584, PC_ZC = 4096;
__host__ __device__ __forceinline__ int inproj_src_col(int n) {
    if (n < 512) return n;
    const int pc = n - 512, s = pc >> 9;
    const int seg = (s == 0) ? 1 : (s == 1) ? 2 : (s == 2) ? 6 : (s == 3) ? 3 : (s == 4) ? 4 : (s == 5) ? 5 : (s == 6) ? 7 : (s == 7) ? 8 : 9;
    return seg * 512 + (pc & 511);
}

constexpr size_t OFF_CTL = 0;
constexpr size_t OFF_SS = 1u << 20;
constexpr size_t OFF_PROJ = 2u << 20;
constexpr size_t SZ_PROJ = (size_t)NTOK * PLD * 2;
constexpr size_t OFF_XAG = OFF_PROJ + SZ_PROJ;
constexpr size_t SZ_XAG = (size_t)32 * NCHUNK_TOT * 512 * 2;
constexpr size_t OFF_XB = OFF_XAG + SZ_XAG;
constexpr size_t SZ_XB = (size_t)NTOK * DM * 2;
constexpr size_t OFF_G = OFF_XB + SZ_XB;
constexpr size_t SZ_G = (size_t)NTOK * 512 * 2;
constexpr size_t OFF_W = OFF_G + SZ_G;
constexpr size_t WS_NEED_NAIVE = OFF_W;

__host__ __device__ __forceinline__ unsigned f2bf(float f) { unsigned u = __builtin_bit_cast(unsigned, f); return (u + 0x7fffu + ((u >> 16) & 1u)) >> 16; }
__host__ __device__ __forceinline__ float bf2f(bf16_t b) { return __builtin_bit_cast(float, (unsigned)b << 16); }
namespace pg8 {
#define PG8_LAS __attribute__((address_space(3)))
typedef short bf16x8 __attribute__((ext_vector_type(8)));
typedef float f32x4 __attribute__((ext_vector_type(4)));
typedef unsigned u32x4 __attribute__((ext_vector_type(4)));
typedef unsigned u32x2 __attribute__((ext_vector_type(2)));
constexpr int BM = 256, BK = 64, HALF = 128, HTB = HALF * BK * 2  , STAGE_BYTES = 8 * HTB, NXCD = 8, WGM = 8;

__host__ __device__ __forceinline__ int lds_byte(int r, int c) { const int st = (r >> 4) * 2 + (c >> 5), rr = r & 15, cc = c & 31, ob = rr * 64 + cc * 2; return st * 1024 + (ob ^ (((ob >> 9) & 1) << 5)); }
__host__ __device__ __forceinline__ void stage_rc(int b, int& R, int& C) { const int st = b / 1024, sb = b % 1024, swz = sb ^ (((sb >> 9) & 1) << 5); R = (st >> 1) * 16 + swz / 64; C = (st & 1) * 32 + (swz % 64) / 2; }
__host__ __device__ __forceinline__ int perm32(int rho) { const int n = rho >> 4, i = rho & 15; return 8 * (i >> 2) + 4 * n + (i & 3); }

struct Unit { int pm, pn, bz; };
struct Gemm { const bf16_t* A; const bf16_t* Bt; int lda, ldb, K; size_t a_bz, b_bz; };

struct StaticOrder {
    int nM, nN, nwg, G, c;
    __host__ __device__ void init(int M, int N, int G_, int c_) { nM = M / BM; nN = N / BM; nwg = nM * nN; G = G_; c = c_; }
    __host__ __device__ bool next(int i, Unit& u) const {
        const long L = (long)i * G + c; if (L >= nwg) return false;
        int wgid = (int)L; { const int q = nwg / NXCD, r = nwg % NXCD, xcd = wgid % NXCD, off = wgid / NXCD; wgid = (xcd < r ? xcd * (q + 1) : r * (q + 1) + (xcd - r) * q) + off; }
        const int nig = WGM * nN, gid = wgid / nig, fm = gid * WGM, gsz = (nM - fm) < WGM ? (nM - fm) : WGM;
        u.pm = fm + ((wgid % nig) % gsz); u.pn = (wgid % nig) / gsz; u.bz = 0; return true;
    }
};
struct BatchOrder {
    int nM, nwg, G, c;
    __host__ __device__ void init(int nM_, int nBatch, int G_, int c_) { nM = nM_; nwg = nM_ * nBatch; G = G_; c = c_; }
    __host__ __device__ bool next(int i, Unit& u) const {
        const long L = (long)i * G + c; if (L >= nwg) return false;
        u.bz = (int)L >> 2; u.pm = (int)L & 3; u.pn = 0; return true;
    }
};

__device__ __forceinline__ unsigned cvt_pk_bf16(float lo, float hi) { unsigned r; asm volatile("v_cvt_pk_bf16_f32 %0, %1, %2" : "=v"(r) : "v"(lo), "v"(hi)); return r; }
__device__ __forceinline__ u32x4 pack8(const f32x4 v0, const f32x4 v1) { u32x4 w; w.x = cvt_pk_bf16(v0[0], v0[1]); w.y = cvt_pk_bf16(v0[2], v0[3]); w.z = cvt_pk_bf16(v1[0], v1[1]); w.w = cvt_pk_bf16(v1[2], v1[3]); return w; }
__device__ __forceinline__ float bfl(unsigned w) { return __builtin_bit_cast(float, w << 16); }
__device__ __forceinline__ float bfh(unsigned w) { return __builtin_bit_cast(float, w & 0xffff0000u); }


struct EpiInProj {
    static constexpr bool PERM = true, AFTER_DRAIN = false;
    const float* sspart; bf16_t* proj; bf16_t* xag;
    __device__ __forceinline__ void operator()(const f32x4 (&acc)[2][2][4][2], const Unit& u, int wr, int wc, int fr, int fq) const {
        const int row0 = u.pm * BM + wr * 64 + fr, colt = u.pn * BM + wc * 32 + 8 * fq;
#pragma unroll
        for (int ai = 0; ai < 2; ++ai)
#pragma unroll
            for (int m = 0; m < 4; ++m) {
                const int row = row0 + ai * HALF + m * 16;
                const f32x4* sp = (const f32x4*)(sspart + (size_t)row * 16);
                const f32x4 s0 = sp[0], s1 = sp[1], s2 = sp[2], s3 = sp[3];
                const float ss = (((s0[0] + s0[1]) + (s0[2] + s0[3])) + ((s1[0] + s1[1]) + (s1[2] + s1[3]))) + (((s2[0] + s2[1]) + (s2[2] + s2[3])) + ((s3[0] + s3[1]) + (s3[2] + s3[3])));
                const float rinv = rsqrtf(ss * (1.0f / DM) + RMS_EPS);
#pragma unroll
                for (int bj = 0; bj < 2; ++bj) {
                    const int col = colt + bj * HALF;
                    const u32x4 w = pack8(acc[ai][bj][m][0] * rinv, acc[ai][bj][m][1] * rinv);
                    bf16_t* dst = (u.pn < 2) ? xag + ((size_t)(col >> 4) * NCHUNK_TOT + (row >> 4)) * 512 + (row & 15) * 16 + (col & 15)
                                             : proj + (size_t)row * PLD + (col - 512);
                    *(u32x4*)dst = w;
                }
                asm volatile("" ::: "memory");
            }
    }
};
struct EpiE {
    static constexpr bool PERM = true, AFTER_DRAIN = false;
    float* E;
    __device__ __forceinline__ void operator()(const f32x4 (&acc)[2][2][4][2], const Unit& u, int wr, int wc, int fr, int fq) const {
        const int row0 = u.pm * BM + wr * 64 + fr, colt = wc * 32 + 8 * fq;
#pragma unroll
        for (int ai = 0; ai < 2; ++ai)
#pragma unroll
            for (int m = 0; m < 4; ++m) {
                float* rp = E + ((size_t)u.bz * NCHUNK_TOT + row0 + ai * HALF + m * 16) * 256 + colt;
#pragma unroll
                for (int bj = 0; bj < 2; ++bj) { *(f32x4*)(rp + bj * HALF) = acc[ai][bj][m][0]; *(f32x4*)(rp + bj * HALF + 4) = acc[ai][bj][m][1]; }
                asm volatile("" ::: "memory");
            }
    }
};
struct EpiY {
    static constexpr bool PERM = true, AFTER_DRAIN = false;
    bf16_t* G;
    __device__ __forceinline__ static float gelu(float y) {
        const float a = 0.7978845608028654f * (y + 0.044715f * y * y * y);
        return y * __builtin_amdgcn_rcpf(1.0f + __builtin_amdgcn_exp2f(-2.885390081777927f * a));
    }
    __device__ __forceinline__ void operator()(const f32x4 (&acc)[2][2][4][2], const Unit& u, int wr, int wc, int fr, int fq) const {
        const int row0 = u.pm * BM + wr * 64 + fr, colt = wc * 32 + 8 * fq;
#pragma unroll
        for (int ai = 0; ai < 2; ++ai)
#pragma unroll
            for (int m = 0; m < 4; ++m) {
                const int n = row0 + ai * HALF + m * 16;
#pragma unroll
                for (int bj = 0; bj < 2; ++bj) {
                    const int col = colt + bj * HALF, t = col >> 4, c0 = col & 15;
                    f32x4 v0 = acc[ai][bj][m][0], v1 = acc[ai][bj][m][1];
#pragma unroll
                    for (int e = 0; e < 4; ++e) { v0[e] = gelu(v0[e]); v1[e] = gelu(v1[e]); }
                    *(u32x4*)(G + ((size_t)n * 16 + t) * 512 + u.bz * 16 + c0) = pack8(v0, v1);
                }
                asm volatile("" ::: "memory");
            }
    }
};
struct EpiGlu {
    static constexpr bool PERM = true, AFTER_DRAIN = false;
    const bf16_t* G; const float* bias; bf16_t* proj;
    __device__ __forceinline__ static float sig(float v) { return __builtin_amdgcn_rcpf(1.0f + __builtin_amdgcn_exp2f(-1.4426950408889634f * v)); }
    __device__ __forceinline__ void operator()(const f32x4 (&acc)[2][2][4][2], const Unit& u, int wr, int wc, int fr, int fq) const {
        const int row0 = u.pm * BM + wr * 64 + fr, colt = u.pn * BM + wc * 32 + 8 * fq;
#pragma unroll
        for (int bj = 0; bj < 2; ++bj) {
            const int col = colt + bj * HALF;
            const f32x4 b0 = *(const f32x4*)(bias + col), b1 = *(const f32x4*)(bias + col + 4);
#pragma unroll
            for (int ai = 0; ai < 2; ++ai)
#pragma unroll
                for (int m = 0; m < 4; ++m) {
                    const int row = row0 + ai * HALF + m * 16;
                    const u32x4 gg = *(const u32x4*)(G + (size_t)row * 512 + col);
                    bf16_t* zp = proj + (size_t)row * PLD + PC_ZA + col;
                    const u32x4 zz = *(const u32x4*)zp;
                    const f32x4 a0 = acc[ai][bj][m][0] + b0, a1 = acc[ai][bj][m][1] + b1;
                    f32x4 o0, o1;
#pragma unroll
                    for (int e = 0; e < 4; ++e) {
                        const unsigned gw0 = gg[e >> 1], zw0 = zz[e >> 1], gw1 = gg[2 + (e >> 1)], zw1 = zz[2 + (e >> 1)];
                        const float g0 = (e & 1) ? bfh(gw0) : bfl(gw0), z0 = (e & 1) ? bfh(zw0) : bfl(zw0);
                        const float g1 = (e & 1) ? bfh(gw1) : bfl(gw1), z1 = (e & 1) ? bfh(zw1) : bfl(zw1);
                        o0[e] = g0 * sig(a0[e]) * (z0 * sig(z0)); o1[e] = g1 * sig(a1[e]) * (z1 * sig(z1));
                    }
                    *(u32x4*)zp = pack8(o0, o1);
                    asm volatile("" ::: "memory");
                }
        }
    }
};
struct EpiOutProj {
    static constexpr bool PERM = true, AFTER_DRAIN = false;
    const float* xold; float* xout; bf16_t* xb; float* sspart; int write_xb;
    __device__ __forceinline__ void operator()(const f32x4 (&acc)[2][2][4][2], const Unit& u, int wr, int wc, int fr, int fq) const {
        const int row0 = u.pm * BM + wr * 64 + fr, colt = u.pn * BM + wc * 32 + 8 * fq;
#pragma unroll
        for (int ai = 0; ai < 2; ++ai)
#pragma unroll
            for (int m = 0; m < 4; ++m) {
                const int row = row0 + ai * HALF + m * 16;
                float ssl = 0.f;
#pragma unroll
                for (int bj = 0; bj < 2; ++bj) {
                    const size_t off = (size_t)row * DM + colt + bj * HALF;
                    const f32x4 n0 = *(const f32x4*)(xold + off) + acc[ai][bj][m][0], n1 = *(const f32x4*)(xold + off + 4) + acc[ai][bj][m][1];
                    *(f32x4*)(xout + off) = n0; *(f32x4*)(xout + off + 4) = n1;
                    if (write_xb) *(u32x4*)(xb + off) = pack8(n0, n1);
                    ssl += ((n0[0] * n0[0] + n0[1] * n0[1]) + (n0[2] * n0[2] + n0[3] * n0[3])) + ((n1[0] * n1[0] + n1[1] * n1[1]) + (n1[2] * n1[2] + n1[3] * n1[3]));
                }
                ssl += __shfl_xor(ssl, 16); ssl += __shfl_xor(ssl, 32);
                if (fq == 0) sspart[(size_t)row * 16 + u.pn * 4 + wc] = ssl;
                asm volatile("" ::: "memory");
            }
    }
};

template <class Epi, class Sched, bool ALIGN_EPI = true>
__device__ __forceinline__ void gemm_phase(PG8_LAS unsigned char* lds, const Gemm g, const Sched& S, const Epi& E) {
    int tid = threadIdx.x; asm volatile("" : "+v"(tid));
    const int wid = __builtin_amdgcn_readfirstlane(tid >> 6), lane = tid & 63, wr = wid >> 2, wc = wid & 3, fr = lane & 15, fq = lane >> 4;
    int K = g.K; asm volatile("" : "+s"(K));
    const int nt = K / BK;
    unsigned voffA[2], voffB[2];
#pragma unroll
    for (int i = 0; i < 2; ++i) { int R, C; stage_rc(tid * 16 + i * 8192, R, C); const int Rb = Epi::PERM ? ((R & ~31) + perm32(R & 31)) : R;
        voffA[i] = (unsigned)(R * g.lda + C) * 2u; voffB[i] = (unsigned)(Rb * g.ldb + C) * 2u; }
    const size_t kstep = (size_t)(BK * 2);
    const size_t hstepA = (size_t)HALF * g.lda * 2, hstepB = (size_t)HALF * g.ldb * 2;
    const unsigned ldsw = (unsigned)wid * 1024u;
    const int aoff = lds_byte(wr * 64 + fr, fq * 8), boff = lds_byte(wc * 32 + fr, fq * 8);
#define PG8_SA(b, h) (((b) * 2 + (h)) * HTB)
#define PG8_SB(b, h) ((4 + (b) * 2 + (h)) * HTB)
#define PG8_STAGE(bufoff, gbase, voff) do { _Pragma("unroll") for (int _i = 0; _i < 2; ++_i) \
        __builtin_amdgcn_global_load_lds((const unsigned*)((const char*)(gbase) + (voff)[_i]), (PG8_LAS unsigned*)(lds + (bufoff) + ldsw + _i * 8192), 16, 0, 0); } while (0)
#define PG8_LDA(dst, b, h) do { _Pragma("unroll") for (int m = 0; m < 4; ++m) _Pragma("unroll") for (int k = 0; k < 2; ++k) dst[m][k] = *(const PG8_LAS bf16x8*)(lds + PG8_SA(b, h) + aoff + m * 2048 + k * 1024); } while (0)
#define PG8_LDB(dst, b, h) do { _Pragma("unroll") for (int n = 0; n < 2; ++n) _Pragma("unroll") for (int k = 0; k < 2; ++k) dst[n][k] = *(const PG8_LAS bf16x8*)(lds + PG8_SB(b, h) + boff + n * 2048 + k * 1024); } while (0)
#define PG8_MMA(ai, bj, At, Bt) do { __builtin_amdgcn_s_setprio(1); _Pragma("unroll") for (int m = 0; m < 4; ++m) _Pragma("unroll") for (int n = 0; n < 2; ++n) _Pragma("unroll") for (int k = 0; k < 2; ++k) \
        acc[ai][bj][m][n] = __builtin_amdgcn_mfma_f32_16x16x32_bf16(Bt[n][k], At[m][k], acc[ai][bj][m][n], 0, 0, 0); __builtin_amdgcn_s_setprio(0); } while (0)
#define PG8_WAIT_V(n) asm volatile("s_waitcnt vmcnt(" #n ")" ::: "memory")
#define PG8_WAIT_L(n) asm volatile("s_waitcnt lgkmcnt(" #n ")" ::: "memory")
#define PG8_BAR __builtin_amdgcn_s_barrier()
#define PG8_SCHED __builtin_amdgcn_sched_barrier(0)
#define PG8_ABASE(u) ((const char*)g.A + ((size_t)(u).bz * g.a_bz + (size_t)(u).pm * BM * g.lda) * 2)
#define PG8_BBASE(u) ((const char*)g.Bt + ((size_t)(u).bz * g.b_bz + (size_t)(u).pn * BM * g.ldb) * 2)
    Unit cur, nxt; int ui = 0;
    if (!S.next(0, cur)) return;
    f32x4 acc[2][2][4][2];
#pragma unroll
    for (int a = 0; a < 2; ++a)
#pragma unroll
        for (int b = 0; b < 2; ++b)
#pragma unroll
            for (int m = 0; m < 4; ++m)
#pragma unroll
                for (int n = 0; n < 2; ++n) acc[a][b][m][n] = (f32x4){0.f, 0.f, 0.f, 0.f};
    bf16x8 At[4][2], B0[2][2], B1[2][2];
    const char* cA = PG8_ABASE(cur); const char* cB = PG8_BBASE(cur);
    PG8_STAGE(PG8_SB(0, 0), cB, voffB); PG8_STAGE(PG8_SB(0, 1), cB + hstepB, voffB); PG8_STAGE(PG8_SA(0, 0), cA, voffA); PG8_STAGE(PG8_SA(0, 1), cA + hstepA, voffA);
    if (wr == 1) PG8_BAR;
    PG8_WAIT_V(2); PG8_BAR;
    PG8_STAGE(PG8_SB(1, 0), cB + kstep, voffB); PG8_STAGE(PG8_SA(1, 0), cA + kstep, voffA); PG8_STAGE(PG8_SB(1, 1), cB + hstepB + kstep, voffB);
    PG8_WAIT_V(6); PG8_BAR;
    for (;;) {
        const bool has_next = S.next(ui + 1, nxt);
        const char* nA = has_next ? PG8_ABASE(nxt) : cA; const char* nB = has_next ? PG8_BBASE(nxt) : cB;
        for (int t = 0; t < nt; t += 2) {
            const bool last = (t == nt - 2);
            const char* a1 = cA + (size_t)(t + 1) * kstep;
            const char* a2 = last ? nA : cA + (size_t)(t + 2) * kstep; const char* b2 = last ? nB : cB + (size_t)(t + 2) * kstep;
            const char* a3 = a2 + kstep; const char* b3 = b2 + kstep;
            PG8_LDB(B0, 0, 0); PG8_LDB(B1, 0, 1); PG8_SCHED; PG8_LDA(At, 0, 0); PG8_STAGE(PG8_SA(1, 1), a1 + hstepA, voffA);
            PG8_WAIT_V(8); PG8_WAIT_L(0); PG8_BAR; PG8_MMA(0, 0, At, B0); PG8_MMA(0, 1, At, B1); PG8_BAR; PG8_SCHED;
            PG8_LDA(At, 0, 1); PG8_STAGE(PG8_SB(0, 0), b2, voffB); PG8_STAGE(PG8_SB(0, 1), b2 + hstepB, voffB); PG8_STAGE(PG8_SA(0, 0), a2, voffA);
            PG8_WAIT_V(8); PG8_WAIT_L(0); PG8_BAR; PG8_MMA(1, 0, At, B0); PG8_MMA(1, 1, At, B1); PG8_BAR; PG8_SCHED;
            PG8_LDB(B0, 1, 0); PG8_LDB(B1, 1, 1); PG8_SCHED; PG8_LDA(At, 1, 0); PG8_STAGE(PG8_SA(0, 1), a2 + hstepA, voffA);
            PG8_WAIT_V(8); PG8_WAIT_L(0); PG8_BAR; PG8_MMA(0, 0, At, B0); PG8_MMA(0, 1, At, B1); PG8_BAR; PG8_SCHED;
            PG8_LDA(At, 1, 1); PG8_STAGE(PG8_SB(1, 0), b3, voffB); PG8_STAGE(PG8_SB(1, 1), b3 + hstepB, voffB); PG8_STAGE(PG8_SA(1, 0), a3, voffA);
            PG8_WAIT_V(8); PG8_WAIT_L(0); PG8_BAR; PG8_MMA(1, 0, At, B0); PG8_MMA(1, 1, At, B1); PG8_BAR; PG8_SCHED;
        }
        if constexpr (ALIGN_EPI) { if (wr == 0) PG8_BAR; }
        E(acc, cur, wr, wc, fr, fq);
        if (!has_next) break;
#pragma unroll
        for (int a = 0; a < 2; ++a)
#pragma unroll
            for (int b = 0; b < 2; ++b)
#pragma unroll
                for (int m = 0; m < 4; ++m)
#pragma unroll
                    for (int n = 0; n < 2; ++n) acc[a][b][m][n] = (f32x4){0.f, 0.f, 0.f, 0.f};
        cur = nxt; cA = nA; cB = nB; ++ui;
        if constexpr (ALIGN_EPI) { if (wr == 1) PG8_BAR; }
    }
    PG8_WAIT_V(0);
    if constexpr (!ALIGN_EPI) { if (wr == 0) PG8_BAR; }
    PG8_BAR;
#undef PG8_SA
#undef PG8_SB
#undef PG8_STAGE
#undef PG8_LDA
#undef PG8_LDB
#undef PG8_MMA
#undef PG8_WAIT_V
#undef PG8_WAIT_L
#undef PG8_BAR
#undef PG8_SCHED
#undef PG8_ABASE
#undef PG8_BBASE
}
}
namespace att {
#define LAS __attribute__((address_space(3)))
typedef short bf16x8 __attribute__((ext_vector_type(8)));
typedef short s16x4 __attribute__((ext_vector_type(4)));
typedef float f32x4 __attribute__((ext_vector_type(4)));
typedef float f32x4u __attribute__((ext_vector_type(4), aligned(4)));
typedef unsigned u32x4 __attribute__((ext_vector_type(4)));
typedef unsigned u32x2 __attribute__((ext_vector_type(2)));
typedef float f32x2_t __attribute__((ext_vector_type(2)));
typedef __bf16 bf16x2_t __attribute__((ext_vector_type(2)));
constexpr int VROW = 160;
constexpr int VTILE = 32 * VROW;
constexpr int WAVE_LDS = 2 * VTILE;
constexpr float C2 = 0.125f * 1.4426950408889634f;
constexpr float NEG = -1e30f, MFLOOR = -1e20f;
constexpr int TBW = 640, TBOFF = 240;

__device__ __forceinline__ unsigned cvtpk(float lo, float hi) { f32x2_t v = {lo, hi}; bf16x2_t b = __builtin_convertvector(v, bf16x2_t); return __builtin_bit_cast(unsigned, b); }
__device__ __forceinline__ s16x4 vtr(LAS const char* p) { typedef short v4i16_t __attribute__((ext_vector_type(4))); return __builtin_bit_cast(s16x4, __builtin_amdgcn_ds_read_tr16_b64_v4i16((LAS v4i16_t*)p)); }

struct State { float m, l; f32x4 acc[4]; };

__device__ __forceinline__ void softmax_pv(State& st, f32x4 t0, f32x4 t1, LAS const char* vt, int lane) {
    float mx = fmaxf(fmaxf(fmaxf(t0[0], t0[1]), fmaxf(t0[2], t0[3])), fmaxf(fmaxf(t1[0], t1[1]), fmaxf(t1[2], t1[3])));
    mx = fmaxf(mx, __shfl_xor(mx, 16)); mx = fmaxf(mx, __shfl_xor(mx, 32));
    const float mn = fmaxf(st.m, mx);
    const float alpha = __builtin_amdgcn_exp2f(st.m - mn);
    st.m = mn;
    f32x4 p0, p1;
#pragma unroll
    for (int e = 0; e < 4; ++e) { p0[e] = __builtin_amdgcn_exp2f(t0[e] - mn); p1[e] = __builtin_amdgcn_exp2f(t1[e] - mn); }
    st.l = st.l * alpha + (((p0[0] + p0[1]) + (p0[2] + p0[3])) + ((p1[0] + p1[1]) + (p1[2] + p1[3])));
    u32x4 pw; pw.x = cvtpk(p0[0], p0[1]); pw.y = cvtpk(p0[2], p0[3]); pw.z = cvtpk(p1[0], p1[1]); pw.w = cvtpk(p1[2], p1[3]);
    const bf16x8 pb = __builtin_bit_cast(bf16x8, pw);
    const int g = lane >> 4, qq = (lane & 15) >> 2, pp = lane & 3;
    LAS const char* vb = vt + (4 * g + qq) * VROW + pp * 8;
#pragma unroll
    for (int mt = 0; mt < 4; ++mt) {
        const s16x4 lo = vtr(vb + mt * 32), hi = vtr(vb + 16 * VROW + mt * 32);
        const bf16x8 av = (bf16x8){lo[0], lo[1], lo[2], lo[3], hi[0], hi[1], hi[2], hi[3]};
        st.acc[mt] = st.acc[mt] * alpha;
        st.acc[mt] = __builtin_amdgcn_mfma_f32_16x16x32_bf16(av, pb, st.acc[mt], 0, 0, 0);
    }
}

__device__ __forceinline__ void finish(State& st, bf16_t* outp  , const bf16_t* zp, int lane) {
    float l = st.l; l += __shfl_xor(l, 16); l += __shfl_xor(l, 32);
    const float rl = 1.0f / l;
    const int g = lane >> 4;
#pragma unroll
    for (int mt = 0; mt < 4; ++mt) {
        const u32x2 zz = *(const u32x2*)(zp + mt * 16 + 4 * g);
        float o[4];
#pragma unroll
        for (int e = 0; e < 4; ++e) {
            const unsigned zw = zz[e >> 1]; const float z = (e & 1) ? __builtin_bit_cast(float, zw & 0xffff0000u) : __builtin_bit_cast(float, zw << 16);
            const float sz = z * __builtin_amdgcn_rcpf(1.0f + __builtin_amdgcn_exp2f(-1.4426950408889634f * z));
            o[e] = st.acc[mt][e] * rl * sz;
        }
        u32x2 w; w.x = cvtpk(o[0], o[1]); w.y = cvtpk(o[2], o[3]);
        *(u32x2*)(outp + mt * 16 + 4 * g) = w;
    }
}

__device__ __forceinline__ void dil_task(bf16_t* proj, const float* tbl, int task, LAS char* vbuf, int lane) {
    const int r = task & 15, qb = (task >> 4) & 15, h = (task >> 8) & 7, b = task >> 11;
    const int q = lane & 15, g = lane >> 4;
    const int qr = qb * 256 + r;
    bf16_t* pb_ = proj + (size_t)b * SEQ * PLD;
    const bf16_t* qp = pb_ + (size_t)(qr + 16 * q) * PLD + PC_QC + h * 64 + g * 8;
    const bf16x8 bq0 = *(const bf16x8*)qp, bq1 = *(const bf16x8*)(qp + 32);
    const bf16_t* kbase = pb_ + PC_KC + h * 64 + g * 8;
    const bf16_t* vbase = pb_ + PC_VC + h * 64 + (lane & 1) * 32;
    const int sv = lane >> 1;
    State st; st.m = MFLOOR; st.l = 0.f;
#pragma unroll
    for (int mt = 0; mt < 4; ++mt) st.acc[mt] = (f32x4){0.f, 0.f, 0.f, 0.f};
    const float* tbh = tbl + (size_t)h * 3 * TBW;

#define DIL_PARAMS(ks, d, e, pat, ul0) int d, e, pat, ul0; if ((ks) < 5) { d = 16; e = 1; pat = 0; ul0 = (ks) * 32; } else if ((ks) < 11) { d = 4; e = 4; pat = 1; ul0 = ((ks) - 5) * 32; } else { d = 1; e = 16; pat = 2; ul0 = ((ks) - 11) * 32; }
    bf16x8 k00, k01, k10, k11; u32x4 v0, v1, v2, v3; f32x4 bb0, bb1;
    auto issue = [&](int ks) {
        DIL_PARAMS(ks, d, e, pat, ul0);
        const int pbase = qr + d * (ul0 - 64);
        int p0 = pbase + d * q, p1 = p0 + 16 * d, pv = pbase + d * sv;
        p0 = p0 < 0 ? 0 : (p0 > SEQ - 1 ? SEQ - 1 : p0); p1 = p1 < 0 ? 0 : (p1 > SEQ - 1 ? SEQ - 1 : p1); pv = pv < 0 ? 0 : (pv > SEQ - 1 ? SEQ - 1 : pv);
        const bf16_t* ka = kbase + (size_t)p0 * PLD; const bf16_t* kb = kbase + (size_t)p1 * PLD; const bf16_t* va = vbase + (size_t)pv * PLD;
        k00 = *(const bf16x8*)ka; k01 = *(const bf16x8*)(ka + 32); k10 = *(const bf16x8*)kb; k11 = *(const bf16x8*)(kb + 32);
        v0 = *(const u32x4*)va; v1 = *(const u32x4*)(va + 8); v2 = *(const u32x4*)(va + 16); v3 = *(const u32x4*)(va + 24);
        const float* tp = tbh + pat * TBW + TBOFF + ul0 + 4 * g - e * q;
        bb0 = *(const f32x4u*)tp; bb1 = *(const f32x4u*)(tp + 16);
    };
    issue(0);
#pragma unroll 1
    for (int ks = 0; ks < 23; ++ks) {
        const bf16x8 a00 = k00, a01 = k01, a10 = k10, a11 = k11; const u32x4 w0 = v0, w1 = v1, w2 = v2, w3 = v3; const f32x4 c0 = bb0, c1 = bb1;
        if (ks + 1 < 23) issue(ks + 1);
        LAS char* vt = vbuf + (ks & 1) * VTILE;
        LAS char* vw = vt + sv * VROW + (lane & 1) * 64;
        *(LAS u32x4*)vw = w0; *(LAS u32x4*)(vw + 16) = w1; *(LAS u32x4*)(vw + 32) = w2; *(LAS u32x4*)(vw + 48) = w3;
        f32x4 s0 = (f32x4){0.f, 0.f, 0.f, 0.f}, s1 = s0;
        s0 = __builtin_amdgcn_mfma_f32_16x16x32_bf16(a00, bq0, s0, 0, 0, 0); s0 = __builtin_amdgcn_mfma_f32_16x16x32_bf16(a01, bq1, s0, 0, 0, 0);
        s1 = __builtin_amdgcn_mfma_f32_16x16x32_bf16(a10, bq0, s1, 0, 0, 0); s1 = __builtin_amdgcn_mfma_f32_16x16x32_bf16(a11, bq1, s1, 0, 0, 0);
        f32x4 t0 = s0 * C2 + c0, t1 = s1 * C2 + c1;
        {
            DIL_PARAMS(ks, d, e, pat, ul0);
            const int pbase = qr + d * (ul0 - 64);
            if (pbase < 0 || pbase + 31 * d > SEQ - 1) {
                const int pk = pbase + d * 4 * g;
#pragma unroll
                for (int x = 0; x < 4; ++x) { if ((unsigned)(pk + d * x) >= (unsigned)SEQ) t0[x] = NEG; if ((unsigned)(pk + d * (16 + x)) >= (unsigned)SEQ) t1[x] = NEG; }
            }
        }
        softmax_pv(st, t0, t1, vt, lane);
    }
#undef DIL_PARAMS
    bf16_t* outp = pb_ + (size_t)(qr + 16 * q) * PLD + PC_QC + h * 64;
    finish(st, outp, pb_ + (size_t)(qr + 16 * q) * PLD + PC_ZC + h * 64, lane);
}

__device__ __forceinline__ void na_task(bf16_t* proj, const float* rpb2, int task, LAS char* vbuf, int lane) {
    const int jt = task & 3, r = (task >> 2) & 63, h = (task >> 8) & 7, b = task >> 11;
    const int q = lane & 15, g = lane >> 4;
    const int j0 = 16 * jt, j = j0 + q;
    int w0 = j0 - 8; w0 = w0 < 0 ? 0 : (w0 > 32 ? 32 : w0);
    int rs = r - 4; rs = rs < 0 ? 0 : (rs > 56 ? 56 : rs);
    int cs = j - 8; cs = cs < 0 ? 0 : (cs > 48 ? 48 : cs);
    bf16_t* pb_ = proj + (size_t)b * SEQ * PLD;
    const size_t tq = (size_t)(r * 64 + j);
    const bf16_t* qp = pb_ + tq * PLD + PC_QB + h * 64 + g * 8;
    const bf16x8 bq0 = *(const bf16x8*)qp, bq1 = *(const bf16x8*)(qp + 32);
    const bf16_t* kbase = pb_ + (size_t)(rs * 64 + w0 + q) * PLD + PC_KB + h * 64 + g * 8;
    const int sv = lane >> 1;
    const bf16_t* vbase = pb_ + (size_t)(rs * 64 + w0 + sv) * PLD + PC_VB + h * 64 + (lane & 1) * 32;
    const float* tb = rpb2 + ((size_t)h * 15 + (rs - r + 7)) * 64 + (w0 + 4 * g - j + 32);
    State st; st.m = MFLOOR; st.l = 0.f;
#pragma unroll
    for (int mt = 0; mt < 4; ++mt) st.acc[mt] = (f32x4){0.f, 0.f, 0.f, 0.f};
    const int kc0 = w0 + 4 * g - cs;
    bf16x8 k00, k01, k10, k11; u32x4 v0, v1, v2, v3; f32x4 bb0, bb1;
    auto issue = [&](int ks) {
        const bf16_t* ka = kbase + (size_t)ks * 64 * PLD; const bf16_t* kb = ka + (size_t)16 * PLD; const bf16_t* va = vbase + (size_t)ks * 64 * PLD;
        k00 = *(const bf16x8*)ka; k01 = *(const bf16x8*)(ka + 32); k10 = *(const bf16x8*)kb; k11 = *(const bf16x8*)(kb + 32);
        v0 = *(const u32x4*)va; v1 = *(const u32x4*)(va + 8); v2 = *(const u32x4*)(va + 16); v3 = *(const u32x4*)(va + 24);
        const float* tp = tb + ks * 64;
        bb0 = *(const f32x4u*)tp; bb1 = *(const f32x4u*)(tp + 16);
    };
    issue(0);
#pragma unroll 1
    for (int ks = 0; ks < 8; ++ks) {
        const bf16x8 a00 = k00, a01 = k01, a10 = k10, a11 = k11; const u32x4 w0_ = v0, w1 = v1, w2 = v2, w3 = v3; const f32x4 c0 = bb0, c1 = bb1;
        if (ks + 1 < 8) issue(ks + 1);
        LAS char* vt = vbuf + (ks & 1) * VTILE;
        LAS char* vw = vt + sv * VROW + (lane & 1) * 64;
        *(LAS u32x4*)vw = w0_; *(LAS u32x4*)(vw + 16) = w1; *(LAS u32x4*)(vw + 32) = w2; *(LAS u32x4*)(vw + 48) = w3;
        f32x4 s0 = (f32x4){0.f, 0.f, 0.f, 0.f}, s1 = s0;
        s0 = __builtin_amdgcn_mfma_f32_16x16x32_bf16(a00, bq0, s0, 0, 0, 0); s0 = __builtin_amdgcn_mfma_f32_16x16x32_bf16(a01, bq1, s0, 0, 0, 0);
        s1 = __builtin_amdgcn_mfma_f32_16x16x32_bf16(a10, bq0, s1, 0, 0, 0); s1 = __builtin_amdgcn_mfma_f32_16x16x32_bf16(a11, bq1, s1, 0, 0, 0);
        f32x4 t0 = s0 * C2 + c0, t1 = s1 * C2 + c1;
#pragma unroll
        for (int x = 0; x < 4; ++x) { if ((unsigned)(kc0 + x) >= 16u) t0[x] = NEG; if ((unsigned)(kc0 + 16 + x) >= 16u) t1[x] = NEG; }
        softmax_pv(st, t0, t1, vt, lane);
    }
    finish(st, pb_ + tq * PLD + PC_QB + h * 64, pb_ + tq * PLD + PC_ZB + h * 64, lane);
}
#undef LAS
}
constexpr int NWAVES = 8;
#define GAS __attribute__((address_space(1)))
#define LAS __attribute__((address_space(3)))
typedef unsigned v4u __attribute__((ext_vector_type(4)));
typedef float f32x4 __attribute__((ext_vector_type(4)));
typedef GAS unsigned gu32;
#define RLX_AGENT __ATOMIC_RELAXED, __HIP_MEMORY_SCOPE_AGENT

constexpr size_t SZ_WINT = (size_t)IN_COLS * DM * 2, SZ_WOUTT = (size_t)DM * MIXW * 2, SZ_GLUT = 512 * 512 * 2, SZ_TM = (size_t)32 * 256 * 512 * 2, SZ_MS = (size_t)32 * 256 * 256 * 2;
constexpr size_t OFF_WOUTT0 = OFF_W, OFF_WOUTT1 = OFF_WOUTT0 + SZ_WOUTT, OFF_WINT1 = OFF_WOUTT1 + SZ_WOUTT, OFF_GLUT1 = OFF_WINT1 + SZ_WINT, OFF_TM1 = OFF_GLUT1 + SZ_GLUT, OFF_MS1 = OFF_TM1 + SZ_TM;
constexpr size_t WS_NEED = OFF_MS1 + SZ_MS;
constexpr size_t DO_WINT0 = 0, DO_GLUT0 = DO_WINT0 + SZ_WINT, DO_TM0 = DO_GLUT0 + SZ_GLUT, DO_MS0 = DO_TM0 + SZ_TM;
static_assert(DO_MS0 + SZ_MS <= (size_t)NTOK * DM * 4, "layer-0 tables fit in d_out");
static_assert(WS_NEED <= (size_t)256 * 1024 * 1024, "workspace map fits 256 MiB");
constexpr size_t CTL_ZERO_BYTES = 262144;
constexpr int CW_BAR = 1024;
constexpr size_t OFF_RPB2 = 524288;
constexpr size_t OFF_T5TB = OFF_RPB2 + 2 * 8 * 15 * 64 * 4;
static_assert(OFF_T5TB + 8 * 3 * att::TBW * 4 <= OFF_SS, "small tables fit in the control MiB");

constexpr int RING_BYTES = 131072;
constexpr int MISC_OFF = RING_BYTES;
constexpr int LDS_BYTES = 147456;
static_assert(NWAVES * att::WAVE_LDS <= RING_BYTES, "attention LDS");

#define XB_TMO      128
#define XB_XCNT(j)  (256  + 64 * (j))
#define XB_XSUB(j)  (1280 + 64 * (j))
#define XB_XGEN(j)  (2304 + 64 * (j))
#define XB_TOP      3328
#define XB_TOPGEN   3392
#define XCD_BAR_WORDS 3456
#define XB_SPIN_CAP (1u << 18)
__device__ __forceinline__ unsigned xb_ld(unsigned* p)              { return __hip_atomic_load(p, __ATOMIC_RELAXED, __HIP_MEMORY_SCOPE_AGENT); }
__device__ __forceinline__ unsigned xb_add(unsigned* p, unsigned v) { return __hip_atomic_fetch_add(p, v, __ATOMIC_RELAXED, __HIP_MEMORY_SCOPE_AGENT); }
__device__ __forceinline__ unsigned xb_xcc_id() { return (unsigned)__builtin_amdgcn_s_getreg((3 << 11) | 20) & 0xFu; }
#define XB_SPIN(cond, bar) do { unsigned _sp = 0; while (cond) { __builtin_amdgcn_s_sleep(1); \
    if ((++_sp & 255u) == 0u) { if (xb_ld(&(bar)[XB_TMO])) break; if (_sp > XB_SPIN_CAP) { atomicAdd(&(bar)[XB_TMO], 1u); break; } } } } while (0)
struct XcdBarrier { unsigned* bar; unsigned x; volatile LAS unsigned* st; };
__device__ __forceinline__ XcdBarrier xcd_barrier_post(unsigned* bar, volatile LAS unsigned* st) {
    XcdBarrier b; b.bar = bar; b.x = xb_xcc_id(); b.st = st;
    if (threadIdx.x == 0) (void)xb_add(&bar[XB_XCNT(b.x)], 1u);
    return b;
}
__device__ __forceinline__ void xcd_barrier_complete(unsigned* bar, unsigned x, unsigned& nloc, unsigned& nx) {
    const unsigned G = gridDim.x * gridDim.y * gridDim.z;
    unsigned sum, cnt, mine, sp = 0u;
    for (;;) {
        sum = 0u; cnt = 0u; mine = 0u;
#pragma unroll
        for (unsigned j = 0; j < 16; ++j) { const unsigned c = xb_ld(&bar[XB_XCNT(j)]); sum += c; cnt += (c > 0u) ? 1u : 0u; mine = (j == x) ? c : mine; }
        if (sum == G) break;
        __builtin_amdgcn_s_sleep(1);
        if ((++sp & 255u) == 0u) { if (xb_ld(&bar[XB_TMO])) break; if (sp > XB_SPIN_CAP) { atomicAdd(&bar[XB_TMO], 1u); break; } }
    }
    nloc = mine > 0u ? mine : 1u; nx = cnt > 0u ? cnt : 1u;
}
__device__ __forceinline__ void xcd_barrier(const XcdBarrier& b) {
    asm volatile("s_waitcnt vmcnt(0)" ::: "memory");
    __syncthreads();
    if (threadIdx.x == 0) {
        unsigned* bar = b.bar;
        __builtin_amdgcn_s_waitcnt(0);
        unsigned nloc = b.st[0], nx = b.st[1];
        if (nloc == 0u) { xcd_barrier_complete(bar, b.x, nloc, nx); b.st[0] = nloc; b.st[1] = nx; }
        const unsigned old = xb_add(&bar[XB_XSUB(b.x)], 1u);
        const unsigned gen = old / nloc;
        if (old + 1u == (gen + 1u) * nloc) {
            __builtin_amdgcn_fence(__ATOMIC_RELEASE, "agent");
            asm volatile("s_waitcnt vmcnt(0)" ::: "memory");
            const unsigned og = xb_add(&bar[XB_TOP], 1u);
            const unsigned tg = og / nx;
            if (og + 1u == (tg + 1u) * nx) xb_add(&bar[XB_TOPGEN], 1u);
            else XB_SPIN(xb_ld(&bar[XB_TOPGEN]) == tg, bar);
            __builtin_amdgcn_fence(__ATOMIC_ACQUIRE, "agent");
            xb_add(&bar[XB_XGEN(b.x)], 1u);
            asm volatile("s_waitcnt vmcnt(0)" ::: "memory");
        } else {
            XB_SPIN(xb_ld(&bar[XB_XGEN(b.x)]) == gen, bar);
            __builtin_amdgcn_fence(__ATOMIC_ACQUIRE, "agent");
            asm volatile("s_waitcnt vmcnt(0)" ::: "memory");
        }
    }
    __syncthreads();
}

struct Args { const float* in[17]; float* out; unsigned char* ws; int ph_lo, ph_hi; int li, skip; };

__device__ __forceinline__ float wave_sum(float v) {
#pragma unroll
    for (int o = 1; o < 64; o <<= 1) v += __shfl_xor(v, o);
    return v;
}
__device__ __forceinline__ unsigned pk2(float lo, float hi) { return f2bf(lo) | (f2bf(hi) << 16); }

__device__ __forceinline__ void p0_transpose_item(const float* W, int K, int Nsrc, bf16_t* WT, int k0, int n0s, int n0d, const float* kscale, LAS float* scr, int lane) {
#pragma unroll 8
    for (int i = 0; i < 32; ++i) { const int kk = 2 * i + (lane >> 5); float v = W[(size_t)(k0 + kk) * Nsrc + n0s + (lane & 31)]; if (kscale) v *= kscale[k0 + kk]; scr[kk * 33 + (lane & 31)] = v; }
    asm volatile("s_waitcnt lgkmcnt(0)" ::: "memory");
    const int c = lane & 7;
#pragma unroll
    for (int j = 0; j < 4; ++j) { const int n = (lane >> 3) + 8 * j; const LAS float* s = scr + (8 * c) * 33 + n;
        v4u o; o.x = pk2(s[0 * 33], s[1 * 33]); o.y = pk2(s[2 * 33], s[3 * 33]); o.z = pk2(s[4 * 33], s[5 * 33]); o.w = pk2(s[6 * 33], s[7 * 33]);
        *(v4u*)(WT + (size_t)(n0d + n) * K + k0 + 8 * c) = o; }
    asm volatile("s_waitcnt lgkmcnt(0)" ::: "memory");
}
__device__ __forceinline__ void p0_xrow(const float* xrow, bf16_t* orow, float* ssrow, int lane) {
    const f32x4* xr = (const f32x4*)xrow + lane;
    f32x4 v[4]; float s = 0.f;
#pragma unroll
    for (int j = 0; j < 4; ++j) { v[j] = xr[64 * j]; s += (v[j].x * v[j].x + v[j].y * v[j].y) + (v[j].z * v[j].z + v[j].w * v[j].w); }
    s = wave_sum(s);
    unsigned long long* o8 = (unsigned long long*)orow + lane;
#pragma unroll
    for (int j = 0; j < 4; ++j) o8[64 * j] = (unsigned long long)pk2(v[j].x, v[j].y) | ((unsigned long long)pk2(v[j].z, v[j].w) << 32);
    if (lane < 16) ssrow[lane] = lane == 0 ? s : 0.f;
}
__device__ __forceinline__ int t5_bucket_dev(int rel) {
    const int n = rel < 0 ? -rel : rel;
    int large = 8 + (int)(log((double)(n < 1 ? 1 : n) / 8.0) / log(128.0) * 8.0);
    large = large > 15 ? 15 : large;
    return (rel > 0 ? 16 : 0) + (n < 8 ? n : large);
}
__device__ __forceinline__ void p0_ssm_tables(const Args& a, int l, int g, bf16_t* TM, bf16_t* Ms, LAS float* scr) {
    int tid = threadIdx.x; asm volatile("" : "+v"(tid));
    LAS float* pw = scr;
    LAS float* fc = scr + 2 * 64 * 17 * 2;
    LAS float* k0x = fc + 2 * 64 * 2;
    const float* lam_re = a.in[4]; const float* lam_im = a.in[5]; const float* log_dt = a.in[6];
    const float* b_re = a.in[7]; const float* b_im = a.in[8]; const float* c_re = a.in[9]; const float* c_im = a.in[10]; const float* dskip = a.in[11];
    if (tid < 128) {
        const int d = tid >> 6, p = tid & 63, pg = (l * 2 + d) * 32 + g;
        const float lre = lam_re[pg * 64 + p], lim = lam_im[pg * 64 + p], dt = expf(log_dt[pg]);
        const float er = expf(lre * dt), lbr = er * cosf(lim * dt), lbi = er * sinf(lim * dt);
        const float nr = lbr - 1.f, ni = lbi, den = lre * lre + lim * lim;
        fc[(d * 64 + p) * 2] = (nr * lre + ni * lim) / den; fc[(d * 64 + p) * 2 + 1] = (ni * lre - nr * lim) / den;
        float wr = 1.f, wi = 0.f;
        for (int k = 0; k <= 16; ++k) { pw[((d * 64 + p) * 17 + k) * 2] = wr; pw[((d * 64 + p) * 17 + k) * 2 + 1] = wi; const float t = wr * lbr - wi * lbi; wi = wr * lbi + wi * lbr; wr = t; }
    }
    __syncthreads();
    const int d = tid >> 8, c = (tid >> 4) & 15, cp = tid & 15, pg = (l * 2 + d) * 32 + g;
    float Kk[16];
#pragma unroll
    for (int k = 0; k < 16; ++k) Kk[k] = 0.f;
    for (int p = 0; p < 64; ++p) {
        const float Cr = c_re[((size_t)pg * 16 + c) * 64 + p], Ci = c_im[((size_t)pg * 16 + c) * 64 + p];
        const float br = b_re[((size_t)pg * 64 + p) * 16 + cp], bi = b_im[((size_t)pg * 64 + p) * 16 + cp];
        const float fr = fc[(d * 64 + p) * 2], fi = fc[(d * 64 + p) * 2 + 1];
        const float bbr = fr * br - fi * bi, bbi = fr * bi + fi * br;
        const LAS float* pwp = pw + (d * 64 + p) * 17 * 2;
#pragma unroll
        for (int k = 0; k < 16; ++k) { const float pr = pwp[2 * k], pi = pwp[2 * k + 1]; const float wr = Cr * pr - Ci * pi, wi = Cr * pi + Ci * pr; Kk[k] += wr * bbr - wi * bbi; }
        if (cp == (p & 15)) {
#pragma unroll
            for (int e = 1; e <= 16; ++e) { const float pr = pwp[2 * e], pi = pwp[2 * e + 1]; const float wr = Cr * pr - Ci * pi, wi = Cr * pi + Ci * pr;
                const int t = d == 0 ? e - 1 : 16 - e; bf16_t* row = TM + (size_t)(t * 16 + c) * 512 + 256 + d * 128 + p;
                row[0] = (bf16_t)f2bf(wr); row[64] = (bf16_t)f2bf(-wi); }
        }
        {
            const float pr = pwp[2 * c], pi = pwp[2 * c + 1]; const float vr = pr * bbr - pi * bbi, vi = pr * bbi + pi * bbr;
            const int s = d == 0 ? 15 - c : c;
            Ms[(size_t)(d * 128 + p) * 256 + s * 16 + cp] = (bf16_t)f2bf(vr); Ms[(size_t)(d * 128 + 64 + p) * 256 + s * 16 + cp] = (bf16_t)f2bf(vi);
        }
    }
    LAS float* Kt = k0x;
#pragma unroll
    for (int k = 0; k < 16; ++k) Kt[(d * 16 + k) * 256 + c * 16 + cp] = Kk[k];
    __syncthreads();
    for (int idx = tid; idx < 256 * 128; idx += NWAVES * 64) {
        const int row = idx >> 7, col = (idx & 127) * 2, t = row >> 4, cc = row & 15, s_ = col >> 4, c2 = col & 15, k = t - s_;
        float v0, v1;
        if (k > 0) { v0 = Kt[k * 256 + cc * 16 + c2]; v1 = Kt[k * 256 + cc * 16 + c2 + 1]; }
        else if (k < 0) { v0 = Kt[(16 - k) * 256 + cc * 16 + c2]; v1 = Kt[(16 - k) * 256 + cc * 16 + c2 + 1]; }
        else { v0 = Kt[cc * 16 + c2] + Kt[16 * 256 + cc * 16 + c2]; v1 = Kt[cc * 16 + c2 + 1] + Kt[16 * 256 + cc * 16 + c2 + 1];
               const float dd = dskip[l * 512 + g * 16 + cc]; if (c2 == cc) v0 += dd; if (c2 + 1 == cc) v1 += dd; }
        *(unsigned*)(TM + (size_t)row * 512 + col) = pk2(v0, v1);
    }
    __syncthreads();
}

constexpr int N_PHASES = 14;
__global__ void __launch_bounds__(NWAVES * 64, 2) mega_fwd(Args args) {
    extern __shared__ __attribute__((aligned(16))) unsigned char lds_raw[];
    LAS unsigned char* lds = (LAS unsigned char*)lds_raw;
    volatile LAS unsigned* MISC = (volatile LAS unsigned*)(lds + MISC_OFF);
    const int tid = threadIdx.x;
#define PHASE_LANES int ptid = threadIdx.x; asm volatile("" : "+v"(ptid)); const int lane = ptid & 63, wave = __builtin_amdgcn_readfirstlane(ptid >> 6); (void)lane; (void)wave;
    const int G = gridDim.x; int vcu; { const int bx = blockIdx.x; vcu = (G % 8 == 0) ? (bx % 8) * (G / 8) + bx / 8 : bx; }
    unsigned char* ws = args.ws; unsigned char* dout = (unsigned char*)args.out;
    unsigned* ctl = (unsigned*)(ws + OFF_CTL);
    if (tid < 32) MISC[tid] = 0u;
    __syncthreads();
    XcdBarrier bar = xcd_barrier_post(ctl + CW_BAR + args.li * XCD_BAR_WORDS, MISC + 8);
    const int lo = args.ph_lo, hi = args.ph_hi;
#ifndef CT_SKIP
#define CT_SKIP 0
#endif
#ifndef PHASE_MASK
#define PHASE_MASK 0x3fff
#endif
#define INR(k) (lo <= (k) && (k) < hi)
#define IN(k) (((PHASE_MASK >> (k)) & 1) && INR(k))
#define INL(j) (((PHASE_MASK >> ((j) + 1)) & 1) && INR(pb + (j)))
#define SEAM(k) do { if (INR(k) && INR((k) + 1)) xcd_barrier(bar); } while (0)

    bf16_t* proj = (bf16_t*)(ws + OFF_PROJ); bf16_t* xag = (bf16_t*)(ws + OFF_XAG); bf16_t* xb = (bf16_t*)(ws + OFF_XB); float* Ebuf = (float*)(ws + OFF_XB);
    bf16_t* Gb = (bf16_t*)(ws + OFF_G); float* sspart = (float*)(ws + OFF_SS);
    float* rpb2 = (float*)(ws + OFF_RPB2); float* t5tb = (float*)(ws + OFF_T5TB);

    if (IN(0)) {
        PHASE_LANES
        const int NTB = 64;
        if (vcu < NTB && G > NTB) {
            const int l = vcu >> 5, g = vcu & 31;
            bf16_t* TM = (bf16_t*)(l == 0 ? dout + DO_TM0 : ws + OFF_TM1) + (size_t)g * 256 * 512;
            bf16_t* Ms = (bf16_t*)(l == 0 ? dout + DO_MS0 : ws + OFF_MS1) + (size_t)g * 256 * 256;
            p0_ssm_tables(args, l, g, TM, Ms, (LAS float*)lds);
        } else {
            if (vcu == NTB) {
                const float* rpb = args.in[14]; const float* t5 = args.in[15];
                for (int i = ptid; i < 2 * 8 * 15 * 64; i += NWAVES * 64) { const int cc = i & 63, rest = i >> 6; const int cr = cc - 17;
                    rpb2[i] = (cr >= 0 && cr <= 30) ? rpb[(size_t)rest * 31 + cr] * 1.4426950408889634f : 0.f; }
                for (int i = ptid; i < 8 * 3 * att::TBW; i += NWAVES * 64) { const int idx = i % att::TBW, pat = (i / att::TBW) % 3, h = i / (3 * att::TBW); const int w = idx - att::TBOFF;
                    const int d = pat == 0 ? 16 : (pat == 1 ? 4 : 1);
                    t5tb[i] = (w >= 0 && w <= 128) ? t5[t5_bucket_dev(d * (w - 64)) * 8 + h] * 1.4426950408889634f : att::NEG; }
            }
            LAS float* scr = (LAS float*)(lds + wave * 16384);
            const int gw = (vcu - NTB) * NWAVES + wave, NGW = (G - NTB) * NWAVES;
            constexpr int I_IN = (DM / 64) * (IN_COLS / 32), I_OUT = (MIXW / 64) * (DM / 32), I_GLU = (512 / 64) * (512 / 32), I_L = I_IN + I_OUT + I_GLU;
            for (int it = gw; it < 2 * I_L; it += NGW) {
                const int l = it / I_L; int r = it % I_L;
                if (r < I_IN) { const int nblk = IN_COLS / 32, kb = r / nblk, nb = r % nblk;
                    p0_transpose_item(args.in[2] + (size_t)l * DM * IN_COLS, DM, IN_COLS, (bf16_t*)(l == 0 ? dout + DO_WINT0 : ws + OFF_WINT1), 64 * kb, inproj_src_col(32 * nb), 32 * nb, args.in[1] + l * DM, scr, lane); continue; }
                r -= I_IN;
                if (r < I_OUT) { const int nblk = DM / 32, kb = r / nblk, nb = r % nblk;
                    p0_transpose_item(args.in[3] + (size_t)l * MIXW * DM, MIXW, DM, (bf16_t*)(ws + (l == 0 ? OFF_WOUTT0 : OFF_WOUTT1)), 64 * kb, 32 * nb, 32 * nb, nullptr, scr, lane); continue; }
                r -= I_OUT;
                { const int nblk = 512 / 32, kb = r / nblk, nb = r % nblk;
                    p0_transpose_item(args.in[12] + (size_t)l * 512 * 512, 512, 512, (bf16_t*)(l == 0 ? dout + DO_GLUT0 : ws + OFF_GLUT1), 64 * kb, 32 * nb, 32 * nb, nullptr, scr, lane); }
            }
            for (int m = gw; m < NTOK; m += NGW) p0_xrow(args.in[0] + (size_t)m * DM, xb + (size_t)m * DM, sspart + (size_t)m * 16, lane);
        }
    }
    SEAM(0);

    for (int l = 0; l < DEPTH; ++l) {
        const int pb = 1 + 6 * l;
        const bf16_t* WinT = (const bf16_t*)(l == 0 ? dout + DO_WINT0 : ws + OFF_WINT1);
        const bf16_t* WoutT = (const bf16_t*)(ws + (l == 0 ? OFF_WOUTT0 : OFF_WOUTT1));
        const bf16_t* GluT = (const bf16_t*)(l == 0 ? dout + DO_GLUT0 : ws + OFF_GLUT1);
        const bf16_t* TM = (const bf16_t*)(l == 0 ? dout + DO_TM0 : ws + OFF_TM1);
        const bf16_t* Ms = (const bf16_t*)(l == 0 ? dout + DO_MS0 : ws + OFF_MS1);
        if (INL(0)) {
            pg8::Gemm gm{xb, WinT, DM, DM, DM, 0, 0}; pg8::StaticOrder S; S.init(NTOK, IN_COLS, G, (int)blockIdx.x);
            pg8::EpiInProj E{sspart, proj, xag};
            pg8::gemm_phase<pg8::EpiInProj, pg8::StaticOrder>(lds, gm, S, E);
        }
        SEAM(pb + 0);
        if (INL(1)) {
            if (!(CT_SKIP & 1) && !(args.skip & 1)) { pg8::Gemm gm{xag, Ms, 512, 256, 256, (size_t)NCHUNK_TOT * 512, (size_t)256 * 256}; pg8::BatchOrder S; S.init(4, 32, G, vcu);
              pg8::EpiE E{Ebuf};
              pg8::gemm_phase<pg8::EpiE, pg8::BatchOrder>(lds, gm, S, E); }
            __syncthreads();
            PHASE_LANES
            LAS char* vbuf = (LAS char*)(lds + wave * att::WAVE_LDS);
            const int gw = vcu * NWAVES + wave, NGW = G * NWAVES;
            if (!(CT_SKIP & 2) && !(args.skip & 2)) for (int t = gw; t < 8192; t += NGW) att::na_task(proj, rpb2 + (size_t)l * 8 * 15 * 64, t, vbuf, lane);
            if (!(CT_SKIP & 4) && !(args.skip & 4)) for (int t = gw; t < 8192; t += NGW) att::dil_task(proj, t5tb, t, vbuf, lane);
        }
        SEAM(pb + 1);
        if (INL(2)) {
            PHASE_LANES
            if (wave == 0) {
                const float* lam_re = args.in[4]; const float* lam_im = args.in[5]; const float* log_dt = args.in[6];
                for (int cg = vcu; cg < 256; cg += G) {
                    const int g = cg >> 3, b = (cg >> 1) & 3, d = cg & 1, p = lane, pg = (l * 2 + d) * 32 + g;
                    const float lre = lam_re[pg * 64 + p], lim = lam_im[pg * 64 + p], dt = expf(log_dt[pg]);
                    const float er = expf(lre * dt); float ar = er * cosf(lim * dt), ai = er * sinf(lim * dt);
#pragma unroll
                    for (int i = 0; i < 4; ++i) { const float t = ar * ar - ai * ai; ai = 2.f * ar * ai; ar = t; }
                    const float* __restrict__ Ep = Ebuf + ((size_t)g * NCHUNK_TOT + b * NCHUNK) * 256 + d * 128 + p;
                    bf16_t* __restrict__ Cp = xag + ((size_t)g * NCHUNK_TOT + b * NCHUNK) * 512 + 256 + d * 128 + p;
                    float cr = 0.f, ci = 0.f;
#pragma unroll 8
                    for (int s = 0; s < NCHUNK; ++s) {
                        const int k = d == 0 ? s : NCHUNK - 1 - s;
                        const float er_ = Ep[(size_t)k * 256], ei_ = Ep[(size_t)k * 256 + 64];
                        Cp[(size_t)k * 512] = (bf16_t)f2bf(cr); Cp[(size_t)k * 512 + 64] = (bf16_t)f2bf(ci);
                        const float t = ar * cr - ai * ci + er_; ci = ar * ci + ai * cr + ei_; cr = t;
                    }
                }
            }
        }
        SEAM(pb + 2);
        if (INL(3)) {
            pg8::Gemm gm{xag, TM, 512, 512, 512, (size_t)NCHUNK_TOT * 512, (size_t)256 * 512}; pg8::BatchOrder S; S.init(4, 32, G, vcu);
            pg8::EpiY E{Gb};
            pg8::gemm_phase<pg8::EpiY, pg8::BatchOrder>(lds, gm, S, E);
        }
        SEAM(pb + 3);
        if (INL(4)) {
            pg8::Gemm gm{Gb, GluT, 512, 512, 512, 0, 0}; pg8::StaticOrder S; S.init(NTOK, 512, G, (int)blockIdx.x);
            pg8::EpiGlu E{Gb, args.in[13] + l * 512, proj};
            pg8::gemm_phase<pg8::EpiGlu, pg8::StaticOrder>(lds, gm, S, E);
        }
        SEAM(pb + 4);
        if (INL(5)) {
            pg8::Gemm gm{proj, WoutT, PLD, MIXW, MIXW, 0, 0}; pg8::StaticOrder S; S.init(NTOK, DM, G, (int)blockIdx.x);
            pg8::EpiOutProj E{l == 0 ? args.in[0] : args.out, args.out, xb, sspart, l == 0 ? 1 : 0};
            pg8::gemm_phase<pg8::EpiOutProj, pg8::StaticOrder>(lds, gm, S, E);
        }
        SEAM(pb + 5);
    }
    if (IN(13)) {
        PHASE_LANES
        const float* fg = args.in[16];
        const int gw = vcu * NWAVES + wave, NGW = G * NWAVES;
        for (int m = gw; m < NTOK; m += NGW) {
            const f32x4* sp = (const f32x4*)(sspart + (size_t)m * 16);
            const f32x4 s0 = sp[0], s1 = sp[1], s2 = sp[2], s3 = sp[3];
            const float ss = (((s0[0] + s0[1]) + (s0[2] + s0[3])) + ((s1[0] + s1[1]) + (s1[2] + s1[3]))) + (((s2[0] + s2[1]) + (s2[2] + s2[3])) + ((s3[0] + s3[1]) + (s3[2] + s3[3])));
            const float rinv = rsqrtf(ss * (1.0f / DM) + RMS_EPS);
            f32x4* xr = (f32x4*)(args.out + (size_t)m * DM) + lane;
#pragma unroll
            for (int j = 0; j < 4; ++j) { const f32x4 gv = *((const f32x4*)fg + lane + 64 * j); xr[64 * j] = xr[64 * j] * rinv * gv; }
        }
    }
#undef IN
#undef INL
#undef INR
#undef SEAM
}
#define HOST_PLAN launch_mega(d_in, d_out, d_ws, stream, 0, N_PHASES, 0, 0);
static int g_grid = 0;
static void launch_mega(void* const* d_in, void* d_out, void* d_ws, hipStream_t stream, int lo, int hi, int li, int skip) {
    Args a{};
    for (int i = 0; i < 17; ++i) a.in[i] = (const float*)d_in[i];
    a.out = (float*)d_out; a.ws = (unsigned char*)d_ws; a.ph_lo = lo; a.ph_hi = hi; a.li = li; a.skip = skip;
    hipLaunchKernelGGL(mega_fwd, dim3(g_grid), dim3(NWAVES * 64), LDS_BYTES, stream, a);
    const hipError_t le = hipPeekAtLastError();
    if (le != hipSuccess) fprintf(stderr, "kernel_launch: launch failed: %s (grid %d)\n", hipGetErrorName(le), g_grid);
}
extern "C" void kernel_launch(void* const* d_in, const int* in_sizes, int n_in, void* d_out, int out_size, void* d_ws, size_t ws_size, hipStream_t stream) {
    if (g_grid == 0) {
        if (n_in != 17 || in_sizes[0] != NTOK * DM || out_size != NTOK * DM || ws_size < WS_NEED) { fprintf(stderr, "kernel_launch: unexpected shapes (n_in %d in0 %d out %d ws %zu need %zu)\n", n_in, n_in > 0 ? in_sizes[0] : -1, out_size, ws_size, (size_t)WS_NEED); g_grid = -1; return; }
        int dev = 0, cus = 0, per_cu = 0;
        if (hipGetDevice(&dev) != hipSuccess || hipDeviceGetAttribute(&cus, hipDeviceAttributeMultiprocessorCount, dev) != hipSuccess) { g_grid = -1; return; }
        if (hipFuncSetAttribute((const void*)mega_fwd, hipFuncAttributeMaxDynamicSharedMemorySize, LDS_BYTES) != hipSuccess) { fprintf(stderr, "kernel_launch: hipFuncSetAttribute failed\n"); g_grid = -1; return; }
        if (hipOccupancyMaxActiveBlocksPerMultiprocessor(&per_cu, (const void*)mega_fwd, NWAVES * 64, LDS_BYTES) != hipSuccess || per_cu < 1) { fprintf(stderr, "kernel_launch: occupancy query says %d\n", per_cu); per_cu = 1; }
        (void)hipGetLastError();
        g_grid = cus * 1;
    }
    if (g_grid < 0) return;
    (void)hipMemsetAsync((char*)d_ws + OFF_CTL, 0, CTL_ZERO_BYTES, stream);
    HOST_PLAN
}
```

```cpp
#include <hip/hip_runtime.h>
#include <cstdio>
#include <cstdint>
#include <cmath>

typedef unsigned short bf16_t;

constexpr int NB = 4, SEQ = 4096, DM = 1024, NTOK = NB * SEQ, DEPTH = 2;
constexpr int IN_COLS = 5120, MIXW = 1536;
constexpr float RMS_EPS = 1e-6f;
constexpr int LCH = 16;
constexpr int NCHUNK = SEQ / LCH;
constexpr int NCHUNK_TOT = NB * NCHUNK;
constexpr int PLD = 4608;
constexpr int PC_ZA = 0, PC_QB = 512, PC_QC = 1024, PC_KB = 1536, PC_VB = 2048, PC_ZB = 2560, PC_KC = 3072, PC_VC = 3584, PC_ZC = 4096;
__host__ __device__ __forceinline__ int inproj_src_col(int n) {
    if (n < 512) return n;
    const int pc = n - 512, s = pc >> 9;
    const int seg = (s == 0) ? 1 : (s == 1) ? 2 : (s == 2) ? 6 : (s == 3) ? 3 : (s == 4) ? 4 : (s == 5) ? 5 : (s == 6) ? 7 : (s == 7) ? 8 : 9;
    return seg * 512 + (pc & 511);
}

constexpr size_t OFF_CTL = 0;
constexpr size_t OFF_SS = 1u << 20;
constexpr size_t OFF_PROJ = 2u << 20;
constexpr size_t SZ_PROJ = (size_t)NTOK * PLD * 2;
constexpr size_t OFF_XAG = OFF_PROJ + SZ_PROJ;
constexpr size_t SZ_XAG = (size_t)32 * NCHUNK_TOT * 512 * 2;
constexpr size_t OFF_XB = OFF_XAG + SZ_XAG;
constexpr size_t SZ_XB = (size_t)NTOK * DM * 2;
constexpr size_t OFF_G = OFF_XB + SZ_XB;
constexpr size_t SZ_G = (size_t)NTOK * 512 * 2;
constexpr size_t OFF_W = OFF_G + SZ_G;
constexpr size_t WS_NEED_NAIVE = OFF_W;

__host__ __device__ __forceinline__ unsigned f2bf(float f) { unsigned u = __builtin_bit_cast(unsigned, f); return (u + 0x7fffu + ((u >> 16) & 1u)) >> 16; }
__host__ __device__ __forceinline__ float bf2f(bf16_t b) { return __builtin_bit_cast(float, (unsigned)b << 16); }
namespace pg8 {
#define PG8_LAS __attribute__((address_space(3)))
typedef short bf16x8 __attribute__((ext_vector_type(8)));
typedef float f32x4 __attribute__((ext_vector_type(4)));
typedef unsigned u32x4 __attribute__((ext_vector_type(4)));
typedef unsigned u32x2 __attribute__((ext_vector_type(2)));
constexpr int BM = 256, BK = 64, HALF = 128, HTB = HALF * BK * 2  , STAGE_BYTES = 8 * HTB, NXCD = 8, WGM = 8;

__host__ __device__ __forceinline__ int lds_byte(int r, int c) { const int st = (r >> 4) * 2 + (c >> 5), rr = r & 15, cc = c & 31, ob = rr * 64 + cc * 2; return st * 1024 + (ob ^ (((ob >> 9) & 1) << 5)); }
__host__ __device__ __forceinline__ void stage_rc(int b, int& R, int& C) { const int st = b / 1024, sb = b % 1024, swz = sb ^ (((sb >> 9) & 1) << 5); R = (st >> 1) * 16 + swz / 64; C = (st & 1) * 32 + (swz % 64) / 2; }
__host__ __device__ __forceinline__ int perm32(int rho) { const int n = rho >> 4, i = rho & 15; return 8 * (i >> 2) + 4 * n + (i & 3); }

struct Unit { int pm, pn, bz; };
struct Gemm { const bf16_t* A; const bf16_t* Bt; int lda, ldb, K; size_t a_bz, b_bz; };

struct StaticOrder {
    int nM, nN, nwg, G, c;
    __host__ __device__ void init(int M, int N, int G_, int c_) { nM = M / BM; nN = N / BM; nwg = nM * nN; G = G_; c = c_; }
    __host__ __device__ bool next(int i, Unit& u) const {
        const long L = (long)i * G + c; if (L >= nwg) return false;
        int wgid = (int)L; { const int q = nwg / NXCD, r = nwg % NXCD, xcd = wgid % NXCD, off = wgid / NXCD; wgid = (xcd < r ? xcd * (q + 1) : r * (q + 1) + (xcd - r) * q) + off; }
        const int nig = WGM * nN, gid = wgid / nig, fm = gid * WGM, gsz = (nM - fm) < WGM ? (nM - fm) : WGM;
        u.pm = fm + ((wgid % nig) % gsz); u.pn = (wgid % nig) / gsz; u.bz = 0; return true;
    }
};
struct BatchOrder {
    int nM, nwg, G, c;
    __host__ __device__ void init(int nM_, int nBatch, int G_, int c_) { nM = nM_; nwg = nM_ * nBatch; G = G_; c = c_; }
    __host__ __device__ bool next(int i, Unit& u) const {
        const long L = (long)i * G + c; if (L >= nwg) return false;
        u.bz = (int)L >> 2; u.pm = (int)L & 3; u.pn = 0; return true;
    }
};

__device__ __forceinline__ unsigned cvt_pk_bf16(float lo, float hi) { unsigned r; asm volatile("v_cvt_pk_bf16_f32 %0, %1, %2" : "=v"(r) : "v"(lo), "v"(hi)); return r; }
__device__ __forceinline__ u32x4 pack8(const f32x4 v0, const f32x4 v1) { u32x4 w; w.x = cvt_pk_bf16(v0[0], v0[1]); w.y = cvt_pk_bf16(v0[2], v0[3]); w.z = cvt_pk_bf16(v1[0], v1[1]); w.w = cvt_pk_bf16(v1[2], v1[3]); return w; }
__device__ __forceinline__ float bfl(unsigned w) { return __builtin_bit_cast(float, w << 16); }
__device__ __forceinline__ float bfh(unsigned w) { return __builtin_bit_cast(float, w & 0xffff0000u); }


struct EpiInProj {
    static constexpr bool PERM = true, AFTER_DRAIN = false;
    const float* sspart; bf16_t* proj; bf16_t* xag;
    __device__ __forceinline__ void operator()(const f32x4 (&acc)[2][2][4][2], const Unit& u, int wr, int wc, int fr, int fq) const {
        const int row0 = u.pm * BM + wr * 64 + fr, colt = u.pn * BM + wc * 32 + 8 * fq;
#pragma unroll
        for (int ai = 0; ai < 2; ++ai)
#pragma unroll
            for (int m = 0; m < 4; ++m) {
                const int row = row0 + ai * HALF + m * 16;
                const f32x4* sp = (const f32x4*)(sspart + (size_t)row * 16);
                const f32x4 s0 = sp[0], s1 = sp[1], s2 = sp[2], s3 = sp[3];
                const float ss = (((s0[0] + s0[1]) + (s0[2] + s0[3])) + ((s1[0] + s1[1]) + (s1[2] + s1[3]))) + (((s2[0] + s2[1]) + (s2[2] + s2[3])) + ((s3[0] + s3[1]) + (s3[2] + s3[3])));
                const float rinv = rsqrtf(ss * (1.0f / DM) + RMS_EPS);
#pragma unroll
                for (int bj = 0; bj < 2; ++bj) {
                    const int col = colt + bj * HALF;
                    const u32x4 w = pack8(acc[ai][bj][m][0] * rinv, acc[ai][bj][m][1] * rinv);
                    bf16_t* dst = (u.pn < 2) ? xag + ((size_t)(col >> 4) * NCHUNK_TOT + (row >> 4)) * 512 + (row & 15) * 16 + (col & 15)
                                             : proj + (size_t)row * PLD + (col - 512);
                    *(u32x4*)dst = w;
                }
                asm volatile("" ::: "memory");
            }
    }
};
struct EpiE {
    static constexpr bool PERM = true, AFTER_DRAIN = false;
    float* E;
    __device__ __forceinline__ void operator()(const f32x4 (&acc)[2][2][4][2], const Unit& u, int wr, int wc, int fr, int fq) const {
        const int row0 = u.pm * BM + wr * 64 + fr, colt = wc * 32 + 8 * fq;
#pragma unroll
        for (int ai = 0; ai < 2; ++ai)
#pragma unroll
            for (int m = 0; m < 4; ++m) {
                float* rp = E + ((size_t)u.bz * NCHUNK_TOT + row0 + ai * HALF + m * 16) * 256 + colt;
#pragma unroll
                for (int bj = 0; bj < 2; ++bj) { *(f32x4*)(rp + bj * HALF) = acc[ai][bj][m][0]; *(f32x4*)(rp + bj * HALF + 4) = acc[ai][bj][m][1]; }
                asm volatile("" ::: "memory");
            }
    }
};
struct EpiY {
    static constexpr bool PERM = true, AFTER_DRAIN = false;
    bf16_t* G;
    __device__ __forceinline__ static float gelu(float y) {
        const float a = 0.7978845608028654f * (y + 0.044715f * y * y * y);
        return y * __builtin_amdgcn_rcpf(1.0f + __builtin_amdgcn_exp2f(-2.885390081777927f * a));
    }
    __device__ __forceinline__ void operator()(const f32x4 (&acc)[2][2][4][2], const Unit& u, int wr, int wc, int fr, int fq) const {
        const int row0 = u.pm * BM + wr * 64 + fr, colt = wc * 32 + 8 * fq;
#pragma unroll
        for (int ai = 0; ai < 2; ++ai)
#pragma unroll
            for (int m = 0; m < 4; ++m) {
                const int n = row0 + ai * HALF + m * 16;
#pragma unroll
                for (int bj = 0; bj < 2; ++bj) {
                    const int col = colt + bj * HALF, t = col >> 4, c0 = col & 15;
                    f32x4 v0 = acc[ai][bj][m][0], v1 = acc[ai][bj][m][1];
#pragma unroll
                    for (int e = 0; e < 4; ++e) { v0[e] = gelu(v0[e]); v1[e] = gelu(v1[e]); }
                    *(u32x4*)(G + ((size_t)n * 16 + t) * 512 + u.bz * 16 + c0) = pack8(v0, v1);
                }
                asm volatile("" ::: "memory");
            }
    }
};
struct EpiGlu {
    static constexpr bool PERM = true, AFTER_DRAIN = false;
    const bf16_t* G; const float* bias; bf16_t* proj;
    __device__ __forceinline__ static float sig(float v) { return __builtin_amdgcn_rcpf(1.0f + __builtin_amdgcn_exp2f(-1.4426950408889634f * v)); }
    __device__ __forceinline__ void operator()(const f32x4 (&acc)[2][2][4][2], const Unit& u, int wr, int wc, int fr, int fq) const {
        const int row0 = u.pm * BM + wr * 64 + fr, colt = u.pn * BM + wc * 32 + 8 * fq;
#pragma unroll
        for (int bj = 0; bj < 2; ++bj) {
            const int col = colt + bj * HALF;
            const f32x4 b0 = *(const f32x4*)(bias + col), b1 = *(const f32x4*)(bias + col + 4);
#pragma unroll
            for (int ai = 0; ai < 2; ++ai)
#pragma unroll
                for (int m = 0; m < 4; ++m) {
                    const int row = row0 + ai * HALF + m * 16;
                    const u32x4 gg = *(const u32x4*)(G + (size_t)row * 512 + col);
                    bf16_t* zp = proj + (size_t)row * PLD + PC_ZA + col;
                    const u32x4 zz = *(const u32x4*)zp;
                    const f32x4 a0 = acc[ai][bj][m][0] + b0, a1 = acc[ai][bj][m][1] + b1;
                    f32x4 o0, o1;
#pragma unroll
                    for (int e = 0; e < 4; ++e) {
                        const unsigned gw0 = gg[e >> 1], zw0 = zz[e >> 1], gw1 = gg[2 + (e >> 1)], zw1 = zz[2 + (e >> 1)];
                        const float g0 = (e & 1) ? bfh(gw0) : bfl(gw0), z0 = (e & 1) ? bfh(zw0) : bfl(zw0);
                        const float g1 = (e & 1) ? bfh(gw1) : bfl(gw1), z1 = (e & 1) ? bfh(zw1) : bfl(zw1);
                        o0[e] = g0 * sig(a0[e]) * (z0 * sig(z0)); o1[e] = g1 * sig(a1[e]) * (z1 * sig(z1));
                    }
                    *(u32x4*)zp = pack8(o0, o1);
                    asm volatile("" ::: "memory");
                }
        }
    }
};
struct EpiOutProj {
    static constexpr bool PERM = true, AFTER_DRAIN = false;
    const float* xold; float* xout; bf16_t* xb; float* sspart; int write_xb;
    __device__ __forceinline__ void operator()(const f32x4 (&acc)[2][2][4][2], const Unit& u, int wr, int wc, int fr, int fq) const {
        const int row0 = u.pm * BM + wr * 64 + fr, colt = u.pn * BM + wc * 32 + 8 * fq;
#pragma unroll
        for (int ai = 0; ai < 2; ++ai)
#pragma unroll
            for (int m = 0; m < 4; ++m) {
                const int row = row0 + ai * HALF + m * 16;
                float ssl = 0.f;
#pragma unroll
                for (int bj = 0; bj < 2; ++bj) {
                    const size_t off = (size_t)row * DM + colt + bj * HALF;
                    const f32x4 n0 = *(const f32x4*)(xold + off) + acc[ai][bj][m][0], n1 = *(const f32x4*)(xold + off + 4) + acc[ai][bj][m][1];
                    *(f32x4*)(xout + off) = n0; *(f32x4*)(xout + off + 4) = n1;
                    if (write_xb) *(u32x4*)(xb + off) = pack8(n0, n1);
                    ssl += ((n0[0] * n0[0] + n0[1] * n0[1]) + (n0[2] * n0[2] + n0[3] * n0[3])) + ((n1[0] * n1[0] + n1[1] * n1[1]) + (n1[2] * n1[2] + n1[3] * n1[3]));
                }
                ssl += __shfl_xor(ssl, 16); ssl += __shfl_xor(ssl, 32);
                if (fq == 0) sspart[(size_t)row * 16 + u.pn * 4 + wc] = ssl;
                asm volatile("" ::: "memory");
            }
    }
};

template <class Epi, class Sched, bool ALIGN_EPI = true>
__device__ __forceinline__ void gemm_phase(PG8_LAS unsigned char* lds, const Gemm g, const Sched& S, const Epi& E) {
    int tid = threadIdx.x; asm volatile("" : "+v"(tid));
    const int wid = __builtin_amdgcn_readfirstlane(tid >> 6), lane = tid & 63, wr = wid >> 2, wc = wid & 3, fr = lane & 15, fq = lane >> 4;
    int K = g.K; asm volatile("" : "+s"(K));
    const int nt = K / BK;
    unsigned voffA[2], voffB[2];
#pragma unroll
    for (int i = 0; i < 2; ++i) { int R, C; stage_rc(tid * 16 + i * 8192, R, C); const int Rb = Epi::PERM ? ((R & ~31) + perm32(R & 31)) : R;
        voffA[i] = (unsigned)(R * g.lda + C) * 2u; voffB[i] = (unsigned)(Rb * g.ldb + C) * 2u; }
    const size_t kstep = (size_t)(BK * 2);
    const size_t hstepA = (size_t)HALF * g.lda * 2, hstepB = (size_t)HALF * g.ldb * 2;
    const unsigned ldsw = (unsigned)wid * 1024u;
    const int aoff = lds_byte(wr * 64 + fr, fq * 8), boff = lds_byte(wc * 32 + fr, fq * 8);
#define PG8_SA(b, h) (((b) * 2 + (h)) * HTB)
#define PG8_SB(b, h) ((4 + (b) * 2 + (h)) * HTB)
#define PG8_STAGE(bufoff, gbase, voff) do { _Pragma("unroll") for (int _i = 0; _i < 2; ++_i) \
        __builtin_amdgcn_global_load_lds((const unsigned*)((const char*)(gbase) + (voff)[_i]), (PG8_LAS unsigned*)(lds + (bufoff) + ldsw + _i * 8192), 16, 0, 0); } while (0)
#define PG8_LDA(dst, b, h) do { _Pragma("unroll") for (int m = 0; m < 4; ++m) _Pragma("unroll") for (int k = 0; k < 2; ++k) dst[m][k] = *(const PG8_LAS bf16x8*)(lds + PG8_SA(b, h) + aoff + m * 2048 + k * 1024); } while (0)
#define PG8_LDB(dst, b, h) do { _Pragma("unroll") for (int n = 0; n < 2; ++n) _Pragma("unroll") for (int k = 0; k < 2; ++k) dst[n][k] = *(const PG8_LAS bf16x8*)(lds + PG8_SB(b, h) + boff + n * 2048 + k * 1024); } while (0)
#define PG8_MMA(ai, bj, At, Bt) do { __builtin_amdgcn_s_setprio(1); _Pragma("unroll") for (int m = 0; m < 4; ++m) _Pragma("unroll") for (int n = 0; n < 2; ++n) _Pragma("unroll") for (int k = 0; k < 2; ++k) \
        acc[ai][bj][m][n] = __builtin_amdgcn_mfma_f32_16x16x32_bf16(Bt[n][k], At[m][k], acc[ai][bj][m][n], 0, 0, 0); __builtin_amdgcn_s_setprio(0); } while (0)
#define PG8_WAIT_V(n) asm volatile("s_waitcnt vmcnt(" #n ")" ::: "memory")
#define PG8_WAIT_L(n) asm volatile("s_waitcnt lgkmcnt(" #n ")" ::: "memory")
#define PG8_BAR __builtin_amdgcn_s_barrier()
#define PG8_SCHED __builtin_amdgcn_sched_barrier(0)
#define PG8_ABASE(u) ((const char*)g.A + ((size_t)(u).bz * g.a_bz + (size_t)(u).pm * BM * g.lda) * 2)
#define PG8_BBASE(u) ((const char*)g.Bt + ((size_t)(u).bz * g.b_bz + (size_t)(u).pn * BM * g.ldb) * 2)
    Unit cur, nxt; int ui = 0;
    if (!S.next(0, cur)) return;
    f32x4 acc[2][2][4][2];
#pragma unroll
    for (int a = 0; a < 2; ++a)
#pragma unroll
        for (int b = 0; b < 2; ++b)
#pragma unroll
            for (int m = 0; m < 4; ++m)
#pragma unroll
                for (int n = 0; n < 2; ++n) acc[a][b][m][n] = (f32x4){0.f, 0.f, 0.f, 0.f};
    bf16x8 At[4][2], B0[2][2], B1[2][2];
    const char* cA = PG8_ABASE(cur); const char* cB = PG8_BBASE(cur);
    PG8_STAGE(PG8_SB(0, 0), cB, voffB); PG8_STAGE(PG8_SB(0, 1), cB + hstepB, voffB); PG8_STAGE(PG8_SA(0, 0), cA, voffA); PG8_STAGE(PG8_SA(0, 1), cA + hstepA, voffA);
    if (wr == 1) PG8_BAR;
    PG8_WAIT_V(2); PG8_BAR;
    PG8_STAGE(PG8_SB(1, 0), cB + kstep, voffB); PG8_STAGE(PG8_SA(1, 0), cA + kstep, voffA); PG8_STAGE(PG8_SB(1, 1), cB + hstepB + kstep, voffB);
    PG8_WAIT_V(6); PG8_BAR;
    for (;;) {
        const bool has_next = S.next(ui + 1, nxt);
        const char* nA = has_next ? PG8_ABASE(nxt) : cA; const char* nB = has_next ? PG8_BBASE(nxt) : cB;
        for (int t = 0; t < nt; t += 2) {
            const bool last = (t == nt - 2);
            const char* a1 = cA + (size_t)(t + 1) * kstep;
            const char* a2 = last ? nA : cA + (size_t)(t + 2) * kstep; const char* b2 = last ? nB : cB + (size_t)(t + 2) * kstep;
            const char* a3 = a2 + kstep; const char* b3 = b2 + kstep;
            PG8_LDB(B0, 0, 0); PG8_LDB(B1, 0, 1); PG8_SCHED; PG8_LDA(At, 0, 0); PG8_STAGE(PG8_SA(1, 1), a1 + hstepA, voffA);
            PG8_WAIT_V(8); PG8_WAIT_L(0); PG8_BAR; PG8_MMA(0, 0, At, B0); PG8_MMA(0, 1, At, B1); PG8_BAR; PG8_SCHED;
            PG8_LDA(At, 0, 1); PG8_STAGE(PG8_SB(0, 0), b2, voffB); PG8_STAGE(PG8_SB(0, 1), b2 + hstepB, voffB); PG8_STAGE(PG8_SA(0, 0), a2, voffA);
            PG8_WAIT_V(8); PG8_WAIT_L(0); PG8_BAR; PG8_MMA(1, 0, At, B0); PG8_MMA(1, 1, At, B1); PG8_BAR; PG8_SCHED;
            PG8_LDB(B0, 1, 0); PG8_LDB(B1, 1, 1); PG8_SCHED; PG8_LDA(At, 1, 0); PG8_STAGE(PG8_SA(0, 1), a2 + hstepA, voffA);
            PG8_WAIT_V(8); PG8_WAIT_L(0); PG8_BAR; PG8_MMA(0, 0, At, B0); PG8_MMA(0, 1, At, B1); PG8_BAR; PG8_SCHED;
            PG8_LDA(At, 1, 1); PG8_STAGE(PG8_SB(1, 0), b3, voffB); PG8_STAGE(PG8_SB(1, 1), b3 + hstepB, voffB); PG8_STAGE(PG8_SA(1, 0), a3, voffA);
            PG8_WAIT_V(8); PG8_WAIT_L(0); PG8_BAR; PG8_MMA(1, 0, At, B0); PG8_MMA(1, 1, At, B1); PG8_BAR; PG8_SCHED;
        }
        if constexpr (ALIGN_EPI) { if (wr == 0) PG8_BAR; }
        E(acc, cur, wr, wc, fr, fq);
        if (!has_next) break;
#pragma unroll
        for (int a = 0; a < 2; ++a)
#pragma unroll
            for (int b = 0; b < 2; ++b)
#pragma unroll
                for (int m = 0; m < 4; ++m)
#pragma unroll
                    for (int n = 0; n < 2; ++n) acc[a][b][m][n] = (f32x4){0.f, 0.f, 0.f, 0.f};
        cur = nxt; cA = nA; cB = nB; ++ui;
        if constexpr (ALIGN_EPI) { if (wr == 1) PG8_BAR; }
    }
    PG8_WAIT_V(0);
    if constexpr (!ALIGN_EPI) { if (wr == 0) PG8_BAR; }
    PG8_BAR;
#undef PG8_SA
#undef PG8_SB
#undef PG8_STAGE
#undef PG8_LDA
#undef PG8_LDB
#undef PG8_MMA
#undef PG8_WAIT_V
#undef PG8_WAIT_L
#undef PG8_BAR
#undef PG8_SCHED
#undef PG8_ABASE
#undef PG8_BBASE
}
}
namespace att {
#define LAS __attribute__((address_space(3)))
typedef short bf16x8 __attribute__((ext_vector_type(8)));
typedef short s16x4 __attribute__((ext_vector_type(4)));
typedef float f32x4 __attribute__((ext_vector_type(4)));
typedef float f32x4u __attribute__((ext_vector_type(4), aligned(4)));
typedef unsigned u32x4 __attribute__((ext_vector_type(4)));
typedef unsigned u32x2 __attribute__((ext_vector_type(2)));
typedef float f32x2_t __attribute__((ext_vector_type(2)));
typedef __bf16 bf16x2_t __attribute__((ext_vector_type(2)));
constexpr int VROW = 160;
constexpr int VTILE = 32 * VROW;
constexpr int WAVE_LDS = 2 * VTILE;
constexpr float C2 = 0.125f * 1.4426950408889634f;
constexpr float NEG = -1e30f, MFLOOR = -1e20f;
constexpr int TBW = 640, TBOFF = 240;

__device__ __forceinline__ unsigned cvtpk(float lo, float hi) { f32x2_t v = {lo, hi}; bf16x2_t b = __builtin_convertvector(v, bf16x2_t); return __builtin_bit_cast(unsigned, b); }
__device__ __forceinline__ s16x4 vtr(LAS const char* p) { typedef short v4i16_t __attribute__((ext_vector_type(4))); return __builtin_bit_cast(s16x4, __builtin_amdgcn_ds_read_tr16_b64_v4i16((LAS v4i16_t*)p)); }

struct State { float m, l; f32x4 acc[4]; };

__device__ __forceinline__ void softmax_pv(State& st, f32x4 t0, f32x4 t1, LAS const char* vt, int lane) {
    float mx = fmaxf(fmaxf(fmaxf(t0[0], t0[1]), fmaxf(t0[2], t0[3])), fmaxf(fmaxf(t1[0], t1[1]), fmaxf(t1[2], t1[3])));
    mx = fmaxf(mx, __shfl_xor(mx, 16)); mx = fmaxf(mx, __shfl_xor(mx, 32));
    const float mn = fmaxf(st.m, mx);
    const float alpha = __builtin_amdgcn_exp2f(st.m - mn);
    st.m = mn;
    f32x4 p0, p1;
#pragma unroll
    for (int e = 0; e < 4; ++e) { p0[e] = __builtin_amdgcn_exp2f(t0[e] - mn); p1[e] = __builtin_amdgcn_exp2f(t1[e] - mn); }
    st.l = st.l * alpha + (((p0[0] + p0[1]) + (p0[2] + p0[3])) + ((p1[0] + p1[1]) + (p1[2] + p1[3])));
    u32x4 pw; pw.x = cvtpk(p0[0], p0[1]); pw.y = cvtpk(p0[2], p0[3]); pw.z = cvtpk(p1[0], p1[1]); pw.w = cvtpk(p1[2], p1[3]);
    const bf16x8 pb = __builtin_bit_cast(bf16x8, pw);
    const int g = lane >> 4, qq = (lane & 15) >> 2, pp = lane & 3;
    LAS const char* vb = vt + (4 * g + qq) * VROW + pp * 8;
#pragma unroll
    for (int mt = 0; mt < 4; ++mt) {
        const s16x4 lo = vtr(vb + mt * 32), hi = vtr(vb + 16 * VROW + mt * 32);
        const bf16x8 av = (bf16x8){lo[0], lo[1], lo[2], lo[3], hi[0], hi[1], hi[2], hi[3]};
        st.acc[mt] = st.acc[mt] * alpha;
        st.acc[mt] = __builtin_amdgcn_mfma_f32_16x16x32_bf16(av, pb, st.acc[mt], 0, 0, 0);
    }
}

__device__ __forceinline__ void finish(State& st, bf16_t* outp  , const bf16_t* zp, int lane) {
    float l = st.l; l += __shfl_xor(l, 16); l += __shfl_xor(l, 32);
    const float rl = 1.0f / l;
    const int g = lane >> 4;
#pragma unroll
    for (int mt = 0; mt < 4; ++mt) {
        const u32x2 zz = *(const u32x2*)(zp + mt * 16 + 4 * g);
        float o[4];
#pragma unroll
        for (int e = 0; e < 4; ++e) {
            const unsigned zw = zz[e >> 1]; const float z = (e & 1) ? __builtin_bit_cast(float, zw & 0xffff0000u) : __builtin_bit_cast(float, zw << 16);
            const float sz = z * __builtin_amdgcn_rcpf(1.0f + __builtin_amdgcn_exp2f(-1.4426950408889634f * z));
            o[e] = st.acc[mt][e] * rl * sz;
        }
        u32x2 w; w.x = cvtpk(o[0], o[1]); w.y = cvtpk(o[2], o[3]);
        *(u32x2*)(outp + mt * 16 + 4 * g) = w;
    }
}

__device__ __forceinline__ void dil_task(bf16_t* proj, const float* tbl, int task, LAS char* vbuf, int lane, bf16_t* dry = nullptr) {
    const int r = task & 15, qb = (task >> 4) & 15, h = (task >> 8) & 7, b = task >> 11;
    const int q = lane & 15, g = lane >> 4;
    const int qr = qb * 256 + r;
    bf16_t* pb_ = proj + (size_t)b * SEQ * PLD;
    const bf16_t* qp = pb_ + (size_t)(qr + 16 * q) * PLD + PC_QC + h * 64 + g * 8;
    const bf16x8 bq0 = *(const bf16x8*)qp, bq1 = *(const bf16x8*)(qp + 32);
    const bf16_t* kbase = pb_ + PC_KC + h * 64 + g * 8;
    const bf16_t* vbase = pb_ + PC_VC + h * 64 + (lane & 1) * 32;
    const int sv = lane >> 1;
    State st; st.m = MFLOOR; st.l = 0.f;
#pragma unroll
    for (int mt = 0; mt < 4; ++mt) st.acc[mt] = (f32x4){0.f, 0.f, 0.f, 0.f};
    const float* tbh = tbl + (size_t)h * 3 * TBW;

#define DIL_PARAMS(ks, d, e, pat, ul0) int d, e, pat, ul0; if ((ks) < 5) { d = 16; e = 1; pat = 0; ul0 = (ks) * 32; } else if ((ks) < 11) { d = 4; e = 4; pat = 1; ul0 = ((ks) - 5) * 32; } else { d = 1; e = 16; pat = 2; ul0 = ((ks) - 11) * 32; }
    bf16x8 k00, k01, k10, k11; u32x4 v0, v1, v2, v3; f32x4 bb0, bb1;
    auto issue = [&](int ks) {
        DIL_PARAMS(ks, d, e, pat, ul0);
        const int pbase = qr + d * (ul0 - 64);
        int p0 = pbase + d * q, p1 = p0 + 16 * d, pv = pbase + d * sv;
        p0 = p0 < 0 ? 0 : (p0 > SEQ - 1 ? SEQ - 1 : p0); p1 = p1 < 0 ? 0 : (p1 > SEQ - 1 ? SEQ - 1 : p1); pv = pv < 0 ? 0 : (pv > SEQ - 1 ? SEQ - 1 : pv);
        const bf16_t* ka = kbase + (size_t)p0 * PLD; const bf16_t* kb = kbase + (size_t)p1 * PLD; const bf16_t* va = vbase + (size_t)pv * PLD;
        k00 = *(const bf16x8*)ka; k01 = *(const bf16x8*)(ka + 32); k10 = *(const bf16x8*)kb; k11 = *(const bf16x8*)(kb + 32);
        v0 = *(const u32x4*)va; v1 = *(const u32x4*)(va + 8); v2 = *(const u32x4*)(va + 16); v3 = *(const u32x4*)(va + 24);
        const float* tp = tbh + pat * TBW + TBOFF + ul0 + 4 * g - e * q;
        bb0 = *(const f32x4u*)tp; bb1 = *(const f32x4u*)(tp + 16);
    };
    issue(0);
#pragma unroll 1
    for (int ks = 0; ks < 23; ++ks) {
        const bf16x8 a00 = k00, a01 = k01, a10 = k10, a11 = k11; const u32x4 w0 = v0, w1 = v1, w2 = v2, w3 = v3; const f32x4 c0 = bb0, c1 = bb1;
        if (ks + 1 < 23) issue(ks + 1);
        LAS char* vt = vbuf + (ks & 1) * VTILE;
        LAS char* vw = vt + sv * VROW + (lane & 1) * 64;
        *(LAS u32x4*)vw = w0; *(LAS u32x4*)(vw + 16) = w1; *(LAS u32x4*)(vw + 32) = w2; *(LAS u32x4*)(vw + 48) = w3;
        f32x4 s0 = (f32x4){0.f, 0.f, 0.f, 0.f}, s1 = s0;
        s0 = __builtin_amdgcn_mfma_f32_16x16x32_bf16(a00, bq0, s0, 0, 0, 0); s0 = __builtin_amdgcn_mfma_f32_16x16x32_bf16(a01, bq1, s0, 0, 0, 0);
        s1 = __builtin_amdgcn_mfma_f32_16x16x32_bf16(a10, bq0, s1, 0, 0, 0); s1 = __builtin_amdgcn_mfma_f32_16x16x32_bf16(a11, bq1, s1, 0, 0, 0);
        f32x4 t0 = s0 * C2 + c0, t1 = s1 * C2 + c1;
        {
            DIL_PARAMS(ks, d, e, pat, ul0);
            const int pbase = qr + d * (ul0 - 64);
            if (pbase < 0 || pbase + 31 * d > SEQ - 1) {
                const int pk = pbase + d * 4 * g;
#pragma unroll
                for (int x = 0; x < 4; ++x) { if ((unsigned)(pk + d * x) >= (unsigned)SEQ) t0[x] = NEG; if ((unsigned)(pk + d * (16 + x)) >= (unsigned)SEQ) t1[x] = NEG; }
            }
        }
        softmax_pv(st, t0, t1, vt, lane);
    }
#undef DIL_PARAMS
    bf16_t* outp = dry ? dry + ((size_t)task * 16 + q) * 64 : pb_ + (size_t)(qr + 16 * q) * PLD + PC_QC + h * 64;
    finish(st, outp, pb_ + (size_t)(qr + 16 * q) * PLD + PC_ZC + h * 64, lane);
}

__device__ __forceinline__ void na_task(bf16_t* proj, const float* rpb2, int task, LAS char* vbuf, int lane, bf16_t* dry = nullptr) {
    const int jt = task & 3, r = (task >> 2) & 63, h = (task >> 8) & 7, b = task >> 11;
    const int q = lane & 15, g = lane >> 4;
    const int j0 = 16 * jt, j = j0 + q;
    int w0 = j0 - 8; w0 = w0 < 0 ? 0 : (w0 > 32 ? 32 : w0);
    int rs = r - 4; rs = rs < 0 ? 0 : (rs > 56 ? 56 : rs);
    int cs = j - 8; cs = cs < 0 ? 0 : (cs > 48 ? 48 : cs);
    bf16_t* pb_ = proj + (size_t)b * SEQ * PLD;
    const size_t tq = (size_t)(r * 64 + j);
    const bf16_t* qp = pb_ + tq * PLD + PC_QB + h * 64 + g * 8;
    const bf16x8 bq0 = *(const bf16x8*)qp, bq1 = *(const bf16x8*)(qp + 32);
    const bf16_t* kbase = pb_ + (size_t)(rs * 64 + w0 + q) * PLD + PC_KB + h * 64 + g * 8;
    const int sv = lane >> 1;
    const bf16_t* vbase = pb_ + (size_t)(rs * 64 + w0 + sv) * PLD + PC_VB + h * 64 + (lane & 1) * 32;
    const float* tb = rpb2 + ((size_t)h * 15 + (rs - r + 7)) * 64 + (w0 + 4 * g - j + 32);
    State st; st.m = MFLOOR; st.l = 0.f;
#pragma unroll
    for (int mt = 0; mt < 4; ++mt) st.acc[mt] = (f32x4){0.f, 0.f, 0.f, 0.f};
    const int kc0 = w0 + 4 * g - cs;
    bf16x8 k00, k01, k10, k11; u32x4 v0, v1, v2, v3; f32x4 bb0, bb1;
    auto issue = [&](int ks) {
        const bf16_t* ka = kbase + (size_t)ks * 64 * PLD; const bf16_t* kb = ka + (size_t)16 * PLD; const bf16_t* va = vbase + (size_t)ks * 64 * PLD;
        k00 = *(const bf16x8*)ka; k01 = *(const bf16x8*)(ka + 32); k10 = *(const bf16x8*)kb; k11 = *(const bf16x8*)(kb + 32);
        v0 = *(const u32x4*)va; v1 = *(const u32x4*)(va + 8); v2 = *(const u32x4*)(va + 16); v3 = *(const u32x4*)(va + 24);
        const float* tp = tb + ks * 64;
        bb0 = *(const f32x4u*)tp; bb1 = *(const f32x4u*)(tp + 16);
    };
    issue(0);
#pragma unroll 1
    for (int ks = 0; ks < 8; ++ks) {
        const bf16x8 a00 = k00, a01 = k01, a10 = k10, a11 = k11; const u32x4 w0_ = v0, w1 = v1, w2 = v2, w3 = v3; const f32x4 c0 = bb0, c1 = bb1;
        if (ks + 1 < 8) issue(ks + 1);
        LAS char* vt = vbuf + (ks & 1) * VTILE;
        LAS char* vw = vt + sv * VROW + (lane & 1) * 64;
        *(LAS u32x4*)vw = w0_; *(LAS u32x4*)(vw + 16) = w1; *(LAS u32x4*)(vw + 32) = w2; *(LAS u32x4*)(vw + 48) = w3;
        f32x4 s0 = (f32x4){0.f, 0.f, 0.f, 0.f}, s1 = s0;
        s0 = __builtin_amdgcn_mfma_f32_16x16x32_bf16(a00, bq0, s0, 0, 0, 0); s0 = __builtin_amdgcn_mfma_f32_16x16x32_bf16(a01, bq1, s0, 0, 0, 0);
        s1 = __builtin_amdgcn_mfma_f32_16x16x32_bf16(a10, bq0, s1, 0, 0, 0); s1 = __builtin_amdgcn_mfma_f32_16x16x32_bf16(a11, bq1, s1, 0, 0, 0);
        f32x4 t0 = s0 * C2 + c0, t1 = s1 * C2 + c1;
#pragma unroll
        for (int x = 0; x < 4; ++x) { if ((unsigned)(kc0 + x) >= 16u) t0[x] = NEG; if ((unsigned)(kc0 + 16 + x) >= 16u) t1[x] = NEG; }
        softmax_pv(st, t0, t1, vt, lane);
    }
    finish(st, dry ? dry + ((size_t)task * 16 + q) * 64 : pb_ + tq * PLD + PC_QB + h * 64, pb_ + tq * PLD + PC_ZB + h * 64, lane);
}
#undef LAS
}
constexpr int NWAVES = 8;
#define GAS __attribute__((address_space(1)))
#define LAS __attribute__((address_space(3)))
typedef unsigned v4u __attribute__((ext_vector_type(4)));
typedef float f32x4 __attribute__((ext_vector_type(4)));
typedef GAS unsigned gu32;
#define RLX_AGENT __ATOMIC_RELAXED, __HIP_MEMORY_SCOPE_AGENT

constexpr size_t SZ_WINT = (size_t)IN_COLS * DM * 2, SZ_WOUTT = (size_t)DM * MIXW * 2, SZ_GLUT = 512 * 512 * 2, SZ_TM = (size_t)32 * 256 * 512 * 2, SZ_MS = (size_t)32 * 256 * 256 * 2;
constexpr size_t OFF_WOUTT0 = OFF_W, OFF_WOUTT1 = OFF_WOUTT0 + SZ_WOUTT, OFF_WINT1 = OFF_WOUTT1 + SZ_WOUTT, OFF_GLUT1 = OFF_WINT1 + SZ_WINT, OFF_TM1 = OFF_GLUT1 + SZ_GLUT, OFF_MS1 = OFF_TM1 + SZ_TM;
constexpr size_t WS_NEED = OFF_MS1 + SZ_MS;
constexpr size_t DO_WINT0 = 0, DO_GLUT0 = DO_WINT0 + SZ_WINT, DO_TM0 = DO_GLUT0 + SZ_GLUT, DO_MS0 = DO_TM0 + SZ_TM;
static_assert(DO_MS0 + SZ_MS <= (size_t)NTOK * DM * 4, "layer-0 tables fit in d_out");
static_assert(WS_NEED <= (size_t)256 * 1024 * 1024, "workspace map fits 256 MiB");
constexpr size_t CTL_ZERO_BYTES = 262144;
constexpr int CW_BAR = 1024;
constexpr int CW_WORK = 256;
constexpr size_t OFF_RPB2 = 524288;
constexpr size_t OFF_T5TB = OFF_RPB2 + 2 * 8 * 15 * 64 * 4;
static_assert(OFF_T5TB + 8 * 3 * att::TBW * 4 <= OFF_SS, "small tables fit in the control MiB");

constexpr int RING_BYTES = 131072;
constexpr int MISC_OFF = RING_BYTES;
constexpr int LDS_BYTES = 147456;
static_assert(NWAVES * att::WAVE_LDS <= RING_BYTES, "attention LDS");

#define XB_TMO      128
#define XB_XCNT(j)  (256  + 64 * (j))
#define XB_XSUB(j)  (1280 + 64 * (j))
#define XB_XGEN(j)  (2304 + 64 * (j))
#define XB_TOP      3328
#define XB_TOPGEN   3392
#define XCD_BAR_WORDS 3456
#define XB_SPIN_CAP (1u << 18)
__device__ __forceinline__ unsigned xb_ld(unsigned* p)              { return __hip_atomic_load(p, __ATOMIC_RELAXED, __HIP_MEMORY_SCOPE_AGENT); }
__device__ __forceinline__ unsigned xb_add(unsigned* p, unsigned v) { return __hip_atomic_fetch_add(p, v, __ATOMIC_RELAXED, __HIP_MEMORY_SCOPE_AGENT); }
__device__ __forceinline__ unsigned xb_xcc_id() { return (unsigned)__builtin_amdgcn_s_getreg((3 << 11) | 20) & 0xFu; }
#define XB_SPIN(cond, bar) do { unsigned _sp = 0; while (cond) { __builtin_amdgcn_s_sleep(1); \
    if ((++_sp & 255u) == 0u) { if (xb_ld(&(bar)[XB_TMO])) break; if (_sp > XB_SPIN_CAP) { atomicAdd(&(bar)[XB_TMO], 1u); break; } } } } while (0)
struct XcdBarrier { unsigned* bar; unsigned x; volatile LAS unsigned* st; };
__device__ __forceinline__ XcdBarrier xcd_barrier_post(unsigned* bar, volatile LAS unsigned* st) {
    XcdBarrier b; b.bar = bar; b.x = xb_xcc_id(); b.st = st;
    if (threadIdx.x == 0) (void)xb_add(&bar[XB_XCNT(b.x)], 1u);
    return b;
}
__device__ __forceinline__ void xcd_barrier_complete(unsigned* bar, unsigned x, unsigned& nloc, unsigned& nx) {
    const unsigned G = gridDim.x * gridDim.y * gridDim.z;
    unsigned sum, cnt, mine, sp = 0u;
    for (;;) {
        sum = 0u; cnt = 0u; mine = 0u;
#pragma unroll
        for (unsigned j = 0; j < 16; ++j) { const unsigned c = xb_ld(&bar[XB_XCNT(j)]); sum += c; cnt += (c > 0u) ? 1u : 0u; mine = (j == x) ? c : mine; }
        if (sum == G) break;
        __builtin_amdgcn_s_sleep(1);
        if ((++sp & 255u) == 0u) { if (xb_ld(&bar[XB_TMO])) break; if (sp > XB_SPIN_CAP) { atomicAdd(&bar[XB_TMO], 1u); break; } }
    }
    nloc = mine > 0u ? mine : 1u; nx = cnt > 0u ? cnt : 1u;
}
__device__ __forceinline__ void xcd_barrier(const XcdBarrier& b) {
    asm volatile("s_waitcnt vmcnt(0)" ::: "memory");
    __syncthreads();
    if (threadIdx.x == 0) {
        unsigned* bar = b.bar;
        __builtin_amdgcn_s_waitcnt(0);
        unsigned nloc = b.st[0], nx = b.st[1];
        if (nloc == 0u) { xcd_barrier_complete(bar, b.x, nloc, nx); b.st[0] = nloc; b.st[1] = nx; }
        const unsigned old = xb_add(&bar[XB_XSUB(b.x)], 1u);
        const unsigned gen = old / nloc;
        if (old + 1u == (gen + 1u) * nloc) {
            __builtin_amdgcn_fence(__ATOMIC_RELEASE, "agent");
            asm volatile("s_waitcnt vmcnt(0)" ::: "memory");
            const unsigned og = xb_add(&bar[XB_TOP], 1u);
            const unsigned tg = og / nx;
            if (og + 1u == (tg + 1u) * nx) xb_add(&bar[XB_TOPGEN], 1u);
            else XB_SPIN(xb_ld(&bar[XB_TOPGEN]) == tg, bar);
            __builtin_amdgcn_fence(__ATOMIC_ACQUIRE, "agent");
            xb_add(&bar[XB_XGEN(b.x)], 1u);
            asm volatile("s_waitcnt vmcnt(0)" ::: "memory");
        } else {
            XB_SPIN(xb_ld(&bar[XB_XGEN(b.x)]) == gen, bar);
            __builtin_amdgcn_fence(__ATOMIC_ACQUIRE, "agent");
            asm volatile("s_waitcnt vmcnt(0)" ::: "memory");
        }
    }
    __syncthreads();
}

struct Args { const float* in[17]; float* out; unsigned char* ws; int ph_lo, ph_hi; int li, skip; };

__device__ __forceinline__ float wave_sum(float v) {
#pragma unroll
    for (int o = 1; o < 64; o <<= 1) v += __shfl_xor(v, o);
    return v;
}
__device__ __forceinline__ unsigned pk2(float lo, float hi) { return f2bf(lo) | (f2bf(hi) << 16); }

__device__ __forceinline__ void p0_transpose_item(const float* W, int K, int Nsrc, bf16_t* WT, int k0, int n0s, int n0d, const float* kscale, LAS float* scr, int lane) {
#pragma unroll 8
    for (int i = 0; i < 32; ++i) { const int kk = 2 * i + (lane >> 5); float v = W[(size_t)(k0 + kk) * Nsrc + n0s + (lane & 31)]; if (kscale) v *= kscale[k0 + kk]; scr[kk * 33 + (lane & 31)] = v; }
    asm volatile("s_waitcnt lgkmcnt(0)" ::: "memory");
    const int c = lane & 7;
#pragma unroll
    for (int j = 0; j < 4; ++j) { const int n = (lane >> 3) + 8 * j; const LAS float* s = scr + (8 * c) * 33 + n;
        v4u o; o.x = pk2(s[0 * 33], s[1 * 33]); o.y = pk2(s[2 * 33], s[3 * 33]); o.z = pk2(s[4 * 33], s[5 * 33]); o.w = pk2(s[6 * 33], s[7 * 33]);
        *(v4u*)(WT + (size_t)(n0d + n) * K + k0 + 8 * c) = o; }
    asm volatile("s_waitcnt lgkmcnt(0)" ::: "memory");
}
__device__ __forceinline__ void p0_xrow(const float* xrow, bf16_t* orow, float* ssrow, int lane) {
    const f32x4* xr = (const f32x4*)xrow + lane;
    f32x4 v[4]; float s = 0.f;
#pragma unroll
    for (int j = 0; j < 4; ++j) { v[j] = xr[64 * j]; s += (v[j].x * v[j].x + v[j].y * v[j].y) + (v[j].z * v[j].z + v[j].w * v[j].w); }
    s = wave_sum(s);
    unsigned long long* o8 = (unsigned long long*)orow + lane;
#pragma unroll
    for (int j = 0; j < 4; ++j) o8[64 * j] = (unsigned long long)pk2(v[j].x, v[j].y) | ((unsigned long long)pk2(v[j].z, v[j].w) << 32);
    if (lane < 16) ssrow[lane] = lane == 0 ? s : 0.f;
}
__device__ __forceinline__ int t5_bucket_dev(int rel) {
    const int n = rel < 0 ? -rel : rel;
    int large = 8 + (int)(log((double)(n < 1 ? 1 : n) / 8.0) / log(128.0) * 8.0);
    large = large > 15 ? 15 : large;
    return (rel > 0 ? 16 : 0) + (n < 8 ? n : large);
}
__device__ __forceinline__ void p0_ssm_tables(const Args& a, int l, int g, int d, bf16_t* TM, bf16_t* Ms, LAS float* scr) {
    int tid = threadIdx.x; asm volatile("" : "+v"(tid));
    LAS float* pw = scr;
    LAS float* fc = pw + 64 * 17 * 2;
    LAS float* Cc = fc + 2 * 64 * 2;
    LAS float* Bb = Cc + 2048;
    LAS float* C2 = Bb + 2048;
    LAS float* B2 = C2 + 2048;
    LAS float* Kt = B2 + 2048;
    const float* lam_re = a.in[4]; const float* lam_im = a.in[5]; const float* log_dt = a.in[6];
    const float* b_re = a.in[7]; const float* b_im = a.in[8]; const float* c_re = a.in[9]; const float* c_im = a.in[10]; const float* dskip = a.in[11];
    const int pg = (l * 2 + d) * 32 + g, pg2 = (l * 2 + (1 - d)) * 32 + g;
    if (tid < 128) {
        const int o = tid >> 6, p = tid & 63, pgx = o == 0 ? pg : pg2;
        const float lre = lam_re[pgx * 64 + p], lim = lam_im[pgx * 64 + p], dt = expf(log_dt[pgx]);
        const float er = expf(lre * dt), lbr = er * cosf(lim * dt), lbi = er * sinf(lim * dt);
        const float nr = lbr - 1.f, ni = lbi, den = lre * lre + lim * lim;
        fc[(o * 64 + p) * 2] = (nr * lre + ni * lim) / den; fc[(o * 64 + p) * 2 + 1] = (ni * lre - nr * lim) / den;
        if (o == 0) { float wr = 1.f, wi = 0.f;
            for (int k = 0; k <= 16; ++k) { pw[(p * 17 + k) * 2] = wr; pw[(p * 17 + k) * 2 + 1] = wi; const float t = wr * lbr - wi * lbi; wi = wr * lbi + wi * lbr; wr = t; } }
    }
    __syncthreads();
    for (int i = tid; i < 1024; i += NWAVES * 64) {
        Cc[i * 2] = c_re[(size_t)pg * 1024 + i]; Cc[i * 2 + 1] = c_im[(size_t)pg * 1024 + i];
        { const int p = i >> 4; const float br = b_re[(size_t)pg * 1024 + i], bi = b_im[(size_t)pg * 1024 + i], fr = fc[p * 2], fi = fc[p * 2 + 1];
          Bb[i * 2] = fr * br - fi * bi; Bb[i * 2 + 1] = fr * bi + fi * br; }
        if (d == 0) {
            C2[i * 2] = c_re[(size_t)pg2 * 1024 + i]; C2[i * 2 + 1] = c_im[(size_t)pg2 * 1024 + i];
            const int p = i >> 4; const float br = b_re[(size_t)pg2 * 1024 + i], bi = b_im[(size_t)pg2 * 1024 + i], fr = fc[(64 + p) * 2], fi = fc[(64 + p) * 2 + 1];
            B2[i * 2] = fr * br - fi * bi; B2[i * 2 + 1] = fr * bi + fi * br; }
    }
    __syncthreads();
    {
        const int kh = tid >> 8, c = (tid >> 4) & 15, cp = tid & 15;
        float Kk[8];
#pragma unroll
        for (int k = 0; k < 8; ++k) Kk[k] = 0.f;
        float k0o = 0.f;
#pragma unroll 2
        for (int p = 0; p < 64; ++p) {
            const float Cr = Cc[(c * 64 + p) * 2], Ci = Cc[(c * 64 + p) * 2 + 1], br = Bb[(p * 16 + cp) * 2], bi = Bb[(p * 16 + cp) * 2 + 1];
            const LAS float* pwp = pw + (p * 17 + kh * 8) * 2;
#pragma unroll
            for (int k = 0; k < 8; ++k) { const float pr = pwp[2 * k], pi = pwp[2 * k + 1]; const float wr = Cr * pr - Ci * pi, wi = Cr * pi + Ci * pr; Kk[k] += wr * br - wi * bi; }
            if (d == 0 && kh == 0) k0o += C2[(c * 64 + p) * 2] * B2[(p * 16 + cp) * 2] - C2[(c * 64 + p) * 2 + 1] * B2[(p * 16 + cp) * 2 + 1];
        }
#pragma unroll
        for (int k = 0; k < 8; ++k) Kt[(kh * 8 + k) * 256 + c * 16 + cp] = Kk[k];
        if (d == 0 && kh == 0) Kt[16 * 256 + c * 16 + cp] = k0o;
    }
    __syncthreads();
    for (int idx = tid; idx < 256 * 128; idx += NWAVES * 64) {
        const int row = idx >> 7, col = (idx & 127) * 2, t = row >> 4, cc = row & 15, s_ = col >> 4, c2 = col & 15;
        const int k = d == 0 ? t - s_ : s_ - t;
        if (k < 0 || (d == 1 && k == 0)) continue;
        float v0 = Kt[k * 256 + cc * 16 + c2], v1 = Kt[k * 256 + cc * 16 + c2 + 1];
        if (k == 0) { v0 += Kt[16 * 256 + cc * 16 + c2]; v1 += Kt[16 * 256 + cc * 16 + c2 + 1];
            const float dd = dskip[l * 512 + g * 16 + cc]; if (c2 == cc) v0 += dd; if (c2 + 1 == cc) v1 += dd; }
        *(unsigned*)(TM + (size_t)row * 512 + col) = pk2(v0, v1);
    }
    {
        const int p = tid & 63, cq = tid >> 6;
#pragma unroll
        for (int h2 = 0; h2 < 2; ++h2) { const int c = cq + 8 * h2; const float Cr = Cc[(c * 64 + p) * 2], Ci = Cc[(c * 64 + p) * 2 + 1];
#pragma unroll 4
            for (int e = 1; e <= 16; ++e) { const float pr = pw[(p * 17 + e) * 2], pi = pw[(p * 17 + e) * 2 + 1]; const float wr = Cr * pr - Ci * pi, wi = Cr * pi + Ci * pr;
                const int t = d == 0 ? e - 1 : 16 - e; bf16_t* rowp = TM + (size_t)(t * 16 + c) * 512 + 256 + d * 128 + p;
                rowp[0] = (bf16_t)f2bf(wr); rowp[64] = (bf16_t)f2bf(-wi); } }
    }
    {
        const int sc = tid & 255, e = sc >> 4, cp = sc & 15, ph = tid >> 8, s_ = d == 0 ? 15 - e : e;
#pragma unroll 4
        for (int it = 0; it < 32; ++it) { const int p = ph + 2 * it; const float pr = pw[(p * 17 + e) * 2], pi = pw[(p * 17 + e) * 2 + 1], br = Bb[(p * 16 + cp) * 2], bi = Bb[(p * 16 + cp) * 2 + 1];
            Ms[(size_t)(d * 128 + p) * 256 + s_ * 16 + cp] = (bf16_t)f2bf(pr * br - pi * bi); Ms[(size_t)(d * 128 + 64 + p) * 256 + s_ * 16 + cp] = (bf16_t)f2bf(pr * bi + pi * br); }
    }
    __syncthreads();
}

constexpr int N_PHASES = 14;
__global__ void __launch_bounds__(NWAVES * 64, 2) mega_fwd(Args args) {
    extern __shared__ __attribute__((aligned(16))) unsigned char lds_raw[];
    LAS unsigned char* lds = (LAS unsigned char*)lds_raw;
    volatile LAS unsigned* MISC = (volatile LAS unsigned*)(lds + MISC_OFF);
    const int tid = threadIdx.x;
#define PHASE_LANES int ptid = threadIdx.x; asm volatile("" : "+v"(ptid)); const int lane = ptid & 63, wave = __builtin_amdgcn_readfirstlane(ptid >> 6); (void)lane; (void)wave;
    const int G = gridDim.x; int vcu; { const int bx = blockIdx.x; vcu = (G % 8 == 0) ? (bx % 8) * (G / 8) + bx / 8 : bx; }
    unsigned char* ws = args.ws; unsigned char* dout = (unsigned char*)args.out;
    unsigned* ctl = (unsigned*)(ws + OFF_CTL);
    if (tid < 32) MISC[tid] = 0u;
    __syncthreads();
    XcdBarrier bar = xcd_barrier_post(ctl + CW_BAR + args.li * XCD_BAR_WORDS, MISC + 8);
    const int lo = args.ph_lo, hi = args.ph_hi;
#ifndef REP_P0
#define REP_P0 1
#endif
#ifndef REP_INPROJ
#define REP_INPROJ 1
#endif
#ifndef REP_EG
#define REP_EG 1
#endif
#ifndef DRY_NA
#define DRY_NA 0
#endif
#ifndef DRY_DIL
#define DRY_DIL 0
#endif
#ifndef REP_SCAN
#define REP_SCAN 1
#endif
#ifndef REP_Y
#define REP_Y 1
#endif
#ifndef CT_SKIP
#define CT_SKIP 0
#endif
#ifndef PHASE_MASK
#define PHASE_MASK 0x3fff
#endif
#define INR(k) (lo <= (k) && (k) < hi)
#define IN(k) (((PHASE_MASK >> (k)) & 1) && INR(k))
#define INL(j) (((PHASE_MASK >> ((j) + 1)) & 1) && INR(pb + (j)))
#define SEAM(k) do { if (INR(k) && INR((k) + 1)) xcd_barrier(bar); } while (0)

    bf16_t* proj = (bf16_t*)(ws + OFF_PROJ); bf16_t* xag = (bf16_t*)(ws + OFF_XAG); bf16_t* xb = (bf16_t*)(ws + OFF_XB); float* Ebuf = (float*)(ws + OFF_XB);
    bf16_t* Gb = (bf16_t*)(ws + OFF_G); float* sspart = (float*)(ws + OFF_SS);
    float* rpb2 = (float*)(ws + OFF_RPB2); float* t5tb = (float*)(ws + OFF_T5TB);

    if (IN(0)) for (int rep_ = 0; rep_ < REP_P0; ++rep_) {
        PHASE_LANES
        const int NTB = 128;
        for (int ti = vcu; ti < NTB; ti += G) {
            const int l = ti >> 6, g = (ti >> 1) & 31, d = ti & 1;
            bf16_t* TM = (bf16_t*)(l == 0 ? dout + DO_TM0 : ws + OFF_TM1) + (size_t)g * 256 * 512;
            bf16_t* Ms = (bf16_t*)(l == 0 ? dout + DO_MS0 : ws + OFF_MS1) + (size_t)g * 256 * 256;
            p0_ssm_tables(args, l, g, d, TM, Ms, (LAS float*)lds);
        }
        if (vcu == G - 1) {
            const float* rpb = args.in[14]; const float* t5 = args.in[15];
            for (int i = ptid; i < 2 * 8 * 15 * 64; i += NWAVES * 64) { const int cc = i & 63, rest = i >> 6; const int cr = cc - 17;
                rpb2[i] = (cr >= 0 && cr <= 30) ? rpb[(size_t)rest * 31 + cr] * 1.4426950408889634f : 0.f; }
            for (int i = ptid; i < 8 * 3 * att::TBW; i += NWAVES * 64) { const int idx = i % att::TBW, pat = (i / att::TBW) % 3, h = i / (3 * att::TBW); const int w = idx - att::TBOFF;
                const int d = pat == 0 ? 16 : (pat == 1 ? 4 : 1);
                t5tb[i] = (w >= 0 && w <= 128) ? t5[t5_bucket_dev(d * (w - 64)) * 8 + h] * 1.4426950408889634f : att::NEG; }
        }
        {
            LAS float* scr = (LAS float*)(lds + wave * 16384);
            constexpr int I_IN = (DM / 64) * (IN_COLS / 32), I_OUT = (MIXW / 64) * (DM / 32), I_GLU = (512 / 64) * (512 / 32), I_L = I_IN + I_OUT + I_GLU, I_TOT = 2 * I_L + NTOK;
            unsigned* qctr = ctl + CW_WORK + rep_ * 64;
            for (;;) {
                unsigned base = 0; if (lane == 0) base = __hip_atomic_fetch_add(qctr, 4u, __ATOMIC_RELAXED, __HIP_MEMORY_SCOPE_AGENT);
                base = __builtin_amdgcn_readfirstlane(base);
                if (base >= (unsigned)I_TOT) break;
                for (int it = (int)base; it < (int)base + 4 && it < I_TOT; ++it) {
                    if (it >= 2 * I_L) { const int mrow = it - 2 * I_L; p0_xrow(args.in[0] + (size_t)mrow * DM, xb + (size_t)mrow * DM, sspart + (size_t)mrow * 16, lane); continue; }
                    const int l = it / I_L; int r = it % I_L;
                    if (r < I_IN) { const int nblk = IN_COLS / 32, kb = r / nblk, nb = r % nblk;
                        p0_transpose_item(args.in[2] + (size_t)l * DM * IN_COLS, DM, IN_COLS, (bf16_t*)(l == 0 ? dout + DO_WINT0 : ws + OFF_WINT1), 64 * kb, inproj_src_col(32 * nb), 32 * nb, args.in[1] + l * DM, scr, lane); continue; }
                    r -= I_IN;
                    if (r < I_OUT) { const int nblk = DM / 32, kb = r / nblk, nb = r % nblk;
                        p0_transpose_item(args.in[3] + (size_t)l * MIXW * DM, MIXW, DM, (bf16_t*)(ws + (l == 0 ? OFF_WOUTT0 : OFF_WOUTT1)), 64 * kb, 32 * nb, 32 * nb, nullptr, scr, lane); continue; }
                    r -= I_OUT;
                    { const int nblk = 512 / 32, kb = r / nblk, nb = r % nblk;
                        p0_transpose_item(args.in[12] + (size_t)l * 512 * 512, 512, 512, (bf16_t*)(l == 0 ? dout + DO_GLUT0 : ws + OFF_GLUT1), 64 * kb, 32 * nb, 32 * nb, nullptr, scr, lane); }
                }
            }
        }
    }
    SEAM(0);

    for (int l = 0; l < DEPTH; ++l) {
        const int pb = 1 + 6 * l;
        const bf16_t* WinT = (const bf16_t*)(l == 0 ? dout + DO_WINT0 : ws + OFF_WINT1);
        const bf16_t* WoutT = (const bf16_t*)(ws + (l == 0 ? OFF_WOUTT0 : OFF_WOUTT1));
        const bf16_t* GluT = (const bf16_t*)(l == 0 ? dout + DO_GLUT0 : ws + OFF_GLUT1);
        const bf16_t* TM = (const bf16_t*)(l == 0 ? dout + DO_TM0 : ws + OFF_TM1);
        const bf16_t* Ms = (const bf16_t*)(l == 0 ? dout + DO_MS0 : ws + OFF_MS1);
        if (INL(0)) for (int rep_ = 0; rep_ < REP_INPROJ; ++rep_) {
            pg8::Gemm gm{xb, WinT, DM, DM, DM, 0, 0}; pg8::StaticOrder S; S.init(NTOK, IN_COLS, G, (int)blockIdx.x);
            pg8::EpiInProj E{sspart, proj, xag};
            pg8::gemm_phase<pg8::EpiInProj, pg8::StaticOrder>(lds, gm, S, E);
        }
        SEAM(pb + 0);
        if (INL(1)) {
            if (!(CT_SKIP & 1) && !(args.skip & 1)) for (int rep_ = 0; rep_ < REP_EG; ++rep_) { pg8::Gemm gm{xag, Ms, 512, 256, 256, (size_t)NCHUNK_TOT * 512, (size_t)256 * 256}; pg8::BatchOrder S; S.init(4, 32, G, vcu);
              pg8::EpiE E{Ebuf};
              pg8::gemm_phase<pg8::EpiE, pg8::BatchOrder>(lds, gm, S, E); }
            __syncthreads();
            PHASE_LANES
            LAS char* vbuf = (LAS char*)(lds + wave * att::WAVE_LDS);
            const int gw = vcu * NWAVES + wave, NGW = G * NWAVES;
            for (int rep_ = 0; rep_ < DRY_NA; ++rep_) for (int t = gw; t < 8192; t += NGW) att::na_task(proj, rpb2 + (size_t)l * 8 * 15 * 64, t, vbuf, lane, Gb);
            if (!(CT_SKIP & 2) && !(args.skip & 2)) for (int t = gw; t < 8192; t += NGW) att::na_task(proj, rpb2 + (size_t)l * 8 * 15 * 64, t, vbuf, lane);
            for (int rep_ = 0; rep_ < DRY_DIL; ++rep_) for (int t = gw; t < 8192; t += NGW) att::dil_task(proj, t5tb, t, vbuf, lane, Gb);
            if (!(CT_SKIP & 4) && !(args.skip & 4)) for (int t = gw; t < 8192; t += NGW) att::dil_task(proj, t5tb, t, vbuf, lane);
        }
        SEAM(pb + 1);
        if (INL(2)) for (int rep_ = 0; rep_ < REP_SCAN; ++rep_) {
            PHASE_LANES
            const float* lam_re = args.in[4]; const float* lam_im = args.in[5]; const float* log_dt = args.in[6];
            LAS float* sx = (LAS float*)lds;
            for (int cg = vcu; cg < 256; cg += G) {
                const int g = cg >> 3, b = (cg >> 1) & 3, d = cg & 1, p = lane, pg = (l * 2 + d) * 32 + g;
                const float lre = lam_re[pg * 64 + p], lim = lam_im[pg * 64 + p], dt = expf(log_dt[pg]);
                const float er = expf(lre * dt); float ar = er * cosf(lim * dt), ai = er * sinf(lim * dt);
#pragma unroll
                for (int i = 0; i < 4; ++i) { const float t = ar * ar - ai * ai; ai = 2.f * ar * ai; ar = t; }
                const float* Ep = Ebuf + ((size_t)g * NCHUNK_TOT + b * NCHUNK) * 256 + d * 128 + p;
                bf16_t* Cp = xag + ((size_t)g * NCHUNK_TOT + b * NCHUNK) * 512 + 256 + d * 128 + p;
                float er_[32], ei_[32];
#pragma unroll
                for (int i = 0; i < 32; ++i) { const int s = wave * 32 + i, k = d == 0 ? s : NCHUNK - 1 - s; er_[i] = Ep[(size_t)k * 256]; ei_[i] = Ep[(size_t)k * 256 + 64]; }
                float cr = 0.f, ci = 0.f;
#pragma unroll
                for (int i = 0; i < 32; ++i) { const float xr = er_[i], xi = ei_[i]; er_[i] = cr; ei_[i] = ci; const float t = ar * cr - ai * ci + xr; ci = ar * ci + ai * cr + xi; cr = t; }
                sx[(wave * 64 + lane) * 2] = cr; sx[(wave * 64 + lane) * 2 + 1] = ci;
                float a32r = ar, a32i = ai;
#pragma unroll
                for (int i = 0; i < 5; ++i) { const float t = a32r * a32r - a32i * a32i; a32i = 2.f * a32r * a32i; a32r = t; }
                __syncthreads();
                float inr = 0.f, ini = 0.f;
                for (int j = 0; j < wave; ++j) { const float tr = sx[(j * 64 + lane) * 2], ti = sx[(j * 64 + lane) * 2 + 1]; const float t = a32r * inr - a32i * ini + tr; ini = a32r * ini + a32i * inr + ti; inr = t; }
                float pr = inr, pi = ini;
#pragma unroll
                for (int i = 0; i < 32; ++i) { const int s = wave * 32 + i, k = d == 0 ? s : NCHUNK - 1 - s;
                    Cp[(size_t)k * 512] = (bf16_t)f2bf(er_[i] + pr); Cp[(size_t)k * 512 + 64] = (bf16_t)f2bf(ei_[i] + pi);
                    const float t = ar * pr - ai * pi; pi = ar * pi + ai * pr; pr = t; }
                __syncthreads();
            }
        }
        SEAM(pb + 2);
        if (INL(3)) for (int rep_ = 0; rep_ < REP_Y; ++rep_) {
            pg8::Gemm gm{xag, TM, 512, 512, 512, (size_t)NCHUNK_TOT * 512, (size_t)256 * 512}; pg8::BatchOrder S; S.init(4, 32, G, vcu);
            pg8::EpiY E{Gb};
            pg8::gemm_phase<pg8::EpiY, pg8::BatchOrder>(lds, gm, S, E);
        }
        SEAM(pb + 3);
        if (INL(4)) {
            pg8::Gemm gm{Gb, GluT, 512, 512, 512, 0, 0}; pg8::StaticOrder S; S.init(NTOK, 512, G, (int)blockIdx.x);
            pg8::EpiGlu E{Gb, args.in[13] + l * 512, proj};
            pg8::gemm_phase<pg8::EpiGlu, pg8::StaticOrder>(lds, gm, S, E);
        }
        SEAM(pb + 4);
        if (INL(5)) {
            pg8::Gemm gm{proj, WoutT, PLD, MIXW, MIXW, 0, 0}; pg8::StaticOrder S; S.init(NTOK, DM, G, (int)blockIdx.x);
            pg8::EpiOutProj E{l == 0 ? args.in[0] : args.out, args.out, xb, sspart, l == 0 ? 1 : 0};
            pg8::gemm_phase<pg8::EpiOutProj, pg8::StaticOrder>(lds, gm, S, E);
        }
        SEAM(pb + 5);
    }
    if (IN(13)) {
        PHASE_LANES
        const float* fg = args.in[16];
        const int gw = vcu * NWAVES + wave, NGW = G * NWAVES;
        for (int m = gw; m < NTOK; m += NGW) {
            const f32x4* sp = (const f32x4*)(sspart + (size_t)m * 16);
            const f32x4 s0 = sp[0], s1 = sp[1], s2 = sp[2], s3 = sp[3];
            const float ss = (((s0[0] + s0[1]) + (s0[2] + s0[3])) + ((s1[0] + s1[1]) + (s1[2] + s1[3]))) + (((s2[0] + s2[1]) + (s2[2] + s2[3])) + ((s3[0] + s3[1]) + (s3[2] + s3[3])));
            const float rinv = rsqrtf(ss * (1.0f / DM) + RMS_EPS);
            f32x4* xr = (f32x4*)(args.out + (size_t)m * DM) + lane;
#pragma unroll
            for (int j = 0; j < 4; ++j) { const f32x4 gv = *((const f32x4*)fg + lane + 64 * j); xr[64 * j] = xr[64 * j] * rinv * gv; }
        }
    }
#undef IN
#undef INL
#undef INR
#undef SEAM
}
#define HOST_PLAN launch_mega(d_in, d_out, d_ws, stream, 0, N_PHASES, 0, 0);
static int g_grid = 0;
static void launch_mega(void* const* d_in, void* d_out, void* d_ws, hipStream_t stream, int lo, int hi, int li, int skip) {
    Args a{};
    for (int i = 0; i < 17; ++i) a.in[i] = (const float*)d_in[i];
    a.out = (float*)d_out; a.ws = (unsigned char*)d_ws; a.ph_lo = lo; a.ph_hi = hi; a.li = li; a.skip = skip;
    hipLaunchKernelGGL(mega_fwd, dim3(g_grid), dim3(NWAVES * 64), LDS_BYTES, stream, a);
    const hipError_t le = hipPeekAtLastError();
    if (le != hipSuccess) fprintf(stderr, "kernel_launch: launch failed: %s (grid %d)\n", hipGetErrorName(le), g_grid);
}
extern "C" void kernel_launch(void* const* d_in, const int* in_sizes, int n_in, void* d_out, int out_size, void* d_ws, size_t ws_size, hipStream_t stream) {
    if (g_grid == 0) {
        if (n_in != 17 || in_sizes[0] != NTOK * DM || out_size != NTOK * DM || ws_size < WS_NEED) { fprintf(stderr, "kernel_launch: unexpected shapes (n_in %d in0 %d out %d ws %zu need %zu)\n", n_in, n_in > 0 ? in_sizes[0] : -1, out_size, ws_size, (size_t)WS_NEED); g_grid = -1; return; }
        int dev = 0, cus = 0, per_cu = 0;
        if (hipGetDevice(&dev) != hipSuccess || hipDeviceGetAttribute(&cus, hipDeviceAttributeMultiprocessorCount, dev) != hipSuccess) { g_grid = -1; return; }
        if (hipFuncSetAttribute((const void*)mega_fwd, hipFuncAttributeMaxDynamicSharedMemorySize, LDS_BYTES) != hipSuccess) { fprintf(stderr, "kernel_launch: hipFuncSetAttribute failed\n"); g_grid = -1; return; }
        if (hipOccupancyMaxActiveBlocksPerMultiprocessor(&per_cu, (const void*)mega_fwd, NWAVES * 64, LDS_BYTES) != hipSuccess || per_cu < 1) { fprintf(stderr, "kernel_launch: occupancy query says %d\n", per_cu); per_cu = 1; }
        (void)hipGetLastError();
        g_grid = cus * 1;
    }
    if (g_grid < 0) return;
    (void)hipMemsetAsync((char*)d_ws + OFF_CTL, 0, CTL_ZERO_BYTES, stream);
    HOST_PLAN
}
```

```cpp
#include <hip/hip_runtime.h>
#include <cstdio>
#include <cstdint>
#include <cmath>

typedef unsigned short bf16_t;

constexpr int NB = 4, SEQ = 4096, DM = 1024, NTOK = NB * SEQ, DEPTH = 2;
constexpr int IN_COLS = 5120, MIXW = 1536;
constexpr float RMS_EPS = 1e-6f;
constexpr int LCH = 16;
constexpr int NCHUNK = SEQ / LCH;
constexpr int NCHUNK_TOT = NB * NCHUNK;
constexpr int PLD = 4608;
constexpr int PC_ZA = 0, PC_QB = 512, PC_QC = 1024, PC_KB = 1536, PC_VB = 2048, PC_ZB = 2560, PC_KC = 3072, PC_VC = 3584, PC_ZC = 4096;
__host__ __device__ __forceinline__ int inproj_src_col(int n) {
    if (n < 512) return n;
    const int pc = n - 512, s = pc >> 9;
    const int seg = (s == 0) ? 1 : (s == 1) ? 2 : (s == 2) ? 6 : (s == 3) ? 3 : (s == 4) ? 4 : (s == 5) ? 5 : (s == 6) ? 7 : (s == 7) ? 8 : 9;
    return seg * 512 + (pc & 511);
}

constexpr size_t OFF_CTL = 0;
constexpr size_t OFF_SS = 1u << 20;
constexpr size_t OFF_PROJ = 2u << 20;
constexpr size_t SZ_PROJ = (size_t)NTOK * PLD * 2;
constexpr size_t OFF_XAG = OFF_PROJ + SZ_PROJ;
constexpr size_t SZ_XAG = (size_t)32 * NCHUNK_TOT * 512 * 2;
constexpr size_t OFF_XB = OFF_XAG + SZ_XAG;
constexpr size_t SZ_XB = (size_t)NTOK * DM * 2;
constexpr size_t OFF_G = OFF_XB + SZ_XB;
constexpr size_t SZ_G = (size_t)NTOK * 512 * 2;
constexpr size_t OFF_W = OFF_G + SZ_G;
constexpr size_t WS_NEED_NAIVE = OFF_W;

__host__ __device__ __forceinline__ unsigned f2bf(float f) { unsigned u = __builtin_bit_cast(unsigned, f); return (u + 0x7fffu + ((u >> 16) & 1u)) >> 16; }
__host__ __device__ __forceinline__ float bf2f(bf16_t b) { return __builtin_bit_cast(float, (unsigned)b << 16); }
namespace pg8 {
#define PG8_LAS __attribute__((address_space(3)))
typedef short bf16x8 __attribute__((ext_vector_type(8)));
typedef float f32x4 __attribute__((ext_vector_type(4)));
typedef unsigned u32x4 __attribute__((ext_vector_type(4)));
typedef unsigned u32x2 __attribute__((ext_vector_type(2)));
constexpr int BM = 256, BK = 64, HALF = 128, HTB = HALF * BK * 2  , STAGE_BYTES = 8 * HTB, NXCD = 8, WGM = 8;

__host__ __device__ __forceinline__ int lds_byte(int r, int c) { const int st = (r >> 4) * 2 + (c >> 5), rr = r & 15, cc = c & 31, ob = rr * 64 + cc * 2; return st * 1024 + (ob ^ (((ob >> 9) & 1) << 5)); }
__host__ __device__ __forceinline__ void stage_rc(int b, int& R, int& C) { const int st = b / 1024, sb = b % 1024, swz = sb ^ (((sb >> 9) & 1) << 5); R = (st >> 1) * 16 + swz / 64; C = (st & 1) * 32 + (swz % 64) / 2; }
__host__ __device__ __forceinline__ int perm32(int rho) { const int n = rho >> 4, i = rho & 15; return 8 * (i >> 2) + 4 * n + (i & 3); }

struct Unit { int pm, pn, bz; };
struct Gemm { const bf16_t* A; const bf16_t* Bt; int lda, ldb, K; size_t a_bz, b_bz; };

struct StaticOrder {
    int nM, nN, nwg, G, c;
    __host__ __device__ void init(int M, int N, int G_, int c_) { nM = M / BM; nN = N / BM; nwg = nM * nN; G = G_; c = c_; }
    __host__ __device__ bool next(int i, Unit& u) const {
        const long L = (long)i * G + c; if (L >= nwg) return false;
        int wgid = (int)L; { const int q = nwg / NXCD, r = nwg % NXCD, xcd = wgid % NXCD, off = wgid / NXCD; wgid = (xcd < r ? xcd * (q + 1) : r * (q + 1) + (xcd - r) * q) + off; }
        const int nig = WGM * nN, gid = wgid / nig, fm = gid * WGM, gsz = (nM - fm) < WGM ? (nM - fm) : WGM;
        u.pm = fm + ((wgid % nig) % gsz); u.pn = (wgid % nig) / gsz; u.bz = 0; return true;
    }
};
struct BatchOrder {
    int nM, nwg, G, c;
    __host__ __device__ void init(int nM_, int nBatch, int G_, int c_) { nM = nM_; nwg = nM_ * nBatch; G = G_; c = c_; }
    __host__ __device__ bool next(int i, Unit& u) const {
        const long L = (long)i * G + c; if (L >= nwg) return false;
        u.bz = (int)L >> 2; u.pm = (int)L & 3; u.pn = 0; return true;
    }
};

__device__ __forceinline__ unsigned cvt_pk_bf16(float lo, float hi) { unsigned r; asm volatile("v_cvt_pk_bf16_f32 %0, %1, %2" : "=v"(r) : "v"(lo), "v"(hi)); return r; }
__device__ __forceinline__ u32x4 pack8(const f32x4 v0, const f32x4 v1) { u32x4 w; w.x = cvt_pk_bf16(v0[0], v0[1]); w.y = cvt_pk_bf16(v0[2], v0[3]); w.z = cvt_pk_bf16(v1[0], v1[1]); w.w = cvt_pk_bf16(v1[2], v1[3]); return w; }
__device__ __forceinline__ float bfl(unsigned w) { return __builtin_bit_cast(float, w << 16); }
__device__ __forceinline__ float bfh(unsigned w) { return __builtin_bit_cast(float, w & 0xffff0000u); }


struct EpiInProj {
    static constexpr bool PERM = true, AFTER_DRAIN = false;
    const float* sspart; bf16_t* proj; bf16_t* xag;
    __device__ __forceinline__ void operator()(const f32x4 (&acc)[2][2][4][2], const Unit& u, int wr, int wc, int fr, int fq) const {
        const int row0 = u.pm * BM + wr * 64 + fr, colt = u.pn * BM + wc * 32 + 8 * fq;
#pragma unroll
        for (int ai = 0; ai < 2; ++ai)
#pragma unroll
            for (int m = 0; m < 4; ++m) {
                const int row = row0 + ai * HALF + m * 16;
                const f32x4* sp = (const f32x4*)(sspart + (size_t)row * 16);
                const f32x4 s0 = sp[0], s1 = sp[1], s2 = sp[2], s3 = sp[3];
                const float ss = (((s0[0] + s0[1]) + (s0[2] + s0[3])) + ((s1[0] + s1[1]) + (s1[2] + s1[3]))) + (((s2[0] + s2[1]) + (s2[2] + s2[3])) + ((s3[0] + s3[1]) + (s3[2] + s3[3])));
                const float rinv = rsqrtf(ss * (1.0f / DM) + RMS_EPS);
#pragma unroll
                for (int bj = 0; bj < 2; ++bj) {
                    const int col = colt + bj * HALF;
                    const u32x4 w = pack8(acc[ai][bj][m][0] * rinv, acc[ai][bj][m][1] * rinv);
                    bf16_t* dst = (u.pn < 2) ? xag + ((size_t)(col >> 4) * NCHUNK_TOT + (row >> 4)) * 512 + (row & 15) * 16 + (col & 15)
                                             : proj + (size_t)row * PLD + (col - 512);
                    *(u32x4*)dst = w;
                }
                asm volatile("" ::: "memory");
            }
    }
};
struct EpiE {
    static constexpr bool PERM = true, AFTER_DRAIN = false;
    float* E;
    __device__ __forceinline__ void operator()(const f32x4 (&acc)[2][2][4][2], const Unit& u, int wr, int wc, int fr, int fq) const {
        const int row0 = u.pm * BM + wr * 64 + fr, colt = wc * 32 + 8 * fq;
#pragma unroll
        for (int ai = 0; ai < 2; ++ai)
#pragma unroll
            for (int m = 0; m < 4; ++m) {
                float* rp = E + ((size_t)u.bz * NCHUNK_TOT + row0 + ai * HALF + m * 16) * 256 + colt;
#pragma unroll
                for (int bj = 0; bj < 2; ++bj) { *(f32x4*)(rp + bj * HALF) = acc[ai][bj][m][0]; *(f32x4*)(rp + bj * HALF + 4) = acc[ai][bj][m][1]; }
                asm volatile("" ::: "memory");
            }
    }
};
struct EpiY {
    static constexpr bool PERM = true, AFTER_DRAIN = false;
    bf16_t* G;
    __device__ __forceinline__ static float gelu(float y) {
        const float a = 0.7978845608028654f * (y + 0.044715f * y * y * y);
        return y * __builtin_amdgcn_rcpf(1.0f + __builtin_amdgcn_exp2f(-2.885390081777927f * a));
    }
    __device__ __forceinline__ void operator()(const f32x4 (&acc)[2][2][4][2], const Unit& u, int wr, int wc, int fr, int fq) const {
        const int row0 = u.pm * BM + wr * 64 + fr, colt = wc * 32 + 8 * fq;
#pragma unroll
        for (int ai = 0; ai < 2; ++ai)
#pragma unroll
            for (int m = 0; m < 4; ++m) {
                const int n = row0 + ai * HALF + m * 16;
#pragma unroll
                for (int bj = 0; bj < 2; ++bj) {
                    const int col = colt + bj * HALF, t = col >> 4, c0 = col & 15;
                    f32x4 v0 = acc[ai][bj][m][0], v1 = acc[ai][bj][m][1];
#pragma unroll
                    for (int e = 0; e < 4; ++e) { v0[e] = gelu(v0[e]); v1[e] = gelu(v1[e]); }
                    *(u32x4*)(G + ((size_t)n * 16 + t) * 512 + u.bz * 16 + c0) = pack8(v0, v1);
                }
                asm volatile("" ::: "memory");
            }
    }
};
struct EpiGlu {
    static constexpr bool PERM = true, AFTER_DRAIN = false;
    const bf16_t* G; const float* bias; bf16_t* proj;
    __device__ __forceinline__ static float sig(float v) { return __builtin_amdgcn_rcpf(1.0f + __builtin_amdgcn_exp2f(-1.4426950408889634f * v)); }
    __device__ __forceinline__ void operator()(const f32x4 (&acc)[2][2][4][2], const Unit& u, int wr, int wc, int fr, int fq) const {
        const int row0 = u.pm * BM + wr * 64 + fr, colt = u.pn * BM + wc * 32 + 8 * fq;
#pragma unroll
        for (int bj = 0; bj < 2; ++bj) {
            const int col = colt + bj * HALF;
            const f32x4 b0 = *(const f32x4*)(bias + col), b1 = *(const f32x4*)(bias + col + 4);
#pragma unroll
            for (int ai = 0; ai < 2; ++ai)
#pragma unroll
                for (int m = 0; m < 4; ++m) {
                    const int row = row0 + ai * HALF + m * 16;
                    const u32x4 gg = *(const u32x4*)(G + (size_t)row * 512 + col);
                    bf16_t* zp = proj + (size_t)row * PLD + PC_ZA + col;
                    const u32x4 zz = *(const u32x4*)zp;
                    const f32x4 a0 = acc[ai][bj][m][0] + b0, a1 = acc[ai][bj][m][1] + b1;
                    f32x4 o0, o1;
#pragma unroll
                    for (int e = 0; e < 4; ++e) {
                        const unsigned gw0 = gg[e >> 1], zw0 = zz[e >> 1], gw1 = gg[2 + (e >> 1)], zw1 = zz[2 + (e >> 1)];
                        const float g0 = (e & 1) ? bfh(gw0) : bfl(gw0), z0 = (e & 1) ? bfh(zw0) : bfl(zw0);
                        const float g1 = (e & 1) ? bfh(gw1) : bfl(gw1), z1 = (e & 1) ? bfh(zw1) : bfl(zw1);
                        o0[e] = g0 * sig(a0[e]) * (z0 * sig(z0)); o1[e] = g1 * sig(a1[e]) * (z1 * sig(z1));
                    }
                    *(u32x4*)zp = pack8(o0, o1);
                    asm volatile("" ::: "memory");
                }
        }
    }
};
struct EpiOutProj {
    static constexpr bool PERM = true, AFTER_DRAIN = false;
    const float* xold; float* xout; bf16_t* xb; float* sspart; int write_xb;
    __device__ __forceinline__ void operator()(const f32x4 (&acc)[2][2][4][2], const Unit& u, int wr, int wc, int fr, int fq) const {
        const int row0 = u.pm * BM + wr * 64 + fr, colt = u.pn * BM + wc * 32 + 8 * fq;
#pragma unroll
        for (int ai = 0; ai < 2; ++ai)
#pragma unroll
            for (int m = 0; m < 4; ++m) {
                const int row = row0 + ai * HALF + m * 16;
                float ssl = 0.f;
#pragma unroll
                for (int bj = 0; bj < 2; ++bj) {
                    const size_t off = (size_t)row * DM + colt + bj * HALF;
                    const f32x4 n0 = *(const f32x4*)(xold + off) + acc[ai][bj][m][0], n1 = *(const f32x4*)(xold + off + 4) + acc[ai][bj][m][1];
                    *(f32x4*)(xout + off) = n0; *(f32x4*)(xout + off + 4) = n1;
                    if (write_xb) *(u32x4*)(xb + off) = pack8(n0, n1);
                    ssl += ((n0[0] * n0[0] + n0[1] * n0[1]) + (n0[2] * n0[2] + n0[3] * n0[3])) + ((n1[0] * n1[0] + n1[1] * n1[1]) + (n1[2] * n1[2] + n1[3] * n1[3]));
                }
                ssl += __shfl_xor(ssl, 16); ssl += __shfl_xor(ssl, 32);
                if (fq == 0) sspart[(size_t)row * 16 + u.pn * 4 + wc] = ssl;
                asm volatile("" ::: "memory");
            }
    }
};

template <class Epi, class Sched, bool ALIGN_EPI = true>
__device__ __forceinline__ void gemm_phase(PG8_LAS unsigned char* lds, const Gemm g, const Sched& S, const Epi& E) {
    int tid = threadIdx.x; asm volatile("" : "+v"(tid));
    const int wid = __builtin_amdgcn_readfirstlane(tid >> 6), lane = tid & 63, wr = wid >> 2, wc = wid & 3, fr = lane & 15, fq = lane >> 4;
    int K = g.K; asm volatile("" : "+s"(K));
    const int nt = K / BK;
    unsigned voffA[2], voffB[2];
#pragma unroll
    for (int i = 0; i < 2; ++i) { int R, C; stage_rc(tid * 16 + i * 8192, R, C); const int Rb = Epi::PERM ? ((R & ~31) + perm32(R & 31)) : R;
        voffA[i] = (unsigned)(R * g.lda + C) * 2u; voffB[i] = (unsigned)(Rb * g.ldb + C) * 2u; }
    const size_t kstep = (size_t)(BK * 2);
    const size_t hstepA = (size_t)HALF * g.lda * 2, hstepB = (size_t)HALF * g.ldb * 2;
    const unsigned ldsw = (unsigned)wid * 1024u;
    const int aoff = lds_byte(wr * 64 + fr, fq * 8), boff = lds_byte(wc * 32 + fr, fq * 8);
#define PG8_SA(b, h) (((b) * 2 + (h)) * HTB)
#define PG8_SB(b, h) ((4 + (b) * 2 + (h)) * HTB)
#define PG8_STAGE(bufoff, gbase, voff) do { _Pragma("unroll") for (int _i = 0; _i < 2; ++_i) \
        __builtin_amdgcn_global_load_lds((const unsigned*)((const char*)(gbase) + (voff)[_i]), (PG8_LAS unsigned*)(lds + (bufoff) + ldsw + _i * 8192), 16, 0, 0); } while (0)
#define PG8_LDA(dst, b, h) do { _Pragma("unroll") for (int m = 0; m < 4; ++m) _Pragma("unroll") for (int k = 0; k < 2; ++k) dst[m][k] = *(const PG8_LAS bf16x8*)(lds + PG8_SA(b, h) + aoff + m * 2048 + k * 1024); } while (0)
#define PG8_LDB(dst, b, h) do { _Pragma("unroll") for (int n = 0; n < 2; ++n) _Pragma("unroll") for (int k = 0; k < 2; ++k) dst[n][k] = *(const PG8_LAS bf16x8*)(lds + PG8_SB(b, h) + boff + n * 2048 + k * 1024); } while (0)
#define PG8_MMA(ai, bj, At, Bt) do { __builtin_amdgcn_s_setprio(1); _Pragma("unroll") for (int m = 0; m < 4; ++m) _Pragma("unroll") for (int n = 0; n < 2; ++n) _Pragma("unroll") for (int k = 0; k < 2; ++k) \
        acc[ai][bj][m][n] = __builtin_amdgcn_mfma_f32_16x16x32_bf16(Bt[n][k], At[m][k], acc[ai][bj][m][n], 0, 0, 0); __builtin_amdgcn_s_setprio(0); } while (0)
#define PG8_WAIT_V(n) asm volatile("s_waitcnt vmcnt(" #n ")" ::: "memory")
#define PG8_WAIT_L(n) asm volatile("s_waitcnt lgkmcnt(" #n ")" ::: "memory")
#define PG8_BAR __builtin_amdgcn_s_barrier()
#define PG8_SCHED __builtin_amdgcn_sched_barrier(0)
#define PG8_ABASE(u) ((const char*)g.A + ((size_t)(u).bz * g.a_bz + (size_t)(u).pm * BM * g.lda) * 2)
#define PG8_BBASE(u) ((const char*)g.Bt + ((size_t)(u).bz * g.b_bz + (size_t)(u).pn * BM * g.ldb) * 2)
    Unit cur, nxt; int ui = 0;
    if (!S.next(0, cur)) return;
    f32x4 acc[2][2][4][2];
#pragma unroll
    for (int a = 0; a < 2; ++a)
#pragma unroll
        for (int b = 0; b < 2; ++b)
#pragma unroll
            for (int m = 0; m < 4; ++m)
#pragma unroll
                for (int n = 0; n < 2; ++n) acc[a][b][m][n] = (f32x4){0.f, 0.f, 0.f, 0.f};
    bf16x8 At[4][2], B0[2][2], B1[2][2];
    const char* cA = PG8_ABASE(cur); const char* cB = PG8_BBASE(cur);
    PG8_STAGE(PG8_SB(0, 0), cB, voffB); PG8_STAGE(PG8_SB(0, 1), cB + hstepB, voffB); PG8_STAGE(PG8_SA(0, 0), cA, voffA); PG8_STAGE(PG8_SA(0, 1), cA + hstepA, voffA);
    if (wr == 1) PG8_BAR;
    PG8_WAIT_V(2); PG8_BAR;
    PG8_STAGE(PG8_SB(1, 0), cB + kstep, voffB); PG8_STAGE(PG8_SA(1, 0), cA + kstep, voffA); PG8_STAGE(PG8_SB(1, 1), cB + hstepB + kstep, voffB);
    PG8_WAIT_V(6); PG8_BAR;
    for (;;) {
        const bool has_next = S.next(ui + 1, nxt);
        const char* nA = has_next ? PG8_ABASE(nxt) : cA; const char* nB = has_next ? PG8_BBASE(nxt) : cB;
        for (int t = 0; t < nt; t += 2) {
            const bool last = (t == nt - 2);
            const char* a1 = cA + (size_t)(t + 1) * kstep;
            const char* a2 = last ? nA : cA + (size_t)(t + 2) * kstep; const char* b2 = last ? nB : cB + (size_t)(t + 2) * kstep;
            const char* a3 = a2 + kstep; const char* b3 = b2 + kstep;
            PG8_LDB(B0, 0, 0); PG8_LDB(B1, 0, 1); PG8_SCHED; PG8_LDA(At, 0, 0); PG8_STAGE(PG8_SA(1, 1), a1 + hstepA, voffA);
            PG8_WAIT_V(8); PG8_WAIT_L(0); PG8_BAR; PG8_MMA(0, 0, At, B0); PG8_MMA(0, 1, At, B1); PG8_BAR; PG8_SCHED;
            PG8_LDA(At, 0, 1); PG8_STAGE(PG8_SB(0, 0), b2, voffB); PG8_STAGE(PG8_SB(0, 1), b2 + hstepB, voffB); PG8_STAGE(PG8_SA(0, 0), a2, voffA);
            PG8_WAIT_V(8); PG8_WAIT_L(0); PG8_BAR; PG8_MMA(1, 0, At, B0); PG8_MMA(1, 1, At, B1); PG8_BAR; PG8_SCHED;
            PG8_LDB(B0, 1, 0); PG8_LDB(B1, 1, 1); PG8_SCHED; PG8_LDA(At, 1, 0); PG8_STAGE(PG8_SA(0, 1), a2 + hstepA, voffA);
            PG8_WAIT_V(8); PG8_WAIT_L(0); PG8_BAR; PG8_MMA(0, 0, At, B0); PG8_MMA(0, 1, At, B1); PG8_BAR; PG8_SCHED;
            PG8_LDA(At, 1, 1); PG8_STAGE(PG8_SB(1, 0), b3, voffB); PG8_STAGE(PG8_SB(1, 1), b3 + hstepB, voffB); PG8_STAGE(PG8_SA(1, 0), a3, voffA);
            PG8_WAIT_V(8); PG8_WAIT_L(0); PG8_BAR; PG8_MMA(1, 0, At, B0); PG8_MMA(1, 1, At, B1); PG8_BAR; PG8_SCHED;
        }
        if constexpr (ALIGN_EPI) { if (wr == 0) PG8_BAR; }
        E(acc, cur, wr, wc, fr, fq);
        if (!has_next) break;
#pragma unroll
        for (int a = 0; a < 2; ++a)
#pragma unroll
            for (int b = 0; b < 2; ++b)
#pragma unroll
                for (int m = 0; m < 4; ++m)
#pragma unroll
                    for (int n = 0; n < 2; ++n) acc[a][b][m][n] = (f32x4){0.f, 0.f, 0.f, 0.f};
        cur = nxt; cA = nA; cB = nB; ++ui;
        if constexpr (ALIGN_EPI) { if (wr == 1) PG8_BAR; }
    }
    PG8_WAIT_V(0);
    if constexpr (!ALIGN_EPI) { if (wr == 0) PG8_BAR; }
    PG8_BAR;
#undef PG8_SA
#undef PG8_SB
#undef PG8_STAGE
#undef PG8_LDA
#undef PG8_LDB
#undef PG8_MMA
#undef PG8_WAIT_V
#undef PG8_WAIT_L
#undef PG8_BAR
#undef PG8_SCHED
#undef PG8_ABASE
#undef PG8_BBASE
}
}
namespace att {
#define LAS __attribute__((address_space(3)))
typedef short bf16x8 __attribute__((ext_vector_type(8)));
typedef short s16x4 __attribute__((ext_vector_type(4)));
typedef float f32x4 __attribute__((ext_vector_type(4)));
typedef unsigned u32x4 __attribute__((ext_vector_type(4)));
typedef unsigned u32x2 __attribute__((ext_vector_type(2)));
typedef float f32x2_t __attribute__((ext_vector_type(2)));
typedef __bf16 bf16x2_t __attribute__((ext_vector_type(2)));
constexpr int VROW = 160;
constexpr int VTILE = 32 * VROW;
constexpr int WAVE_LDS = 2 * VTILE;
constexpr float C2 = 0.125f * 1.4426950408889634f;
constexpr float NEG = -1e30f, MFLOOR = -1e20f, THR = 8.0f;
constexpr int TBW = 640, TBOFF = 240;
constexpr int T5TB_F = 8 * 3 * TBW, T5S_F = 8 * 4 * TBW, RPBS_F = 2 * 4 * 8 * 15 * 64;

__device__ __forceinline__ unsigned cvtpk(float lo, float hi) { f32x2_t v = {lo, hi}; bf16x2_t b = __builtin_convertvector(v, bf16x2_t); return __builtin_bit_cast(unsigned, b); }
__device__ __forceinline__ s16x4 vtr(LAS const char* p) { typedef short v4i16_t __attribute__((ext_vector_type(4))); return __builtin_bit_cast(s16x4, __builtin_amdgcn_ds_read_tr16_b64_v4i16((LAS v4i16_t*)p)); }

__device__ __forceinline__ float max3f(float a, float b, float c) { float r; asm("v_max3_f32 %0, %1, %2, %3" : "=v"(r) : "v"(a), "v"(b), "v"(c)); return r; }
__device__ __forceinline__ float max2f(float a, float b) { float r; asm("v_max_f32_e32 %0, %1, %2" : "=v"(r) : "v"(a), "v"(b)); return r; }
struct State { float m, l; f32x4 acc[4]; };
struct Stage { bf16x8 k00, k01, k10, k11; u32x4 v0, v1, v2, v3; };
struct Bias { f32x4 b0, b1; };

__device__ __forceinline__ void softmax_pv(State& st, f32x4 t0, f32x4 t1, LAS const char* vt, int lane) {
    const float mloc = max2f(max3f(max3f(t0[0], t0[1], t0[2]), t0[3], t1[0]), max3f(t1[1], t1[2], t1[3]));
    if (__builtin_amdgcn_ballot_w64(mloc > st.m + THR) != 0ull) {
        float mx = max2f(mloc, __shfl_xor(mloc, 16)); mx = max2f(mx, __shfl_xor(mx, 32));
        const float mn = max2f(st.m, mx);
        const float alpha = __builtin_amdgcn_exp2f(st.m - mn);
        st.m = mn; st.l *= alpha;
#pragma unroll
        for (int mt = 0; mt < 4; ++mt) st.acc[mt] = st.acc[mt] * alpha;
    }
    const float mn = st.m;
    f32x4 p0, p1;
#pragma unroll
    for (int e = 0; e < 4; ++e) { p0[e] = __builtin_amdgcn_exp2f(t0[e] - mn); p1[e] = __builtin_amdgcn_exp2f(t1[e] - mn); }
    st.l += (((p0[0] + p0[1]) + (p0[2] + p0[3])) + ((p1[0] + p1[1]) + (p1[2] + p1[3])));
    u32x4 pw; pw.x = cvtpk(p0[0], p0[1]); pw.y = cvtpk(p0[2], p0[3]); pw.z = cvtpk(p1[0], p1[1]); pw.w = cvtpk(p1[2], p1[3]);
    const bf16x8 pb = __builtin_bit_cast(bf16x8, pw);
    const int g = lane >> 4, qq = (lane & 15) >> 2, pp = lane & 3;
    LAS const char* vb = vt + (4 * g + qq) * VROW + pp * 8;
#pragma unroll
    for (int mt = 0; mt < 4; ++mt) {
        const s16x4 lo = vtr(vb + mt * 32), hi = vtr(vb + 16 * VROW + mt * 32);
        const bf16x8 av = (bf16x8){lo[0], lo[1], lo[2], lo[3], hi[0], hi[1], hi[2], hi[3]};
        st.acc[mt] = __builtin_amdgcn_mfma_f32_16x16x32_bf16(av, pb, st.acc[mt], 0, 0, 0);
    }
}
__device__ __forceinline__ void write_v(const Stage& s, LAS char* vt, int lane) {
    LAS char* vw = vt + (lane >> 1) * VROW + (lane & 1) * 64;
    *(LAS u32x4*)vw = s.v0; *(LAS u32x4*)(vw + 16) = s.v1; *(LAS u32x4*)(vw + 32) = s.v2; *(LAS u32x4*)(vw + 48) = s.v3;
}
__device__ __forceinline__ void qk(const Stage& s, const Bias& bs, bf16x8 bq0, bf16x8 bq1, f32x4& t0, f32x4& t1) {
    f32x4 s0 = (f32x4){0.f, 0.f, 0.f, 0.f}, s1 = s0;
    s0 = __builtin_amdgcn_mfma_f32_16x16x32_bf16(s.k00, bq0, s0, 0, 0, 0); s0 = __builtin_amdgcn_mfma_f32_16x16x32_bf16(s.k01, bq1, s0, 0, 0, 0);
    s1 = __builtin_amdgcn_mfma_f32_16x16x32_bf16(s.k10, bq0, s1, 0, 0, 0); s1 = __builtin_amdgcn_mfma_f32_16x16x32_bf16(s.k11, bq1, s1, 0, 0, 0);
    t0 = s0 * C2 + bs.b0; t1 = s1 * C2 + bs.b1;
}

__device__ __forceinline__ void finish(State& st, bf16_t* outp  , const bf16_t* zp, int lane) {
    float l = st.l; l += __shfl_xor(l, 16); l += __shfl_xor(l, 32);
    const float rl = 1.0f / l;
    const int g = lane >> 4;
#pragma unroll
    for (int mt = 0; mt < 4; ++mt) {
        const u32x2 zz = *(const u32x2*)(zp + mt * 16 + 4 * g);
        float o[4];
#pragma unroll
        for (int e = 0; e < 4; ++e) {
            const unsigned zw = zz[e >> 1]; const float z = (e & 1) ? __builtin_bit_cast(float, zw & 0xffff0000u) : __builtin_bit_cast(float, zw << 16);
            const float sz = z * __builtin_amdgcn_rcpf(1.0f + __builtin_amdgcn_exp2f(-1.4426950408889634f * z));
            o[e] = st.acc[mt][e] * rl * sz;
        }
        u32x2 w; w.x = cvtpk(o[0], o[1]); w.y = cvtpk(o[2], o[3]);
        *(u32x2*)(outp + mt * 16 + 4 * g) = w;
    }
}

template <int V = 0>
__device__ __forceinline__ void dil_task(bf16_t* proj, const float* tbl, int task, LAS char* vbuf, int lane, bf16_t* dry = nullptr) {
    const int r = task & 15, qb = (task >> 4) & 15, h = (task >> 8) & 7, b = task >> 11;
    const int q = lane & 15, g = lane >> 4;
    const int qr = qb * 256 + r;
    bf16_t* pb_ = proj + (size_t)b * SEQ * PLD;
    const bf16_t* qp = pb_ + (size_t)(qr + 16 * q) * PLD + PC_QC + h * 64 + g * 8;
    const bf16x8 bq0 = *(const bf16x8*)qp, bq1 = *(const bf16x8*)(qp + 32);
    const char* kbase = (const char*)(pb_ + PC_KC + h * 64);
    const char* vbase = (const char*)(pb_ + PC_VC + h * 64);
    const unsigned klane = (unsigned)g * 16u, vlane = (unsigned)(lane & 1) * 64u;
    const int sv = lane >> 1;
    State st; st.m = MFLOOR; st.l = 0.f;
#pragma unroll
    for (int mt = 0; mt < 4; ++mt) st.acc[mt] = (f32x4){0.f, 0.f, 0.f, 0.f};
    const float* tb0 = tbl + T5TB_F + ((size_t)h * 4 + (q & 3)) * TBW + TBOFF + 4 * g - (q & ~3);
    const float* tb1 = tbl + ((size_t)h * 3 + 1) * TBW + TBOFF + 4 * g - 4 * q;
    const float* tb2 = tbl + ((size_t)h * 3 + 2) * TBW + TBOFF + 4 * g - 16 * q;

#define DIL_PARAMS(ks, d, pat, ul0) const int pat = ((ks) >= 5) + ((ks) >= 11), d = 16 >> (2 * pat), ul0 = ((ks) - (5 * pat + (pat >> 1))) * 32;
    auto issue = [&](int ks, Stage& s) {
        if (V == 1 && ks > 2) return;
        DIL_PARAMS(ks, d, pat, ul0);
        const int pbase = qr + d * (ul0 - 64);
        int p0 = pbase + d * q, p1 = p0 + 16 * d, pv = pbase + d * sv;
        p0 = p0 < 0 ? 0 : (p0 > SEQ - 1 ? SEQ - 1 : p0); p1 = p1 < 0 ? 0 : (p1 > SEQ - 1 ? SEQ - 1 : p1); pv = pv < 0 ? 0 : (pv > SEQ - 1 ? SEQ - 1 : pv);
        const char* ka = kbase + ((unsigned)p0 * (unsigned)(PLD * 2) + klane); const char* kb = kbase + ((unsigned)p1 * (unsigned)(PLD * 2) + klane);
        const char* va = vbase + ((unsigned)pv * (unsigned)(PLD * 2) + vlane);
        if (V != 4 && V != 5) { s.k00 = *(const bf16x8*)ka; s.k01 = *(const bf16x8*)(ka + 64); s.k10 = *(const bf16x8*)kb; s.k11 = *(const bf16x8*)(kb + 64); }
        if (V != 3 && V != 5) { s.v0 = *(const u32x4*)va; s.v1 = *(const u32x4*)(va + 16); s.v2 = *(const u32x4*)(va + 32); s.v3 = *(const u32x4*)(va + 48); }
    };
    auto issue_b = [&](int ks, Bias& bs) {
        if (V == 1 && ks > 1) return;
        if (V == 3 || V == 4) return;
        DIL_PARAMS(ks, d, pat, ul0); (void)d;
        const float* tp = (pat == 0 ? tb0 : (pat == 1 ? tb1 : tb2)) + ul0;
        bs.b0 = *(const f32x4*)tp; bs.b1 = *(const f32x4*)(tp + 16);
    };
    auto compute = [&](int ks, const Stage& s, const Bias& bs) {
        if (V == 3) { asm volatile("" :: "v"(s.k00), "v"(s.k01), "v"(s.k10), "v"(s.k11)); return; }
        if (V == 4) { asm volatile("" :: "v"(s.v0), "v"(s.v1), "v"(s.v2), "v"(s.v3)); return; }
        if (V == 5) { asm volatile("" :: "v"(bs.b0), "v"(bs.b1)); return; }
        if (V == 2) { asm volatile("" :: "v"(s.k00), "v"(s.k01), "v"(s.k10), "v"(s.k11), "v"(s.v0), "v"(s.v1), "v"(s.v2), "v"(s.v3), "v"(bs.b0), "v"(bs.b1)); return; }
        LAS char* vt = vbuf + (ks & 1) * VTILE;
        write_v(s, vt, lane);
        f32x4 t0, t1; qk(s, bs, bq0, bq1, t0, t1);
        {
            DIL_PARAMS(ks, d, pat, ul0); (void)pat;
            const int pbase = qr + d * (ul0 - 64);
            if (pbase < 0 || pbase + 31 * d > SEQ - 1) {
                const int pk = pbase + d * 4 * g;
#pragma unroll
                for (int x = 0; x < 4; ++x) { if ((unsigned)(pk + d * x) >= (unsigned)SEQ) t0[x] = NEG; if ((unsigned)(pk + d * (16 + x)) >= (unsigned)SEQ) t1[x] = NEG; }
            }
        }
        softmax_pv(st, t0, t1, vt, lane);
    };
    Stage A, B, C, D;
    Bias X, Y;
    issue(0, A); issue(1, B); issue(2, C); issue_b(0, X);
#pragma unroll 1
    for (int ks = 0; ks < 20; ks += 4) {
        issue(ks + 3, D); issue_b(ks + 1, Y); compute(ks, A, X);
        issue(ks + 4, A); issue_b(ks + 2, X); compute(ks + 1, B, Y);
        issue(ks + 5, B); issue_b(ks + 3, Y); compute(ks + 2, C, X);
        issue(ks + 6, C); issue_b(ks + 4, X); compute(ks + 3, D, Y);
    }
    issue_b(21, Y); compute(20, A, X); issue_b(22, X); compute(21, B, Y); compute(22, C, X);
#undef DIL_PARAMS
    bf16_t* outp = dry ? dry + ((size_t)task * 16 + q) * 64 : pb_ + (size_t)(qr + 16 * q) * PLD + PC_QC + h * 64;
    finish(st, outp, pb_ + (size_t)(qr + 16 * q) * PLD + PC_ZC + h * 64, lane);
}

__device__ __forceinline__ void na_task(bf16_t* proj, const float* rpbs, int task, LAS char* vbuf, int lane, bf16_t* dry = nullptr) {
    const int jt = task & 3, r = (task >> 2) & 63, h = (task >> 8) & 7, b = task >> 11;
    const int q = lane & 15, g = lane >> 4;
    const int j0 = 16 * jt, j = j0 + q;
    int w0 = j0 - 8; w0 = w0 < 0 ? 0 : (w0 > 32 ? 32 : w0);
    int rs = r - 4; rs = rs < 0 ? 0 : (rs > 56 ? 56 : rs);
    int cs = j - 8; cs = cs < 0 ? 0 : (cs > 48 ? 48 : cs);
    bf16_t* pb_ = proj + (size_t)b * SEQ * PLD;
    const size_t tq = (size_t)(r * 64 + j);
    const bf16_t* qp = pb_ + tq * PLD + PC_QB + h * 64 + g * 8;
    const bf16x8 bq0 = *(const bf16x8*)qp, bq1 = *(const bf16x8*)(qp + 32);
    const char* kbase = (const char*)(pb_ + (size_t)(rs * 64 + w0) * PLD + PC_KB + h * 64);
    const char* vbase = (const char*)(pb_ + (size_t)(rs * 64 + w0) * PLD + PC_VB + h * 64);
    const int sv = lane >> 1;
    const unsigned koff = (unsigned)q * (unsigned)(PLD * 2) + (unsigned)g * 16u, voff = (unsigned)sv * (unsigned)(PLD * 2) + (unsigned)(lane & 1) * 64u;
    const int col = w0 - j + 32, c4 = col & 3;
    const float* tb = rpbs + (((size_t)c4 * 8 + h) * 15 + (rs - r + 7)) * 64 + (col - c4) + 4 * g;
    State st; st.m = MFLOOR; st.l = 0.f;
#pragma unroll
    for (int mt = 0; mt < 4; ++mt) st.acc[mt] = (f32x4){0.f, 0.f, 0.f, 0.f};
    const int kc0 = w0 + 4 * g - cs;
    auto issue = [&](int ks, Stage& s) {
        const char* ka = kbase + (size_t)ks * (64 * PLD * 2) + koff; const char* kb = ka + 16 * PLD * 2; const char* va = vbase + (size_t)ks * (64 * PLD * 2) + voff;
        s.k00 = *(const bf16x8*)ka; s.k01 = *(const bf16x8*)(ka + 64); s.k10 = *(const bf16x8*)kb; s.k11 = *(const bf16x8*)(kb + 64);
        s.v0 = *(const u32x4*)va; s.v1 = *(const u32x4*)(va + 16); s.v2 = *(const u32x4*)(va + 32); s.v3 = *(const u32x4*)(va + 48);
    };
    auto issue_b = [&](int ks, Bias& bs) { const float* tp = tb + ks * 64; bs.b0 = *(const f32x4*)tp; bs.b1 = *(const f32x4*)(tp + 16); };
    auto compute = [&](int ks, const Stage& s, const Bias& bs) {
        LAS char* vt = vbuf + (ks & 1) * VTILE;
        write_v(s, vt, lane);
        f32x4 t0, t1; qk(s, bs, bq0, bq1, t0, t1);
#pragma unroll
        for (int x = 0; x < 4; ++x) { if ((unsigned)(kc0 + x) >= 16u) t0[x] = NEG; if ((unsigned)(kc0 + 16 + x) >= 16u) t1[x] = NEG; }
        softmax_pv(st, t0, t1, vt, lane);
    };
    Stage A, B, C, D;
    Bias X, Y;
    issue(0, A); issue(1, B); issue(2, C); issue_b(0, X);
    issue(3, D); issue_b(1, Y); compute(0, A, X);
    issue(4, A); issue_b(2, X); compute(1, B, Y);
    issue(5, B); issue_b(3, Y); compute(2, C, X);
    issue(6, C); issue_b(4, X); compute(3, D, Y);
    issue(7, D); issue_b(5, Y); compute(4, A, X);
    issue_b(6, X); compute(5, B, Y); issue_b(7, Y); compute(6, C, X); compute(7, D, Y);
    finish(st, dry ? dry + ((size_t)task * 16 + q) * 64 : pb_ + tq * PLD + PC_QB + h * 64, pb_ + tq * PLD + PC_ZB + h * 64, lane);
}

constexpr int NA_IMG = 480 * 128;
__device__ __forceinline__ int fK(int kidx) { return (kidx >> 1) & 7; }
__device__ __forceinline__ int fV(int kidx) { return ((kidx >> 1) & 3) * 2; }
__device__ __forceinline__ void na_block_task(bf16_t* proj, const float* rpbs, int bt, LAS char* lds, int lane, int wave) {
    const int jt = bt & 3, rb = (bt >> 2) & 7, h = (bt >> 5) & 7, b = bt >> 8;
    const int r0 = 8 * rb, j0 = 16 * jt;
    int w0 = j0 - 8; w0 = w0 < 0 ? 0 : (w0 > 32 ? 32 : w0);
    int Rb = r0 - 4; Rb = Rb < 0 ? 0 : Rb;
    int Re = r0 + 3; Re = Re > 56 ? 56 : Re; Re += 8;
    const int nins = (Re - Rb) * 4;
    bf16_t* pb_ = proj + (size_t)b * SEQ * PLD;
    LAS char* Kimg = lds; LAS char* Vimg = lds + NA_IMG;
    {
        const int kl = lane >> 3, c = lane & 7;
        for (int ii = wave; ii < nins; ii += 8) {
            const int key = 8 * ii + kl, rl = key >> 5, col = key & 31;
            const bf16_t* row = pb_ + (size_t)((Rb + rl) * 64 + w0 + col) * PLD + h * 64;
            __builtin_amdgcn_global_load_lds((const unsigned*)(row + PC_KB + ((c ^ fK(key)) * 8)), (LAS unsigned*)(Kimg + ii * 1024), 16, 0, 0);
            __builtin_amdgcn_global_load_lds((const unsigned*)(row + PC_VB + ((c ^ fV(key)) * 8)), (LAS unsigned*)(Vimg + ii * 1024), 16, 0, 0);
        }
    }
    const int q = lane & 15, g = lane >> 4, qq = q >> 2, pp = lane & 3;
    const int r = r0 + wave, j = j0 + q;
    int rs = r - 4; rs = rs < 0 ? 0 : (rs > 56 ? 56 : rs);
    int cs = j - 8; cs = cs < 0 ? 0 : (cs > 48 ? 48 : cs);
    const size_t tq = (size_t)(r * 64 + j);
    const bf16_t* qp = pb_ + tq * PLD + PC_QB + h * 64 + g * 8;
    const bf16x8 bq0 = *(const bf16x8*)qp, bq1 = *(const bf16x8*)(qp + 32);
    const int col = w0 - j + 32, c4 = col & 3;
    const float* tb = rpbs + (((size_t)c4 * 8 + h) * 15 + (rs - r + 7)) * 64 + (col - c4) + 4 * g;
    const int kc0 = w0 + 4 * g - cs;
    State st; st.m = MFLOOR; st.l = 0.f;
#pragma unroll
    for (int mt = 0; mt < 4; ++mt) st.acc[mt] = (f32x4){0.f, 0.f, 0.f, 0.f};
    Bias bs; bs.b0 = *(const f32x4*)tb; bs.b1 = *(const f32x4*)(tb + 16);
    __syncthreads();
    const int kbase = (rs - Rb) * 32;
#pragma unroll 1
    for (int ks = 0; ks < 8; ++ks) {
        Bias nb = bs; if (ks + 1 < 8) { const float* tp = tb + (ks + 1) * 64; nb.b0 = *(const f32x4*)tp; nb.b1 = *(const f32x4*)(tp + 16); }
        const int k0 = kbase + ks * 32 + q, k1 = k0 + 16;
        const bf16x8 a00 = *(LAS const bf16x8*)(Kimg + k0 * 128 + ((g ^ fK(k0)) * 16)), a01 = *(LAS const bf16x8*)(Kimg + k0 * 128 + (((4 + g) ^ fK(k0)) * 16));
        const bf16x8 a10 = *(LAS const bf16x8*)(Kimg + k1 * 128 + ((g ^ fK(k1)) * 16)), a11 = *(LAS const bf16x8*)(Kimg + k1 * 128 + (((4 + g) ^ fK(k1)) * 16));
        f32x4 s0 = (f32x4){0.f, 0.f, 0.f, 0.f}, s1 = s0;
        s0 = __builtin_amdgcn_mfma_f32_16x16x32_bf16(a00, bq0, s0, 0, 0, 0); s0 = __builtin_amdgcn_mfma_f32_16x16x32_bf16(a01, bq1, s0, 0, 0, 0);
        s1 = __builtin_amdgcn_mfma_f32_16x16x32_bf16(a10, bq0, s1, 0, 0, 0); s1 = __builtin_amdgcn_mfma_f32_16x16x32_bf16(a11, bq1, s1, 0, 0, 0);
        f32x4 t0 = s0 * C2 + bs.b0, t1 = s1 * C2 + bs.b1;
#pragma unroll
        for (int x = 0; x < 4; ++x) { if ((unsigned)(kc0 + x) >= 16u) t0[x] = NEG; if ((unsigned)(kc0 + 16 + x) >= 16u) t1[x] = NEG; }
        const float mloc = max2f(max3f(max3f(t0[0], t0[1], t0[2]), t0[3], t1[0]), max3f(t1[1], t1[2], t1[3]));
        if (__builtin_amdgcn_ballot_w64(mloc > st.m + THR) != 0ull) {
            float mx = max2f(mloc, __shfl_xor(mloc, 16)); mx = max2f(mx, __shfl_xor(mx, 32));
            const float mn = max2f(st.m, mx); const float alpha = __builtin_amdgcn_exp2f(st.m - mn);
            st.m = mn; st.l *= alpha;
#pragma unroll
            for (int mt = 0; mt < 4; ++mt) st.acc[mt] = st.acc[mt] * alpha;
        }
        const float mn = st.m; f32x4 p0, p1;
#pragma unroll
        for (int e = 0; e < 4; ++e) { p0[e] = __builtin_amdgcn_exp2f(t0[e] - mn); p1[e] = __builtin_amdgcn_exp2f(t1[e] - mn); }
        st.l += (((p0[0] + p0[1]) + (p0[2] + p0[3])) + ((p1[0] + p1[1]) + (p1[2] + p1[3])));
        u32x4 pw; pw.x = cvtpk(p0[0], p0[1]); pw.y = cvtpk(p0[2], p0[3]); pw.z = cvtpk(p1[0], p1[1]); pw.w = cvtpk(p1[2], p1[3]);
        const bf16x8 pb = __builtin_bit_cast(bf16x8, pw);
        const int v0k = kbase + ks * 32 + 4 * g + qq, v1k = v0k + 16;
        LAS const char* vr0 = Vimg + v0k * 128 + (pp & 1) * 8; LAS const char* vr1 = Vimg + v1k * 128 + (pp & 1) * 8;
        const int f0 = fV(v0k), f1 = fV(v1k), ch = pp >> 1;
#pragma unroll
        for (int mt = 0; mt < 4; ++mt) {
            const s16x4 lo = vtr(vr0 + (((mt * 2 + ch) ^ f0) * 16)), hi = vtr(vr1 + (((mt * 2 + ch) ^ f1) * 16));
            const bf16x8 av = (bf16x8){lo[0], lo[1], lo[2], lo[3], hi[0], hi[1], hi[2], hi[3]};
            st.acc[mt] = __builtin_amdgcn_mfma_f32_16x16x32_bf16(av, pb, st.acc[mt], 0, 0, 0);
        }
        bs = nb;
    }
    finish(st, pb_ + tq * PLD + PC_QB + h * 64, pb_ + tq * PLD + PC_ZB + h * 64, lane);
    __syncthreads();
}
#undef LAS
}
constexpr int NWAVES = 8;
#define GAS __attribute__((address_space(1)))
#define LAS __attribute__((address_space(3)))
typedef unsigned v4u __attribute__((ext_vector_type(4)));
typedef float f32x4 __attribute__((ext_vector_type(4)));
typedef GAS unsigned gu32;
#define RLX_AGENT __ATOMIC_RELAXED, __HIP_MEMORY_SCOPE_AGENT

constexpr size_t SZ_WINT = (size_t)IN_COLS * DM * 2, SZ_WOUTT = (size_t)DM * MIXW * 2, SZ_GLUT = 512 * 512 * 2, SZ_TM = (size_t)32 * 256 * 512 * 2, SZ_MS = (size_t)32 * 256 * 256 * 2;
constexpr size_t OFF_WOUTT0 = OFF_W, OFF_WOUTT1 = OFF_WOUTT0 + SZ_WOUTT, OFF_WINT1 = OFF_WOUTT1 + SZ_WOUTT, OFF_GLUT1 = OFF_WINT1 + SZ_WINT, OFF_TM1 = OFF_GLUT1 + SZ_GLUT, OFF_MS1 = OFF_TM1 + SZ_TM;
constexpr size_t WS_NEED = OFF_MS1 + SZ_MS;
constexpr size_t DO_WINT0 = 0, DO_GLUT0 = DO_WINT0 + SZ_WINT, DO_TM0 = DO_GLUT0 + SZ_GLUT, DO_MS0 = DO_TM0 + SZ_TM;
static_assert(DO_MS0 + SZ_MS <= (size_t)NTOK * DM * 4, "layer-0 tables fit in d_out");
static_assert(WS_NEED <= (size_t)256 * 1024 * 1024, "workspace map fits 256 MiB");
constexpr size_t CTL_ZERO_BYTES = 262144;
constexpr int CW_BAR = 1024;
constexpr int CW_WORK = 256;
constexpr size_t OFF_T5TB = 524288;
constexpr size_t OFF_RPBS = OFF_T5TB + (size_t)(att::T5TB_F + att::T5S_F) * 4;
static_assert(OFF_RPBS + (size_t)att::RPBS_F * 4 <= OFF_SS, "small tables fit in the control MiB");

constexpr int RING_BYTES = 131072;
constexpr int MISC_OFF = RING_BYTES;
constexpr int LDS_BYTES = 147456;
static_assert(NWAVES * att::WAVE_LDS <= RING_BYTES && 2 * att::NA_IMG <= RING_BYTES, "attention LDS");

#define XB_TMO      128
#define XB_XCNT(j)  (256  + 64 * (j))
#define XB_XSUB(j)  (1280 + 64 * (j))
#define XB_XGEN(j)  (2304 + 64 * (j))
#define XB_TOP      3328
#define XB_TOPGEN   3392
#define XCD_BAR_WORDS 3456
#define XB_SPIN_CAP (1u << 18)
__device__ __forceinline__ unsigned xb_ld(unsigned* p)              { return __hip_atomic_load(p, __ATOMIC_RELAXED, __HIP_MEMORY_SCOPE_AGENT); }
__device__ __forceinline__ unsigned xb_add(unsigned* p, unsigned v) { return __hip_atomic_fetch_add(p, v, __ATOMIC_RELAXED, __HIP_MEMORY_SCOPE_AGENT); }
__device__ __forceinline__ unsigned xb_xcc_id() { return (unsigned)__builtin_amdgcn_s_getreg((3 << 11) | 20) & 0xFu; }
#define XB_SPIN(cond, bar) do { unsigned _sp = 0; while (cond) { __builtin_amdgcn_s_sleep(1); \
    if ((++_sp & 255u) == 0u) { if (xb_ld(&(bar)[XB_TMO])) break; if (_sp > XB_SPIN_CAP) { atomicAdd(&(bar)[XB_TMO], 1u); break; } } } } while (0)
struct XcdBarrier { unsigned* bar; unsigned x; volatile LAS unsigned* st; };
__device__ __forceinline__ XcdBarrier xcd_barrier_post(unsigned* bar, volatile LAS unsigned* st) {
    XcdBarrier b; b.bar = bar; b.x = xb_xcc_id(); b.st = st;
    if (threadIdx.x == 0) (void)xb_add(&bar[XB_XCNT(b.x)], 1u);
    return b;
}
__device__ __forceinline__ void xcd_barrier_complete(unsigned* bar, unsigned x, unsigned& nloc, unsigned& nx) {
    const unsigned G = gridDim.x * gridDim.y * gridDim.z;
    unsigned sum, cnt, mine, sp = 0u;
    for (;;) {
        sum = 0u; cnt = 0u; mine = 0u;
#pragma unroll
        for (unsigned j = 0; j < 16; ++j) { const unsigned c = xb_ld(&bar[XB_XCNT(j)]); sum += c; cnt += (c > 0u) ? 1u : 0u; mine = (j == x) ? c : mine; }
        if (sum == G) break;
        __builtin_amdgcn_s_sleep(1);
        if ((++sp & 255u) == 0u) { if (xb_ld(&bar[XB_TMO])) break; if (sp > XB_SPIN_CAP) { atomicAdd(&bar[XB_TMO], 1u); break; } }
    }
    nloc = mine > 0u ? mine : 1u; nx = cnt > 0u ? cnt : 1u;
}
__device__ __forceinline__ void xcd_barrier(const XcdBarrier& b) {
    asm volatile("s_waitcnt vmcnt(0)" ::: "memory");
    __syncthreads();
    if (threadIdx.x == 0) {
        unsigned* bar = b.bar;
        __builtin_amdgcn_s_waitcnt(0);
        unsigned nloc = b.st[0], nx = b.st[1];
        if (nloc == 0u) { xcd_barrier_complete(bar, b.x, nloc, nx); b.st[0] = nloc; b.st[1] = nx; }
        const unsigned old = xb_add(&bar[XB_XSUB(b.x)], 1u);
        const unsigned gen = old / nloc;
        if (old + 1u == (gen + 1u) * nloc) {
            __builtin_amdgcn_fence(__ATOMIC_RELEASE, "agent");
            asm volatile("s_waitcnt vmcnt(0)" ::: "memory");
            const unsigned og = xb_add(&bar[XB_TOP], 1u);
            const unsigned tg = og / nx;
            if (og + 1u == (tg + 1u) * nx) xb_add(&bar[XB_TOPGEN], 1u);
            else XB_SPIN(xb_ld(&bar[XB_TOPGEN]) == tg, bar);
            __builtin_amdgcn_fence(__ATOMIC_ACQUIRE, "agent");
            xb_add(&bar[XB_XGEN(b.x)], 1u);
            asm volatile("s_waitcnt vmcnt(0)" ::: "memory");
        } else {
            XB_SPIN(xb_ld(&bar[XB_XGEN(b.x)]) == gen, bar);
            __builtin_amdgcn_fence(__ATOMIC_ACQUIRE, "agent");
            asm volatile("s_waitcnt vmcnt(0)" ::: "memory");
        }
    }
    __syncthreads();
}

struct Args { const float* in[17]; float* out; unsigned char* ws; int ph_lo, ph_hi; int li, skip; };

__device__ __forceinline__ float wave_sum(float v) {
#pragma unroll
    for (int o = 1; o < 64; o <<= 1) v += __shfl_xor(v, o);
    return v;
}
__device__ __forceinline__ unsigned pk2(float lo, float hi) { return f2bf(lo) | (f2bf(hi) << 16); }

__device__ __forceinline__ void p0_transpose_item(const float* W, int K, int Nsrc, bf16_t* WT, int k0, int n0s, int n0d, const float* kscale, LAS float* scr, int lane) {
    float tv[32];
#pragma unroll
    for (int i = 0; i < 32; ++i) { const int kk = 2 * i + (lane >> 5); tv[i] = W[(size_t)(k0 + kk) * Nsrc + n0s + (lane & 31)]; }
    const float ksc = kscale ? kscale[k0 + lane] : 1.f;
#pragma unroll
    for (int i = 0; i < 32; ++i) { const int kk = 2 * i + (lane >> 5); scr[kk * 33 + (lane & 31)] = tv[i] * __shfl(ksc, kk); }
    asm volatile("s_waitcnt lgkmcnt(0)" ::: "memory");
    const int c = lane & 7;
#pragma unroll
    for (int j = 0; j < 4; ++j) { const int n = (lane >> 3) + 8 * j; const LAS float* s = scr + (8 * c) * 33 + n;
        v4u o; o.x = pk2(s[0 * 33], s[1 * 33]); o.y = pk2(s[2 * 33], s[3 * 33]); o.z = pk2(s[4 * 33], s[5 * 33]); o.w = pk2(s[6 * 33], s[7 * 33]);
        *(v4u*)(WT + (size_t)(n0d + n) * K + k0 + 8 * c) = o; }
    asm volatile("s_waitcnt lgkmcnt(0)" ::: "memory");
}
__device__ __forceinline__ void p0_xrow(const float* xrow, bf16_t* orow, float* ssrow, int lane) {
    const f32x4* xr = (const f32x4*)xrow + lane;
    f32x4 v[4]; float s = 0.f;
#pragma unroll
    for (int j = 0; j < 4; ++j) { v[j] = xr[64 * j]; s += (v[j].x * v[j].x + v[j].y * v[j].y) + (v[j].z * v[j].z + v[j].w * v[j].w); }
    s = wave_sum(s);
    unsigned long long* o8 = (unsigned long long*)orow + lane;
#pragma unroll
    for (int j = 0; j < 4; ++j) o8[64 * j] = (unsigned long long)pk2(v[j].x, v[j].y) | ((unsigned long long)pk2(v[j].z, v[j].w) << 32);
    if (lane < 16) ssrow[lane] = lane == 0 ? s : 0.f;
}
__device__ __forceinline__ int t5_bucket_dev(int rel) {
    const int n = rel < 0 ? -rel : rel;
    const int large = 8 + (n >= 15) + (n >= 27) + (n >= 50) + (n >= 91) + (n >= 166) + (n >= 305) + (n >= 559);
    return (rel > 0 ? 16 : 0) + (n < 8 ? n : large);
}
__device__ __forceinline__ void p0_ssm_tables(const Args& a, int l, int g, int d, bf16_t* TM, bf16_t* Ms, LAS float* scr) {
    int tid = threadIdx.x; asm volatile("" : "+v"(tid));
    LAS float* pw = scr;
    LAS float* fc = pw + 64 * 17 * 2;
    LAS float* Cc = fc + 2 * 64 * 2;
    LAS float* Bb = Cc + 2048;
    LAS float* C2 = Bb + 2048;
    LAS float* B2 = C2 + 2048;
    LAS float* Kt = B2 + 2048;
    const float* lam_re = a.in[4]; const float* lam_im = a.in[5]; const float* log_dt = a.in[6];
    const float* b_re = a.in[7]; const float* b_im = a.in[8]; const float* c_re = a.in[9]; const float* c_im = a.in[10]; const float* dskip = a.in[11];
    const int pg = (l * 2 + d) * 32 + g, pg2 = (l * 2 + (1 - d)) * 32 + g;
    if (tid < 128) {
        const int o = tid >> 6, p = tid & 63, pgx = o == 0 ? pg : pg2;
        const float lre = lam_re[pgx * 64 + p], lim = lam_im[pgx * 64 + p], dt = expf(log_dt[pgx]);
        const float er = expf(lre * dt), lbr = er * cosf(lim * dt), lbi = er * sinf(lim * dt);
        const float nr = lbr - 1.f, ni = lbi, den = lre * lre + lim * lim;
        fc[(o * 64 + p) * 2] = (nr * lre + ni * lim) / den; fc[(o * 64 + p) * 2 + 1] = (ni * lre - nr * lim) / den;
        if (o == 0) { float wr = 1.f, wi = 0.f;
            for (int k = 0; k <= 16; ++k) { pw[(p * 17 + k) * 2] = wr; pw[(p * 17 + k) * 2 + 1] = wi; const float t = wr * lbr - wi * lbi; wi = wr * lbi + wi * lbr; wr = t; } }
    }
    __syncthreads();
    for (int i = tid; i < 1024; i += NWAVES * 64) {
        Cc[i * 2] = c_re[(size_t)pg * 1024 + i]; Cc[i * 2 + 1] = c_im[(size_t)pg * 1024 + i];
        { const int p = i >> 4; const float br = b_re[(size_t)pg * 1024 + i], bi = b_im[(size_t)pg * 1024 + i], fr = fc[p * 2], fi = fc[p * 2 + 1];
          Bb[i * 2] = fr * br - fi * bi; Bb[i * 2 + 1] = fr * bi + fi * br; }
        if (d == 0) {
            C2[i * 2] = c_re[(size_t)pg2 * 1024 + i]; C2[i * 2 + 1] = c_im[(size_t)pg2 * 1024 + i];
            const int p = i >> 4; const float br = b_re[(size_t)pg2 * 1024 + i], bi = b_im[(size_t)pg2 * 1024 + i], fr = fc[(64 + p) * 2], fi = fc[(64 + p) * 2 + 1];
            B2[i * 2] = fr * br - fi * bi; B2[i * 2 + 1] = fr * bi + fi * br; }
    }
    __syncthreads();
    {
        const int kh = tid >> 8, c = (tid >> 4) & 15, cp = tid & 15;
        float Kk[8];
#pragma unroll
        for (int k = 0; k < 8; ++k) Kk[k] = 0.f;
        float k0o = 0.f;
#pragma unroll 2
        for (int p = 0; p < 64; ++p) {
            const float Cr = Cc[(c * 64 + p) * 2], Ci = Cc[(c * 64 + p) * 2 + 1], br = Bb[(p * 16 + cp) * 2], bi = Bb[(p * 16 + cp) * 2 + 1];
            const LAS float* pwp = pw + (p * 17 + kh * 8) * 2;
#pragma unroll
            for (int k = 0; k < 8; ++k) { const float pr = pwp[2 * k], pi = pwp[2 * k + 1]; const float wr = Cr * pr - Ci * pi, wi = Cr * pi + Ci * pr; Kk[k] += wr * br - wi * bi; }
            if (d == 0 && kh == 0) k0o += C2[(c * 64 + p) * 2] * B2[(p * 16 + cp) * 2] - C2[(c * 64 + p) * 2 + 1] * B2[(p * 16 + cp) * 2 + 1];
        }
#pragma unroll
        for (int k = 0; k < 8; ++k) Kt[(kh * 8 + k) * 256 + c * 16 + cp] = Kk[k];
        if (d == 0 && kh == 0) Kt[16 * 256 + c * 16 + cp] = k0o;
    }
    __syncthreads();
    for (int idx = tid; idx < 256 * 128; idx += NWAVES * 64) {
        const int row = idx >> 7, col = (idx & 127) * 2, t = row >> 4, cc = row & 15, s_ = col >> 4, c2 = col & 15;
        const int k = d == 0 ? t - s_ : s_ - t;
        if (k < 0 || (d == 1 && k == 0)) continue;
        float v0 = Kt[k * 256 + cc * 16 + c2], v1 = Kt[k * 256 + cc * 16 + c2 + 1];
        if (k == 0) { v0 += Kt[16 * 256 + cc * 16 + c2]; v1 += Kt[16 * 256 + cc * 16 + c2 + 1];
            const float dd = dskip[l * 512 + g * 16 + cc]; if (c2 == cc) v0 += dd; if (c2 + 1 == cc) v1 += dd; }
        *(unsigned*)(TM + (size_t)row * 512 + col) = pk2(v0, v1);
    }
    {
        const int p = tid & 63, cq = tid >> 6;
#pragma unroll
        for (int h2 = 0; h2 < 2; ++h2) { const int c = cq + 8 * h2; const float Cr = Cc[(c * 64 + p) * 2], Ci = Cc[(c * 64 + p) * 2 + 1];
#pragma unroll 4
            for (int e = 1; e <= 16; ++e) { const float pr = pw[(p * 17 + e) * 2], pi = pw[(p * 17 + e) * 2 + 1]; const float wr = Cr * pr - Ci * pi, wi = Cr * pi + Ci * pr;
                const int t = d == 0 ? e - 1 : 16 - e; bf16_t* rowp = TM + (size_t)(t * 16 + c) * 512 + 256 + d * 128 + p;
                rowp[0] = (bf16_t)f2bf(wr); rowp[64] = (bf16_t)f2bf(-wi); } }
    }
    {
        const int sc = tid & 255, e = sc >> 4, cp = sc & 15, ph = tid >> 8, s_ = d == 0 ? 15 - e : e;
#pragma unroll 4
        for (int it = 0; it < 32; ++it) { const int p = ph + 2 * it; const float pr = pw[(p * 17 + e) * 2], pi = pw[(p * 17 + e) * 2 + 1], br = Bb[(p * 16 + cp) * 2], bi = Bb[(p * 16 + cp) * 2 + 1];
            Ms[(size_t)(d * 128 + p) * 256 + s_ * 16 + cp] = (bf16_t)f2bf(pr * br - pi * bi); Ms[(size_t)(d * 128 + 64 + p) * 256 + s_ * 16 + cp] = (bf16_t)f2bf(pr * bi + pi * br); }
    }
    __syncthreads();
}

constexpr int N_PHASES = 14;
__global__ void __launch_bounds__(NWAVES * 64, 2) mega_fwd(Args args) {
    extern __shared__ __attribute__((aligned(16))) unsigned char lds_raw[];
    LAS unsigned char* lds = (LAS unsigned char*)lds_raw;
    volatile LAS unsigned* MISC = (volatile LAS unsigned*)(lds + MISC_OFF);
    const int tid = threadIdx.x;
#define PHASE_LANES int ptid = threadIdx.x; asm volatile("" : "+v"(ptid)); const int lane = ptid & 63, wave = __builtin_amdgcn_readfirstlane(ptid >> 6); (void)lane; (void)wave;
    const int G = gridDim.x; int vcu; { const int bx = blockIdx.x; vcu = (G % 8 == 0) ? (bx % 8) * (G / 8) + bx / 8 : bx; }
    unsigned char* ws = args.ws; unsigned char* dout = (unsigned char*)args.out;
    unsigned* ctl = (unsigned*)(ws + OFF_CTL);
    if (tid < 32) MISC[tid] = 0u;
    __syncthreads();
    XcdBarrier bar = xcd_barrier_post(ctl + CW_BAR + args.li * XCD_BAR_WORDS, MISC + 8);
    const int lo = args.ph_lo, hi = args.ph_hi;
#ifndef REP_P0
#define REP_P0 1
#endif
#ifndef REP_INPROJ
#define REP_INPROJ 1
#endif
#ifndef REP_EG
#define REP_EG 1
#endif
#ifndef DRY_NA
#define DRY_NA 0
#endif
#ifndef DRY_DIL
#define DRY_DIL 0
#endif
#ifndef REP_SCAN
#define REP_SCAN 1
#endif
#ifndef REP_Y
#define REP_Y 1
#endif
#ifndef DRYVAR
#define DRYVAR 0
#endif
#ifndef CT_SKIP
#define CT_SKIP 0
#endif
#ifndef PHASE_MASK
#define PHASE_MASK 0x3fff
#endif
#define INR(k) (lo <= (k) && (k) < hi)
#define IN(k) (((PHASE_MASK >> (k)) & 1) && INR(k))
#define INL(j) (((PHASE_MASK >> ((j) + 1)) & 1) && INR(pb + (j)))
#define SEAM(k) do { if (INR(k) && INR((k) + 1)) xcd_barrier(bar); } while (0)

    bf16_t* proj = (bf16_t*)(ws + OFF_PROJ); bf16_t* xag = (bf16_t*)(ws + OFF_XAG); bf16_t* xb = (bf16_t*)(ws + OFF_XB); float* Ebuf = (float*)(ws + OFF_XB);
    bf16_t* Gb = (bf16_t*)(ws + OFF_G); float* sspart = (float*)(ws + OFF_SS);
    float* rpbs = (float*)(ws + OFF_RPBS); float* t5tb = (float*)(ws + OFF_T5TB);

    if (IN(0)) for (int rep_ = 0; rep_ < REP_P0; ++rep_) {
        PHASE_LANES
        const int NTB = 128;
        for (int ti = vcu; ti < NTB; ti += G) {
            const int l = ti >> 6, g = (ti >> 1) & 31, d = ti & 1;
            bf16_t* TM = (bf16_t*)(l == 0 ? dout + DO_TM0 : ws + OFF_TM1) + (size_t)g * 256 * 512;
            bf16_t* Ms = (bf16_t*)(l == 0 ? dout + DO_MS0 : ws + OFF_MS1) + (size_t)g * 256 * 256;
            p0_ssm_tables(args, l, g, d, TM, Ms, (LAS float*)lds);
        }
        {
            const float* rpb = args.in[14]; const float* t5 = args.in[15];
            for (int i = vcu * NWAVES * 64 + ptid; i < att::RPBS_F; i += G * NWAVES * 64) {
                const int ii = i & 63, rr = (i >> 6) % 15, h = (i / (64 * 15)) & 7, c = (i / (64 * 15 * 8)) & 3, l = i / (64 * 15 * 8 * 4); const int cr = ii + c - 17;
                rpbs[i] = (ii + c < 64 && cr >= 0 && cr <= 30) ? rpb[(((size_t)l * 8 + h) * 15 + rr) * 31 + cr] * 1.4426950408889634f : 0.f; }
            for (int i = vcu * NWAVES * 64 + ptid; i < att::T5TB_F + att::T5S_F; i += G * NWAVES * 64) {
                int h, pat, idx;
                if (i < att::T5TB_F) { idx = i % att::TBW; pat = (i / att::TBW) % 3; h = i / (3 * att::TBW); }
                else { const int i2 = i - att::T5TB_F; const int c = (i2 / att::TBW) & 3; h = i2 / (4 * att::TBW); pat = 0; idx = i2 % att::TBW - c; }
                const int w = idx - att::TBOFF; const int d = pat == 0 ? 16 : (pat == 1 ? 4 : 1);
                t5tb[i] = (idx >= 0 && w >= 0 && w <= 128) ? t5[t5_bucket_dev(d * (w - 64)) * 8 + h] * 1.4426950408889634f : att::NEG; }
        }
        {
            LAS float* scr = (LAS float*)(lds + wave * 16384);
            constexpr int I_IN = (DM / 64) * (IN_COLS / 32), I_OUT = (MIXW / 64) * (DM / 32), I_GLU = (512 / 64) * (512 / 32), I_L = I_IN + I_OUT + I_GLU, I_TOT = 2 * I_L + NTOK;
            const int NW_ALL = G * NWAVES, gw = vcu * NWAVES + wave; const bool tblk = vcu < NTB && G > NTB;
            const int NW2 = tblk ? 0 : (G - NTB) * NWAVES, gw2 = (vcu - NTB) * NWAVES + wave;
            const int P1N = G > NTB ? 9 : (I_TOT + NW_ALL - 1) / NW_ALL, I_P1 = P1N * NW_ALL < I_TOT ? P1N * NW_ALL : I_TOT;
            for (int pass = 0; pass < 2; ++pass) {
                const int i0 = pass == 0 ? gw : I_P1 + gw2, i1 = pass == 0 ? I_P1 : I_TOT, st = pass == 0 ? NW_ALL : NW2;
                if (pass == 1 && NW2 == 0) break;
                for (int it = i0; it < i1; it += st) {
                    if (it >= 2 * I_L) { const int mrow = it - 2 * I_L; p0_xrow(args.in[0] + (size_t)mrow * DM, xb + (size_t)mrow * DM, sspart + (size_t)mrow * 16, lane); continue; }
                    const int l = it / I_L; int r = it % I_L;
                    if (r < I_IN) { const int nblk = IN_COLS / 32, kb = r / nblk, nb = r % nblk;
                        p0_transpose_item(args.in[2] + (size_t)l * DM * IN_COLS, DM, IN_COLS, (bf16_t*)(l == 0 ? dout + DO_WINT0 : ws + OFF_WINT1), 64 * kb, inproj_src_col(32 * nb), 32 * nb, args.in[1] + l * DM, scr, lane); continue; }
                    r -= I_IN;
                    if (r < I_OUT) { const int nblk = DM / 32, kb = r / nblk, nb = r % nblk;
                        p0_transpose_item(args.in[3] + (size_t)l * MIXW * DM, MIXW, DM, (bf16_t*)(ws + (l == 0 ? OFF_WOUTT0 : OFF_WOUTT1)), 64 * kb, 32 * nb, 32 * nb, nullptr, scr, lane); continue; }
                    r -= I_OUT;
                    { const int nblk = 512 / 32, kb = r / nblk, nb = r % nblk;
                        p0_transpose_item(args.in[12] + (size_t)l * 512 * 512, 512, 512, (bf16_t*)(l == 0 ? dout + DO_GLUT0 : ws + OFF_GLUT1), 64 * kb, 32 * nb, 32 * nb, nullptr, scr, lane); }
                }
            }
        }
    }
    SEAM(0);

    for (int l = 0; l < DEPTH; ++l) {
        const int pb = 1 + 6 * l;
        const bf16_t* WinT = (const bf16_t*)(l == 0 ? dout + DO_WINT0 : ws + OFF_WINT1);
        const bf16_t* WoutT = (const bf16_t*)(ws + (l == 0 ? OFF_WOUTT0 : OFF_WOUTT1));
        const bf16_t* GluT = (const bf16_t*)(l == 0 ? dout + DO_GLUT0 : ws + OFF_GLUT1);
        const bf16_t* TM = (const bf16_t*)(l == 0 ? dout + DO_TM0 : ws + OFF_TM1);
        const bf16_t* Ms = (const bf16_t*)(l == 0 ? dout + DO_MS0 : ws + OFF_MS1);
        if (INL(0)) for (int rep_ = 0; rep_ < REP_INPROJ; ++rep_) {
            pg8::Gemm gm{xb, WinT, DM, DM, DM, 0, 0}; pg8::StaticOrder S; S.init(NTOK, IN_COLS, G, (int)blockIdx.x);
            pg8::EpiInProj E{sspart, proj, xag};
            pg8::gemm_phase<pg8::EpiInProj, pg8::StaticOrder>(lds, gm, S, E);
        }
        SEAM(pb + 0);
        if (INL(1)) {
            if (!(CT_SKIP & 1) && !(args.skip & 1)) for (int rep_ = 0; rep_ < REP_EG; ++rep_) { pg8::Gemm gm{xag, Ms, 512, 256, 256, (size_t)NCHUNK_TOT * 512, (size_t)256 * 256}; pg8::BatchOrder S; S.init(4, 32, G, vcu);
              pg8::EpiE E{Ebuf};
              pg8::gemm_phase<pg8::EpiE, pg8::BatchOrder>(lds, gm, S, E); }
            __syncthreads();
            PHASE_LANES
            LAS char* vbuf = (LAS char*)(lds + wave * att::WAVE_LDS);
            const int gw = vcu * NWAVES + wave, NGW = G * NWAVES;
            for (int rep_ = 0; rep_ < DRY_NA; ++rep_) for (int t = gw; t < 8192; t += NGW) att::na_task(proj, rpbs + (size_t)l * 4 * 8 * 15 * 64, t, vbuf, lane, Gb);
            if (!(CT_SKIP & 2) && !(args.skip & 2)) for (int bt = vcu; bt < 1024; bt += G) att::na_block_task(proj, rpbs + (size_t)l * 4 * 8 * 15 * 64, bt, (LAS char*)lds, lane, wave);
            for (int rep_ = 0; rep_ < DRY_DIL; ++rep_) for (int t = gw; t < 8192; t += NGW) att::dil_task<DRYVAR>(proj, t5tb, t, vbuf, lane, Gb);
            if (!(CT_SKIP & 4) && !(args.skip & 4)) for (int t = gw; t < 8192; t += NGW) att::dil_task(proj, t5tb, t, vbuf, lane);
        }
        SEAM(pb + 1);
        if (INL(2)) for (int rep_ = 0; rep_ < REP_SCAN; ++rep_) {
            PHASE_LANES
            const float* lam_re = args.in[4]; const float* lam_im = args.in[5]; const float* log_dt = args.in[6];
            LAS float* sx = (LAS float*)lds;
            for (int cg = vcu; cg < 256; cg += G) {
                const int g = cg >> 3, b = (cg >> 1) & 3, d = cg & 1, p = lane, pg = (l * 2 + d) * 32 + g;
                const float lre = lam_re[pg * 64 + p], lim = lam_im[pg * 64 + p], dt = expf(log_dt[pg]);
                const float er = expf(lre * dt); float ar = er * cosf(lim * dt), ai = er * sinf(lim * dt);
#pragma unroll
                for (int i = 0; i < 4; ++i) { const float t = ar * ar - ai * ai; ai = 2.f * ar * ai; ar = t; }
                const float* Ep = Ebuf + ((size_t)g * NCHUNK_TOT + b * NCHUNK) * 256 + d * 128 + p;
                bf16_t* Cp = xag + ((size_t)g * NCHUNK_TOT + b * NCHUNK) * 512 + 256 + d * 128 + p;
                float er_[32], ei_[32];
#pragma unroll
                for (int i = 0; i < 32; ++i) { const int s = wave * 32 + i, k = d == 0 ? s : NCHUNK - 1 - s; er_[i] = Ep[(size_t)k * 256]; ei_[i] = Ep[(size_t)k * 256 + 64]; }
                float cr = 0.f, ci = 0.f;
#pragma unroll
                for (int i = 0; i < 32; ++i) { const float xr = er_[i], xi = ei_[i]; er_[i] = cr; ei_[i] = ci; const float t = ar * cr - ai * ci + xr; ci = ar * ci + ai * cr + xi; cr = t; }
                sx[(wave * 64 + lane) * 2] = cr; sx[(wave * 64 + lane) * 2 + 1] = ci;
                float a32r = ar, a32i = ai;
#pragma unroll
                for (int i = 0; i < 5; ++i) { const float t = a32r * a32r - a32i * a32i; a32i = 2.f * a32r * a32i; a32r = t; }
                __syncthreads();
                float inr = 0.f, ini = 0.f;
                for (int j = 0; j < wave; ++j) { const float tr = sx[(j * 64 + lane) * 2], ti = sx[(j * 64 + lane) * 2 + 1]; const float t = a32r * inr - a32i * ini + tr; ini = a32r * ini + a32i * inr + ti; inr = t; }
                float pr = inr, pi = ini;
#pragma unroll
                for (int i = 0; i < 32; ++i) { const int s = wave * 32 + i, k = d == 0 ? s : NCHUNK - 1 - s;
                    Cp[(size_t)k * 512] = (bf16_t)f2bf(er_[i] + pr); Cp[(size_t)k * 512 + 64] = (bf16_t)f2bf(ei_[i] + pi);
                    const float t = ar * pr - ai * pi; pi = ar * pi + ai * pr; pr = t; }
                __syncthreads();
            }
        }
        SEAM(pb + 2);
        if (INL(3)) for (int rep_ = 0; rep_ < REP_Y; ++rep_) {
            pg8::Gemm gm{xag, TM, 512, 512, 512, (size_t)NCHUNK_TOT * 512, (size_t)256 * 512}; pg8::BatchOrder S; S.init(4, 32, G, vcu);
            pg8::EpiY E{Gb};
            pg8::gemm_phase<pg8::EpiY, pg8::BatchOrder>(lds, gm, S, E);
        }
        SEAM(pb + 3);
        if (INL(4)) {
            pg8::Gemm gm{Gb, GluT, 512, 512, 512, 0, 0}; pg8::StaticOrder S; S.init(NTOK, 512, G, (int)blockIdx.x);
            pg8::EpiGlu E{Gb, args.in[13] + l * 512, proj};
            pg8::gemm_phase<pg8::EpiGlu, pg8::StaticOrder>(lds, gm, S, E);
        }
        SEAM(pb + 4);
        if (INL(5)) {
            pg8::Gemm gm{proj, WoutT, PLD, MIXW, MIXW, 0, 0}; pg8::StaticOrder S; S.init(NTOK, DM, G, (int)blockIdx.x);
            pg8::EpiOutProj E{l == 0 ? args.in[0] : args.out, args.out, xb, sspart, l == 0 ? 1 : 0};
            pg8::gemm_phase<pg8::EpiOutProj, pg8::StaticOrder>(lds, gm, S, E);
        }
        SEAM(pb + 5);
    }
    if (IN(13)) {
        PHASE_LANES
        const float* fg = args.in[16];
        const int gw = vcu * NWAVES + wave, NGW = G * NWAVES;
        for (int m = gw; m < NTOK; m += NGW) {
            const f32x4* sp = (const f32x4*)(sspart + (size_t)m * 16);
            const f32x4 s0 = sp[0], s1 = sp[1], s2 = sp[2], s3 = sp[3];
            const float ss = (((s0[0] + s0[1]) + (s0[2] + s0[3])) + ((s1[0] + s1[1]) + (s1[2] + s1[3]))) + (((s2[0] + s2[1]) + (s2[2] + s2[3])) + ((s3[0] + s3[1]) + (s3[2] + s3[3])));
            const float rinv = rsqrtf(ss * (1.0f / DM) + RMS_EPS);
            f32x4* xr = (f32x4*)(args.out + (size_t)m * DM) + lane;
#pragma unroll
            for (int j = 0; j < 4; ++j) { const f32x4 gv = *((const f32x4*)fg + lane + 64 * j); xr[64 * j] = xr[64 * j] * rinv * gv; }
        }
    }
#undef IN
#undef INL
#undef INR
#undef SEAM
}
#define HOST_PLAN launch_mega(d_in, d_out, d_ws, stream, 0, N_PHASES, 0, 0);
static int g_grid = 0;
static void launch_mega(void* const* d_in, void* d_out, void* d_ws, hipStream_t stream, int lo, int hi, int li, int skip) {
    Args a{};
    for (int i = 0; i < 17; ++i) a.in[i] = (const float*)d_in[i];
    a.out = (float*)d_out; a.ws = (unsigned char*)d_ws; a.ph_lo = lo; a.ph_hi = hi; a.li = li; a.skip = skip;
    hipLaunchKernelGGL(mega_fwd, dim3(g_grid), dim3(NWAVES * 64), LDS_BYTES, stream, a);
    const hipError_t le = hipPeekAtLastError();
    if (le != hipSuccess) fprintf(stderr, "kernel_launch: launch failed: %s (grid %d)\n", hipGetErrorName(le), g_grid);
}
extern "C" void kernel_launch(void* const* d_in, const int* in_sizes, int n_in, void* d_out, int out_size, void* d_ws, size_t ws_size, hipStream_t stream) {
    if (g_grid == 0) {
        if (n_in != 17 || in_sizes[0] != NTOK * DM || out_size != NTOK * DM || ws_size < WS_NEED) { fprintf(stderr, "kernel_launch: unexpected shapes (n_in %d in0 %d out %d ws %zu need %zu)\n", n_in, n_in > 0 ? in_sizes[0] : -1, out_size, ws_size, (size_t)WS_NEED); g_grid = -1; return; }
        int dev = 0, cus = 0, per_cu = 0;
        if (hipGetDevice(&dev) != hipSuccess || hipDeviceGetAttribute(&cus, hipDeviceAttributeMultiprocessorCount, dev) != hipSuccess) { g_grid = -1; return; }
        if (hipFuncSetAttribute((const void*)mega_fwd, hipFuncAttributeMaxDynamicSharedMemorySize, LDS_BYTES) != hipSuccess) { fprintf(stderr, "kernel_launch: hipFuncSetAttribute failed\n"); g_grid = -1; return; }
        if (hipOccupancyMaxActiveBlocksPerMultiprocessor(&per_cu, (const void*)mega_fwd, NWAVES * 64, LDS_BYTES) != hipSuccess || per_cu < 1) { fprintf(stderr, "kernel_launch: occupancy query says %d\n", per_cu); per_cu = 1; }
        (void)hipGetLastError();
        g_grid = cus * 1;
    }
    if (g_grid < 0) return;
    (void)hipMemsetAsync((char*)d_ws + OFF_CTL, 0, CTL_ZERO_BYTES, stream);
    HOST_PLAN
}
```

```cpp
#include <hip/hip_runtime.h>
#include <cstdio>
#include <cstdint>
#include <cmath>

typedef unsigned short bf16_t;

constexpr int NB = 4, SEQ = 4096, DM = 1024, NTOK = NB * SEQ, DEPTH = 2;
constexpr int IN_COLS = 5120, MIXW = 1536;
constexpr float RMS_EPS = 1e-6f;
constexpr int LCH = 16;
constexpr int NCHUNK = SEQ / LCH;
constexpr int NCHUNK_TOT = NB * NCHUNK;
constexpr int PLD = 4608;
constexpr int PC_ZA = 0, PC_QB = 512, PC_QC = 1024, PC_KB = 1536, PC_VB = 2048, PC_ZB = 2560, PC_KC = 3072, PC_VC = 3584, PC_ZC = 4096;
__host__ __device__ __forceinline__ int inproj_src_col(int n) {
    if (n < 512) return n;
    const int pc = n - 512, s = pc >> 9;
    const int seg = (s == 0) ? 1 : (s == 1) ? 2 : (s == 2) ? 6 : (s == 3) ? 3 : (s == 4) ? 4 : (s == 5) ? 5 : (s == 6) ? 7 : (s == 7) ? 8 : 9;
    return seg * 512 + (pc & 511);
}

constexpr size_t OFF_CTL = 0;
constexpr size_t OFF_SS = 1u << 20;
constexpr size_t OFF_PROJ = 2u << 20;
constexpr size_t SZ_PROJ = (size_t)NTOK * PLD * 2;
constexpr size_t OFF_XAG = OFF_PROJ + SZ_PROJ;
constexpr size_t SZ_XAG = (size_t)32 * NCHUNK_TOT * 512 * 2;
constexpr size_t OFF_XB = OFF_XAG + SZ_XAG;
constexpr size_t SZ_XB = (size_t)NTOK * DM * 2;
constexpr size_t OFF_G = OFF_XB + SZ_XB;
constexpr size_t SZ_G = (size_t)NTOK * 512 * 2;
constexpr size_t OFF_W = OFF_G + SZ_G;
constexpr size_t WS_NEED_NAIVE = OFF_W;

__host__ __device__ __forceinline__ unsigned f2bf(float f) { unsigned u = __builtin_bit_cast(unsigned, f); return (u + 0x7fffu + ((u >> 16) & 1u)) >> 16; }
__host__ __device__ __forceinline__ float bf2f(bf16_t b) { return __builtin_bit_cast(float, (unsigned)b << 16); }

__device__ __forceinline__ int hw_lane() { int r; asm volatile("v_mbcnt_lo_u32_b32 %0, -1, 0\n\tv_mbcnt_hi_u32_b32 %0, -1, %0" : "=v"(r)); return r; }
namespace pg8 {
#define PG8_LAS __attribute__((address_space(3)))
typedef short bf16x8 __attribute__((ext_vector_type(8)));
typedef float f32x4 __attribute__((ext_vector_type(4)));
typedef unsigned u32x4 __attribute__((ext_vector_type(4)));
typedef unsigned u32x2 __attribute__((ext_vector_type(2)));
constexpr int BM = 256, BK = 64, HALF = 128, HTB = HALF * BK * 2  , STAGE_BYTES = 8 * HTB, NXCD = 8, WGM = 8;

__host__ __device__ __forceinline__ int lds_byte(int r, int c) { const int st = (r >> 4) * 2 + (c >> 5), rr = r & 15, cc = c & 31, ob = rr * 64 + cc * 2; return st * 1024 + (ob ^ (((ob >> 9) & 1) << 5)); }
__host__ __device__ __forceinline__ void stage_rc(int b, int& R, int& C) { const int st = b / 1024, sb = b % 1024, swz = sb ^ (((sb >> 9) & 1) << 5); R = (st >> 1) * 16 + swz / 64; C = (st & 1) * 32 + (swz % 64) / 2; }
__host__ __device__ __forceinline__ int perm32(int rho) { const int n = rho >> 4, i = rho & 15; return 8 * (i >> 2) + 4 * n + (i & 3); }

struct Unit { int pm, pn, bz; };
struct Gemm { const bf16_t* A; const bf16_t* Bt; int lda, ldb, K; size_t a_bz, b_bz; };

struct StaticOrder {
    int nM, nN, nwg, G, c;
    __host__ __device__ void init(int M, int N, int G_, int c_) { nM = M / BM; nN = N / BM; nwg = nM * nN; G = G_; c = c_; }
    __host__ __device__ bool next(int i, Unit& u) const {
        const long L = (long)i * G + c; if (L >= nwg) return false;
        int wgid = (int)L; { const int q = nwg / NXCD, r = nwg % NXCD, xcd = wgid % NXCD, off = wgid / NXCD; wgid = (xcd < r ? xcd * (q + 1) : r * (q + 1) + (xcd - r) * q) + off; }
        const int nig = WGM * nN, gid = wgid / nig, fm = gid * WGM, gsz = (nM - fm) < WGM ? (nM - fm) : WGM;
        u.pm = fm + ((wgid % nig) % gsz); u.pn = (wgid % nig) / gsz; u.bz = 0; return true;
    }
};
struct BatchOrder {
    int nM, nwg, G, c;
    __host__ __device__ void init(int nM_, int nBatch, int G_, int c_) { nM = nM_; nwg = nM_ * nBatch; G = G_; c = c_; }
    __host__ __device__ bool next(int i, Unit& u) const {
        const long L = (long)i * G + c; if (L >= nwg) return false;
        u.bz = (int)L >> 2; u.pm = (int)L & 3; u.pn = 0; return true;
    }
};

__device__ __forceinline__ unsigned cvt_pk_bf16(float lo, float hi) { unsigned r; asm volatile("v_cvt_pk_bf16_f32 %0, %1, %2" : "=v"(r) : "v"(lo), "v"(hi)); return r; }
__device__ __forceinline__ u32x4 pack8(const f32x4 v0, const f32x4 v1) { u32x4 w; w.x = cvt_pk_bf16(v0[0], v0[1]); w.y = cvt_pk_bf16(v0[2], v0[3]); w.z = cvt_pk_bf16(v1[0], v1[1]); w.w = cvt_pk_bf16(v1[2], v1[3]); return w; }
__device__ __forceinline__ float bfl(unsigned w) { return __builtin_bit_cast(float, w << 16); }
__device__ __forceinline__ float bfh(unsigned w) { return __builtin_bit_cast(float, w & 0xffff0000u); }


struct EpiInProj {
    static constexpr bool PERM = true, AFTER_DRAIN = false;
    const float* sspart; bf16_t* proj; bf16_t* xag;
    __device__ __forceinline__ void operator()(const f32x4 (&acc)[2][2][4][2], const Unit& u, int wr, int wc, int fr, int fq) const {
        const int row0 = u.pm * BM + wr * 64 + fr, colt = u.pn * BM + wc * 32 + 8 * fq;
#pragma unroll
        for (int ai = 0; ai < 2; ++ai)
#pragma unroll
            for (int m = 0; m < 4; ++m) {
                const int row = row0 + ai * HALF + m * 16;
                const f32x4* sp = (const f32x4*)(sspart + (size_t)row * 16);
                const f32x4 s0 = sp[0], s1 = sp[1], s2 = sp[2], s3 = sp[3];
                const float ss = (((s0[0] + s0[1]) + (s0[2] + s0[3])) + ((s1[0] + s1[1]) + (s1[2] + s1[3]))) + (((s2[0] + s2[1]) + (s2[2] + s2[3])) + ((s3[0] + s3[1]) + (s3[2] + s3[3])));
                const float rinv = rsqrtf(ss * (1.0f / DM) + RMS_EPS);
#pragma unroll
                for (int bj = 0; bj < 2; ++bj) {
                    const int col = colt + bj * HALF;
                    const u32x4 w = pack8(acc[ai][bj][m][0] * rinv, acc[ai][bj][m][1] * rinv);
                    bf16_t* dst = (u.pn < 2) ? xag + ((size_t)(col >> 4) * NCHUNK_TOT + (row >> 4)) * 512 + (row & 15) * 16 + (col & 15)
                                             : proj + (size_t)row * PLD + (col - 512);
                    *(u32x4*)dst = w;
                }
                asm volatile("" ::: "memory");
            }
    }
};
struct EpiE {
    static constexpr bool PERM = true, AFTER_DRAIN = false;
    float* E;
    __device__ __forceinline__ void operator()(const f32x4 (&acc)[2][2][4][2], const Unit& u, int wr, int wc, int fr, int fq) const {
        const int row0 = u.pm * BM + wr * 64 + fr, colt = wc * 32 + 8 * fq;
#pragma unroll
        for (int ai = 0; ai < 2; ++ai)
#pragma unroll
            for (int m = 0; m < 4; ++m) {
                float* rp = E + ((size_t)u.bz * NCHUNK_TOT + row0 + ai * HALF + m * 16) * 256 + colt;
#pragma unroll
                for (int bj = 0; bj < 2; ++bj) { *(f32x4*)(rp + bj * HALF) = acc[ai][bj][m][0]; *(f32x4*)(rp + bj * HALF + 4) = acc[ai][bj][m][1]; }
                asm volatile("" ::: "memory");
            }
    }
};
struct EpiY {
    static constexpr bool PERM = true, AFTER_DRAIN = false;
    bf16_t* G;
    __device__ __forceinline__ static float gelu(float y) {
        const float a = 0.7978845608028654f * (y + 0.044715f * y * y * y);
        return y * __builtin_amdgcn_rcpf(1.0f + __builtin_amdgcn_exp2f(-2.885390081777927f * a));
    }
    __device__ __forceinline__ void operator()(const f32x4 (&acc)[2][2][4][2], const Unit& u, int wr, int wc, int fr, int fq) const {
        const int row0 = u.pm * BM + wr * 64 + fr, colt = wc * 32 + 8 * fq;
#pragma unroll
        for (int ai = 0; ai < 2; ++ai)
#pragma unroll
            for (int m = 0; m < 4; ++m) {
                const int n = row0 + ai * HALF + m * 16;
#pragma unroll
                for (int bj = 0; bj < 2; ++bj) {
                    const int col = colt + bj * HALF, t = col >> 4, c0 = col & 15;
                    f32x4 v0 = acc[ai][bj][m][0], v1 = acc[ai][bj][m][1];
#pragma unroll
                    for (int e = 0; e < 4; ++e) { v0[e] = gelu(v0[e]); v1[e] = gelu(v1[e]); }
                    *(u32x4*)(G + ((size_t)n * 16 + t) * 512 + u.bz * 16 + c0) = pack8(v0, v1);
                }
                asm volatile("" ::: "memory");
            }
    }
};
struct EpiGlu {
    static constexpr bool PERM = true, AFTER_DRAIN = false;
    const bf16_t* G; const float* bias; bf16_t* proj;
    __device__ __forceinline__ static float sig(float v) { return __builtin_amdgcn_rcpf(1.0f + __builtin_amdgcn_exp2f(-1.4426950408889634f * v)); }
    __device__ __forceinline__ void operator()(const f32x4 (&acc)[2][2][4][2], const Unit& u, int wr, int wc, int fr, int fq) const {
        const int row0 = u.pm * BM + wr * 64 + fr, colt = u.pn * BM + wc * 32 + 8 * fq;
#pragma unroll
        for (int bj = 0; bj < 2; ++bj) {
            const int col = colt + bj * HALF;
            const f32x4 b0 = *(const f32x4*)(bias + col), b1 = *(const f32x4*)(bias + col + 4);
#pragma unroll
            for (int ai = 0; ai < 2; ++ai)
#pragma unroll
                for (int m = 0; m < 4; ++m) {
                    const int row = row0 + ai * HALF + m * 16;
                    const u32x4 gg = *(const u32x4*)(G + (size_t)row * 512 + col);
                    bf16_t* zp = proj + (size_t)row * PLD + PC_ZA + col;
                    const u32x4 zz = *(const u32x4*)zp;
                    const f32x4 a0 = acc[ai][bj][m][0] + b0, a1 = acc[ai][bj][m][1] + b1;
                    f32x4 o0, o1;
#pragma unroll
                    for (int e = 0; e < 4; ++e) {
                        const unsigned gw0 = gg[e >> 1], zw0 = zz[e >> 1], gw1 = gg[2 + (e >> 1)], zw1 = zz[2 + (e >> 1)];
                        const float g0 = (e & 1) ? bfh(gw0) : bfl(gw0), z0 = (e & 1) ? bfh(zw0) : bfl(zw0);
                        const float g1 = (e & 1) ? bfh(gw1) : bfl(gw1), z1 = (e & 1) ? bfh(zw1) : bfl(zw1);
                        o0[e] = g0 * sig(a0[e]) * (z0 * sig(z0)); o1[e] = g1 * sig(a1[e]) * (z1 * sig(z1));
                    }
                    *(u32x4*)zp = pack8(o0, o1);
                    asm volatile("" ::: "memory");
                }
        }
    }
};
struct EpiOutProj {
    static constexpr bool PERM = true, AFTER_DRAIN = false;
    const float* xold; float* xout; bf16_t* xb; float* sspart; int write_xb;
    __device__ __forceinline__ void operator()(const f32x4 (&acc)[2][2][4][2], const Unit& u, int wr, int wc, int fr, int fq) const {
        const int row0 = u.pm * BM + wr * 64 + fr, colt = u.pn * BM + wc * 32 + 8 * fq;
#pragma unroll
        for (int ai = 0; ai < 2; ++ai)
#pragma unroll
            for (int m = 0; m < 4; ++m) {
                const int row = row0 + ai * HALF + m * 16;
                float ssl = 0.f;
#pragma unroll
                for (int bj = 0; bj < 2; ++bj) {
                    const size_t off = (size_t)row * DM + colt + bj * HALF;
                    const f32x4 n0 = *(const f32x4*)(xold + off) + acc[ai][bj][m][0], n1 = *(const f32x4*)(xold + off + 4) + acc[ai][bj][m][1];
                    *(f32x4*)(xout + off) = n0; *(f32x4*)(xout + off + 4) = n1;
                    if (write_xb) *(u32x4*)(xb + off) = pack8(n0, n1);
                    ssl += ((n0[0] * n0[0] + n0[1] * n0[1]) + (n0[2] * n0[2] + n0[3] * n0[3])) + ((n1[0] * n1[0] + n1[1] * n1[1]) + (n1[2] * n1[2] + n1[3] * n1[3]));
                }
                ssl += __shfl_xor(ssl, 16); ssl += __shfl_xor(ssl, 32);
                if (fq == 0) sspart[(size_t)row * 16 + u.pn * 4 + wc] = ssl;
                asm volatile("" ::: "memory");
            }
    }
};

template <class Epi, class Sched, bool ALIGN_EPI = true>
__device__ __forceinline__ void gemm_phase(PG8_LAS unsigned char* lds, const Gemm g, const Sched& S, const Epi& E, int wave_s) {
    int tid = wave_s * 64 + hw_lane(); asm volatile("" : "+v"(tid));
    const int wid = __builtin_amdgcn_readfirstlane(tid >> 6), lane = tid & 63, wr = wid >> 2, wc = wid & 3, fr = lane & 15, fq = lane >> 4;
    int K = g.K; asm volatile("" : "+s"(K));
    const int nt = K / BK;
    unsigned voffA[2], voffB[2];
#pragma unroll
    for (int i = 0; i < 2; ++i) { int R, C; stage_rc(tid * 16 + i * 8192, R, C); const int Rb = Epi::PERM ? ((R & ~31) + perm32(R & 31)) : R;
        voffA[i] = (unsigned)(R * g.lda + C) * 2u; voffB[i] = (unsigned)(Rb * g.ldb + C) * 2u; }
    const size_t kstep = (size_t)(BK * 2);
    const size_t hstepA = (size_t)HALF * g.lda * 2, hstepB = (size_t)HALF * g.ldb * 2;
    const unsigned ldsw = (unsigned)wid * 1024u;
    const int aoff = lds_byte(wr * 64 + fr, fq * 8), boff = lds_byte(wc * 32 + fr, fq * 8);
#define PG8_SA(b, h) (((b) * 2 + (h)) * HTB)
#define PG8_SB(b, h) ((4 + (b) * 2 + (h)) * HTB)
#define PG8_STAGE(bufoff, gbase, voff) do { _Pragma("unroll") for (int _i = 0; _i < 2; ++_i) \
        __builtin_amdgcn_global_load_lds((const unsigned*)((const char*)(gbase) + (voff)[_i]), (PG8_LAS unsigned*)(lds + (bufoff) + ldsw + _i * 8192), 16, 0, 0); } while (0)
#define PG8_LDA(dst, b, h) do { _Pragma("unroll") for (int m = 0; m < 4; ++m) _Pragma("unroll") for (int k = 0; k < 2; ++k) dst[m][k] = *(const PG8_LAS bf16x8*)(lds + PG8_SA(b, h) + aoff + m * 2048 + k * 1024); } while (0)
#define PG8_LDB(dst, b, h) do { _Pragma("unroll") for (int n = 0; n < 2; ++n) _Pragma("unroll") for (int k = 0; k < 2; ++k) dst[n][k] = *(const PG8_LAS bf16x8*)(lds + PG8_SB(b, h) + boff + n * 2048 + k * 1024); } while (0)
#define PG8_MMA(ai, bj, At, Bt) do { __builtin_amdgcn_s_setprio(1); _Pragma("unroll") for (int m = 0; m < 4; ++m) _Pragma("unroll") for (int n = 0; n < 2; ++n) _Pragma("unroll") for (int k = 0; k < 2; ++k) \
        acc[ai][bj][m][n] = __builtin_amdgcn_mfma_f32_16x16x32_bf16(Bt[n][k], At[m][k], acc[ai][bj][m][n], 0, 0, 0); __builtin_amdgcn_s_setprio(0); } while (0)
#define PG8_WAIT_V(n) asm volatile("s_waitcnt vmcnt(" #n ")" ::: "memory")
#define PG8_WAIT_L(n) asm volatile("s_waitcnt lgkmcnt(" #n ")" ::: "memory")
#define PG8_BAR __builtin_amdgcn_s_barrier()
#define PG8_SCHED __builtin_amdgcn_sched_barrier(0)
#define PG8_ABASE(u) ((const char*)g.A + ((size_t)(u).bz * g.a_bz + (size_t)(u).pm * BM * g.lda) * 2)
#define PG8_BBASE(u) ((const char*)g.Bt + ((size_t)(u).bz * g.b_bz + (size_t)(u).pn * BM * g.ldb) * 2)
    Unit cur, nxt; int ui = 0;
    if (!S.next(0, cur)) return;
    f32x4 acc[2][2][4][2];
#pragma unroll
    for (int a = 0; a < 2; ++a)
#pragma unroll
        for (int b = 0; b < 2; ++b)
#pragma unroll
            for (int m = 0; m < 4; ++m)
#pragma unroll
                for (int n = 0; n < 2; ++n) acc[a][b][m][n] = (f32x4){0.f, 0.f, 0.f, 0.f};
    bf16x8 At[4][2], B0[2][2], B1[2][2];
    const char* cA = PG8_ABASE(cur); const char* cB = PG8_BBASE(cur);
    PG8_STAGE(PG8_SB(0, 0), cB, voffB); PG8_STAGE(PG8_SB(0, 1), cB + hstepB, voffB); PG8_STAGE(PG8_SA(0, 0), cA, voffA); PG8_STAGE(PG8_SA(0, 1), cA + hstepA, voffA);
    if (wr == 1) PG8_BAR;
    PG8_WAIT_V(2); PG8_BAR;
    PG8_STAGE(PG8_SB(1, 0), cB + kstep, voffB); PG8_STAGE(PG8_SA(1, 0), cA + kstep, voffA); PG8_STAGE(PG8_SB(1, 1), cB + hstepB + kstep, voffB);
    PG8_WAIT_V(6); PG8_BAR;
    for (;;) {
        const bool has_next = S.next(ui + 1, nxt);
        const char* nA = has_next ? PG8_ABASE(nxt) : cA; const char* nB = has_next ? PG8_BBASE(nxt) : cB;
        for (int t = 0; t < nt; t += 2) {
            const bool last = (t == nt - 2);
            const char* a1 = cA + (size_t)(t + 1) * kstep;
            const char* a2 = last ? nA : cA + (size_t)(t + 2) * kstep; const char* b2 = last ? nB : cB + (size_t)(t + 2) * kstep;
            const char* a3 = a2 + kstep; const char* b3 = b2 + kstep;
            PG8_LDB(B0, 0, 0); PG8_LDB(B1, 0, 1); PG8_SCHED; PG8_LDA(At, 0, 0); PG8_STAGE(PG8_SA(1, 1), a1 + hstepA, voffA);
            PG8_WAIT_V(8); PG8_WAIT_L(0); PG8_BAR; PG8_MMA(0, 0, At, B0); PG8_MMA(0, 1, At, B1); PG8_BAR; PG8_SCHED;
            PG8_LDA(At, 0, 1); PG8_STAGE(PG8_SB(0, 0), b2, voffB); PG8_STAGE(PG8_SB(0, 1), b2 + hstepB, voffB); PG8_STAGE(PG8_SA(0, 0), a2, voffA);
            PG8_WAIT_V(8); PG8_WAIT_L(0); PG8_BAR; PG8_MMA(1, 0, At, B0); PG8_MMA(1, 1, At, B1); PG8_BAR; PG8_SCHED;
            PG8_LDB(B0, 1, 0); PG8_LDB(B1, 1, 1); PG8_SCHED; PG8_LDA(At, 1, 0); PG8_STAGE(PG8_SA(0, 1), a2 + hstepA, voffA);
            PG8_WAIT_V(8); PG8_WAIT_L(0); PG8_BAR; PG8_MMA(0, 0, At, B0); PG8_MMA(0, 1, At, B1); PG8_BAR; PG8_SCHED;
            PG8_LDA(At, 1, 1); PG8_STAGE(PG8_SB(1, 0), b3, voffB); PG8_STAGE(PG8_SB(1, 1), b3 + hstepB, voffB); PG8_STAGE(PG8_SA(1, 0), a3, voffA);
            PG8_WAIT_V(8); PG8_WAIT_L(0); PG8_BAR; PG8_MMA(1, 0, At, B0); PG8_MMA(1, 1, At, B1); PG8_BAR; PG8_SCHED;
        }
        if constexpr (ALIGN_EPI) { if (wr == 0) PG8_BAR; }
        E(acc, cur, wr, wc, fr, fq);
        if (!has_next) break;
#pragma unroll
        for (int a = 0; a < 2; ++a)
#pragma unroll
            for (int b = 0; b < 2; ++b)
#pragma unroll
                for (int m = 0; m < 4; ++m)
#pragma unroll
                    for (int n = 0; n < 2; ++n) acc[a][b][m][n] = (f32x4){0.f, 0.f, 0.f, 0.f};
        cur = nxt; cA = nA; cB = nB; ++ui;
        if constexpr (ALIGN_EPI) { if (wr == 1) PG8_BAR; }
    }
    PG8_WAIT_V(0);
    if constexpr (!ALIGN_EPI) { if (wr == 0) PG8_BAR; }
    PG8_BAR;
#undef PG8_SA
#undef PG8_SB
#undef PG8_STAGE
#undef PG8_LDA
#undef PG8_LDB
#undef PG8_MMA
#undef PG8_WAIT_V
#undef PG8_WAIT_L
#undef PG8_BAR
#undef PG8_SCHED
#undef PG8_ABASE
#undef PG8_BBASE
}
}
namespace att {
#define LAS __attribute__((address_space(3)))
typedef short bf16x8 __attribute__((ext_vector_type(8)));
typedef short s16x4 __attribute__((ext_vector_type(4)));
typedef float f32x4 __attribute__((ext_vector_type(4)));
typedef unsigned u32x4 __attribute__((ext_vector_type(4)));
typedef unsigned u32x2 __attribute__((ext_vector_type(2)));
typedef float f32x2_t __attribute__((ext_vector_type(2)));
typedef __bf16 bf16x2_t __attribute__((ext_vector_type(2)));
constexpr int VROW = 160;
constexpr int VTILE = 32 * VROW;
constexpr int WAVE_LDS = 2 * VTILE;
constexpr float C2 = 0.125f * 1.4426950408889634f;
constexpr float NEG = -1e30f, MFLOOR = -1e20f, THR = 8.0f;
constexpr int TBW = 640, TBOFF = 240;
constexpr int T5TB_F = 8 * 3 * TBW, T5S_F = 8 * 4 * TBW, RPBS_F = 2 * 4 * 8 * 15 * 64;

__device__ __forceinline__ unsigned cvtpk(float lo, float hi) { f32x2_t v = {lo, hi}; bf16x2_t b = __builtin_convertvector(v, bf16x2_t); return __builtin_bit_cast(unsigned, b); }
__device__ __forceinline__ s16x4 vtr(LAS const char* p) { typedef short v4i16_t __attribute__((ext_vector_type(4))); return __builtin_bit_cast(s16x4, __builtin_amdgcn_ds_read_tr16_b64_v4i16((LAS v4i16_t*)p)); }

__device__ __forceinline__ float max3f(float a, float b, float c) { float r; asm("v_max3_f32 %0, %1, %2, %3" : "=v"(r) : "v"(a), "v"(b), "v"(c)); return r; }
__device__ __forceinline__ float max2f(float a, float b) { float r; asm("v_max_f32_e32 %0, %1, %2" : "=v"(r) : "v"(a), "v"(b)); return r; }
struct State { float m, l; f32x4 acc[4]; };
struct Stage { bf16x8 k00, k01, k10, k11; u32x4 v0, v1, v2, v3; };
struct Bias { f32x4 b0, b1; };

__device__ __forceinline__ void softmax_pv(State& st, f32x4 t0, f32x4 t1, LAS const char* vt, int lane) {
    const float mloc = max2f(max3f(max3f(t0[0], t0[1], t0[2]), t0[3], t1[0]), max3f(t1[1], t1[2], t1[3]));
    if (__builtin_amdgcn_ballot_w64(mloc > st.m + THR) != 0ull) {
        float mx = max2f(mloc, __shfl_xor(mloc, 16)); mx = max2f(mx, __shfl_xor(mx, 32));
        const float mn = max2f(st.m, mx);
        const float alpha = __builtin_amdgcn_exp2f(st.m - mn);
        st.m = mn; st.l *= alpha;
#pragma unroll
        for (int mt = 0; mt < 4; ++mt) st.acc[mt] = st.acc[mt] * alpha;
    }
    const float mn = st.m;
    f32x4 p0, p1;
#pragma unroll
    for (int e = 0; e < 4; ++e) { p0[e] = __builtin_amdgcn_exp2f(t0[e] - mn); p1[e] = __builtin_amdgcn_exp2f(t1[e] - mn); }
    st.l += (((p0[0] + p0[1]) + (p0[2] + p0[3])) + ((p1[0] + p1[1]) + (p1[2] + p1[3])));
    u32x4 pw; pw.x = cvtpk(p0[0], p0[1]); pw.y = cvtpk(p0[2], p0[3]); pw.z = cvtpk(p1[0], p1[1]); pw.w = cvtpk(p1[2], p1[3]);
    const bf16x8 pb = __builtin_bit_cast(bf16x8, pw);
    const int g = lane >> 4, qq = (lane & 15) >> 2, pp = lane & 3;
    LAS const char* vb = vt + (4 * g + qq) * VROW + pp * 8;
#pragma unroll
    for (int mt = 0; mt < 4; ++mt) {
        const s16x4 lo = vtr(vb + mt * 32), hi = vtr(vb + 16 * VROW + mt * 32);
        const bf16x8 av = (bf16x8){lo[0], lo[1], lo[2], lo[3], hi[0], hi[1], hi[2], hi[3]};
        st.acc[mt] = __builtin_amdgcn_mfma_f32_16x16x32_bf16(av, pb, st.acc[mt], 0, 0, 0);
    }
}
__device__ __forceinline__ void write_v(const Stage& s, LAS char* vt, int lane) {
    LAS char* vw = vt + (lane >> 1) * VROW + (lane & 1) * 64;
    *(LAS u32x4*)vw = s.v0; *(LAS u32x4*)(vw + 16) = s.v1; *(LAS u32x4*)(vw + 32) = s.v2; *(LAS u32x4*)(vw + 48) = s.v3;
}
__device__ __forceinline__ void qk(const Stage& s, const Bias& bs, bf16x8 bq0, bf16x8 bq1, f32x4& t0, f32x4& t1) {
    f32x4 s0 = (f32x4){0.f, 0.f, 0.f, 0.f}, s1 = s0;
    s0 = __builtin_amdgcn_mfma_f32_16x16x32_bf16(s.k00, bq0, s0, 0, 0, 0); s0 = __builtin_amdgcn_mfma_f32_16x16x32_bf16(s.k01, bq1, s0, 0, 0, 0);
    s1 = __builtin_amdgcn_mfma_f32_16x16x32_bf16(s.k10, bq0, s1, 0, 0, 0); s1 = __builtin_amdgcn_mfma_f32_16x16x32_bf16(s.k11, bq1, s1, 0, 0, 0);
    t0 = s0 * C2 + bs.b0; t1 = s1 * C2 + bs.b1;
}

__device__ __forceinline__ void finish(State& st, bf16_t* outp  , const bf16_t* zp, int lane) {
    float l = st.l; l += __shfl_xor(l, 16); l += __shfl_xor(l, 32);
    const float rl = 1.0f / l;
    const int g = lane >> 4;
#pragma unroll
    for (int mt = 0; mt < 4; ++mt) {
        const u32x2 zz = *(const u32x2*)(zp + mt * 16 + 4 * g);
        float o[4];
#pragma unroll
        for (int e = 0; e < 4; ++e) {
            const unsigned zw = zz[e >> 1]; const float z = (e & 1) ? __builtin_bit_cast(float, zw & 0xffff0000u) : __builtin_bit_cast(float, zw << 16);
            const float sz = z * __builtin_amdgcn_rcpf(1.0f + __builtin_amdgcn_exp2f(-1.4426950408889634f * z));
            o[e] = st.acc[mt][e] * rl * sz;
        }
        u32x2 w; w.x = cvtpk(o[0], o[1]); w.y = cvtpk(o[2], o[3]);
        *(u32x2*)(outp + mt * 16 + 4 * g) = w;
    }
}

template <int V = 0>
__device__ __forceinline__ void dil_task(bf16_t* proj, const float* tbl, int task, LAS char* vbuf, int lane, bf16_t* dry = nullptr) {
    const int r = task & 15, qb = (task >> 4) & 15, h = (task >> 8) & 7, b = task >> 11;
    const int q = lane & 15, g = lane >> 4;
    const int qr = qb * 256 + r;
    bf16_t* pb_ = proj + (size_t)b * SEQ * PLD;
    const bf16_t* qp = pb_ + (size_t)(qr + 16 * q) * PLD + PC_QC + h * 64 + g * 8;
    const bf16x8 bq0 = *(const bf16x8*)qp, bq1 = *(const bf16x8*)(qp + 32);
    const char* kbase = (const char*)(pb_ + PC_KC + h * 64);
    const char* vbase = (const char*)(pb_ + PC_VC + h * 64);
    const unsigned klane = (unsigned)g * 16u, vlane = (unsigned)(lane & 1) * 64u;
    const int sv = lane >> 1;
    State st; st.m = MFLOOR; st.l = 0.f;
#pragma unroll
    for (int mt = 0; mt < 4; ++mt) st.acc[mt] = (f32x4){0.f, 0.f, 0.f, 0.f};
    const float* tb0 = tbl + T5TB_F + ((size_t)h * 4 + (q & 3)) * TBW + TBOFF + 4 * g - (q & ~3);
    const float* tb1 = tbl + ((size_t)h * 3 + 1) * TBW + TBOFF + 4 * g - 4 * q;
    const float* tb2 = tbl + ((size_t)h * 3 + 2) * TBW + TBOFF + 4 * g - 16 * q;

#define DIL_PARAMS(ks, d, pat, ul0) const int pat = ((ks) >= 5) + ((ks) >= 11), d = 16 >> (2 * pat), ul0 = ((ks) - (5 * pat + (pat >> 1))) * 32;
    auto issue = [&](int ks, Stage& s) {
        if (V == 1 && ks > 2) return;
        DIL_PARAMS(ks, d, pat, ul0);
        const int pbase = qr + d * (ul0 - 64);
        int p0 = pbase + d * q, p1 = p0 + 16 * d, pv = pbase + d * sv;
        p0 = p0 < 0 ? 0 : (p0 > SEQ - 1 ? SEQ - 1 : p0); p1 = p1 < 0 ? 0 : (p1 > SEQ - 1 ? SEQ - 1 : p1); pv = pv < 0 ? 0 : (pv > SEQ - 1 ? SEQ - 1 : pv);
        const char* ka = kbase + ((unsigned)p0 * (unsigned)(PLD * 2) + klane); const char* kb = kbase + ((unsigned)p1 * (unsigned)(PLD * 2) + klane);
        const char* va = vbase + ((unsigned)pv * (unsigned)(PLD * 2) + vlane);
        if (V != 4 && V != 5) { s.k00 = *(const bf16x8*)ka; s.k01 = *(const bf16x8*)(ka + 64); s.k10 = *(const bf16x8*)kb; s.k11 = *(const bf16x8*)(kb + 64); }
        if (V != 3 && V != 5) { s.v0 = *(const u32x4*)va; s.v1 = *(const u32x4*)(va + 16); s.v2 = *(const u32x4*)(va + 32); s.v3 = *(const u32x4*)(va + 48); }
    };
    auto issue_b = [&](int ks, Bias& bs) {
        if (V == 1 && ks > 1) return;
        if (V == 3 || V == 4) return;
        DIL_PARAMS(ks, d, pat, ul0); (void)d;
        const float* tp = (pat == 0 ? tb0 : (pat == 1 ? tb1 : tb2)) + ul0;
        bs.b0 = *(const f32x4*)tp; bs.b1 = *(const f32x4*)(tp + 16);
    };
    auto compute = [&](int ks, const Stage& s, const Bias& bs) {
        if (V == 3) { asm volatile("" :: "v"(s.k00), "v"(s.k01), "v"(s.k10), "v"(s.k11)); return; }
        if (V == 4) { asm volatile("" :: "v"(s.v0), "v"(s.v1), "v"(s.v2), "v"(s.v3)); return; }
        if (V == 5) { asm volatile("" :: "v"(bs.b0), "v"(bs.b1)); return; }
        if (V == 2) { asm volatile("" :: "v"(s.k00), "v"(s.k01), "v"(s.k10), "v"(s.k11), "v"(s.v0), "v"(s.v1), "v"(s.v2), "v"(s.v3), "v"(bs.b0), "v"(bs.b1)); return; }
        LAS char* vt = vbuf + (ks & 1) * VTILE;
        write_v(s, vt, lane);
        f32x4 t0, t1; qk(s, bs, bq0, bq1, t0, t1);
        {
            DIL_PARAMS(ks, d, pat, ul0); (void)pat;
            const int pbase = qr + d * (ul0 - 64);
            if (pbase < 0 || pbase + 31 * d > SEQ - 1) {
                const int pk = pbase + d * 4 * g;
#pragma unroll
                for (int x = 0; x < 4; ++x) { if ((unsigned)(pk + d * x) >= (unsigned)SEQ) t0[x] = NEG; if ((unsigned)(pk + d * (16 + x)) >= (unsigned)SEQ) t1[x] = NEG; }
            }
        }
        softmax_pv(st, t0, t1, vt, lane);
    };
    Stage A, B, C, D;
    Bias X, Y;
    issue(0, A); issue(1, B); issue(2, C); issue_b(0, X);
#pragma unroll 1
    for (int ks = 0; ks < 20; ks += 4) {
        issue(ks + 3, D); issue_b(ks + 1, Y); compute(ks, A, X);
        issue(ks + 4, A); issue_b(ks + 2, X); compute(ks + 1, B, Y);
        issue(ks + 5, B); issue_b(ks + 3, Y); compute(ks + 2, C, X);
        issue(ks + 6, C); issue_b(ks + 4, X); compute(ks + 3, D, Y);
    }
    issue_b(21, Y); compute(20, A, X); issue_b(22, X); compute(21, B, Y); compute(22, C, X);
#undef DIL_PARAMS
    bf16_t* outp = dry ? dry + ((size_t)task * 16 + q) * 64 : pb_ + (size_t)(qr + 16 * q) * PLD + PC_QC + h * 64;
    finish(st, outp, pb_ + (size_t)(qr + 16 * q) * PLD + PC_ZC + h * 64, lane);
}

__device__ __forceinline__ void na_task(bf16_t* proj, const float* rpbs, int task, LAS char* vbuf, int lane, bf16_t* dry = nullptr) {
    const int jt = task & 3, r = (task >> 2) & 63, h = (task >> 8) & 7, b = task >> 11;
    const int q = lane & 15, g = lane >> 4;
    const int j0 = 16 * jt, j = j0 + q;
    int w0 = j0 - 8; w0 = w0 < 0 ? 0 : (w0 > 32 ? 32 : w0);
    int rs = r - 4; rs = rs < 0 ? 0 : (rs > 56 ? 56 : rs);
    int cs = j - 8; cs = cs < 0 ? 0 : (cs > 48 ? 48 : cs);
    bf16_t* pb_ = proj + (size_t)b * SEQ * PLD;
    const size_t tq = (size_t)(r * 64 + j);
    const bf16_t* qp = pb_ + tq * PLD + PC_QB + h * 64 + g * 8;
    const bf16x8 bq0 = *(const bf16x8*)qp, bq1 = *(const bf16x8*)(qp + 32);
    const char* kbase = (const char*)(pb_ + (size_t)(rs * 64 + w0) * PLD + PC_KB + h * 64);
    const char* vbase = (const char*)(pb_ + (size_t)(rs * 64 + w0) * PLD + PC_VB + h * 64);
    const int sv = lane >> 1;
    const unsigned koff = (unsigned)q * (unsigned)(PLD * 2) + (unsigned)g * 16u, voff = (unsigned)sv * (unsigned)(PLD * 2) + (unsigned)(lane & 1) * 64u;
    const int col = w0 - j + 32, c4 = col & 3;
    const float* tb = rpbs + (((size_t)c4 * 8 + h) * 15 + (rs - r + 7)) * 64 + (col - c4) + 4 * g;
    State st; st.m = MFLOOR; st.l = 0.f;
#pragma unroll
    for (int mt = 0; mt < 4; ++mt) st.acc[mt] = (f32x4){0.f, 0.f, 0.f, 0.f};
    const int kc0 = w0 + 4 * g - cs;
    auto issue = [&](int ks, Stage& s) {
        const char* ka = kbase + (size_t)ks * (64 * PLD * 2) + koff; const char* kb = ka + 16 * PLD * 2; const char* va = vbase + (size_t)ks * (64 * PLD * 2) + voff;
        s.k00 = *(const bf16x8*)ka; s.k01 = *(const bf16x8*)(ka + 64); s.k10 = *(const bf16x8*)kb; s.k11 = *(const bf16x8*)(kb + 64);
        s.v0 = *(const u32x4*)va; s.v1 = *(const u32x4*)(va + 16); s.v2 = *(const u32x4*)(va + 32); s.v3 = *(const u32x4*)(va + 48);
    };
    auto issue_b = [&](int ks, Bias& bs) { const float* tp = tb + ks * 64; bs.b0 = *(const f32x4*)tp; bs.b1 = *(const f32x4*)(tp + 16); };
    auto compute = [&](int ks, const Stage& s, const Bias& bs) {
        LAS char* vt = vbuf + (ks & 1) * VTILE;
        write_v(s, vt, lane);
        f32x4 t0, t1; qk(s, bs, bq0, bq1, t0, t1);
#pragma unroll
        for (int x = 0; x < 4; ++x) { if ((unsigned)(kc0 + x) >= 16u) t0[x] = NEG; if ((unsigned)(kc0 + 16 + x) >= 16u) t1[x] = NEG; }
        softmax_pv(st, t0, t1, vt, lane);
    };
    Stage A, B, C, D;
    Bias X, Y;
    issue(0, A); issue(1, B); issue(2, C); issue_b(0, X);
    issue(3, D); issue_b(1, Y); compute(0, A, X);
    issue(4, A); issue_b(2, X); compute(1, B, Y);
    issue(5, B); issue_b(3, Y); compute(2, C, X);
    issue(6, C); issue_b(4, X); compute(3, D, Y);
    issue(7, D); issue_b(5, Y); compute(4, A, X);
    issue_b(6, X); compute(5, B, Y); issue_b(7, Y); compute(6, C, X); compute(7, D, Y);
    finish(st, dry ? dry + ((size_t)task * 16 + q) * 64 : pb_ + tq * PLD + PC_QB + h * 64, pb_ + tq * PLD + PC_ZB + h * 64, lane);
}

constexpr int NA_IMG = 480 * 128;
__device__ __forceinline__ int fK(int kidx) { return (kidx >> 1) & 7; }
__device__ __forceinline__ int fV(int kidx) { return ((kidx >> 1) & 3) * 2; }
__device__ __forceinline__ void na_block_task(bf16_t* proj, const float* rpbs, int bt, LAS char* lds, int lane, int wave) {
    asm volatile("" : "+v"(lane));
    const int jt = bt & 3, rb = (bt >> 2) & 7, h = (bt >> 5) & 7, b = bt >> 8;
    const int r0 = 8 * rb, j0 = 16 * jt;
    int w0 = j0 - 8; w0 = w0 < 0 ? 0 : (w0 > 32 ? 32 : w0);
    int Rb = r0 - 4; Rb = Rb < 0 ? 0 : Rb;
    int Re = r0 + 3; Re = Re > 56 ? 56 : Re; Re += 8;
    const int nins = (Re - Rb) * 4;
    bf16_t* pb_ = proj + (size_t)b * SEQ * PLD;
    LAS char* Kimg = lds; LAS char* Vimg = lds + NA_IMG;
    {
        const int kl = lane >> 3, c = lane & 7;
        for (int ii = wave; ii < nins; ii += 8) {
            const int key = 8 * ii + kl, rl = key >> 5, col = key & 31;
            const bf16_t* row = pb_ + (size_t)((Rb + rl) * 64 + w0 + col) * PLD + h * 64;
            __builtin_amdgcn_global_load_lds((const unsigned*)(row + PC_KB + ((c ^ fK(key)) * 8)), (LAS unsigned*)(Kimg + ii * 1024), 16, 0, 0);
            __builtin_amdgcn_global_load_lds((const unsigned*)(row + PC_VB + ((c ^ fV(key)) * 8)), (LAS unsigned*)(Vimg + ii * 1024), 16, 0, 0);
        }
    }
    const int q = lane & 15, g = lane >> 4, qq = q >> 2, pp = lane & 3;
    const int r = r0 + wave, j = j0 + q;
    int rs = r - 4; rs = rs < 0 ? 0 : (rs > 56 ? 56 : rs);
    int cs = j - 8; cs = cs < 0 ? 0 : (cs > 48 ? 48 : cs);
    const size_t tq = (size_t)(r * 64 + j);
    const bf16_t* qp = pb_ + tq * PLD + PC_QB + h * 64 + g * 8;
    const bf16x8 bq0 = *(const bf16x8*)qp, bq1 = *(const bf16x8*)(qp + 32);
    const int col = w0 - j + 32, c4 = col & 3;
    const float* tb = rpbs + (((size_t)c4 * 8 + h) * 15 + (rs - r + 7)) * 64 + (col - c4) + 4 * g;
    const int kc0 = w0 + 4 * g - cs;
    State st; st.m = MFLOOR; st.l = 0.f;
#pragma unroll
    for (int mt = 0; mt < 4; ++mt) st.acc[mt] = (f32x4){0.f, 0.f, 0.f, 0.f};
    Bias bs; bs.b0 = *(const f32x4*)tb; bs.b1 = *(const f32x4*)(tb + 16);
    __syncthreads();
    const int kbase = (rs - Rb) * 32;
#pragma unroll 1
    for (int ks = 0; ks < 8; ++ks) {
        Bias nb = bs; if (ks + 1 < 8) { const float* tp = tb + (ks + 1) * 64; nb.b0 = *(const f32x4*)tp; nb.b1 = *(const f32x4*)(tp + 16); }
        const int k0 = kbase + ks * 32 + q, k1 = k0 + 16;
        const bf16x8 a00 = *(LAS const bf16x8*)(Kimg + k0 * 128 + ((g ^ fK(k0)) * 16)), a01 = *(LAS const bf16x8*)(Kimg + k0 * 128 + (((4 + g) ^ fK(k0)) * 16));
        const bf16x8 a10 = *(LAS const bf16x8*)(Kimg + k1 * 128 + ((g ^ fK(k1)) * 16)), a11 = *(LAS const bf16x8*)(Kimg + k1 * 128 + (((4 + g) ^ fK(k1)) * 16));
        f32x4 s0 = (f32x4){0.f, 0.f, 0.f, 0.f}, s1 = s0;
        s0 = __builtin_amdgcn_mfma_f32_16x16x32_bf16(a00, bq0, s0, 0, 0, 0); s0 = __builtin_amdgcn_mfma_f32_16x16x32_bf16(a01, bq1, s0, 0, 0, 0);
        s1 = __builtin_amdgcn_mfma_f32_16x16x32_bf16(a10, bq0, s1, 0, 0, 0); s1 = __builtin_amdgcn_mfma_f32_16x16x32_bf16(a11, bq1, s1, 0, 0, 0);
        f32x4 t0 = s0 * C2 + bs.b0, t1 = s1 * C2 + bs.b1;
#pragma unroll
        for (int x = 0; x < 4; ++x) { if ((unsigned)(kc0 + x) >= 16u) t0[x] = NEG; if ((unsigned)(kc0 + 16 + x) >= 16u) t1[x] = NEG; }
        const float mloc = max2f(max3f(max3f(t0[0], t0[1], t0[2]), t0[3], t1[0]), max3f(t1[1], t1[2], t1[3]));
        if (__builtin_amdgcn_ballot_w64(mloc > st.m + THR) != 0ull) {
            float mx = max2f(mloc, __shfl_xor(mloc, 16)); mx = max2f(mx, __shfl_xor(mx, 32));
            const float mn = max2f(st.m, mx); const float alpha = __builtin_amdgcn_exp2f(st.m - mn);
            st.m = mn; st.l *= alpha;
#pragma unroll
            for (int mt = 0; mt < 4; ++mt) st.acc[mt] = st.acc[mt] * alpha;
        }
        const float mn = st.m; f32x4 p0, p1;
#pragma unroll
        for (int e = 0; e < 4; ++e) { p0[e] = __builtin_amdgcn_exp2f(t0[e] - mn); p1[e] = __builtin_amdgcn_exp2f(t1[e] - mn); }
        st.l += (((p0[0] + p0[1]) + (p0[2] + p0[3])) + ((p1[0] + p1[1]) + (p1[2] + p1[3])));
        u32x4 pw; pw.x = cvtpk(p0[0], p0[1]); pw.y = cvtpk(p0[2], p0[3]); pw.z = cvtpk(p1[0], p1[1]); pw.w = cvtpk(p1[2], p1[3]);
        const bf16x8 pb = __builtin_bit_cast(bf16x8, pw);
        const int v0k = kbase + ks * 32 + 4 * g + qq, v1k = v0k + 16;
        LAS const char* vr0 = Vimg + v0k * 128 + (pp & 1) * 8; LAS const char* vr1 = Vimg + v1k * 128 + (pp & 1) * 8;
        const int f0 = fV(v0k), f1 = fV(v1k), ch = pp >> 1;
#pragma unroll
        for (int mt = 0; mt < 4; ++mt) {
            const s16x4 lo = vtr(vr0 + (((mt * 2 + ch) ^ f0) * 16)), hi = vtr(vr1 + (((mt * 2 + ch) ^ f1) * 16));
            const bf16x8 av = (bf16x8){lo[0], lo[1], lo[2], lo[3], hi[0], hi[1], hi[2], hi[3]};
            st.acc[mt] = __builtin_amdgcn_mfma_f32_16x16x32_bf16(av, pb, st.acc[mt], 0, 0, 0);
        }
        bs = nb;
    }
    finish(st, pb_ + tq * PLD + PC_QB + h * 64, pb_ + tq * PLD + PC_ZB + h * 64, lane);
    __syncthreads();
}

constexpr int DIL_IMG = 400 * 128;
struct QF { bf16x8 q0, q1; };
__device__ __forceinline__ void lds_step(State& st, const QF& qf, LAS const char* Kimg, LAS const char* Vimg, int k0, int v0k, const Bias& bs, bool needm, int pk, int d, int lane) {
    const int g = lane >> 4, pp = lane & 3; const int k1 = k0 + 16, v1k = v0k + 16;
    const bf16x8 a00 = *(LAS const bf16x8*)(Kimg + k0 * 128 + ((g ^ fK(k0)) * 16)), a01 = *(LAS const bf16x8*)(Kimg + k0 * 128 + (((4 + g) ^ fK(k0)) * 16));
    const bf16x8 a10 = *(LAS const bf16x8*)(Kimg + k1 * 128 + ((g ^ fK(k1)) * 16)), a11 = *(LAS const bf16x8*)(Kimg + k1 * 128 + (((4 + g) ^ fK(k1)) * 16));
    f32x4 s0 = (f32x4){0.f, 0.f, 0.f, 0.f}, s1 = s0;
    s0 = __builtin_amdgcn_mfma_f32_16x16x32_bf16(a00, qf.q0, s0, 0, 0, 0); s0 = __builtin_amdgcn_mfma_f32_16x16x32_bf16(a01, qf.q1, s0, 0, 0, 0);
    s1 = __builtin_amdgcn_mfma_f32_16x16x32_bf16(a10, qf.q0, s1, 0, 0, 0); s1 = __builtin_amdgcn_mfma_f32_16x16x32_bf16(a11, qf.q1, s1, 0, 0, 0);
    f32x4 t0 = s0 * C2 + bs.b0, t1 = s1 * C2 + bs.b1;
    if (needm) {
#pragma unroll
        for (int x = 0; x < 4; ++x) { if ((unsigned)(pk + d * x) >= (unsigned)SEQ) t0[x] = NEG; if ((unsigned)(pk + d * (16 + x)) >= (unsigned)SEQ) t1[x] = NEG; }
    }
    const float mloc = max2f(max3f(max3f(t0[0], t0[1], t0[2]), t0[3], t1[0]), max3f(t1[1], t1[2], t1[3]));
    if (__builtin_amdgcn_ballot_w64(mloc > st.m + THR) != 0ull) {
        float mx = max2f(mloc, __shfl_xor(mloc, 16)); mx = max2f(mx, __shfl_xor(mx, 32));
        const float mn = max2f(st.m, mx); const float alpha = __builtin_amdgcn_exp2f(st.m - mn);
        st.m = mn; st.l *= alpha;
#pragma unroll
        for (int mt = 0; mt < 4; ++mt) st.acc[mt] = st.acc[mt] * alpha;
    }
    const float mn = st.m; f32x4 p0, p1;
#pragma unroll
    for (int e = 0; e < 4; ++e) { p0[e] = __builtin_amdgcn_exp2f(t0[e] - mn); p1[e] = __builtin_amdgcn_exp2f(t1[e] - mn); }
    st.l += (((p0[0] + p0[1]) + (p0[2] + p0[3])) + ((p1[0] + p1[1]) + (p1[2] + p1[3])));
    u32x4 pw; pw.x = cvtpk(p0[0], p0[1]); pw.y = cvtpk(p0[2], p0[3]); pw.z = cvtpk(p1[0], p1[1]); pw.w = cvtpk(p1[2], p1[3]);
    const bf16x8 pb = __builtin_bit_cast(bf16x8, pw);
    LAS const char* vr0 = Vimg + v0k * 128 + (pp & 1) * 8; LAS const char* vr1 = Vimg + v1k * 128 + (pp & 1) * 8;
    const int f0 = fV(v0k), f1 = fV(v1k), ch = pp >> 1;
#pragma unroll
    for (int mt = 0; mt < 4; ++mt) {
        const s16x4 lo = vtr(vr0 + (((mt * 2 + ch) ^ f0) * 16)), hi = vtr(vr1 + (((mt * 2 + ch) ^ f1) * 16));
        const bf16x8 av = (bf16x8){lo[0], lo[1], lo[2], lo[3], hi[0], hi[1], hi[2], hi[3]};
        st.acc[mt] = __builtin_amdgcn_mfma_f32_16x16x32_bf16(av, pb, st.acc[mt], 0, 0, 0);
    }
}
template <class PF>
__device__ __forceinline__ void stage_keys(bf16_t* pb_, int h, int kcol, int vcol, int nkeys, PF posfn, LAS char* Kimg, LAS char* Vimg, int lane, int wave) {
    const int kl = lane >> 3, c = lane & 7;
    for (int ii = wave; ii < nkeys / 8; ii += 8) {
        const int key = 8 * ii + kl; int pos = posfn(key); pos = pos < 0 ? 0 : (pos > SEQ - 1 ? SEQ - 1 : pos);
        const bf16_t* row = pb_ + (size_t)pos * PLD + h * 64;
        __builtin_amdgcn_global_load_lds((const unsigned*)(row + kcol + ((c ^ fK(key)) * 8)), (LAS unsigned*)(Kimg + ii * 1024), 16, 0, 0);
        __builtin_amdgcn_global_load_lds((const unsigned*)(row + vcol + ((c ^ fV(key)) * 8)), (LAS unsigned*)(Vimg + ii * 1024), 16, 0, 0);
    }
}
__device__ __forceinline__ void dil_block_task(bf16_t* proj, const float* tbl, int bt, LAS char* lds, int lane, int wave) {
    asm volatile("" : "+v"(lane));
    const int qb = bt & 15, h = (bt >> 4) & 7, b = bt >> 7;
    const int q = lane & 15, g = lane >> 4, qq = q >> 2;
    const int q0 = qb * 256;
    const int ra = 4 * (wave >> 1) + (wave & 1), rb = ra + 2;
    bf16_t* pb_ = proj + (size_t)b * SEQ * PLD;
    LAS char* Kimg = lds; LAS char* Vimg = lds + DIL_IMG;
    stage_keys(pb_, h, PC_KC, PC_VC, 400, [&](int k) { return q0 - 64 + k; }, Kimg, Vimg, lane, wave);
    QF qa, qbf;
    { const bf16_t* qp = pb_ + (size_t)(q0 + ra + 16 * q) * PLD + PC_QC + h * 64 + g * 8; qa.q0 = *(const bf16x8*)qp; qa.q1 = *(const bf16x8*)(qp + 32);
      qp += 2 * PLD; qbf.q0 = *(const bf16x8*)qp; qbf.q1 = *(const bf16x8*)(qp + 32); }
    State sa, sb; sa.m = MFLOOR; sa.l = 0.f; sb.m = MFLOOR; sb.l = 0.f;
#pragma unroll
    for (int mt = 0; mt < 4; ++mt) { sa.acc[mt] = (f32x4){0.f, 0.f, 0.f, 0.f}; sb.acc[mt] = (f32x4){0.f, 0.f, 0.f, 0.f}; }
    const unsigned to2 = (unsigned)((h * 3 + 2) * TBW + TBOFF + 4 * g - 16 * q);
    __syncthreads();
    {
        const bool needm = (q0 - 64 < 0) || (q0 + 15 + 383 - 64 > SEQ - 1);
#pragma unroll 1
        for (int ks = 0; ks < 12; ++ks) {
            Bias bs; bs.b0 = *(const f32x4*)(tbl + (to2 + (unsigned)(ks * 32))); bs.b1 = *(const f32x4*)(tbl + (to2 + (unsigned)(ks * 32 + 16)));
            const int u0 = ks * 32;
            lds_step(sa, qa, Kimg, Vimg, u0 + ra + q, u0 + ra + 4 * g + qq, bs, needm, q0 + ra + u0 - 64 + 4 * g, 1, lane);
            lds_step(sb, qbf, Kimg, Vimg, u0 + rb + q, u0 + rb + 4 * g + qq, bs, needm, q0 + rb + u0 - 64 + 4 * g, 1, lane);
        }
    }
    __syncthreads();
    asm volatile("" : "+v"(lane));
#pragma unroll 1
    for (int t = 0; t < 2; ++t) {
        const int q = lane & 15, g = lane >> 4, qq = q >> 2;
        const unsigned to1 = (unsigned)((h * 3 + 1) * TBW + TBOFF + 4 * g - 4 * q);
        const int c0 = 2 * t;
        stage_keys(pb_, h, PC_KC, PC_VC, 392, [&](int k) { const int cl = k >= 196 ? 1 : 0; return q0 - 256 + c0 + cl + 4 * (k - 196 * cl); }, Kimg, Vimg, lane, wave);
        const int r = t == 0 ? ra : rb, cl = r & 1, kb = cl * 196 + (r >> 2);
        const bool needm = (q0 - 256 < 0) || (q0 + 15 + 4 * 127 > SEQ - 1);
        __syncthreads();
#pragma unroll 1
        for (int ks = 0; ks < 6; ++ks) {
            Bias bs; bs.b0 = *(const f32x4*)(tbl + (to1 + (unsigned)(ks * 32))); bs.b1 = *(const f32x4*)(tbl + (to1 + (unsigned)(ks * 32 + 16)));
            const int u0 = ks * 32;
            if (t == 0) lds_step(sa, qa, Kimg, Vimg, kb + u0 + q, kb + u0 + 4 * g + qq, bs, needm, q0 + r + 4 * (u0 - 64 + 4 * g), 4, lane);
            else        lds_step(sb, qbf, Kimg, Vimg, kb + u0 + q, kb + u0 + 4 * g + qq, bs, needm, q0 + r + 4 * (u0 - 64 + 4 * g), 4, lane);
        }
        __syncthreads();
    }
    asm volatile("" : "+v"(lane));
    LAS char* vbuf = lds + wave * WAVE_LDS;
    { const int q = lane & 15, g = lane >> 4;
    const char* kbase = (const char*)(pb_ + PC_KC + h * 64); const char* vbase = (const char*)(pb_ + PC_VC + h * 64);
    const unsigned klane = (unsigned)g * 16u, vlane = (unsigned)(lane & 1) * 64u; const int sv = lane >> 1;
    const unsigned to0 = (unsigned)(T5TB_F + (h * 4 + (q & 3)) * TBW + TBOFF + 4 * g - (q & ~3));
#pragma unroll 1
    for (int t = 0; t < 2; ++t) {
        const int qr = q0 + (t == 0 ? ra : rb);
        auto issue = [&](int ks, Stage& s, Bias& bsn) {
            const int pbase = qr + 16 * (ks * 32 - 64);
            int p0 = pbase + 16 * q, p1 = p0 + 256, pv = pbase + 16 * sv;
            p0 = p0 < 0 ? 0 : (p0 > SEQ - 1 ? SEQ - 1 : p0); p1 = p1 < 0 ? 0 : (p1 > SEQ - 1 ? SEQ - 1 : p1); pv = pv < 0 ? 0 : (pv > SEQ - 1 ? SEQ - 1 : pv);
            const char* ka = kbase + ((unsigned)p0 * (unsigned)(PLD * 2) + klane); const char* kb2 = kbase + ((unsigned)p1 * (unsigned)(PLD * 2) + klane);
            const char* va = vbase + ((unsigned)pv * (unsigned)(PLD * 2) + vlane);
            s.k00 = *(const bf16x8*)ka; s.k01 = *(const bf16x8*)(ka + 64); s.k10 = *(const bf16x8*)kb2; s.k11 = *(const bf16x8*)(kb2 + 64);
            s.v0 = *(const u32x4*)va; s.v1 = *(const u32x4*)(va + 16); s.v2 = *(const u32x4*)(va + 32); s.v3 = *(const u32x4*)(va + 48);
            bsn.b0 = *(const f32x4*)(tbl + (to0 + (unsigned)(ks * 32))); bsn.b1 = *(const f32x4*)(tbl + (to0 + (unsigned)(ks * 32 + 16)));
        };
        auto compute = [&](int ks, const Stage& s, const Bias& bsn, State& st, const QF& qf) {
            LAS char* vt = vbuf + (ks & 1) * VTILE;
            write_v(s, vt, lane);
            f32x4 t0, t1; qk(s, bsn, qf.q0, qf.q1, t0, t1);
            const int pbase = qr + 16 * (ks * 32 - 64);
            if (pbase < 0 || pbase + 31 * 16 > SEQ - 1) {
                const int pk = pbase + 64 * g;
#pragma unroll
                for (int x = 0; x < 4; ++x) { if ((unsigned)(pk + 16 * x) >= (unsigned)SEQ) t0[x] = NEG; if ((unsigned)(pk + 16 * (16 + x)) >= (unsigned)SEQ) t1[x] = NEG; }
            }
            softmax_pv(st, t0, t1, vt, lane);
        };
        Stage A, B; Bias X, Y;
        issue(0, A, X); issue(1, B, Y);
        if (t == 0) { compute(0, A, X, sa, qa); issue(2, A, X); compute(1, B, Y, sa, qa); issue(3, B, Y); compute(2, A, X, sa, qa); issue(4, A, X); compute(3, B, Y, sa, qa); compute(4, A, X, sa, qa); }
        else        { compute(0, A, X, sb, qbf); issue(2, A, X); compute(1, B, Y, sb, qbf); issue(3, B, Y); compute(2, A, X, sb, qbf); issue(4, A, X); compute(3, B, Y, sb, qbf); compute(4, A, X, sb, qbf); }
    }
    }
    asm volatile("" : "+v"(lane));
    { const int q = lane & 15;
    finish(sa, pb_ + (size_t)(q0 + ra + 16 * q) * PLD + PC_QC + h * 64, pb_ + (size_t)(q0 + ra + 16 * q) * PLD + PC_ZC + h * 64, lane);
    finish(sb, pb_ + (size_t)(q0 + rb + 16 * q) * PLD + PC_QC + h * 64, pb_ + (size_t)(q0 + rb + 16 * q) * PLD + PC_ZC + h * 64, lane); }
    __syncthreads();
}
#undef LAS
}
constexpr int NWAVES = 8;
#define GAS __attribute__((address_space(1)))
#define LAS __attribute__((address_space(3)))
typedef unsigned v4u __attribute__((ext_vector_type(4)));
typedef float f32x4 __attribute__((ext_vector_type(4)));
typedef GAS unsigned gu32;
#define RLX_AGENT __ATOMIC_RELAXED, __HIP_MEMORY_SCOPE_AGENT

constexpr size_t SZ_WINT = (size_t)IN_COLS * DM * 2, SZ_WOUTT = (size_t)DM * MIXW * 2, SZ_GLUT = 512 * 512 * 2, SZ_TM = (size_t)32 * 256 * 512 * 2, SZ_MS = (size_t)32 * 256 * 256 * 2;
constexpr size_t OFF_WOUTT0 = OFF_W, OFF_WOUTT1 = OFF_WOUTT0 + SZ_WOUTT, OFF_WINT1 = OFF_WOUTT1 + SZ_WOUTT, OFF_GLUT1 = OFF_WINT1 + SZ_WINT, OFF_TM1 = OFF_GLUT1 + SZ_GLUT, OFF_MS1 = OFF_TM1 + SZ_TM;
constexpr size_t WS_NEED = OFF_MS1 + SZ_MS;
constexpr size_t DO_WINT0 = 0, DO_GLUT0 = DO_WINT0 + SZ_WINT, DO_TM0 = DO_GLUT0 + SZ_GLUT, DO_MS0 = DO_TM0 + SZ_TM;
static_assert(DO_MS0 + SZ_MS <= (size_t)NTOK * DM * 4, "layer-0 tables fit in d_out");
static_assert(WS_NEED <= (size_t)256 * 1024 * 1024, "workspace map fits 256 MiB");
constexpr size_t CTL_ZERO_BYTES = 262144;
constexpr int CW_BAR = 1024;
constexpr int CW_WORK = 256;
constexpr size_t OFF_T5TB = 524288;
constexpr size_t OFF_RPBS = OFF_T5TB + (size_t)(att::T5TB_F + att::T5S_F) * 4;
static_assert(OFF_RPBS + (size_t)att::RPBS_F * 4 <= OFF_SS, "small tables fit in the control MiB");

constexpr int RING_BYTES = 131072;
constexpr int MISC_OFF = RING_BYTES;
constexpr int LDS_BYTES = 147456;
static_assert(NWAVES * att::WAVE_LDS <= RING_BYTES && 2 * att::NA_IMG <= RING_BYTES && 2 * att::DIL_IMG <= RING_BYTES, "attention LDS");

#define XB_TMO      128
#define XB_XCNT(j)  (256  + 64 * (j))
#define XB_XSUB(j)  (1280 + 64 * (j))
#define XB_XGEN(j)  (2304 + 64 * (j))
#define XB_TOP      3328
#define XB_TOPGEN   3392
#define XCD_BAR_WORDS 3456
#define XB_SPIN_CAP (1u << 18)
__device__ __forceinline__ unsigned xb_ld(unsigned* p)              { return __hip_atomic_load(p, __ATOMIC_RELAXED, __HIP_MEMORY_SCOPE_AGENT); }
__device__ __forceinline__ unsigned xb_add(unsigned* p, unsigned v) { return __hip_atomic_fetch_add(p, v, __ATOMIC_RELAXED, __HIP_MEMORY_SCOPE_AGENT); }
__device__ __forceinline__ unsigned xb_xcc_id() { return (unsigned)__builtin_amdgcn_s_getreg((3 << 11) | 20) & 0xFu; }
#define XB_SPIN(cond, bar) do { unsigned _sp = 0; while (cond) { __builtin_amdgcn_s_sleep(1); \
    if ((++_sp & 255u) == 0u) { if (xb_ld(&(bar)[XB_TMO])) break; if (_sp > XB_SPIN_CAP) { atomicAdd(&(bar)[XB_TMO], 1u); break; } } } } while (0)
struct XcdBarrier { unsigned* bar; unsigned x; volatile LAS unsigned* st; };
__device__ __forceinline__ XcdBarrier xcd_barrier_post(unsigned* bar, volatile LAS unsigned* st, int wave_s) {
    XcdBarrier b; b.bar = bar; b.x = xb_xcc_id(); b.st = st;
    if (wave_s == 0 && hw_lane() == 0) (void)xb_add(&bar[XB_XCNT(b.x)], 1u);
    return b;
}
__device__ __forceinline__ void xcd_barrier_complete(unsigned* bar, unsigned x, unsigned& nloc, unsigned& nx) {
    const unsigned G = gridDim.x * gridDim.y * gridDim.z;
    unsigned sum, cnt, mine, sp = 0u;
    for (;;) {
        sum = 0u; cnt = 0u; mine = 0u;
#pragma unroll
        for (unsigned j = 0; j < 16; ++j) { const unsigned c = xb_ld(&bar[XB_XCNT(j)]); sum += c; cnt += (c > 0u) ? 1u : 0u; mine = (j == x) ? c : mine; }
        if (sum == G) break;
        __builtin_amdgcn_s_sleep(1);
        if ((++sp & 255u) == 0u) { if (xb_ld(&bar[XB_TMO])) break; if (sp > XB_SPIN_CAP) { atomicAdd(&bar[XB_TMO], 1u); break; } }
    }
    nloc = mine > 0u ? mine : 1u; nx = cnt > 0u ? cnt : 1u;
}
__device__ __forceinline__ void xcd_barrier(const XcdBarrier& b, int wave_s) {
    asm volatile("s_waitcnt vmcnt(0)" ::: "memory");
    __syncthreads();
    if (wave_s == 0 && hw_lane() == 0) {
        unsigned* bar = b.bar;
        __builtin_amdgcn_s_waitcnt(0);
        unsigned nloc = b.st[0], nx = b.st[1];
        if (nloc == 0u) { xcd_barrier_complete(bar, b.x, nloc, nx); b.st[0] = nloc; b.st[1] = nx; }
        const unsigned old = xb_add(&bar[XB_XSUB(b.x)], 1u);
        const unsigned gen = old / nloc;
        if (old + 1u == (gen + 1u) * nloc) {
            __builtin_amdgcn_fence(__ATOMIC_RELEASE, "agent");
            asm volatile("s_waitcnt vmcnt(0)" ::: "memory");
            const unsigned og = xb_add(&bar[XB_TOP], 1u);
            const unsigned tg = og / nx;
            if (og + 1u == (tg + 1u) * nx) xb_add(&bar[XB_TOPGEN], 1u);
            else XB_SPIN(xb_ld(&bar[XB_TOPGEN]) == tg, bar);
            __builtin_amdgcn_fence(__ATOMIC_ACQUIRE, "agent");
            xb_add(&bar[XB_XGEN(b.x)], 1u);
            asm volatile("s_waitcnt vmcnt(0)" ::: "memory");
        } else {
            XB_SPIN(xb_ld(&bar[XB_XGEN(b.x)]) == gen, bar);
            __builtin_amdgcn_fence(__ATOMIC_ACQUIRE, "agent");
            asm volatile("s_waitcnt vmcnt(0)" ::: "memory");
        }
    }
    __syncthreads();
}

struct Args { const float* in[17]; float* out; unsigned char* ws; int ph_lo, ph_hi; int li, skip; };

__device__ __forceinline__ float wave_sum(float v) {
#pragma unroll
    for (int o = 1; o < 64; o <<= 1) v += __shfl_xor(v, o);
    return v;
}
__device__ __forceinline__ unsigned pk2(float lo, float hi) { return f2bf(lo) | (f2bf(hi) << 16); }

__device__ __forceinline__ void p0_transpose_item(const float* W, int K, int Nsrc, bf16_t* WT, int k0, int n0s, int n0d, const float* kscale, LAS float* scr, int lane) {
    float tv[32];
#pragma unroll
    for (int i = 0; i < 32; ++i) { const int kk = 2 * i + (lane >> 5); tv[i] = W[(size_t)(k0 + kk) * Nsrc + n0s + (lane & 31)]; }
    const float ksc = kscale ? kscale[k0 + lane] : 1.f;
#pragma unroll
    for (int i = 0; i < 32; ++i) { const int kk = 2 * i + (lane >> 5); scr[kk * 33 + (lane & 31)] = tv[i] * __shfl(ksc, kk); }
    asm volatile("s_waitcnt lgkmcnt(0)" ::: "memory");
    const int c = lane & 7;
#pragma unroll
    for (int j = 0; j < 4; ++j) { const int n = (lane >> 3) + 8 * j; const LAS float* s = scr + (8 * c) * 33 + n;
        v4u o; o.x = pk2(s[0 * 33], s[1 * 33]); o.y = pk2(s[2 * 33], s[3 * 33]); o.z = pk2(s[4 * 33], s[5 * 33]); o.w = pk2(s[6 * 33], s[7 * 33]);
        *(v4u*)(WT + (size_t)(n0d + n) * K + k0 + 8 * c) = o; }
    asm volatile("s_waitcnt lgkmcnt(0)" ::: "memory");
}
__device__ __forceinline__ void p0_xrow(const float* xrow, bf16_t* orow, float* ssrow, int lane) {
    const f32x4* xr = (const f32x4*)xrow + lane;
    f32x4 v[4]; float s = 0.f;
#pragma unroll
    for (int j = 0; j < 4; ++j) { v[j] = xr[64 * j]; s += (v[j].x * v[j].x + v[j].y * v[j].y) + (v[j].z * v[j].z + v[j].w * v[j].w); }
    s = wave_sum(s);
    unsigned long long* o8 = (unsigned long long*)orow + lane;
#pragma unroll
    for (int j = 0; j < 4; ++j) o8[64 * j] = (unsigned long long)pk2(v[j].x, v[j].y) | ((unsigned long long)pk2(v[j].z, v[j].w) << 32);
    if (lane < 16) ssrow[lane] = lane == 0 ? s : 0.f;
}
__device__ __forceinline__ int t5_bucket_dev(int rel) {
    const int n = rel < 0 ? -rel : rel;
    const int large = 8 + (n >= 15) + (n >= 27) + (n >= 50) + (n >= 91) + (n >= 166) + (n >= 305) + (n >= 559);
    return (rel > 0 ? 16 : 0) + (n < 8 ? n : large);
}
__device__ __forceinline__ void p0_ssm_tables(const Args& a, int l, int g, int d, bf16_t* TM, bf16_t* Ms, LAS float* scr, int wave_s) {
    int tid = wave_s * 64 + hw_lane(); asm volatile("" : "+v"(tid));
    LAS float* pw = scr;
    LAS float* fc = pw + 64 * 17 * 2;
    LAS float* Cc = fc + 2 * 64 * 2;
    LAS float* Bb = Cc + 2048;
    LAS float* C2 = Bb + 2048;
    LAS float* B2 = C2 + 2048;
    LAS float* Kt = B2 + 2048;
    const float* lam_re = a.in[4]; const float* lam_im = a.in[5]; const float* log_dt = a.in[6];
    const float* b_re = a.in[7]; const float* b_im = a.in[8]; const float* c_re = a.in[9]; const float* c_im = a.in[10]; const float* dskip = a.in[11];
    const int pg = (l * 2 + d) * 32 + g, pg2 = (l * 2 + (1 - d)) * 32 + g;
    if (tid < 128) {
        const int o = tid >> 6, p = tid & 63, pgx = o == 0 ? pg : pg2;
        const float lre = lam_re[pgx * 64 + p], lim = lam_im[pgx * 64 + p], dt = expf(log_dt[pgx]);
        const float er = expf(lre * dt), lbr = er * cosf(lim * dt), lbi = er * sinf(lim * dt);
        const float nr = lbr - 1.f, ni = lbi, den = lre * lre + lim * lim;
        fc[(o * 64 + p) * 2] = (nr * lre + ni * lim) / den; fc[(o * 64 + p) * 2 + 1] = (ni * lre - nr * lim) / den;
        if (o == 0) { float wr = 1.f, wi = 0.f;
            for (int k = 0; k <= 16; ++k) { pw[(p * 17 + k) * 2] = wr; pw[(p * 17 + k) * 2 + 1] = wi; const float t = wr * lbr - wi * lbi; wi = wr * lbi + wi * lbr; wr = t; } }
    }
    __syncthreads();
    for (int i = tid; i < 1024; i += NWAVES * 64) {
        Cc[i * 2] = c_re[(size_t)pg * 1024 + i]; Cc[i * 2 + 1] = c_im[(size_t)pg * 1024 + i];
        { const int p = i >> 4; const float br = b_re[(size_t)pg * 1024 + i], bi = b_im[(size_t)pg * 1024 + i], fr = fc[p * 2], fi = fc[p * 2 + 1];
          Bb[i * 2] = fr * br - fi * bi; Bb[i * 2 + 1] = fr * bi + fi * br; }
        if (d == 0) {
            C2[i * 2] = c_re[(size_t)pg2 * 1024 + i]; C2[i * 2 + 1] = c_im[(size_t)pg2 * 1024 + i];
            const int p = i >> 4; const float br = b_re[(size_t)pg2 * 1024 + i], bi = b_im[(size_t)pg2 * 1024 + i], fr = fc[(64 + p) * 2], fi = fc[(64 + p) * 2 + 1];
            B2[i * 2] = fr * br - fi * bi; B2[i * 2 + 1] = fr * bi + fi * br; }
    }
    __syncthreads();
    {
        const int kh = tid >> 8, c = (tid >> 4) & 15, cp = tid & 15;
        float Kk[8];
#pragma unroll
        for (int k = 0; k < 8; ++k) Kk[k] = 0.f;
        float k0o = 0.f;
#pragma unroll 2
        for (int p = 0; p < 64; ++p) {
            const float Cr = Cc[(c * 64 + p) * 2], Ci = Cc[(c * 64 + p) * 2 + 1], br = Bb[(p * 16 + cp) * 2], bi = Bb[(p * 16 + cp) * 2 + 1];
            const LAS float* pwp = pw + (p * 17 + kh * 8) * 2;
#pragma unroll
            for (int k = 0; k < 8; ++k) { const float pr = pwp[2 * k], pi = pwp[2 * k + 1]; const float wr = Cr * pr - Ci * pi, wi = Cr * pi + Ci * pr; Kk[k] += wr * br - wi * bi; }
            if (d == 0 && kh == 0) k0o += C2[(c * 64 + p) * 2] * B2[(p * 16 + cp) * 2] - C2[(c * 64 + p) * 2 + 1] * B2[(p * 16 + cp) * 2 + 1];
        }
#pragma unroll
        for (int k = 0; k < 8; ++k) Kt[(kh * 8 + k) * 256 + c * 16 + cp] = Kk[k];
        if (d == 0 && kh == 0) Kt[16 * 256 + c * 16 + cp] = k0o;
    }
    __syncthreads();
    for (int idx = tid; idx < 256 * 128; idx += NWAVES * 64) {
        const int row = idx >> 7, col = (idx & 127) * 2, t = row >> 4, cc = row & 15, s_ = col >> 4, c2 = col & 15;
        const int k = d == 0 ? t - s_ : s_ - t;
        if (k < 0 || (d == 1 && k == 0)) continue;
        float v0 = Kt[k * 256 + cc * 16 + c2], v1 = Kt[k * 256 + cc * 16 + c2 + 1];
        if (k == 0) { v0 += Kt[16 * 256 + cc * 16 + c2]; v1 += Kt[16 * 256 + cc * 16 + c2 + 1];
            const float dd = dskip[l * 512 + g * 16 + cc]; if (c2 == cc) v0 += dd; if (c2 + 1 == cc) v1 += dd; }
        *(unsigned*)(TM + (size_t)row * 512 + col) = pk2(v0, v1);
    }
    {
        const int p = tid & 63, cq = tid >> 6;
#pragma unroll
        for (int h2 = 0; h2 < 2; ++h2) { const int c = cq + 8 * h2; const float Cr = Cc[(c * 64 + p) * 2], Ci = Cc[(c * 64 + p) * 2 + 1];
#pragma unroll 4
            for (int e = 1; e <= 16; ++e) { const float pr = pw[(p * 17 + e) * 2], pi = pw[(p * 17 + e) * 2 + 1]; const float wr = Cr * pr - Ci * pi, wi = Cr * pi + Ci * pr;
                const int t = d == 0 ? e - 1 : 16 - e; bf16_t* rowp = TM + (size_t)(t * 16 + c) * 512 + 256 + d * 128 + p;
                rowp[0] = (bf16_t)f2bf(wr); rowp[64] = (bf16_t)f2bf(-wi); } }
    }
    {
        const int sc = tid & 255, e = sc >> 4, cp = sc & 15, ph = tid >> 8, s_ = d == 0 ? 15 - e : e;
#pragma unroll 4
        for (int it = 0; it < 32; ++it) { const int p = ph + 2 * it; const float pr = pw[(p * 17 + e) * 2], pi = pw[(p * 17 + e) * 2 + 1], br = Bb[(p * 16 + cp) * 2], bi = Bb[(p * 16 + cp) * 2 + 1];
            Ms[(size_t)(d * 128 + p) * 256 + s_ * 16 + cp] = (bf16_t)f2bf(pr * br - pi * bi); Ms[(size_t)(d * 128 + 64 + p) * 256 + s_ * 16 + cp] = (bf16_t)f2bf(pr * bi + pi * br); }
    }
    __syncthreads();
}

constexpr int N_PHASES = 14;
__global__ void __launch_bounds__(NWAVES * 64, 2) mega_fwd(Args args) {
    extern __shared__ __attribute__((aligned(16))) unsigned char lds_raw[];
    LAS unsigned char* lds = (LAS unsigned char*)lds_raw;
    volatile LAS unsigned* MISC = (volatile LAS unsigned*)(lds + MISC_OFF);
    const int wave_s = __builtin_amdgcn_readfirstlane((int)threadIdx.x >> 6);
#define PHASE_LANES int lane = hw_lane(); asm volatile("" : "+v"(lane)); const int wave = wave_s; const int ptid = wave * 64 + lane; (void)ptid;
    const int G = gridDim.x; int vcu; { const int bx = blockIdx.x; vcu = (G % 8 == 0) ? (bx % 8) * (G / 8) + bx / 8 : bx; }
    unsigned char* ws = args.ws; unsigned char* dout = (unsigned char*)args.out;
    unsigned* ctl = (unsigned*)(ws + OFF_CTL);
    if (wave_s == 0) { const int l0 = hw_lane(); if (l0 < 32) MISC[l0] = 0u; }
    __syncthreads();
    XcdBarrier bar = xcd_barrier_post(ctl + CW_BAR + args.li * XCD_BAR_WORDS, MISC + 8, wave_s);
    const int lo = args.ph_lo, hi = args.ph_hi;
#ifndef REP_P0
#define REP_P0 1
#endif
#ifndef REP_INPROJ
#define REP_INPROJ 1
#endif
#ifndef REP_EG
#define REP_EG 1
#endif
#ifndef DRY_NA
#define DRY_NA 0
#endif
#ifndef DRY_DIL
#define DRY_DIL 0
#endif
#ifndef REP_SCAN
#define REP_SCAN 1
#endif
#ifndef REP_Y
#define REP_Y 1
#endif
#ifndef DRYVAR
#define DRYVAR 0
#endif
#ifndef CT_SKIP
#define CT_SKIP 0
#endif
#ifndef PHASE_MASK
#define PHASE_MASK 0x3fff
#endif
#define INR(k) (lo <= (k) && (k) < hi)
#define IN(k) (((PHASE_MASK >> (k)) & 1) && INR(k))
#define INL(j) (((PHASE_MASK >> ((j) + 1)) & 1) && INR(pb + (j)))
#define SEAM(k) do { if (INR(k) && INR((k) + 1)) xcd_barrier(bar, wave_s); } while (0)

    bf16_t* proj = (bf16_t*)(ws + OFF_PROJ); bf16_t* xag = (bf16_t*)(ws + OFF_XAG); bf16_t* xb = (bf16_t*)(ws + OFF_XB); float* Ebuf = (float*)(ws + OFF_XB);
    bf16_t* Gb = (bf16_t*)(ws + OFF_G); float* sspart = (float*)(ws + OFF_SS);
    float* rpbs = (float*)(ws + OFF_RPBS); float* t5tb = (float*)(ws + OFF_T5TB);

    if (IN(0)) for (int rep_ = 0; rep_ < REP_P0; ++rep_) {
        PHASE_LANES
        const int NTB = 128;
        for (int ti = vcu; ti < NTB; ti += G) {
            const int l = ti >> 6, g = (ti >> 1) & 31, d = ti & 1;
            bf16_t* TM = (bf16_t*)(l == 0 ? dout + DO_TM0 : ws + OFF_TM1) + (size_t)g * 256 * 512;
            bf16_t* Ms = (bf16_t*)(l == 0 ? dout + DO_MS0 : ws + OFF_MS1) + (size_t)g * 256 * 256;
            p0_ssm_tables(args, l, g, d, TM, Ms, (LAS float*)lds, wave_s);
        }
        {
            const float* rpb = args.in[14]; const float* t5 = args.in[15];
            for (int i = vcu * NWAVES * 64 + ptid; i < att::RPBS_F; i += G * NWAVES * 64) {
                const int ii = i & 63, rr = (i >> 6) % 15, h = (i / (64 * 15)) & 7, c = (i / (64 * 15 * 8)) & 3, l = i / (64 * 15 * 8 * 4); const int cr = ii + c - 17;
                rpbs[i] = (ii + c < 64 && cr >= 0 && cr <= 30) ? rpb[(((size_t)l * 8 + h) * 15 + rr) * 31 + cr] * 1.4426950408889634f : 0.f; }
            for (int i = vcu * NWAVES * 64 + ptid; i < att::T5TB_F + att::T5S_F; i += G * NWAVES * 64) {
                int h, pat, idx;
                if (i < att::T5TB_F) { idx = i % att::TBW; pat = (i / att::TBW) % 3; h = i / (3 * att::TBW); }
                else { const int i2 = i - att::T5TB_F; const int c = (i2 / att::TBW) & 3; h = i2 / (4 * att::TBW); pat = 0; idx = i2 % att::TBW - c; }
                const int w = idx - att::TBOFF; const int d = pat == 0 ? 16 : (pat == 1 ? 4 : 1);
                t5tb[i] = (idx >= 0 && w >= 0 && w <= 128) ? t5[t5_bucket_dev(d * (w - 64)) * 8 + h] * 1.4426950408889634f : att::NEG; }
        }
        {
            LAS float* scr = (LAS float*)(lds + wave * 16384);
            constexpr int I_IN = (DM / 64) * (IN_COLS / 32), I_OUT = (MIXW / 64) * (DM / 32), I_GLU = (512 / 64) * (512 / 32), I_L = I_IN + I_OUT + I_GLU, I_TOT = 2 * I_L + NTOK;
            const int NW_ALL = G * NWAVES, gw = vcu * NWAVES + wave; const bool tblk = vcu < NTB && G > NTB;
            const int NW2 = tblk ? 0 : (G - NTB) * NWAVES, gw2 = (vcu - NTB) * NWAVES + wave;
            const int P1N = G > NTB ? 9 : (I_TOT + NW_ALL - 1) / NW_ALL, I_P1 = P1N * NW_ALL < I_TOT ? P1N * NW_ALL : I_TOT;
            for (int pass = 0; pass < 2; ++pass) {
                const int i0 = pass == 0 ? gw : I_P1 + gw2, i1 = pass == 0 ? I_P1 : I_TOT, st = pass == 0 ? NW_ALL : NW2;
                if (pass == 1 && NW2 == 0) break;
                for (int it = i0; it < i1; it += st) {
                    if (it >= 2 * I_L) { const int mrow = it - 2 * I_L; p0_xrow(args.in[0] + (size_t)mrow * DM, xb + (size_t)mrow * DM, sspart + (size_t)mrow * 16, lane); continue; }
                    const int l = it / I_L; int r = it % I_L;
                    if (r < I_IN) { const int nblk = IN_COLS / 32, kb = r / nblk, nb = r % nblk;
                        p0_transpose_item(args.in[2] + (size_t)l * DM * IN_COLS, DM, IN_COLS, (bf16_t*)(l == 0 ? dout + DO_WINT0 : ws + OFF_WINT1), 64 * kb, inproj_src_col(32 * nb), 32 * nb, args.in[1] + l * DM, scr, lane); continue; }
                    r -= I_IN;
                    if (r < I_OUT) { const int nblk = DM / 32, kb = r / nblk, nb = r % nblk;
                        p0_transpose_item(args.in[3] + (size_t)l * MIXW * DM, MIXW, DM, (bf16_t*)(ws + (l == 0 ? OFF_WOUTT0 : OFF_WOUTT1)), 64 * kb, 32 * nb, 32 * nb, nullptr, scr, lane); continue; }
                    r -= I_OUT;
                    { const int nblk = 512 / 32, kb = r / nblk, nb = r % nblk;
                        p0_transpose_item(args.in[12] + (size_t)l * 512 * 512, 512, 512, (bf16_t*)(l == 0 ? dout + DO_GLUT0 : ws + OFF_GLUT1), 64 * kb, 32 * nb, 32 * nb, nullptr, scr, lane); }
                }
            }
        }
    }
    SEAM(0);

    for (int l = 0; l < DEPTH; ++l) {
        const int pb = 1 + 6 * l;
        const bf16_t* WinT = (const bf16_t*)(l == 0 ? dout + DO_WINT0 : ws + OFF_WINT1);
        const bf16_t* WoutT = (const bf16_t*)(ws + (l == 0 ? OFF_WOUTT0 : OFF_WOUTT1));
        const bf16_t* GluT = (const bf16_t*)(l == 0 ? dout + DO_GLUT0 : ws + OFF_GLUT1);
        const bf16_t* TM = (const bf16_t*)(l == 0 ? dout + DO_TM0 : ws + OFF_TM1);
        const bf16_t* Ms = (const bf16_t*)(l == 0 ? dout + DO_MS0 : ws + OFF_MS1);
        if (INL(0)) for (int rep_ = 0; rep_ < REP_INPROJ; ++rep_) {
            pg8::Gemm gm{xb, WinT, DM, DM, DM, 0, 0}; pg8::StaticOrder S; S.init(NTOK, IN_COLS, G, (int)blockIdx.x);
            pg8::EpiInProj E{sspart, proj, xag};
            pg8::gemm_phase<pg8::EpiInProj, pg8::StaticOrder>(lds, gm, S, E, wave_s);
        }
        SEAM(pb + 0);
        if (INL(1)) {
            if (!(CT_SKIP & 1) && !(args.skip & 1)) for (int rep_ = 0; rep_ < REP_EG; ++rep_) { pg8::Gemm gm{xag, Ms, 512, 256, 256, (size_t)NCHUNK_TOT * 512, (size_t)256 * 256}; pg8::BatchOrder S; S.init(4, 32, G, vcu);
              pg8::EpiE E{Ebuf};
              pg8::gemm_phase<pg8::EpiE, pg8::BatchOrder>(lds, gm, S, E, wave_s); }
            __syncthreads();
            PHASE_LANES
            LAS char* vbuf = (LAS char*)(lds + wave * att::WAVE_LDS);
            const int gw = vcu * NWAVES + wave, NGW = G * NWAVES;
            for (int rep_ = 0; rep_ < DRY_NA; ++rep_) for (int t = gw; t < 8192; t += NGW) att::na_task(proj, rpbs + (size_t)l * 4 * 8 * 15 * 64, t, vbuf, lane, Gb);
            if (!(CT_SKIP & 2) && !(args.skip & 2)) for (int bt = vcu; bt < 1024; bt += G) att::na_block_task(proj, rpbs + (size_t)l * 4 * 8 * 15 * 64, bt, (LAS char*)lds, lane, wave);
            for (int rep_ = 0; rep_ < DRY_DIL; ++rep_) for (int t = gw; t < 8192; t += NGW) att::dil_task<DRYVAR>(proj, t5tb, t, vbuf, lane, Gb);
            if (!(CT_SKIP & 4) && !(args.skip & 4)) for (int bt = vcu; bt < 512; bt += G) att::dil_block_task(proj, t5tb, bt, (LAS char*)lds, lane, wave);
        }
        SEAM(pb + 1);
        if (INL(2)) for (int rep_ = 0; rep_ < REP_SCAN; ++rep_) {
            PHASE_LANES
            const float* lam_re = args.in[4]; const float* lam_im = args.in[5]; const float* log_dt = args.in[6];
            LAS float* sx = (LAS float*)lds;
            for (int cg = vcu; cg < 256; cg += G) {
                const int g = cg >> 3, b = (cg >> 1) & 3, d = cg & 1, p = lane, pg = (l * 2 + d) * 32 + g;
                const float lre = lam_re[pg * 64 + p], lim = lam_im[pg * 64 + p], dt = expf(log_dt[pg]);
                const float er = expf(lre * dt); float ar = er * cosf(lim * dt), ai = er * sinf(lim * dt);
#pragma unroll
                for (int i = 0; i < 4; ++i) { const float t = ar * ar - ai * ai; ai = 2.f * ar * ai; ar = t; }
                const float* Ep = Ebuf + ((size_t)g * NCHUNK_TOT + b * NCHUNK) * 256 + d * 128 + p;
                bf16_t* Cp = xag + ((size_t)g * NCHUNK_TOT + b * NCHUNK) * 512 + 256 + d * 128 + p;
                float er_[32], ei_[32];
#pragma unroll
                for (int i = 0; i < 32; ++i) { const int s = wave * 32 + i, k = d == 0 ? s : NCHUNK - 1 - s; er_[i] = Ep[(size_t)k * 256]; ei_[i] = Ep[(size_t)k * 256 + 64]; }
                float cr = 0.f, ci = 0.f;
#pragma unroll
                for (int i = 0; i < 32; ++i) { const float xr = er_[i], xi = ei_[i]; er_[i] = cr; ei_[i] = ci; const float t = ar * cr - ai * ci + xr; ci = ar * ci + ai * cr + xi; cr = t; }
                sx[(wave * 64 + lane) * 2] = cr; sx[(wave * 64 + lane) * 2 + 1] = ci;
                float a32r = ar, a32i = ai;
#pragma unroll
                for (int i = 0; i < 5; ++i) { const float t = a32r * a32r - a32i * a32i; a32i = 2.f * a32r * a32i; a32r = t; }
                __syncthreads();
                float inr = 0.f, ini = 0.f;
                for (int j = 0; j < wave; ++j) { const float tr = sx[(j * 64 + lane) * 2], ti = sx[(j * 64 + lane) * 2 + 1]; const float t = a32r * inr - a32i * ini + tr; ini = a32r * ini + a32i * inr + ti; inr = t; }
                float pr = inr, pi = ini;
#pragma unroll
                for (int i = 0; i < 32; ++i) { const int s = wave * 32 + i, k = d == 0 ? s : NCHUNK - 1 - s;
                    Cp[(size_t)k * 512] = (bf16_t)f2bf(er_[i] + pr); Cp[(size_t)k * 512 + 64] = (bf16_t)f2bf(ei_[i] + pi);
                    const float t = ar * pr - ai * pi; pi = ar * pi + ai * pr; pr = t; }
                __syncthreads();
            }
        }
        SEAM(pb + 2);
        if (INL(3)) for (int rep_ = 0; rep_ < REP_Y; ++rep_) {
            pg8::Gemm gm{xag, TM, 512, 512, 512, (size_t)NCHUNK_TOT * 512, (size_t)256 * 512}; pg8::BatchOrder S; S.init(4, 32, G, vcu);
            pg8::EpiY E{Gb};
            pg8::gemm_phase<pg8::EpiY, pg8::BatchOrder>(lds, gm, S, E, wave_s);
        }
        SEAM(pb + 3);
        if (INL(4)) {
            pg8::Gemm gm{Gb, GluT, 512, 512, 512, 0, 0}; pg8::StaticOrder S; S.init(NTOK, 512, G, (int)blockIdx.x);
            pg8::EpiGlu E{Gb, args.in[13] + l * 512, proj};
            pg8::gemm_phase<pg8::EpiGlu, pg8::StaticOrder>(lds, gm, S, E, wave_s);
        }
        SEAM(pb + 4);
        if (INL(5)) {
            pg8::Gemm gm{proj, WoutT, PLD, MIXW, MIXW, 0, 0}; pg8::StaticOrder S; S.init(NTOK, DM, G, (int)blockIdx.x);
            pg8::EpiOutProj E{l == 0 ? args.in[0] : args.out, args.out, xb, sspart, l == 0 ? 1 : 0};
            pg8::gemm_phase<pg8::EpiOutProj, pg8::StaticOrder>(lds, gm, S, E, wave_s);
        }
        SEAM(pb + 5);
    }
    if (IN(13)) {
        PHASE_LANES
        const float* fg = args.in[16];
        const int gw = vcu * NWAVES + wave, NGW = G * NWAVES;
        for (int m = gw; m < NTOK; m += NGW) {
            const f32x4* sp = (const f32x4*)(sspart + (size_t)m * 16);
            const f32x4 s0 = sp[0], s1 = sp[1], s2 = sp[2], s3 = sp[3];
            const float ss = (((s0[0] + s0[1]) + (s0[2] + s0[3])) + ((s1[0] + s1[1]) + (s1[2] + s1[3]))) + (((s2[0] + s2[1]) + (s2[2] + s2[3])) + ((s3[0] + s3[1]) + (s3[2] + s3[3])));
            const float rinv = rsqrtf(ss * (1.0f / DM) + RMS_EPS);
            f32x4* xr = (f32x4*)(args.out + (size_t)m * DM) + lane;
#pragma unroll
            for (int j = 0; j < 4; ++j) { const f32x4 gv = *((const f32x4*)fg + lane + 64 * j); xr[64 * j] = xr[64 * j] * rinv * gv; }
        }
    }
#undef IN
#undef INL
#undef INR
#undef SEAM
}
#define HOST_PLAN launch_mega(d_in, d_out, d_ws, stream, 0, N_PHASES, 0, 0);
static int g_grid = 0;
static void launch_mega(void* const* d_in, void* d_out, void* d_ws, hipStream_t stream, int lo, int hi, int li, int skip) {
    Args a{};
    for (int i = 0; i < 17; ++i) a.in[i] = (const float*)d_in[i];
    a.out = (float*)d_out; a.ws = (unsigned char*)d_ws; a.ph_lo = lo; a.ph_hi = hi; a.li = li; a.skip = skip;
    hipLaunchKernelGGL(mega_fwd, dim3(g_grid), dim3(NWAVES * 64), LDS_BYTES, stream, a);
    const hipError_t le = hipPeekAtLastError();
    if (le != hipSuccess) fprintf(stderr, "kernel_launch: launch failed: %s (grid %d)\n", hipGetErrorName(le), g_grid);
}
extern "C" void kernel_launch(void* const* d_in, const int* in_sizes, int n_in, void* d_out, int out_size, void* d_ws, size_t ws_size, hipStream_t stream) {
    if (g_grid == 0) {
        if (n_in != 17 || in_sizes[0] != NTOK * DM || out_size != NTOK * DM || ws_size < WS_NEED) { fprintf(stderr, "kernel_launch: unexpected shapes (n_in %d in0 %d out %d ws %zu need %zu)\n", n_in, n_in > 0 ? in_sizes[0] : -1, out_size, ws_size, (size_t)WS_NEED); g_grid = -1; return; }
        int dev = 0, cus = 0, per_cu = 0;
        if (hipGetDevice(&dev) != hipSuccess || hipDeviceGetAttribute(&cus, hipDeviceAttributeMultiprocessorCount, dev) != hipSuccess) { g_grid = -1; return; }
        if (hipFuncSetAttribute((const void*)mega_fwd, hipFuncAttributeMaxDynamicSharedMemorySize, LDS_BYTES) != hipSuccess) { fprintf(stderr, "kernel_launch: hipFuncSetAttribute failed\n"); g_grid = -1; return; }
        if (hipOccupancyMaxActiveBlocksPerMultiprocessor(&per_cu, (const void*)mega_fwd, NWAVES * 64, LDS_BYTES) != hipSuccess || per_cu < 1) { fprintf(stderr, "kernel_launch: occupancy query says %d\n", per_cu); per_cu = 1; }
        (void)hipGetLastError();
        g_grid = cus * 1;
    }
    if (g_grid < 0) return;
    (void)hipMemsetAsync((char*)d_ws + OFF_CTL, 0, CTL_ZERO_BYTES, stream);
    HOST_PLAN
}
```

```cpp
#include <hip/hip_runtime.h>
#include <cstdio>
#include <cstdint>
#include <cmath>

typedef unsigned short bf16_t;

constexpr int NB = 4, SEQ = 4096, DM = 1024, NTOK = NB * SEQ, DEPTH = 2;
constexpr int IN_COLS = 5120, MIXW = 1536;
constexpr float RMS_EPS = 1e-6f;
constexpr int LCH = 16;
constexpr int NCHUNK = SEQ / LCH;
constexpr int NCHUNK_TOT = NB * NCHUNK;
constexpr int PLD = 4608;
constexpr int PC_ZA = 0, PC_QB = 512, PC_QC = 1024, PC_KB = 1536, PC_VB = 2048, PC_ZB = 2560, PC_KC = 3072, PC_VC = 3584, PC_ZC = 4096;
__host__ __device__ __forceinline__ int inproj_src_col(int n) {
    if (n < 512) return n;
    const int pc = n - 512, s = pc >> 9;
    const int seg = (s == 0) ? 1 : (s == 1) ? 2 : (s == 2) ? 6 : (s == 3) ? 3 : (s == 4) ? 4 : (s == 5) ? 5 : (s == 6) ? 7 : (s == 7) ? 8 : 9;
    return seg * 512 + (pc & 511);
}

constexpr size_t OFF_CTL = 0;
constexpr size_t OFF_SS = 1u << 20;
constexpr size_t OFF_PROJ = 2u << 20;
constexpr size_t SZ_PROJ = (size_t)NTOK * PLD * 2;
constexpr size_t OFF_XAG = OFF_PROJ + SZ_PROJ;
constexpr size_t SZ_XAG = (size_t)32 * NCHUNK_TOT * 512 * 2;
constexpr size_t OFF_XB = OFF_XAG + SZ_XAG;
constexpr size_t SZ_XB = (size_t)NTOK * DM * 2;
constexpr size_t OFF_G = OFF_XB + SZ_XB;
constexpr size_t SZ_G = (size_t)NTOK * 512 * 2;
constexpr size_t OFF_W = OFF_G + SZ_G;
constexpr size_t WS_NEED_NAIVE = OFF_W;

__host__ __device__ __forceinline__ unsigned f2bf(float f) { unsigned u = __builtin_bit_cast(unsigned, f); return (u + 0x7fffu + ((u >> 16) & 1u)) >> 16; }
__host__ __device__ __forceinline__ float bf2f(bf16_t b) { return __builtin_bit_cast(float, (unsigned)b << 16); }

__device__ __forceinline__ int hw_lane() { int r; asm volatile("v_mbcnt_lo_u32_b32 %0, -1, 0\n\tv_mbcnt_hi_u32_b32 %0, -1, %0" : "=v"(r)); return r; }
namespace pg8 {
#define PG8_LAS __attribute__((address_space(3)))
typedef short bf16x8 __attribute__((ext_vector_type(8)));
typedef float f32x4 __attribute__((ext_vector_type(4)));
typedef unsigned u32x4 __attribute__((ext_vector_type(4)));
typedef unsigned u32x2 __attribute__((ext_vector_type(2)));
constexpr int BM = 256, BK = 64, HALF = 128, HTB = HALF * BK * 2  , STAGE_BYTES = 8 * HTB, NXCD = 8, WGM = 8;

__host__ __device__ __forceinline__ int lds_byte(int r, int c) { const int st = (r >> 4) * 2 + (c >> 5), rr = r & 15, cc = c & 31, ob = rr * 64 + cc * 2; return st * 1024 + (ob ^ (((ob >> 9) & 1) << 5)); }
__host__ __device__ __forceinline__ void stage_rc(int b, int& R, int& C) { const int st = b / 1024, sb = b % 1024, swz = sb ^ (((sb >> 9) & 1) << 5); R = (st >> 1) * 16 + swz / 64; C = (st & 1) * 32 + (swz % 64) / 2; }
__host__ __device__ __forceinline__ int perm32(int rho) { const int n = rho >> 4, i = rho & 15; return 8 * (i >> 2) + 4 * n + (i & 3); }

struct Unit { int pm, pn, bz; };
struct Gemm { const bf16_t* A; const bf16_t* Bt; int lda, ldb, K; size_t a_bz, b_bz; };

struct StaticOrder {
    int nM, nN, nwg, G, c;
    __host__ __device__ void init(int M, int N, int G_, int c_) { nM = M / BM; nN = N / BM; nwg = nM * nN; G = G_; c = c_; }
    __host__ __device__ bool next(int i, Unit& u) const {
        const long L = (long)i * G + c; if (L >= nwg) return false;
        int wgid = (int)L; { const int q = nwg / NXCD, r = nwg % NXCD, xcd = wgid % NXCD, off = wgid / NXCD; wgid = (xcd < r ? xcd * (q + 1) : r * (q + 1) + (xcd - r) * q) + off; }
        const int nig = WGM * nN, gid = wgid / nig, fm = gid * WGM, gsz = (nM - fm) < WGM ? (nM - fm) : WGM;
        u.pm = fm + ((wgid % nig) % gsz); u.pn = (wgid % nig) / gsz; u.bz = 0; return true;
    }
};
struct BatchOrder {
    int nM, nwg, G, c;
    __host__ __device__ void init(int nM_, int nBatch, int G_, int c_) { nM = nM_; nwg = nM_ * nBatch; G = G_; c = c_; }
    __host__ __device__ bool next(int i, Unit& u) const {
        const long L = (long)i * G + c; if (L >= nwg) return false;
        u.bz = (int)L >> 2; u.pm = (int)L & 3; u.pn = 0; return true;
    }
};

struct OneUnit { Unit u; __host__ __device__ bool next(int i, Unit& o) const { if (i != 0) return false; o = u; return true; } };

__device__ __forceinline__ unsigned cvt_pk_bf16(float lo, float hi) { unsigned r; asm volatile("v_cvt_pk_bf16_f32 %0, %1, %2" : "=v"(r) : "v"(lo), "v"(hi)); return r; }
__device__ __forceinline__ u32x4 pack8(const f32x4 v0, const f32x4 v1) { u32x4 w; w.x = cvt_pk_bf16(v0[0], v0[1]); w.y = cvt_pk_bf16(v0[2], v0[3]); w.z = cvt_pk_bf16(v1[0], v1[1]); w.w = cvt_pk_bf16(v1[2], v1[3]); return w; }
__device__ __forceinline__ float bfl(unsigned w) { return __builtin_bit_cast(float, w << 16); }
__device__ __forceinline__ float bfh(unsigned w) { return __builtin_bit_cast(float, w & 0xffff0000u); }


struct EpiInProj {
    static constexpr bool PERM = true, AFTER_DRAIN = false;
    const float* sspart; bf16_t* proj; bf16_t* xag;
    __device__ __forceinline__ void operator()(const f32x4 (&acc)[2][2][4][2], const Unit& u, int wr, int wc, int fr, int fq) const {
        const int row0 = u.pm * BM + wr * 64 + fr, colt = u.pn * BM + wc * 32 + 8 * fq;
#pragma unroll
        for (int ai = 0; ai < 2; ++ai)
#pragma unroll
            for (int m = 0; m < 4; ++m) {
                const int row = row0 + ai * HALF + m * 16;
                const f32x4* sp = (const f32x4*)(sspart + (size_t)row * 16);
                const f32x4 s0 = sp[0], s1 = sp[1], s2 = sp[2], s3 = sp[3];
                const float ss = (((s0[0] + s0[1]) + (s0[2] + s0[3])) + ((s1[0] + s1[1]) + (s1[2] + s1[3]))) + (((s2[0] + s2[1]) + (s2[2] + s2[3])) + ((s3[0] + s3[1]) + (s3[2] + s3[3])));
                const float rinv = rsqrtf(ss * (1.0f / DM) + RMS_EPS);
#pragma unroll
                for (int bj = 0; bj < 2; ++bj) {
                    const int col = colt + bj * HALF;
                    const u32x4 w = pack8(acc[ai][bj][m][0] * rinv, acc[ai][bj][m][1] * rinv);
                    bf16_t* dst = (u.pn < 2) ? xag + ((size_t)(col >> 4) * NCHUNK_TOT + (row >> 4)) * 512 + (row & 15) * 16 + (col & 15)
                                             : proj + (size_t)row * PLD + (col - 512);
                    *(u32x4*)dst = w;
                }
                asm volatile("" ::: "memory");
            }
    }
};
struct EpiE {
    static constexpr bool PERM = true, AFTER_DRAIN = false;
    float* E;
    __device__ __forceinline__ void operator()(const f32x4 (&acc)[2][2][4][2], const Unit& u, int wr, int wc, int fr, int fq) const {
        const int row0 = u.pm * BM + wr * 64 + fr, colt = wc * 32 + 8 * fq;
#pragma unroll
        for (int ai = 0; ai < 2; ++ai)
#pragma unroll
            for (int m = 0; m < 4; ++m) {
                float* rp = E + ((size_t)u.bz * NCHUNK_TOT + row0 + ai * HALF + m * 16) * 256 + colt;
#pragma unroll
                for (int bj = 0; bj < 2; ++bj) { *(f32x4*)(rp + bj * HALF) = acc[ai][bj][m][0]; *(f32x4*)(rp + bj * HALF + 4) = acc[ai][bj][m][1]; }
                asm volatile("" ::: "memory");
            }
    }
};
struct EpiY {
    static constexpr bool PERM = true, AFTER_DRAIN = false;
    bf16_t* G;
    __device__ __forceinline__ static float gelu(float y) {
        const float a = 0.7978845608028654f * (y + 0.044715f * y * y * y);
        return y * __builtin_amdgcn_rcpf(1.0f + __builtin_amdgcn_exp2f(-2.885390081777927f * a));
    }
    __device__ __forceinline__ void operator()(const f32x4 (&acc)[2][2][4][2], const Unit& u, int wr, int wc, int fr, int fq) const {
        const int row0 = u.pm * BM + wr * 64 + fr, colt = wc * 32 + 8 * fq;
#pragma unroll
        for (int ai = 0; ai < 2; ++ai)
#pragma unroll
            for (int m = 0; m < 4; ++m) {
                const int n = row0 + ai * HALF + m * 16;
#pragma unroll
                for (int bj = 0; bj < 2; ++bj) {
                    const int col = colt + bj * HALF, t = col >> 4, c0 = col & 15;
                    f32x4 v0 = acc[ai][bj][m][0], v1 = acc[ai][bj][m][1];
#pragma unroll
                    for (int e = 0; e < 4; ++e) { v0[e] = gelu(v0[e]); v1[e] = gelu(v1[e]); }
                    *(u32x4*)(G + ((size_t)n * 16 + t) * 512 + u.bz * 16 + c0) = pack8(v0, v1);
                }
                asm volatile("" ::: "memory");
            }
    }
};
struct EpiGlu {
    static constexpr bool PERM = true, AFTER_DRAIN = false;
    const bf16_t* G; const float* bias; bf16_t* proj; int dry;
    __device__ __forceinline__ static float sig(float v) { return __builtin_amdgcn_rcpf(1.0f + __builtin_amdgcn_exp2f(-1.4426950408889634f * v)); }
    __device__ __forceinline__ void operator()(const f32x4 (&acc)[2][2][4][2], const Unit& u, int wr, int wc, int fr, int fq) const {
        const int row0 = u.pm * BM + wr * 64 + fr, colt = u.pn * BM + wc * 32 + 8 * fq;
#pragma unroll
        for (int bj = 0; bj < 2; ++bj) {
            const int col = colt + bj * HALF;
            const f32x4 b0 = *(const f32x4*)(bias + col), b1 = *(const f32x4*)(bias + col + 4);
#pragma unroll
            for (int ai = 0; ai < 2; ++ai)
#pragma unroll
                for (int m = 0; m < 4; ++m) {
                    const int row = row0 + ai * HALF + m * 16;
                    const u32x4 gg = *(const u32x4*)(G + (size_t)row * 512 + col);
                    bf16_t* zp = proj + (size_t)row * PLD + PC_ZA + col;
                    const u32x4 zz = *(const u32x4*)zp;
                    const f32x4 a0 = acc[ai][bj][m][0] + b0, a1 = acc[ai][bj][m][1] + b1;
                    f32x4 o0, o1;
#pragma unroll
                    for (int e = 0; e < 4; ++e) {
                        const unsigned gw0 = gg[e >> 1], zw0 = zz[e >> 1], gw1 = gg[2 + (e >> 1)], zw1 = zz[2 + (e >> 1)];
                        const float g0 = (e & 1) ? bfh(gw0) : bfl(gw0), z0 = (e & 1) ? bfh(zw0) : bfl(zw0);
                        const float g1 = (e & 1) ? bfh(gw1) : bfl(gw1), z1 = (e & 1) ? bfh(zw1) : bfl(zw1);
                        o0[e] = g0 * sig(a0[e]) * (z0 * sig(z0)); o1[e] = g1 * sig(a1[e]) * (z1 * sig(z1));
                    }
                    if (!dry) *(u32x4*)zp = pack8(o0, o1); else asm volatile("" :: "v"(o0), "v"(o1));
                    asm volatile("" ::: "memory");
                }
        }
    }
};
struct EpiOutProj {
    static constexpr bool PERM = true, AFTER_DRAIN = false;
    const float* xold; float* xout; bf16_t* xb; float* sspart; int write_xb; int dry;
    __device__ __forceinline__ void operator()(const f32x4 (&acc)[2][2][4][2], const Unit& u, int wr, int wc, int fr, int fq) const {
        const int row0 = u.pm * BM + wr * 64 + fr, colt = u.pn * BM + wc * 32 + 8 * fq;
#pragma unroll
        for (int ai = 0; ai < 2; ++ai)
#pragma unroll
            for (int m = 0; m < 4; ++m) {
                const int row = row0 + ai * HALF + m * 16;
                float ssl = 0.f;
#pragma unroll
                for (int bj = 0; bj < 2; ++bj) {
                    const size_t off = (size_t)row * DM + colt + bj * HALF;
                    const f32x4 n0 = *(const f32x4*)(xold + off) + acc[ai][bj][m][0], n1 = *(const f32x4*)(xold + off + 4) + acc[ai][bj][m][1];
                    if (!dry) { *(f32x4*)(xout + off) = n0; *(f32x4*)(xout + off + 4) = n1;
                    if (write_xb) *(u32x4*)(xb + off) = pack8(n0, n1); }
                    ssl += ((n0[0] * n0[0] + n0[1] * n0[1]) + (n0[2] * n0[2] + n0[3] * n0[3])) + ((n1[0] * n1[0] + n1[1] * n1[1]) + (n1[2] * n1[2] + n1[3] * n1[3]));
                }
                ssl += __shfl_xor(ssl, 16); ssl += __shfl_xor(ssl, 32);
                if (fq == 0 && !dry) sspart[(size_t)row * 16 + u.pn * 4 + wc] = ssl; else asm volatile("" :: "v"(ssl));
                asm volatile("" ::: "memory");
            }
    }
};

template <class Epi, class Sched, bool ALIGN_EPI = true>
__device__ __forceinline__ void gemm_phase(PG8_LAS unsigned char* lds, const Gemm g, const Sched& S, const Epi& E, int wave_s) {
    int tid = wave_s * 64 + hw_lane(); asm volatile("" : "+v"(tid));
    const int wid = __builtin_amdgcn_readfirstlane(tid >> 6), lane = tid & 63, wr = wid >> 2, wc = wid & 3, fr = lane & 15, fq = lane >> 4;
    int K = g.K; asm volatile("" : "+s"(K));
    const int nt = K / BK;
    unsigned voffA[2], voffB[2];
#pragma unroll
    for (int i = 0; i < 2; ++i) { int R, C; stage_rc(tid * 16 + i * 8192, R, C); const int Rb = Epi::PERM ? ((R & ~31) + perm32(R & 31)) : R;
        voffA[i] = (unsigned)(R * g.lda + C) * 2u; voffB[i] = (unsigned)(Rb * g.ldb + C) * 2u; }
    const size_t kstep = (size_t)(BK * 2);
    const size_t hstepA = (size_t)HALF * g.lda * 2, hstepB = (size_t)HALF * g.ldb * 2;
    const unsigned ldsw = (unsigned)wid * 1024u;
    const int aoff = lds_byte(wr * 64 + fr, fq * 8), boff = lds_byte(wc * 32 + fr, fq * 8);
#define PG8_SA(b, h) (((b) * 2 + (h)) * HTB)
#define PG8_SB(b, h) ((4 + (b) * 2 + (h)) * HTB)
#define PG8_STAGE(bufoff, gbase, voff) do { _Pragma("unroll") for (int _i = 0; _i < 2; ++_i) \
        __builtin_amdgcn_global_load_lds((const unsigned*)((const char*)(gbase) + (voff)[_i]), (PG8_LAS unsigned*)(lds + (bufoff) + ldsw + _i * 8192), 16, 0, 0); } while (0)
#define PG8_LDA(dst, b, h) do { _Pragma("unroll") for (int m = 0; m < 4; ++m) _Pragma("unroll") for (int k = 0; k < 2; ++k) dst[m][k] = *(const PG8_LAS bf16x8*)(lds + PG8_SA(b, h) + aoff + m * 2048 + k * 1024); } while (0)
#define PG8_LDB(dst, b, h) do { _Pragma("unroll") for (int n = 0; n < 2; ++n) _Pragma("unroll") for (int k = 0; k < 2; ++k) dst[n][k] = *(const PG8_LAS bf16x8*)(lds + PG8_SB(b, h) + boff + n * 2048 + k * 1024); } while (0)
#define PG8_MMA(ai, bj, At, Bt) do { __builtin_amdgcn_s_setprio(1); _Pragma("unroll") for (int m = 0; m < 4; ++m) _Pragma("unroll") for (int n = 0; n < 2; ++n) _Pragma("unroll") for (int k = 0; k < 2; ++k) \
        acc[ai][bj][m][n] = __builtin_amdgcn_mfma_f32_16x16x32_bf16(Bt[n][k], At[m][k], acc[ai][bj][m][n], 0, 0, 0); __builtin_amdgcn_s_setprio(0); } while (0)
#define PG8_WAIT_V(n) asm volatile("s_waitcnt vmcnt(" #n ")" ::: "memory")
#define PG8_WAIT_L(n) asm volatile("s_waitcnt lgkmcnt(" #n ")" ::: "memory")
#define PG8_BAR __builtin_amdgcn_s_barrier()
#define PG8_SCHED __builtin_amdgcn_sched_barrier(0)
#define PG8_ABASE(u) ((const char*)g.A + ((size_t)(u).bz * g.a_bz + (size_t)(u).pm * BM * g.lda) * 2)
#define PG8_BBASE(u) ((const char*)g.Bt + ((size_t)(u).bz * g.b_bz + (size_t)(u).pn * BM * g.ldb) * 2)
    Unit cur, nxt; int ui = 0;
    if (!S.next(0, cur)) return;
    f32x4 acc[2][2][4][2];
#pragma unroll
    for (int a = 0; a < 2; ++a)
#pragma unroll
        for (int b = 0; b < 2; ++b)
#pragma unroll
            for (int m = 0; m < 4; ++m)
#pragma unroll
                for (int n = 0; n < 2; ++n) acc[a][b][m][n] = (f32x4){0.f, 0.f, 0.f, 0.f};
    bf16x8 At[4][2], B0[2][2], B1[2][2];
    const char* cA = PG8_ABASE(cur); const char* cB = PG8_BBASE(cur);
    PG8_STAGE(PG8_SB(0, 0), cB, voffB); PG8_STAGE(PG8_SB(0, 1), cB + hstepB, voffB); PG8_STAGE(PG8_SA(0, 0), cA, voffA); PG8_STAGE(PG8_SA(0, 1), cA + hstepA, voffA);
    if (wr == 1) PG8_BAR;
    PG8_WAIT_V(2); PG8_BAR;
    PG8_STAGE(PG8_SB(1, 0), cB + kstep, voffB); PG8_STAGE(PG8_SA(1, 0), cA + kstep, voffA); PG8_STAGE(PG8_SB(1, 1), cB + hstepB + kstep, voffB);
    PG8_WAIT_V(6); PG8_BAR;
    for (;;) {
        const bool has_next = S.next(ui + 1, nxt);
        const char* nA = has_next ? PG8_ABASE(nxt) : cA; const char* nB = has_next ? PG8_BBASE(nxt) : cB;
        for (int t = 0; t < nt; t += 2) {
            const bool last = (t == nt - 2);
            const char* a1 = cA + (size_t)(t + 1) * kstep;
            const char* a2 = last ? nA : cA + (size_t)(t + 2) * kstep; const char* b2 = last ? nB : cB + (size_t)(t + 2) * kstep;
            const char* a3 = a2 + kstep; const char* b3 = b2 + kstep;
            PG8_LDB(B0, 0, 0); PG8_LDB(B1, 0, 1); PG8_SCHED; PG8_LDA(At, 0, 0); PG8_STAGE(PG8_SA(1, 1), a1 + hstepA, voffA);
            PG8_WAIT_V(8); PG8_WAIT_L(0); PG8_BAR; PG8_MMA(0, 0, At, B0); PG8_MMA(0, 1, At, B1); PG8_BAR; PG8_SCHED;
            PG8_LDA(At, 0, 1); PG8_STAGE(PG8_SB(0, 0), b2, voffB); PG8_STAGE(PG8_SB(0, 1), b2 + hstepB, voffB); PG8_STAGE(PG8_SA(0, 0), a2, voffA);
            PG8_WAIT_V(8); PG8_WAIT_L(0); PG8_BAR; PG8_MMA(1, 0, At, B0); PG8_MMA(1, 1, At, B1); PG8_BAR; PG8_SCHED;
            PG8_LDB(B0, 1, 0); PG8_LDB(B1, 1, 1); PG8_SCHED; PG8_LDA(At, 1, 0); PG8_STAGE(PG8_SA(0, 1), a2 + hstepA, voffA);
            PG8_WAIT_V(8); PG8_WAIT_L(0); PG8_BAR; PG8_MMA(0, 0, At, B0); PG8_MMA(0, 1, At, B1); PG8_BAR; PG8_SCHED;
            PG8_LDA(At, 1, 1); PG8_STAGE(PG8_SB(1, 0), b3, voffB); PG8_STAGE(PG8_SB(1, 1), b3 + hstepB, voffB); PG8_STAGE(PG8_SA(1, 0), a3, voffA);
            PG8_WAIT_V(8); PG8_WAIT_L(0); PG8_BAR; PG8_MMA(1, 0, At, B0); PG8_MMA(1, 1, At, B1); PG8_BAR; PG8_SCHED;
        }
        if constexpr (ALIGN_EPI) { if (wr == 0) PG8_BAR; }
        E(acc, cur, wr, wc, fr, fq);
        if (!has_next) break;
#pragma unroll
        for (int a = 0; a < 2; ++a)
#pragma unroll
            for (int b = 0; b < 2; ++b)
#pragma unroll
                for (int m = 0; m < 4; ++m)
#pragma unroll
                    for (int n = 0; n < 2; ++n) acc[a][b][m][n] = (f32x4){0.f, 0.f, 0.f, 0.f};
        cur = nxt; cA = nA; cB = nB; ++ui;
        if constexpr (ALIGN_EPI) { if (wr == 1) PG8_BAR; }
    }
    PG8_WAIT_V(0);
    if constexpr (!ALIGN_EPI) { if (wr == 0) PG8_BAR; }
    PG8_BAR;
#undef PG8_SA
#undef PG8_SB
#undef PG8_STAGE
#undef PG8_LDA
#undef PG8_LDB
#undef PG8_MMA
#undef PG8_WAIT_V
#undef PG8_WAIT_L
#undef PG8_BAR
#undef PG8_SCHED
#undef PG8_ABASE
#undef PG8_BBASE
}
}
namespace att {
#define LAS __attribute__((address_space(3)))
typedef short bf16x8 __attribute__((ext_vector_type(8)));
typedef short s16x4 __attribute__((ext_vector_type(4)));
typedef float f32x4 __attribute__((ext_vector_type(4)));
typedef unsigned u32x4 __attribute__((ext_vector_type(4)));
typedef unsigned u32x2 __attribute__((ext_vector_type(2)));
typedef float f32x2_t __attribute__((ext_vector_type(2)));
typedef __bf16 bf16x2_t __attribute__((ext_vector_type(2)));
constexpr int VROW = 160;
constexpr int VTILE = 32 * VROW;
constexpr int WAVE_LDS = 2 * VTILE;
constexpr float C2 = 0.125f * 1.4426950408889634f;
constexpr float NEG = -1e30f, MFLOOR = -1e20f, THR = 8.0f;
constexpr int TBW = 640, TBOFF = 240;
constexpr int T5TB_F = 8 * 3 * TBW, T5S_F = 8 * 4 * TBW, RPBS_F = 2 * 4 * 8 * 15 * 64;

__device__ __forceinline__ unsigned cvtpk(float lo, float hi) { f32x2_t v = {lo, hi}; bf16x2_t b = __builtin_convertvector(v, bf16x2_t); return __builtin_bit_cast(unsigned, b); }
__device__ __forceinline__ s16x4 vtr(LAS const char* p) { typedef short v4i16_t __attribute__((ext_vector_type(4))); return __builtin_bit_cast(s16x4, __builtin_amdgcn_ds_read_tr16_b64_v4i16((LAS v4i16_t*)p)); }

__device__ __forceinline__ float max3f(float a, float b, float c) { float r; asm("v_max3_f32 %0, %1, %2, %3" : "=v"(r) : "v"(a), "v"(b), "v"(c)); return r; }
__device__ __forceinline__ float max2f(float a, float b) { float r; asm("v_max_f32_e32 %0, %1, %2" : "=v"(r) : "v"(a), "v"(b)); return r; }
struct State { float m, l; f32x4 acc[4]; };
struct Stage { bf16x8 k00, k01, k10, k11; u32x4 v0, v1, v2, v3; };
struct Bias { f32x4 b0, b1; };

__device__ __forceinline__ void softmax_pv(State& st, f32x4 t0, f32x4 t1, LAS const char* vt, int lane) {
    const float mloc = max2f(max3f(max3f(t0[0], t0[1], t0[2]), t0[3], t1[0]), max3f(t1[1], t1[2], t1[3]));
    if (__builtin_amdgcn_ballot_w64(mloc > st.m + THR) != 0ull) {
        float mx = max2f(mloc, __shfl_xor(mloc, 16)); mx = max2f(mx, __shfl_xor(mx, 32));
        const float mn = max2f(st.m, mx);
        const float alpha = __builtin_amdgcn_exp2f(st.m - mn);
        st.m = mn; st.l *= alpha;
#pragma unroll
        for (int mt = 0; mt < 4; ++mt) st.acc[mt] = st.acc[mt] * alpha;
    }
    const float mn = st.m;
    f32x4 p0, p1;
#pragma unroll
    for (int e = 0; e < 4; ++e) { p0[e] = __builtin_amdgcn_exp2f(t0[e] - mn); p1[e] = __builtin_amdgcn_exp2f(t1[e] - mn); }
    st.l += (((p0[0] + p0[1]) + (p0[2] + p0[3])) + ((p1[0] + p1[1]) + (p1[2] + p1[3])));
    u32x4 pw; pw.x = cvtpk(p0[0], p0[1]); pw.y = cvtpk(p0[2], p0[3]); pw.z = cvtpk(p1[0], p1[1]); pw.w = cvtpk(p1[2], p1[3]);
    const bf16x8 pb = __builtin_bit_cast(bf16x8, pw);
    const int g = lane >> 4, qq = (lane & 15) >> 2, pp = lane & 3;
    LAS const char* vb = vt + (4 * g + qq) * VROW + pp * 8;
#pragma unroll
    for (int mt = 0; mt < 4; ++mt) {
        const s16x4 lo = vtr(vb + mt * 32), hi = vtr(vb + 16 * VROW + mt * 32);
        const bf16x8 av = (bf16x8){lo[0], lo[1], lo[2], lo[3], hi[0], hi[1], hi[2], hi[3]};
        st.acc[mt] = __builtin_amdgcn_mfma_f32_16x16x32_bf16(av, pb, st.acc[mt], 0, 0, 0);
    }
}
__device__ __forceinline__ void write_v(const Stage& s, LAS char* vt, int lane) {
    LAS char* vw = vt + (lane >> 1) * VROW + (lane & 1) * 64;
    *(LAS u32x4*)vw = s.v0; *(LAS u32x4*)(vw + 16) = s.v1; *(LAS u32x4*)(vw + 32) = s.v2; *(LAS u32x4*)(vw + 48) = s.v3;
}
__device__ __forceinline__ void qk(const Stage& s, const Bias& bs, bf16x8 bq0, bf16x8 bq1, f32x4& t0, f32x4& t1) {
    f32x4 s0 = (f32x4){0.f, 0.f, 0.f, 0.f}, s1 = s0;
    s0 = __builtin_amdgcn_mfma_f32_16x16x32_bf16(s.k00, bq0, s0, 0, 0, 0); s0 = __builtin_amdgcn_mfma_f32_16x16x32_bf16(s.k01, bq1, s0, 0, 0, 0);
    s1 = __builtin_amdgcn_mfma_f32_16x16x32_bf16(s.k10, bq0, s1, 0, 0, 0); s1 = __builtin_amdgcn_mfma_f32_16x16x32_bf16(s.k11, bq1, s1, 0, 0, 0);
    t0 = s0 * C2 + bs.b0; t1 = s1 * C2 + bs.b1;
}

__device__ __forceinline__ void finish(State& st, bf16_t* outp  , const bf16_t* zp, int lane) {
    float l = st.l; l += __shfl_xor(l, 16); l += __shfl_xor(l, 32);
    const float rl = 1.0f / l;
    const int g = lane >> 4;
#pragma unroll
    for (int mt = 0; mt < 4; ++mt) {
        const u32x2 zz = *(const u32x2*)(zp + mt * 16 + 4 * g);
        float o[4];
#pragma unroll
        for (int e = 0; e < 4; ++e) {
            const unsigned zw = zz[e >> 1]; const float z = (e & 1) ? __builtin_bit_cast(float, zw & 0xffff0000u) : __builtin_bit_cast(float, zw << 16);
            const float sz = z * __builtin_amdgcn_rcpf(1.0f + __builtin_amdgcn_exp2f(-1.4426950408889634f * z));
            o[e] = st.acc[mt][e] * rl * sz;
        }
        u32x2 w; w.x = cvtpk(o[0], o[1]); w.y = cvtpk(o[2], o[3]);
        *(u32x2*)(outp + mt * 16 + 4 * g) = w;
    }
}

template <int V = 0>
__device__ __forceinline__ void dil_task(bf16_t* proj, const float* tbl, int task, LAS char* vbuf, int lane, bf16_t* dry = nullptr) {
    const int r = task & 15, qb = (task >> 4) & 15, h = (task >> 8) & 7, b = task >> 11;
    const int q = lane & 15, g = lane >> 4;
    const int qr = qb * 256 + r;
    bf16_t* pb_ = proj + (size_t)b * SEQ * PLD;
    const bf16_t* qp = pb_ + (size_t)(qr + 16 * q) * PLD + PC_QC + h * 64 + g * 8;
    const bf16x8 bq0 = *(const bf16x8*)qp, bq1 = *(const bf16x8*)(qp + 32);
    const char* kbase = (const char*)(pb_ + PC_KC + h * 64);
    const char* vbase = (const char*)(pb_ + PC_VC + h * 64);
    const unsigned klane = (unsigned)g * 16u, vlane = (unsigned)(lane & 1) * 64u;
    const int sv = lane >> 1;
    State st; st.m = MFLOOR; st.l = 0.f;
#pragma unroll
    for (int mt = 0; mt < 4; ++mt) st.acc[mt] = (f32x4){0.f, 0.f, 0.f, 0.f};
    const float* tb0 = tbl + T5TB_F + ((size_t)h * 4 + (q & 3)) * TBW + TBOFF + 4 * g - (q & ~3);
    const float* tb1 = tbl + ((size_t)h * 3 + 1) * TBW + TBOFF + 4 * g - 4 * q;
    const float* tb2 = tbl + ((size_t)h * 3 + 2) * TBW + TBOFF + 4 * g - 16 * q;

#define DIL_PARAMS(ks, d, pat, ul0) const int pat = ((ks) >= 5) + ((ks) >= 11), d = 16 >> (2 * pat), ul0 = ((ks) - (5 * pat + (pat >> 1))) * 32;
    auto issue = [&](int ks, Stage& s) {
        if (V == 1 && ks > 2) return;
        DIL_PARAMS(ks, d, pat, ul0);
        const int pbase = qr + d * (ul0 - 64);
        int p0 = pbase + d * q, p1 = p0 + 16 * d, pv = pbase + d * sv;
        p0 = p0 < 0 ? 0 : (p0 > SEQ - 1 ? SEQ - 1 : p0); p1 = p1 < 0 ? 0 : (p1 > SEQ - 1 ? SEQ - 1 : p1); pv = pv < 0 ? 0 : (pv > SEQ - 1 ? SEQ - 1 : pv);
        const char* ka = kbase + ((unsigned)p0 * (unsigned)(PLD * 2) + klane); const char* kb = kbase + ((unsigned)p1 * (unsigned)(PLD * 2) + klane);
        const char* va = vbase + ((unsigned)pv * (unsigned)(PLD * 2) + vlane);
        if (V != 4 && V != 5) { s.k00 = *(const bf16x8*)ka; s.k01 = *(const bf16x8*)(ka + 64); s.k10 = *(const bf16x8*)kb; s.k11 = *(const bf16x8*)(kb + 64); }
        if (V != 3 && V != 5) { s.v0 = *(const u32x4*)va; s.v1 = *(const u32x4*)(va + 16); s.v2 = *(const u32x4*)(va + 32); s.v3 = *(const u32x4*)(va + 48); }
    };
    auto issue_b = [&](int ks, Bias& bs) {
        if (V == 1 && ks > 1) return;
        if (V == 3 || V == 4) return;
        DIL_PARAMS(ks, d, pat, ul0); (void)d;
        const float* tp = (pat == 0 ? tb0 : (pat == 1 ? tb1 : tb2)) + ul0;
        bs.b0 = *(const f32x4*)tp; bs.b1 = *(const f32x4*)(tp + 16);
    };
    auto compute = [&](int ks, const Stage& s, const Bias& bs) {
        if (V == 3) { asm volatile("" :: "v"(s.k00), "v"(s.k01), "v"(s.k10), "v"(s.k11)); return; }
        if (V == 4) { asm volatile("" :: "v"(s.v0), "v"(s.v1), "v"(s.v2), "v"(s.v3)); return; }
        if (V == 5) { asm volatile("" :: "v"(bs.b0), "v"(bs.b1)); return; }
        if (V == 2) { asm volatile("" :: "v"(s.k00), "v"(s.k01), "v"(s.k10), "v"(s.k11), "v"(s.v0), "v"(s.v1), "v"(s.v2), "v"(s.v3), "v"(bs.b0), "v"(bs.b1)); return; }
        LAS char* vt = vbuf + (ks & 1) * VTILE;
        write_v(s, vt, lane);
        f32x4 t0, t1; qk(s, bs, bq0, bq1, t0, t1);
        {
            DIL_PARAMS(ks, d, pat, ul0); (void)pat;
            const int pbase = qr + d * (ul0 - 64);
            if (pbase < 0 || pbase + 31 * d > SEQ - 1) {
                const int pk = pbase + d * 4 * g;
#pragma unroll
                for (int x = 0; x < 4; ++x) { if ((unsigned)(pk + d * x) >= (unsigned)SEQ) t0[x] = NEG; if ((unsigned)(pk + d * (16 + x)) >= (unsigned)SEQ) t1[x] = NEG; }
            }
        }
        softmax_pv(st, t0, t1, vt, lane);
    };
    Stage A, B, C, D;
    Bias X, Y;
    issue(0, A); issue(1, B); issue(2, C); issue_b(0, X);
#pragma unroll 1
    for (int ks = 0; ks < 20; ks += 4) {
        issue(ks + 3, D); issue_b(ks + 1, Y); compute(ks, A, X);
        issue(ks + 4, A); issue_b(ks + 2, X); compute(ks + 1, B, Y);
        issue(ks + 5, B); issue_b(ks + 3, Y); compute(ks + 2, C, X);
        issue(ks + 6, C); issue_b(ks + 4, X); compute(ks + 3, D, Y);
    }
    issue_b(21, Y); compute(20, A, X); issue_b(22, X); compute(21, B, Y); compute(22, C, X);
#undef DIL_PARAMS
    bf16_t* outp = dry ? dry + ((size_t)task * 16 + q) * 64 : pb_ + (size_t)(qr + 16 * q) * PLD + PC_QC + h * 64;
    finish(st, outp, pb_ + (size_t)(qr + 16 * q) * PLD + PC_ZC + h * 64, lane);
}

__device__ __forceinline__ void na_task(bf16_t* proj, const float* rpbs, int task, LAS char* vbuf, int lane, bf16_t* dry = nullptr) {
    const int jt = task & 3, r = (task >> 2) & 63, h = (task >> 8) & 7, b = task >> 11;
    const int q = lane & 15, g = lane >> 4;
    const int j0 = 16 * jt, j = j0 + q;
    int w0 = j0 - 8; w0 = w0 < 0 ? 0 : (w0 > 32 ? 32 : w0);
    int rs = r - 4; rs = rs < 0 ? 0 : (rs > 56 ? 56 : rs);
    int cs = j - 8; cs = cs < 0 ? 0 : (cs > 48 ? 48 : cs);
    bf16_t* pb_ = proj + (size_t)b * SEQ * PLD;
    const size_t tq = (size_t)(r * 64 + j);
    const bf16_t* qp = pb_ + tq * PLD + PC_QB + h * 64 + g * 8;
    const bf16x8 bq0 = *(const bf16x8*)qp, bq1 = *(const bf16x8*)(qp + 32);
    const char* kbase = (const char*)(pb_ + (size_t)(rs * 64 + w0) * PLD + PC_KB + h * 64);
    const char* vbase = (const char*)(pb_ + (size_t)(rs * 64 + w0) * PLD + PC_VB + h * 64);
    const int sv = lane >> 1;
    const unsigned koff = (unsigned)q * (unsigned)(PLD * 2) + (unsigned)g * 16u, voff = (unsigned)sv * (unsigned)(PLD * 2) + (unsigned)(lane & 1) * 64u;
    const int col = w0 - j + 32, c4 = col & 3;
    const float* tb = rpbs + (((size_t)c4 * 8 + h) * 15 + (rs - r + 7)) * 64 + (col - c4) + 4 * g;
    State st; st.m = MFLOOR; st.l = 0.f;
#pragma unroll
    for (int mt = 0; mt < 4; ++mt) st.acc[mt] = (f32x4){0.f, 0.f, 0.f, 0.f};
    const int kc0 = w0 + 4 * g - cs;
    auto issue = [&](int ks, Stage& s) {
        const char* ka = kbase + (size_t)ks * (64 * PLD * 2) + koff; const char* kb = ka + 16 * PLD * 2; const char* va = vbase + (size_t)ks * (64 * PLD * 2) + voff;
        s.k00 = *(const bf16x8*)ka; s.k01 = *(const bf16x8*)(ka + 64); s.k10 = *(const bf16x8*)kb; s.k11 = *(const bf16x8*)(kb + 64);
        s.v0 = *(const u32x4*)va; s.v1 = *(const u32x4*)(va + 16); s.v2 = *(const u32x4*)(va + 32); s.v3 = *(const u32x4*)(va + 48);
    };
    auto issue_b = [&](int ks, Bias& bs) { const float* tp = tb + ks * 64; bs.b0 = *(const f32x4*)tp; bs.b1 = *(const f32x4*)(tp + 16); };
    auto compute = [&](int ks, const Stage& s, const Bias& bs) {
        LAS char* vt = vbuf + (ks & 1) * VTILE;
        write_v(s, vt, lane);
        f32x4 t0, t1; qk(s, bs, bq0, bq1, t0, t1);
#pragma unroll
        for (int x = 0; x < 4; ++x) { if ((unsigned)(kc0 + x) >= 16u) t0[x] = NEG; if ((unsigned)(kc0 + 16 + x) >= 16u) t1[x] = NEG; }
        softmax_pv(st, t0, t1, vt, lane);
    };
    Stage A, B, C, D;
    Bias X, Y;
    issue(0, A); issue(1, B); issue(2, C); issue_b(0, X);
    issue(3, D); issue_b(1, Y); compute(0, A, X);
    issue(4, A); issue_b(2, X); compute(1, B, Y);
    issue(5, B); issue_b(3, Y); compute(2, C, X);
    issue(6, C); issue_b(4, X); compute(3, D, Y);
    issue(7, D); issue_b(5, Y); compute(4, A, X);
    issue_b(6, X); compute(5, B, Y); issue_b(7, Y); compute(6, C, X); compute(7, D, Y);
    finish(st, dry ? dry + ((size_t)task * 16 + q) * 64 : pb_ + tq * PLD + PC_QB + h * 64, pb_ + tq * PLD + PC_ZB + h * 64, lane);
}

constexpr int NA_IMG = 480 * 128;
__device__ __forceinline__ int fK(int kidx) { return (kidx >> 1) & 7; }
__device__ __forceinline__ int fV(int kidx) { return ((kidx >> 1) & 3) * 2; }
constexpr int DIL_IMG = 400 * 128;
struct QF { bf16x8 q0, q1; };
struct LdsBases { LAS const char* ka; LAS const char* kb; LAS const char* v[4]; };
__device__ __forceinline__ LdsBases lds_bases(LAS const char* Kimg, LAS const char* Vimg, int k0  , int v0k  , int lane) {
    const int g = lane >> 4, pp = lane & 3, ch = pp >> 1; LdsBases b;
    b.ka = Kimg + k0 * 128 + ((g ^ fK(k0)) * 16); b.kb = Kimg + k0 * 128 + (((4 + g) ^ fK(k0)) * 16);
    const int f0 = fV(v0k);
#pragma unroll
    for (int mt = 0; mt < 4; ++mt) b.v[mt] = Vimg + v0k * 128 + (pp & 1) * 8 + (((mt * 2 + ch) ^ f0) * 16);
    return b;
}
template <class MF>
__device__ __forceinline__ void lds_step(State& st, const QF& qf, const LdsBases& B, int so, const Bias& bs, MF maskfn) {
    const bf16x8 a00 = *(LAS const bf16x8*)(B.ka + so), a01 = *(LAS const bf16x8*)(B.kb + so);
    const bf16x8 a10 = *(LAS const bf16x8*)(B.ka + so + 2048), a11 = *(LAS const bf16x8*)(B.kb + so + 2048);
    f32x4 s0 = (f32x4){0.f, 0.f, 0.f, 0.f}, s1 = s0;
    s0 = __builtin_amdgcn_mfma_f32_16x16x32_bf16(a00, qf.q0, s0, 0, 0, 0); s0 = __builtin_amdgcn_mfma_f32_16x16x32_bf16(a01, qf.q1, s0, 0, 0, 0);
    s1 = __builtin_amdgcn_mfma_f32_16x16x32_bf16(a10, qf.q0, s1, 0, 0, 0); s1 = __builtin_amdgcn_mfma_f32_16x16x32_bf16(a11, qf.q1, s1, 0, 0, 0);
    f32x4 t0 = s0 * C2 + bs.b0, t1 = s1 * C2 + bs.b1;
    maskfn(t0, t1);
    const float mloc = max2f(max3f(max3f(t0[0], t0[1], t0[2]), t0[3], t1[0]), max3f(t1[1], t1[2], t1[3]));
    if (__builtin_amdgcn_ballot_w64(mloc > st.m + THR) != 0ull) {
        float mx = max2f(mloc, __shfl_xor(mloc, 16)); mx = max2f(mx, __shfl_xor(mx, 32));
        const float mn = max2f(st.m, mx); const float alpha = __builtin_amdgcn_exp2f(st.m - mn);
        st.m = mn; st.l *= alpha;
#pragma unroll
        for (int mt = 0; mt < 4; ++mt) st.acc[mt] = st.acc[mt] * alpha;
    }
    const float mn = st.m; f32x4 p0, p1;
#pragma unroll
    for (int e = 0; e < 4; ++e) { p0[e] = __builtin_amdgcn_exp2f(t0[e] - mn); p1[e] = __builtin_amdgcn_exp2f(t1[e] - mn); }
    st.l += (((p0[0] + p0[1]) + (p0[2] + p0[3])) + ((p1[0] + p1[1]) + (p1[2] + p1[3])));
    u32x4 pw; pw.x = cvtpk(p0[0], p0[1]); pw.y = cvtpk(p0[2], p0[3]); pw.z = cvtpk(p1[0], p1[1]); pw.w = cvtpk(p1[2], p1[3]);
    const bf16x8 pb = __builtin_bit_cast(bf16x8, pw);
#pragma unroll
    for (int mt = 0; mt < 4; ++mt) {
        const s16x4 lo = vtr(B.v[mt] + so), hi = vtr(B.v[mt] + so + 2048);
        const bf16x8 av = (bf16x8){lo[0], lo[1], lo[2], lo[3], hi[0], hi[1], hi[2], hi[3]};
        st.acc[mt] = __builtin_amdgcn_mfma_f32_16x16x32_bf16(av, pb, st.acc[mt], 0, 0, 0);
    }
}
__device__ __forceinline__ void na_block_task(bf16_t* proj, const float* rpbs, int bt, LAS char* lds, int wave, bf16_t* dry) {
    int lane = hw_lane();
    const int jt = bt & 3, rb = (bt >> 2) & 7, h = (bt >> 5) & 7, b = bt >> 8;
    const int r0 = 8 * rb, j0 = 16 * jt;
    int w0 = j0 - 8; w0 = w0 < 0 ? 0 : (w0 > 32 ? 32 : w0);
    int Rb = r0 - 4; Rb = Rb < 0 ? 0 : Rb;
    int Re = r0 + 3; Re = Re > 56 ? 56 : Re; Re += 8;
    const int nins = (Re - Rb) * 4;
    bf16_t* pb_ = proj + (size_t)b * SEQ * PLD;
    LAS char* Kimg = lds; LAS char* Vimg = lds + NA_IMG;
    {
        const int kl = lane >> 3, c = lane & 7;
        for (int ii = wave; ii < nins; ii += 8) {
            const int key = 8 * ii + kl, rl = key >> 5, col = key & 31;
            const bf16_t* row = pb_ + (size_t)((Rb + rl) * 64 + w0 + col) * PLD + h * 64;
            __builtin_amdgcn_global_load_lds((const unsigned*)(row + PC_KB + ((c ^ fK(key)) * 8)), (LAS unsigned*)(Kimg + ii * 1024), 16, 0, 0);
            __builtin_amdgcn_global_load_lds((const unsigned*)(row + PC_VB + ((c ^ fV(key)) * 8)), (LAS unsigned*)(Vimg + ii * 1024), 16, 0, 0);
        }
    }
    const int q = lane & 15, g = lane >> 4, qq = q >> 2, pp = lane & 3;
    const int r = r0 + wave, j = j0 + q;
    int rs = r - 4; rs = rs < 0 ? 0 : (rs > 56 ? 56 : rs);
    int cs = j - 8; cs = cs < 0 ? 0 : (cs > 48 ? 48 : cs);
    const size_t tq = (size_t)(r * 64 + j);
    const bf16_t* qp = pb_ + tq * PLD + PC_QB + h * 64 + g * 8;
    const bf16x8 bq0 = *(const bf16x8*)qp, bq1 = *(const bf16x8*)(qp + 32);
    const int col = w0 - j + 32, c4 = col & 3;
    const float* tb = rpbs + (((size_t)c4 * 8 + h) * 15 + (rs - r + 7)) * 64 + (col - c4) + 4 * g;
    const int kc0 = w0 + 4 * g - cs;
    State st; st.m = MFLOOR; st.l = 0.f;
#pragma unroll
    for (int mt = 0; mt < 4; ++mt) st.acc[mt] = (f32x4){0.f, 0.f, 0.f, 0.f};
    Bias bs; bs.b0 = *(const f32x4*)tb; bs.b1 = *(const f32x4*)(tb + 16);
    __syncthreads();
    const int kbase = (rs - Rb) * 32;
    const LdsBases Bn = lds_bases(Kimg, Vimg, kbase + q, kbase + 4 * g + qq, lane);
    QF qf; qf.q0 = bq0; qf.q1 = bq1;
    auto mk = [=](f32x4& t0, f32x4& t1) {
#pragma unroll
        for (int x = 0; x < 4; ++x) { if ((unsigned)(kc0 + x) >= 16u) t0[x] = NEG; if ((unsigned)(kc0 + 16 + x) >= 16u) t1[x] = NEG; } };
#pragma unroll 2
    for (int ks = 0; ks < 8; ++ks) {
        Bias nb = bs; if (ks + 1 < 8) { const float* tp = tb + (ks + 1) * 64; nb.b0 = *(const f32x4*)tp; nb.b1 = *(const f32x4*)(tp + 16); }
        lds_step(st, qf, Bn, ks * 4096, bs, mk);
        bs = nb;
    }
    finish(st, dry ? dry + (((size_t)bt * 8 + wave) * 16 + q) * 64 : pb_ + tq * PLD + PC_QB + h * 64, pb_ + tq * PLD + PC_ZB + h * 64, lane);
    __syncthreads();
}

template <class PF>
__device__ __forceinline__ void stage_keys(bf16_t* pb_, int h, int kcol, int vcol, int nkeys, PF posfn, LAS char* Kimg, LAS char* Vimg, int lane, int wave) {
    const int kl = lane >> 3, c = lane & 7;
    for (int ii = wave; ii < nkeys / 8; ii += 8) {
        const int key = 8 * ii + kl; int pos = posfn(key); pos = pos < 0 ? 0 : (pos > SEQ - 1 ? SEQ - 1 : pos);
        const bf16_t* row = pb_ + (size_t)pos * PLD + h * 64;
        __builtin_amdgcn_global_load_lds((const unsigned*)(row + kcol + ((c ^ fK(key)) * 8)), (LAS unsigned*)(Kimg + ii * 1024), 16, 0, 0);
        __builtin_amdgcn_global_load_lds((const unsigned*)(row + vcol + ((c ^ fV(key)) * 8)), (LAS unsigned*)(Vimg + ii * 1024), 16, 0, 0);
    }
}
template <int VAR = 0>
__device__ __forceinline__ void dil_block_task(bf16_t* proj, const float* tbl, int bt, LAS char* lds, int wave, bf16_t* dry) {
    int lane = hw_lane();
    const int qb = bt & 15, h = (bt >> 4) & 7, b = bt >> 7;
    const int q = lane & 15, g = lane >> 4, qq = q >> 2;
    const int q0 = qb * 256;
    const int ra = 4 * (wave >> 1) + (wave & 1), rb = ra + 2;
    bf16_t* pb_ = proj + (size_t)b * SEQ * PLD;
    LAS char* Kimg = lds; LAS char* Vimg = lds + DIL_IMG;
    if (VAR != 4) stage_keys(pb_, h, PC_KC, PC_VC, 400, [&](int k) { return q0 - 64 + k; }, Kimg, Vimg, lane, wave);
    QF qa, qbf;
    { const bf16_t* qp = pb_ + (size_t)(q0 + ra + 16 * q) * PLD + PC_QC + h * 64 + g * 8; qa.q0 = *(const bf16x8*)qp; qa.q1 = *(const bf16x8*)(qp + 32);
      qp += 2 * PLD; qbf.q0 = *(const bf16x8*)qp; qbf.q1 = *(const bf16x8*)(qp + 32); }
    State sa, sb; sa.m = MFLOOR; sa.l = 0.f; sb.m = MFLOOR; sb.l = 0.f;
#pragma unroll
    for (int mt = 0; mt < 4; ++mt) { sa.acc[mt] = (f32x4){0.f, 0.f, 0.f, 0.f}; sb.acc[mt] = (f32x4){0.f, 0.f, 0.f, 0.f}; }
    const unsigned to2 = (unsigned)((h * 3 + 2) * TBW + TBOFF + 4 * g - 16 * q);
    __syncthreads();
    {
        const bool needm = (q0 - 64 < 0) || (q0 + 15 + 383 - 64 > SEQ - 1);
        const LdsBases Ba = lds_bases(Kimg, Vimg, ra + q, ra + 4 * g + qq, lane), Bb = lds_bases(Kimg, Vimg, rb + q, rb + 4 * g + qq, lane);
#pragma unroll 2
        for (int ks = 0; ks < (VAR == 3 ? 0 : 12); ++ks) {
            Bias bs; bs.b0 = *(const f32x4*)(tbl + (to2 + (unsigned)(ks * 32))); bs.b1 = *(const f32x4*)(tbl + (to2 + (unsigned)(ks * 32 + 16)));
            const int u0 = ks * 32;
            auto mk = [&](int pk) { return [=](f32x4& t0, f32x4& t1) { if (needm) {
#pragma unroll
                for (int x = 0; x < 4; ++x) { if ((unsigned)(pk + x) >= (unsigned)SEQ) t0[x] = NEG; if ((unsigned)(pk + 16 + x) >= (unsigned)SEQ) t1[x] = NEG; } } }; };
            lds_step(sa, qa, Ba, ks * 4096, bs, mk(q0 + ra + u0 - 64 + 4 * g));
            lds_step(sb, qbf, Bb, ks * 4096, bs, mk(q0 + rb + u0 - 64 + 4 * g));
        }
    }
    __syncthreads();
    asm volatile("" : "+v"(lane));
#pragma unroll 1
    for (int t = 0; t < (VAR == 2 ? 0 : 2); ++t) {
        const int q = lane & 15, g = lane >> 4, qq = q >> 2;
        const unsigned to1 = (unsigned)((h * 3 + 1) * TBW + TBOFF + 4 * g - 4 * q);
        const int c0 = 2 * t;
        if (VAR != 4) stage_keys(pb_, h, PC_KC, PC_VC, 392, [&](int k) { const int cl = k >= 196 ? 1 : 0; return q0 - 256 + c0 + cl + 4 * (k - 196 * cl); }, Kimg, Vimg, lane, wave);
        const int r = t == 0 ? ra : rb, cl = r & 1, kb = cl * 196 + (r >> 2);
        const bool needm = (q0 - 256 < 0) || (q0 + 15 + 4 * 127 > SEQ - 1);
        const LdsBases Bc = lds_bases(Kimg, Vimg, kb + q, kb + 4 * g + qq, lane);
        __syncthreads();
#pragma unroll 2
        for (int ks = 0; ks < 6; ++ks) {
            Bias bs; bs.b0 = *(const f32x4*)(tbl + (to1 + (unsigned)(ks * 32))); bs.b1 = *(const f32x4*)(tbl + (to1 + (unsigned)(ks * 32 + 16)));
            const int u0 = ks * 32;
            const int pk = q0 + r + 4 * (u0 - 64 + 4 * g);
            auto mk = [=](f32x4& t0, f32x4& t1) { if (needm) {
#pragma unroll
                for (int x = 0; x < 4; ++x) { if ((unsigned)(pk + 4 * x) >= (unsigned)SEQ) t0[x] = NEG; if ((unsigned)(pk + 4 * (16 + x)) >= (unsigned)SEQ) t1[x] = NEG; } } };
            if (t == 0) lds_step(sa, qa, Bc, ks * 4096, bs, mk);
            else        lds_step(sb, qbf, Bc, ks * 4096, bs, mk);
        }
        __syncthreads();
    }
    lane = hw_lane();
    {
    const int q = lane & 15, g = lane >> 4, qq = q >> 2;
    LAS char* wbuf = lds + wave * 16384;
    const char* kbase = (const char*)(pb_ + PC_KC + h * 64); const char* vbase = (const char*)(pb_ + PC_VC + h * 64);
    const int kl = lane >> 3, c = lane & 7;
    const unsigned to0 = (unsigned)(T5TB_F + (h * 4 + (q & 3)) * TBW + TBOFF + 4 * g - (q & ~3));
    struct RowStage { u32x4 k[4], v[4]; };
#pragma unroll 1
    for (int t = 0; t < (VAR == 1 ? 0 : 2); ++t) {
        const int qr = q0 + (t == 0 ? ra : rb);
        auto issue = [&](int ks, RowStage& s, Bias& bsn) {
            const int pbase = qr + 16 * (ks * 32 - 64);
#pragma unroll
            for (int i = 0; i < 4; ++i) { int pos = pbase + 16 * (8 * i + kl); pos = pos < 0 ? 0 : (pos > SEQ - 1 ? SEQ - 1 : pos);
                const unsigned off = (unsigned)pos * (unsigned)(PLD * 2) + (unsigned)c * 16u;
                s.k[i] = *(const u32x4*)(kbase + off); s.v[i] = *(const u32x4*)(vbase + off); }
            bsn.b0 = *(const f32x4*)(tbl + (to0 + (unsigned)(ks * 32))); bsn.b1 = *(const f32x4*)(tbl + (to0 + (unsigned)(ks * 32 + 16)));
        };
        auto compute = [&](int ks, const RowStage& s, const Bias& bsn, State& st, const QF& qf) {
            LAS char* Kw = wbuf + (ks & 1) * 8192; LAS char* Vw = Kw + 4096;
#pragma unroll
            for (int i = 0; i < 4; ++i) { const int key = 8 * i + kl;
                *(LAS u32x4*)(Kw + key * 128 + ((c ^ fK(key)) * 16)) = s.k[i]; *(LAS u32x4*)(Vw + key * 128 + ((c ^ fV(key)) * 16)) = s.v[i]; }
            const LdsBases Bw = lds_bases(Kw, Vw, q, 4 * g + qq, lane);
            const int pbase = qr + 16 * (ks * 32 - 64); const bool needm = pbase < 0 || pbase + 31 * 16 > SEQ - 1; const int pk = pbase + 64 * g;
            lds_step(st, qf, Bw, 0, bsn, [=](f32x4& t0, f32x4& t1) { if (needm) {
#pragma unroll
                for (int x = 0; x < 4; ++x) { if ((unsigned)(pk + 16 * x) >= (unsigned)SEQ) t0[x] = NEG; if ((unsigned)(pk + 16 * (16 + x)) >= (unsigned)SEQ) t1[x] = NEG; } } });
        };
        RowStage A, B; Bias X, Y;
        issue(0, A, X); issue(1, B, Y);
        compute(0, A, X, sa, qa); issue(2, A, X); compute(1, B, Y, sa, qa); issue(3, B, Y); compute(2, A, X, sa, qa); issue(4, A, X); compute(3, B, Y, sa, qa); compute(4, A, X, sa, qa);
        { const State ts = sa; sa = sb; sb = ts; const QF tq = qa; qa = qbf; qbf = tq; }
    }
    }
    asm volatile("" : "+v"(lane));
    { const int q = lane & 15;
    finish(sa, dry ? dry + (((size_t)bt * 16 + ra) * 16 + q) * 64 : pb_ + (size_t)(q0 + ra + 16 * q) * PLD + PC_QC + h * 64, pb_ + (size_t)(q0 + ra + 16 * q) * PLD + PC_ZC + h * 64, lane);
    finish(sb, dry ? dry + (((size_t)bt * 16 + rb) * 16 + q) * 64 : pb_ + (size_t)(q0 + rb + 16 * q) * PLD + PC_QC + h * 64, pb_ + (size_t)(q0 + rb + 16 * q) * PLD + PC_ZC + h * 64, lane); }
    __syncthreads();
}
#undef LAS
}
constexpr int NWAVES = 8;
#define GAS __attribute__((address_space(1)))
#define LAS __attribute__((address_space(3)))
typedef unsigned v4u __attribute__((ext_vector_type(4)));
typedef float f32x4 __attribute__((ext_vector_type(4)));
typedef GAS unsigned gu32;
#define RLX_AGENT __ATOMIC_RELAXED, __HIP_MEMORY_SCOPE_AGENT

constexpr size_t SZ_WINT = (size_t)IN_COLS * DM * 2, SZ_WOUTT = (size_t)DM * MIXW * 2, SZ_GLUT = 512 * 512 * 2, SZ_TM = (size_t)32 * 256 * 512 * 2, SZ_MS = (size_t)32 * 256 * 256 * 2;
constexpr size_t OFF_WOUTT0 = OFF_W, OFF_WOUTT1 = OFF_WOUTT0 + SZ_WOUTT, OFF_WINT1 = OFF_WOUTT1 + SZ_WOUTT, OFF_GLUT1 = OFF_WINT1 + SZ_WINT, OFF_TM1 = OFF_GLUT1 + SZ_GLUT, OFF_MS1 = OFF_TM1 + SZ_TM;
constexpr size_t WS_NEED = OFF_MS1 + SZ_MS;
constexpr size_t DO_WINT0 = 0, DO_GLUT0 = DO_WINT0 + SZ_WINT, DO_TM0 = DO_GLUT0 + SZ_GLUT, DO_MS0 = DO_TM0 + SZ_TM;
static_assert(DO_MS0 + SZ_MS <= (size_t)NTOK * DM * 4, "layer-0 tables fit in d_out");
static_assert(WS_NEED <= (size_t)256 * 1024 * 1024, "workspace map fits 256 MiB");
constexpr size_t CTL_ZERO_BYTES = 262144;
constexpr int CW_BAR = 1024;
constexpr int CW_WORK = 256;
constexpr size_t OFF_T5TB = 524288;
constexpr size_t OFF_RPBS = OFF_T5TB + (size_t)(att::T5TB_F + att::T5S_F) * 4;
static_assert(OFF_RPBS + (size_t)att::RPBS_F * 4 <= OFF_SS, "small tables fit in the control MiB");

constexpr int RING_BYTES = 131072;
constexpr int MISC_OFF = RING_BYTES;
constexpr int LDS_BYTES = 147456;
static_assert(NWAVES * att::WAVE_LDS <= RING_BYTES && 2 * att::NA_IMG <= RING_BYTES && 2 * att::DIL_IMG <= RING_BYTES, "attention LDS");

#define XB_TMO      128
#define XB_XCNT(j)  (256  + 64 * (j))
#define XB_XSUB(j)  (1280 + 64 * (j))
#define XB_XGEN(j)  (2304 + 64 * (j))
#define XB_TOP      3328
#define XB_TOPGEN   3392
#define XCD_BAR_WORDS 3456
#define XB_SPIN_CAP (1u << 18)
__device__ __forceinline__ unsigned xb_ld(unsigned* p)              { return __hip_atomic_load(p, __ATOMIC_RELAXED, __HIP_MEMORY_SCOPE_AGENT); }
__device__ __forceinline__ unsigned xb_add(unsigned* p, unsigned v) { return __hip_atomic_fetch_add(p, v, __ATOMIC_RELAXED, __HIP_MEMORY_SCOPE_AGENT); }
__device__ __forceinline__ unsigned xb_xcc_id() { return (unsigned)__builtin_amdgcn_s_getreg((3 << 11) | 20) & 0xFu; }
#define XB_SPIN(cond, bar) do { unsigned _sp = 0; while (cond) { __builtin_amdgcn_s_sleep(1); \
    if ((++_sp & 255u) == 0u) { if (xb_ld(&(bar)[XB_TMO])) break; if (_sp > XB_SPIN_CAP) { atomicAdd(&(bar)[XB_TMO], 1u); break; } } } } while (0)
struct XcdBarrier { unsigned* bar; unsigned x; volatile LAS unsigned* st; };
__device__ __forceinline__ XcdBarrier xcd_barrier_post(unsigned* bar, volatile LAS unsigned* st, int wave_s) {
    XcdBarrier b; b.bar = bar; b.x = xb_xcc_id(); b.st = st;
    if (wave_s == 0 && hw_lane() == 0) (void)xb_add(&bar[XB_XCNT(b.x)], 1u);
    return b;
}
__device__ __forceinline__ void xcd_barrier_complete(unsigned* bar, unsigned x, unsigned& nloc, unsigned& nx) {
    const unsigned G = gridDim.x * gridDim.y * gridDim.z;
    unsigned sum, cnt, mine, sp = 0u;
    for (;;) {
        sum = 0u; cnt = 0u; mine = 0u;
#pragma unroll
        for (unsigned j = 0; j < 16; ++j) { const unsigned c = xb_ld(&bar[XB_XCNT(j)]); sum += c; cnt += (c > 0u) ? 1u : 0u; mine = (j == x) ? c : mine; }
        if (sum == G) break;
        __builtin_amdgcn_s_sleep(1);
        if ((++sp & 255u) == 0u) { if (xb_ld(&bar[XB_TMO])) break; if (sp > XB_SPIN_CAP) { atomicAdd(&bar[XB_TMO], 1u); break; } }
    }
    nloc = mine > 0u ? mine : 1u; nx = cnt > 0u ? cnt : 1u;
}
__device__ __forceinline__ void xcd_barrier(const XcdBarrier& b, int wave_s) {
    asm volatile("s_waitcnt vmcnt(0)" ::: "memory");
    __syncthreads();
    if (wave_s == 0 && hw_lane() == 0) {
        unsigned* bar = b.bar;
        __builtin_amdgcn_s_waitcnt(0);
        unsigned nloc = b.st[0], nx = b.st[1];
        if (nloc == 0u) { xcd_barrier_complete(bar, b.x, nloc, nx); b.st[0] = nloc; b.st[1] = nx; }
        const unsigned old = xb_add(&bar[XB_XSUB(b.x)], 1u);
        const unsigned gen = old / nloc;
        if (old + 1u == (gen + 1u) * nloc) {
            __builtin_amdgcn_fence(__ATOMIC_RELEASE, "agent");
            asm volatile("s_waitcnt vmcnt(0)" ::: "memory");
            const unsigned og = xb_add(&bar[XB_TOP], 1u);
            const unsigned tg = og / nx;
            if (og + 1u == (tg + 1u) * nx) xb_add(&bar[XB_TOPGEN], 1u);
            else XB_SPIN(xb_ld(&bar[XB_TOPGEN]) == tg, bar);
            __builtin_amdgcn_fence(__ATOMIC_ACQUIRE, "agent");
            xb_add(&bar[XB_XGEN(b.x)], 1u);
            asm volatile("s_waitcnt vmcnt(0)" ::: "memory");
        } else {
            XB_SPIN(xb_ld(&bar[XB_XGEN(b.x)]) == gen, bar);
            __builtin_amdgcn_fence(__ATOMIC_ACQUIRE, "agent");
            asm volatile("s_waitcnt vmcnt(0)" ::: "memory");
        }
    }
    __syncthreads();
}

struct Args { const float* in[17]; float* out; unsigned char* ws; int ph_lo, ph_hi; int li, skip; };

__device__ __forceinline__ float wave_sum(float v) {
#pragma unroll
    for (int o = 1; o < 64; o <<= 1) v += __shfl_xor(v, o);
    return v;
}
__device__ __forceinline__ unsigned pk2(float lo, float hi) { return f2bf(lo) | (f2bf(hi) << 16); }

__device__ __forceinline__ void p0_transpose_item(const float* W, int K, int Nsrc, bf16_t* WT, int k0, int n0s, int n0d, const float* kscale, LAS float* scr, int lane) {
    float tv[32];
#pragma unroll
    for (int i = 0; i < 32; ++i) { const int kk = 2 * i + (lane >> 5); tv[i] = W[(size_t)(k0 + kk) * Nsrc + n0s + (lane & 31)]; }
    const float ksc = kscale ? kscale[k0 + lane] : 1.f;
#pragma unroll
    for (int i = 0; i < 32; ++i) { const int kk = 2 * i + (lane >> 5); scr[kk * 33 + (lane & 31)] = tv[i] * __shfl(ksc, kk); }
    asm volatile("s_waitcnt lgkmcnt(0)" ::: "memory");
    const int c = lane & 7;
#pragma unroll
    for (int j = 0; j < 4; ++j) { const int n = (lane >> 3) + 8 * j; const LAS float* s = scr + (8 * c) * 33 + n;
        v4u o; o.x = pk2(s[0 * 33], s[1 * 33]); o.y = pk2(s[2 * 33], s[3 * 33]); o.z = pk2(s[4 * 33], s[5 * 33]); o.w = pk2(s[6 * 33], s[7 * 33]);
        *(v4u*)(WT + (size_t)(n0d + n) * K + k0 + 8 * c) = o; }
    asm volatile("s_waitcnt lgkmcnt(0)" ::: "memory");
}
__device__ __forceinline__ void p0_xrow(const float* xrow, bf16_t* orow, float* ssrow, int lane) {
    const f32x4* xr = (const f32x4*)xrow + lane;
    f32x4 v[4]; float s = 0.f;
#pragma unroll
    for (int j = 0; j < 4; ++j) { v[j] = xr[64 * j]; s += (v[j].x * v[j].x + v[j].y * v[j].y) + (v[j].z * v[j].z + v[j].w * v[j].w); }
    s = wave_sum(s);
    unsigned long long* o8 = (unsigned long long*)orow + lane;
#pragma unroll
    for (int j = 0; j < 4; ++j) o8[64 * j] = (unsigned long long)pk2(v[j].x, v[j].y) | ((unsigned long long)pk2(v[j].z, v[j].w) << 32);
    if (lane < 16) ssrow[lane] = lane == 0 ? s : 0.f;
}
__device__ __forceinline__ int t5_bucket_dev(int rel) {
    const int n = rel < 0 ? -rel : rel;
    const int large = 8 + (n >= 15) + (n >= 27) + (n >= 50) + (n >= 91) + (n >= 166) + (n >= 305) + (n >= 559);
    return (rel > 0 ? 16 : 0) + (n < 8 ? n : large);
}
__device__ __forceinline__ void p0_ssm_tables(const Args& a, int l, int g, int d, bf16_t* TM, bf16_t* Ms, LAS float* scr, int wave_s) {
    int tid = wave_s * 64 + hw_lane(); asm volatile("" : "+v"(tid));
    LAS float* pw = scr;
    LAS float* fc = pw + 64 * 17 * 2;
    LAS float* Cc = fc + 2 * 64 * 2;
    LAS float* Bb = Cc + 2048;
    LAS float* C2 = Bb + 2048;
    LAS float* B2 = C2 + 2048;
    LAS float* Kt = B2 + 2048;
    const float* lam_re = a.in[4]; const float* lam_im = a.in[5]; const float* log_dt = a.in[6];
    const float* b_re = a.in[7]; const float* b_im = a.in[8]; const float* c_re = a.in[9]; const float* c_im = a.in[10]; const float* dskip = a.in[11];
    const int pg = (l * 2 + d) * 32 + g, pg2 = (l * 2 + (1 - d)) * 32 + g;
    if (tid < 128) {
        const int o = tid >> 6, p = tid & 63, pgx = o == 0 ? pg : pg2;
        const float lre = lam_re[pgx * 64 + p], lim = lam_im[pgx * 64 + p], dt = expf(log_dt[pgx]);
        const float er = expf(lre * dt), lbr = er * cosf(lim * dt), lbi = er * sinf(lim * dt);
        const float nr = lbr - 1.f, ni = lbi, den = lre * lre + lim * lim;
        fc[(o * 64 + p) * 2] = (nr * lre + ni * lim) / den; fc[(o * 64 + p) * 2 + 1] = (ni * lre - nr * lim) / den;
        if (o == 0) { float wr = 1.f, wi = 0.f;
            for (int k = 0; k <= 16; ++k) { pw[(p * 17 + k) * 2] = wr; pw[(p * 17 + k) * 2 + 1] = wi; const float t = wr * lbr - wi * lbi; wi = wr * lbi + wi * lbr; wr = t; } }
    }
    __syncthreads();
    for (int i = tid; i < 1024; i += NWAVES * 64) {
        Cc[i * 2] = c_re[(size_t)pg * 1024 + i]; Cc[i * 2 + 1] = c_im[(size_t)pg * 1024 + i];
        { const int p = i >> 4; const float br = b_re[(size_t)pg * 1024 + i], bi = b_im[(size_t)pg * 1024 + i], fr = fc[p * 2], fi = fc[p * 2 + 1];
          Bb[i * 2] = fr * br - fi * bi; Bb[i * 2 + 1] = fr * bi + fi * br; }
        if (d == 0) {
            C2[i * 2] = c_re[(size_t)pg2 * 1024 + i]; C2[i * 2 + 1] = c_im[(size_t)pg2 * 1024 + i];
            const int p = i >> 4; const float br = b_re[(size_t)pg2 * 1024 + i], bi = b_im[(size_t)pg2 * 1024 + i], fr = fc[(64 + p) * 2], fi = fc[(64 + p) * 2 + 1];
            B2[i * 2] = fr * br - fi * bi; B2[i * 2 + 1] = fr * bi + fi * br; }
    }
    __syncthreads();
    {
        const int kh = tid >> 8, c = (tid >> 4) & 15, cp = tid & 15;
        float Kk[8];
#pragma unroll
        for (int k = 0; k < 8; ++k) Kk[k] = 0.f;
        float k0o = 0.f;
#pragma unroll 2
        for (int p = 0; p < 64; ++p) {
            const float Cr = Cc[(c * 64 + p) * 2], Ci = Cc[(c * 64 + p) * 2 + 1], br = Bb[(p * 16 + cp) * 2], bi = Bb[(p * 16 + cp) * 2 + 1];
            const LAS float* pwp = pw + (p * 17 + kh * 8) * 2;
#pragma unroll
            for (int k = 0; k < 8; ++k) { const float pr = pwp[2 * k], pi = pwp[2 * k + 1]; const float wr = Cr * pr - Ci * pi, wi = Cr * pi + Ci * pr; Kk[k] += wr * br - wi * bi; }
            if (d == 0 && kh == 0) k0o += C2[(c * 64 + p) * 2] * B2[(p * 16 + cp) * 2] - C2[(c * 64 + p) * 2 + 1] * B2[(p * 16 + cp) * 2 + 1];
        }
#pragma unroll
        for (int k = 0; k < 8; ++k) Kt[(kh * 8 + k) * 256 + c * 16 + cp] = Kk[k];
        if (d == 0 && kh == 0) Kt[16 * 256 + c * 16 + cp] = k0o;
    }
    __syncthreads();
    for (int idx = tid; idx < 256 * 128; idx += NWAVES * 64) {
        const int row = idx >> 7, col = (idx & 127) * 2, t = row >> 4, cc = row & 15, s_ = col >> 4, c2 = col & 15;
        const int k = d == 0 ? t - s_ : s_ - t;
        if (k < 0 || (d == 1 && k == 0)) continue;
        float v0 = Kt[k * 256 + cc * 16 + c2], v1 = Kt[k * 256 + cc * 16 + c2 + 1];
        if (k == 0) { v0 += Kt[16 * 256 + cc * 16 + c2]; v1 += Kt[16 * 256 + cc * 16 + c2 + 1];
            const float dd = dskip[l * 512 + g * 16 + cc]; if (c2 == cc) v0 += dd; if (c2 + 1 == cc) v1 += dd; }
        *(unsigned*)(TM + (size_t)row * 512 + col) = pk2(v0, v1);
    }
    {
        const int p = tid & 63, cq = tid >> 6;
#pragma unroll
        for (int h2 = 0; h2 < 2; ++h2) { const int c = cq + 8 * h2; const float Cr = Cc[(c * 64 + p) * 2], Ci = Cc[(c * 64 + p) * 2 + 1];
#pragma unroll 4
            for (int e = 1; e <= 16; ++e) { const float pr = pw[(p * 17 + e) * 2], pi = pw[(p * 17 + e) * 2 + 1]; const float wr = Cr * pr - Ci * pi, wi = Cr * pi + Ci * pr;
                const int t = d == 0 ? e - 1 : 16 - e; bf16_t* rowp = TM + (size_t)(t * 16 + c) * 512 + 256 + d * 128 + p;
                rowp[0] = (bf16_t)f2bf(wr); rowp[64] = (bf16_t)f2bf(-wi); } }
    }
    {
        const int sc = tid & 255, e = sc >> 4, cp = sc & 15, ph = tid >> 8, s_ = d == 0 ? 15 - e : e;
#pragma unroll 4
        for (int it = 0; it < 32; ++it) { const int p = ph + 2 * it; const float pr = pw[(p * 17 + e) * 2], pi = pw[(p * 17 + e) * 2 + 1], br = Bb[(p * 16 + cp) * 2], bi = Bb[(p * 16 + cp) * 2 + 1];
            Ms[(size_t)(d * 128 + p) * 256 + s_ * 16 + cp] = (bf16_t)f2bf(pr * br - pi * bi); Ms[(size_t)(d * 128 + 64 + p) * 256 + s_ * 16 + cp] = (bf16_t)f2bf(pr * bi + pi * br); }
    }
    __syncthreads();
}

constexpr int N_PHASES = 10;
__global__ void __launch_bounds__(NWAVES * 64, 2) mega_fwd(Args args) {
    extern __shared__ __attribute__((aligned(16))) unsigned char lds_raw[];
    LAS unsigned char* lds = (LAS unsigned char*)lds_raw;
    volatile LAS unsigned* MISC = (volatile LAS unsigned*)(lds + MISC_OFF);
    const int wave_s = __builtin_amdgcn_readfirstlane((int)threadIdx.x >> 6);
#define PHASE_LANES int lane = hw_lane(); asm volatile("" : "+v"(lane)); const int wave = wave_s; const int ptid = wave * 64 + lane; (void)ptid;
    const int G = gridDim.x; int vcu; { const int bx = blockIdx.x; vcu = (G % 8 == 0) ? (bx % 8) * (G / 8) + bx / 8 : bx; }
    unsigned char* ws = args.ws; unsigned char* dout = (unsigned char*)args.out;
    unsigned* ctl = (unsigned*)(ws + OFF_CTL);
    if (wave_s == 0) { const int l0 = hw_lane(); if (l0 < 32) MISC[l0] = 0u; }
    __syncthreads();
    XcdBarrier bar = xcd_barrier_post(ctl + CW_BAR + args.li * XCD_BAR_WORDS, MISC + 8, wave_s);
    const int lo = args.ph_lo, hi = args.ph_hi;
#ifndef REP_P0
#define REP_P0 1
#endif
#ifndef REP_INPROJ
#define REP_INPROJ 1
#endif
#ifndef REP_EG
#define REP_EG 1
#endif
#ifndef DRY_NA
#define DRY_NA 0
#endif
#ifndef DRY_DIL
#define DRY_DIL 0
#endif
#ifndef REP_SCAN
#define REP_SCAN 1
#endif
#ifndef REP_Y
#define REP_Y 1
#endif
#ifndef DRYVAR
#define DRYVAR 0
#endif
#ifndef CT_SKIP
#define CT_SKIP 0
#endif
#ifndef PHASE_MASK
#define PHASE_MASK 0x3ff
#endif
#define INR(k) (lo <= (k) && (k) < hi)
#define IN(k) (((PHASE_MASK >> ((k) == 9 ? 5 : (k))) & 1) && INR(k))
#define INL(j) (((PHASE_MASK >> ((j) + 1)) & 1) && INR(pb + (j)))
#define SEAM(k) do { if (INR(k) && INR((k) + 1)) xcd_barrier(bar, wave_s); } while (0)

    bf16_t* proj = (bf16_t*)(ws + OFF_PROJ); bf16_t* xag = (bf16_t*)(ws + OFF_XAG); bf16_t* xb = (bf16_t*)(ws + OFF_XB); float* Ebuf = (float*)(ws + OFF_XB);
    bf16_t* Gb = (bf16_t*)(ws + OFF_G); float* sspart = (float*)(ws + OFF_SS);
    float* rpbs = (float*)(ws + OFF_RPBS); float* t5tb = (float*)(ws + OFF_T5TB);
    const int dry = (args.skip >> 8) & 1; bf16_t* dryp = dry ? Gb : nullptr;

    if (IN(0)) for (int rep_ = 0; rep_ < REP_P0; ++rep_) {
        PHASE_LANES
        const int NTB = 128;
        for (int ti = vcu; ti < NTB; ti += G) {
            const int l = ti >> 6, g = (ti >> 1) & 31, d = ti & 1;
            bf16_t* TM = (bf16_t*)(l == 0 ? dout + DO_TM0 : ws + OFF_TM1) + (size_t)g * 256 * 512;
            bf16_t* Ms = (bf16_t*)(l == 0 ? dout + DO_MS0 : ws + OFF_MS1) + (size_t)g * 256 * 256;
            p0_ssm_tables(args, l, g, d, TM, Ms, (LAS float*)lds, wave_s);
        }
        {
            const float* rpb = args.in[14]; const float* t5 = args.in[15];
            for (int i = vcu * NWAVES * 64 + ptid; i < att::RPBS_F; i += G * NWAVES * 64) {
                const int ii = i & 63, rr = (i >> 6) % 15, h = (i / (64 * 15)) & 7, c = (i / (64 * 15 * 8)) & 3, l = i / (64 * 15 * 8 * 4); const int cr = ii + c - 17;
                rpbs[i] = (ii + c < 64 && cr >= 0 && cr <= 30) ? rpb[(((size_t)l * 8 + h) * 15 + rr) * 31 + cr] * 1.4426950408889634f : 0.f; }
            for (int i = vcu * NWAVES * 64 + ptid; i < att::T5TB_F + att::T5S_F; i += G * NWAVES * 64) {
                int h, pat, idx;
                if (i < att::T5TB_F) { idx = i % att::TBW; pat = (i / att::TBW) % 3; h = i / (3 * att::TBW); }
                else { const int i2 = i - att::T5TB_F; const int c = (i2 / att::TBW) & 3; h = i2 / (4 * att::TBW); pat = 0; idx = i2 % att::TBW - c; }
                const int w = idx - att::TBOFF; const int d = pat == 0 ? 16 : (pat == 1 ? 4 : 1);
                t5tb[i] = (idx >= 0 && w >= 0 && w <= 128) ? t5[t5_bucket_dev(d * (w - 64)) * 8 + h] * 1.4426950408889634f : att::NEG; }
        }
        {
            LAS float* scr = (LAS float*)(lds + wave * 16384);
            constexpr int I_IN = (DM / 64) * (IN_COLS / 32), I_OUT = (MIXW / 64) * (DM / 32), I_GLU = (512 / 64) * (512 / 32), I_L = I_IN + I_OUT + I_GLU, I_TOT = 2 * I_L + NTOK;
            const int NW_ALL = G * NWAVES, gw = vcu * NWAVES + wave; const bool tblk = vcu < NTB && G > NTB;
            const int NW2 = tblk ? 0 : (G - NTB) * NWAVES, gw2 = (vcu - NTB) * NWAVES + wave;
            const int P1N = G > NTB ? 9 : (I_TOT + NW_ALL - 1) / NW_ALL, I_P1 = P1N * NW_ALL < I_TOT ? P1N * NW_ALL : I_TOT;
            for (int pass = 0; pass < 2; ++pass) {
                const int i0 = pass == 0 ? gw : I_P1 + gw2, i1 = pass == 0 ? I_P1 : I_TOT, st = pass == 0 ? NW_ALL : NW2;
                if (pass == 1 && NW2 == 0) break;
                for (int it = i0; it < i1; it += st) {
                    if (it >= 2 * I_L) { const int mrow = it - 2 * I_L; p0_xrow(args.in[0] + (size_t)mrow * DM, xb + (size_t)mrow * DM, sspart + (size_t)mrow * 16, lane); continue; }
                    const int l = it / I_L; int r = it % I_L;
                    if (r < I_IN) { const int nblk = IN_COLS / 32, kb = r / nblk, nb = r % nblk;
                        p0_transpose_item(args.in[2] + (size_t)l * DM * IN_COLS, DM, IN_COLS, (bf16_t*)(l == 0 ? dout + DO_WINT0 : ws + OFF_WINT1), 64 * kb, inproj_src_col(32 * nb), 32 * nb, args.in[1] + l * DM, scr, lane); continue; }
                    r -= I_IN;
                    if (r < I_OUT) { const int nblk = DM / 32, kb = r / nblk, nb = r % nblk;
                        p0_transpose_item(args.in[3] + (size_t)l * MIXW * DM, MIXW, DM, (bf16_t*)(ws + (l == 0 ? OFF_WOUTT0 : OFF_WOUTT1)), 64 * kb, 32 * nb, 32 * nb, nullptr, scr, lane); continue; }
                    r -= I_OUT;
                    { const int nblk = 512 / 32, kb = r / nblk, nb = r % nblk;
                        p0_transpose_item(args.in[12] + (size_t)l * 512 * 512, 512, 512, (bf16_t*)(l == 0 ? dout + DO_GLUT0 : ws + OFF_GLUT1), 64 * kb, 32 * nb, 32 * nb, nullptr, scr, lane); }
                }
            }
        }
    }
    SEAM(0);

    for (int l = 0; l < DEPTH; ++l) {
        const int pb = 1 + 4 * l;
        const bf16_t* WinT = (const bf16_t*)(l == 0 ? dout + DO_WINT0 : ws + OFF_WINT1);
        const bf16_t* WoutT = (const bf16_t*)(ws + (l == 0 ? OFF_WOUTT0 : OFF_WOUTT1));
        const bf16_t* GluT = (const bf16_t*)(l == 0 ? dout + DO_GLUT0 : ws + OFF_GLUT1);
        const bf16_t* TM = (const bf16_t*)(l == 0 ? dout + DO_TM0 : ws + OFF_TM1);
        const bf16_t* Ms = (const bf16_t*)(l == 0 ? dout + DO_MS0 : ws + OFF_MS1);
        if (INL(0)) for (int rep_ = 0; rep_ < REP_INPROJ; ++rep_) {
            pg8::Gemm gm{xb, WinT, DM, DM, DM, 0, 0}; pg8::StaticOrder S; S.init(NTOK, IN_COLS, G, (int)blockIdx.x);
            pg8::EpiInProj E{sspart, proj, xag};
            pg8::gemm_phase<pg8::EpiInProj, pg8::StaticOrder>(lds, gm, S, E, wave_s);
        }
        SEAM(pb + 0);
        if (INL(1)) {
            constexpr int NCHAIN = 128;
            if (!(args.skip & 1)) for (int cid = vcu; cid < NCHAIN; cid += G) {
                const int g = cid >> 2, b = cid & 3;
                { pg8::Gemm gm{xag, Ms, 512, 256, 256, (size_t)NCHUNK_TOT * 512, (size_t)256 * 256}; pg8::OneUnit S; S.u = pg8::Unit{b, 0, g};
                  pg8::EpiE E{Ebuf};
                  pg8::gemm_phase<pg8::EpiE, pg8::OneUnit>(lds, gm, S, E, wave_s); }
                asm volatile("s_waitcnt vmcnt(0)" ::: "memory"); __syncthreads();
                {
                    PHASE_LANES
                    const float* lam_re = args.in[4]; const float* lam_im = args.in[5]; const float* log_dt = args.in[6];
                    LAS float* sx = (LAS float*)lds;
#pragma unroll 1
                    for (int d = 0; d < 2; ++d) {
                        const int p = lane, pg = (l * 2 + d) * 32 + g;
                        const float lre = lam_re[pg * 64 + p], lim = lam_im[pg * 64 + p], dt = expf(log_dt[pg]);
                        const float er = expf(lre * dt); float ar = er * cosf(lim * dt), ai = er * sinf(lim * dt);
#pragma unroll
                        for (int i = 0; i < 4; ++i) { const float t = ar * ar - ai * ai; ai = 2.f * ar * ai; ar = t; }
                        const float* Ep = Ebuf + ((size_t)g * NCHUNK_TOT + b * NCHUNK) * 256 + d * 128 + p;
                        bf16_t* Cp = xag + ((size_t)g * NCHUNK_TOT + b * NCHUNK) * 512 + 256 + d * 128 + p;
                        float er_[32], ei_[32];
#pragma unroll
                        for (int i = 0; i < 32; ++i) { const int s = wave * 32 + i, k = d == 0 ? s : NCHUNK - 1 - s; er_[i] = Ep[(size_t)k * 256]; ei_[i] = Ep[(size_t)k * 256 + 64]; }
                        float cr = 0.f, ci = 0.f;
#pragma unroll
                        for (int i = 0; i < 32; ++i) { const float xr = er_[i], xi = ei_[i]; er_[i] = cr; ei_[i] = ci; const float t = ar * cr - ai * ci + xr; ci = ar * ci + ai * cr + xi; cr = t; }
                        sx[(wave * 64 + lane) * 2] = cr; sx[(wave * 64 + lane) * 2 + 1] = ci;
                        float a32r = ar, a32i = ai;
#pragma unroll
                        for (int i = 0; i < 5; ++i) { const float t = a32r * a32r - a32i * a32i; a32i = 2.f * a32r * a32i; a32r = t; }
                        __syncthreads();
                        float inr = 0.f, ini = 0.f;
                        for (int j = 0; j < wave; ++j) { const float tr = sx[(j * 64 + lane) * 2], ti = sx[(j * 64 + lane) * 2 + 1]; const float t = a32r * inr - a32i * ini + tr; ini = a32r * ini + a32i * inr + ti; inr = t; }
                        float pr = inr, pi = ini;
#pragma unroll
                        for (int i = 0; i < 32; ++i) { const int s = wave * 32 + i, k = d == 0 ? s : NCHUNK - 1 - s;
                            Cp[(size_t)k * 512] = (bf16_t)f2bf(er_[i] + pr); Cp[(size_t)k * 512 + 64] = (bf16_t)f2bf(ei_[i] + pi);
                            const float t = ar * pr - ai * pi; pi = ar * pi + ai * pr; pr = t; }
                        __syncthreads();
                    }
                }
                asm volatile("s_waitcnt vmcnt(0)" ::: "memory"); __syncthreads();
                { pg8::Gemm gm{xag, TM, 512, 512, 512, (size_t)NCHUNK_TOT * 512, (size_t)256 * 512}; pg8::OneUnit S; S.u = pg8::Unit{b, 0, g};
                  pg8::EpiY E{Gb};
                  pg8::gemm_phase<pg8::EpiY, pg8::OneUnit>(lds, gm, S, E, wave_s); }
                __syncthreads();
            }
            {
                const float* rp = rpbs + (size_t)l * 4 * 8 * 15 * 64;
                int nNA, naB, naS, nDI, diB, diS;
                if (G == 2 * NCHAIN) {
                    if (vcu < NCHAIN) { nNA = 6; naB = vcu * 6; naS = 1; nDI = 1; diB = vcu; diS = 1; }
                    else { nNA = 2; naB = NCHAIN * 6 + (vcu - NCHAIN) * 2; naS = 1; nDI = 3; diB = NCHAIN + (vcu - NCHAIN) * 3; diS = 1; }
                } else { nNA = (1024 - vcu + G - 1) / G; naB = vcu; naS = G; nDI = (512 - vcu + G - 1) / G; diB = vcu; diS = G; }
#pragma unroll 1
                for (int i = 0; i < ((args.skip & 2) ? 0 : nNA); ++i) att::na_block_task(proj, rp, naB + i * naS, (LAS char*)lds, wave_s, dryp);
#ifdef DILVAR
                if (dry) { for (int i = 0; i < ((args.skip & 4) ? 0 : nDI); ++i) att::dil_block_task<DILVAR>(proj, t5tb, diB + i * diS, (LAS char*)lds, wave_s, dryp); } else
#endif
#pragma unroll 1
                for (int i = 0; i < ((args.skip & 4) ? 0 : nDI); ++i) att::dil_block_task(proj, t5tb, diB + i * diS, (LAS char*)lds, wave_s, dryp);
            }
        }
        SEAM(pb + 1);
        if (INL(2)) {
            pg8::Gemm gm{Gb, GluT, 512, 512, 512, 0, 0}; pg8::StaticOrder S; S.init(NTOK, 512, G, (int)blockIdx.x);
            pg8::EpiGlu E{Gb, args.in[13] + l * 512, proj, dry};
            pg8::gemm_phase<pg8::EpiGlu, pg8::StaticOrder>(lds, gm, S, E, wave_s);
        }
        SEAM(pb + 2);
        if (INL(3)) {
            pg8::Gemm gm{proj, WoutT, PLD, MIXW, MIXW, 0, 0}; pg8::StaticOrder S; S.init(NTOK, DM, G, (int)blockIdx.x);
            pg8::EpiOutProj E{l == 0 ? args.in[0] : args.out, args.out, xb, sspart, l == 0 ? 1 : 0, dry};
            pg8::gemm_phase<pg8::EpiOutProj, pg8::StaticOrder>(lds, gm, S, E, wave_s);
        }
        SEAM(pb + 3);
    }
    if (IN(9)) {
        PHASE_LANES
        const float* fg = args.in[16];
        const int gw = vcu * NWAVES + wave, NGW = G * NWAVES;
        for (int m = gw; m < NTOK; m += NGW) {
            const f32x4* sp = (const f32x4*)(sspart + (size_t)m * 16);
            const f32x4 s0 = sp[0], s1 = sp[1], s2 = sp[2], s3 = sp[3];
            const float ss = (((s0[0] + s0[1]) + (s0[2] + s0[3])) + ((s1[0] + s1[1]) + (s1[2] + s1[3]))) + (((s2[0] + s2[1]) + (s2[2] + s2[3])) + ((s3[0] + s3[1]) + (s3[2] + s3[3])));
            const float rinv = rsqrtf(ss * (1.0f / DM) + RMS_EPS);
            f32x4* xr = (f32x4*)(args.out + (size_t)m * DM) + lane;
#pragma unroll
            for (int j = 0; j < 4; ++j) { const f32x4 gv = *((const f32x4*)fg + lane + 64 * j); const f32x4 ov = xr[64 * j] * rinv * gv; if (!dry) xr[64 * j] = ov; else asm volatile("" :: "v"(ov)); }
        }
    }
#undef IN
#undef INL
#undef INR
#undef SEAM
}
#ifndef EXTRA_PLAN
#define EXTRA_PLAN
#endif
#define HOST_PLAN launch_mega(d_in, d_out, d_ws, stream, 0, N_PHASES, 0, 0); EXTRA_PLAN
static int g_grid = 0;
static void launch_mega(void* const* d_in, void* d_out, void* d_ws, hipStream_t stream, int lo, int hi, int li, int skip) {
    Args a{};
    for (int i = 0; i < 17; ++i) a.in[i] = (const float*)d_in[i];
    a.out = (float*)d_out; a.ws = (unsigned char*)d_ws; a.ph_lo = lo; a.ph_hi = hi; a.li = li; a.skip = skip;
    hipLaunchKernelGGL(mega_fwd, dim3(g_grid), dim3(NWAVES * 64), LDS_BYTES, stream, a);
    const hipError_t le = hipPeekAtLastError();
    if (le != hipSuccess) fprintf(stderr, "kernel_launch: launch failed: %s (grid %d)\n", hipGetErrorName(le), g_grid);
}
extern "C" void kernel_launch(void* const* d_in, const int* in_sizes, int n_in, void* d_out, int out_size, void* d_ws, size_t ws_size, hipStream_t stream) {
    if (g_grid == 0) {
        if (n_in != 17 || in_sizes[0] != NTOK * DM || out_size != NTOK * DM || ws_size < WS_NEED) { fprintf(stderr, "kernel_launch: unexpected shapes (n_in %d in0 %d out %d ws %zu need %zu)\n", n_in, n_in > 0 ? in_sizes[0] : -1, out_size, ws_size, (size_t)WS_NEED); g_grid = -1; return; }
        int dev = 0, cus = 0, per_cu = 0;
        if (hipGetDevice(&dev) != hipSuccess || hipDeviceGetAttribute(&cus, hipDeviceAttributeMultiprocessorCount, dev) != hipSuccess) { g_grid = -1; return; }
        if (hipFuncSetAttribute((const void*)mega_fwd, hipFuncAttributeMaxDynamicSharedMemorySize, LDS_BYTES) != hipSuccess) { fprintf(stderr, "kernel_launch: hipFuncSetAttribute failed\n"); g_grid = -1; return; }
        if (hipOccupancyMaxActiveBlocksPerMultiprocessor(&per_cu, (const void*)mega_fwd, NWAVES * 64, LDS_BYTES) != hipSuccess || per_cu < 1) { fprintf(stderr, "kernel_launch: occupancy query says %d\n", per_cu); per_cu = 1; }
        (void)hipGetLastError();
        g_grid = cus * 1;
    }
    if (g_grid < 0) return;
    (void)hipMemsetAsync((char*)d_ws + OFF_CTL, 0, CTL_ZERO_BYTES, stream);
    HOST_PLAN
}
```

```cpp
#include <hip/hip_runtime.h>
#include <cstdio>
#include <cstdint>
#include <cmath>

typedef unsigned short bf16_t;

constexpr int NB = 4, SEQ = 4096, DM = 1024, NTOK = NB * SEQ, DEPTH = 2;
constexpr int IN_COLS = 5120, MIXW = 1536;
constexpr float RMS_EPS = 1e-6f;
constexpr int LCH = 16;
constexpr int NCHUNK = SEQ / LCH;
constexpr int NCHUNK_TOT = NB * NCHUNK;
constexpr int PLD = 4608;
constexpr int PC_ZA = 0, PC_QB = 512, PC_QC = 1024, PC_KB = 1536, PC_VB = 2048, PC_ZB = 2560, PC_KC = 3072, PC_VC = 3584, PC_ZC = 4096;
__host__ __device__ __forceinline__ int inproj_src_col(int n) {
    if (n < 512) return n;
    const int pc = n - 512, s = pc >> 9;
    const int seg = (s == 0) ? 1 : (s == 1) ? 2 : (s == 2) ? 6 : (s == 3) ? 3 : (s == 4) ? 4 : (s == 5) ? 5 : (s == 6) ? 7 : (s == 7) ? 8 : 9;
    return seg * 512 + (pc & 511);
}

constexpr size_t OFF_CTL = 0;
constexpr size_t OFF_SS = 1u << 20;
constexpr size_t OFF_PROJ = 2u << 20;
constexpr size_t SZ_PROJ = (size_t)NTOK * PLD * 2;
constexpr size_t OFF_XAG = OFF_PROJ + SZ_PROJ;
constexpr size_t SZ_XAG = (size_t)32 * NCHUNK_TOT * 512 * 2;
constexpr size_t OFF_XB = OFF_XAG + SZ_XAG;
constexpr size_t SZ_XB = (size_t)NTOK * DM * 2;
constexpr size_t OFF_G = OFF_XB + SZ_XB;
constexpr size_t SZ_G = (size_t)NTOK * 512 * 2;
constexpr size_t OFF_W = OFF_G + SZ_G;
constexpr size_t WS_NEED_NAIVE = OFF_W;

__host__ __device__ __forceinline__ unsigned f2bf(float f) { unsigned u = __builtin_bit_cast(unsigned, f); return (u + 0x7fffu + ((u >> 16) & 1u)) >> 16; }
__host__ __device__ __forceinline__ float bf2f(bf16_t b) { return __builtin_bit_cast(float, (unsigned)b << 16); }

__device__ __forceinline__ int hw_lane() { int r; asm volatile("v_mbcnt_lo_u32_b32 %0, -1, 0\n\tv_mbcnt_hi_u32_b32 %0, -1, %0" : "=v"(r)); return r; }
namespace pg8 {
#define PG8_LAS __attribute__((address_space(3)))
typedef short bf16x8 __attribute__((ext_vector_type(8)));
typedef float f32x4 __attribute__((ext_vector_type(4)));
typedef unsigned u32x4 __attribute__((ext_vector_type(4)));
typedef unsigned u32x2 __attribute__((ext_vector_type(2)));
constexpr int BM = 256, BK = 64, HALF = 128, HTB = HALF * BK * 2  , STAGE_BYTES = 8 * HTB, NXCD = 8, WGM = 8;

__host__ __device__ __forceinline__ int lds_byte(int r, int c) { const int st = (r >> 4) * 2 + (c >> 5), rr = r & 15, cc = c & 31, ob = rr * 64 + cc * 2; return st * 1024 + (ob ^ (((ob >> 9) & 1) << 5)); }
__host__ __device__ __forceinline__ void stage_rc(int b, int& R, int& C) { const int st = b / 1024, sb = b % 1024, swz = sb ^ (((sb >> 9) & 1) << 5); R = (st >> 1) * 16 + swz / 64; C = (st & 1) * 32 + (swz % 64) / 2; }
__host__ __device__ __forceinline__ int perm32(int rho) { const int n = rho >> 4, i = rho & 15; return 8 * (i >> 2) + 4 * n + (i & 3); }

struct Unit { int pm, pn, bz; };
struct Gemm { const bf16_t* A; const bf16_t* Bt; int lda, ldb, K; size_t a_bz, b_bz; };

struct StaticOrder {
    int nM, nN, nwg, G, c;
    __host__ __device__ void init(int M, int N, int G_, int c_) { nM = M / BM; nN = N / BM; nwg = nM * nN; G = G_; c = c_; }
    __host__ __device__ bool next(int i, Unit& u) const {
        const long L = (long)i * G + c; if (L >= nwg) return false;
        int wgid = (int)L; { const int q = nwg / NXCD, r = nwg % NXCD, xcd = wgid % NXCD, off = wgid / NXCD; wgid = (xcd < r ? xcd * (q + 1) : r * (q + 1) + (xcd - r) * q) + off; }
        const int nig = WGM * nN, gid = wgid / nig, fm = gid * WGM, gsz = (nM - fm) < WGM ? (nM - fm) : WGM;
        u.pm = fm + ((wgid % nig) % gsz); u.pn = (wgid % nig) / gsz; u.bz = 0; return true;
    }
};
struct BatchOrder {
    int nM, nwg, G, c;
    __host__ __device__ void init(int nM_, int nBatch, int G_, int c_) { nM = nM_; nwg = nM_ * nBatch; G = G_; c = c_; }
    __host__ __device__ bool next(int i, Unit& u) const {
        const long L = (long)i * G + c; if (L >= nwg) return false;
        u.bz = (int)L >> 2; u.pm = (int)L & 3; u.pn = 0; return true;
    }
};

struct OneUnit { Unit u; __host__ __device__ bool next(int i, Unit& o) const { if (i != 0) return false; o = u; return true; } };

__device__ __forceinline__ unsigned cvt_pk_bf16(float lo, float hi) { unsigned r; asm volatile("v_cvt_pk_bf16_f32 %0, %1, %2" : "=v"(r) : "v"(lo), "v"(hi)); return r; }
__device__ __forceinline__ u32x4 pack8(const f32x4 v0, const f32x4 v1) { u32x4 w; w.x = cvt_pk_bf16(v0[0], v0[1]); w.y = cvt_pk_bf16(v0[2], v0[3]); w.z = cvt_pk_bf16(v1[0], v1[1]); w.w = cvt_pk_bf16(v1[2], v1[3]); return w; }
__device__ __forceinline__ float bfl(unsigned w) { return __builtin_bit_cast(float, w << 16); }
__device__ __forceinline__ float bfh(unsigned w) { return __builtin_bit_cast(float, w & 0xffff0000u); }


struct EpiInProj {
    static constexpr bool PERM = true, AFTER_DRAIN = false;
    const float* sspart; bf16_t* proj; bf16_t* xag;
    __device__ __forceinline__ void operator()(const f32x4 (&acc)[2][2][4][2], const Unit& u, int wr, int wc, int fr, int fq) const {
        const int row0 = u.pm * BM + wr * 64 + fr, colt = u.pn * BM + wc * 32 + 8 * fq;
#pragma unroll
        for (int ai = 0; ai < 2; ++ai)
#pragma unroll
            for (int m = 0; m < 4; ++m) {
                const int row = row0 + ai * HALF + m * 16;
                const f32x4* sp = (const f32x4*)(sspart + (size_t)row * 16);
                const f32x4 s0 = sp[0], s1 = sp[1], s2 = sp[2], s3 = sp[3];
                const float ss = (((s0[0] + s0[1]) + (s0[2] + s0[3])) + ((s1[0] + s1[1]) + (s1[2] + s1[3]))) + (((s2[0] + s2[1]) + (s2[2] + s2[3])) + ((s3[0] + s3[1]) + (s3[2] + s3[3])));
                const float rinv = rsqrtf(ss * (1.0f / DM) + RMS_EPS);
#pragma unroll
                for (int bj = 0; bj < 2; ++bj) {
                    const int col = colt + bj * HALF;
                    const u32x4 w = pack8(acc[ai][bj][m][0] * rinv, acc[ai][bj][m][1] * rinv);
                    bf16_t* dst = (u.pn < 2) ? xag + ((size_t)(col >> 4) * NCHUNK_TOT + (row >> 4)) * 512 + (row & 15) * 16 + (col & 15)
                                             : proj + (size_t)row * PLD + (col - 512);
                    *(u32x4*)dst = w;
                }
                asm volatile("" ::: "memory");
            }
    }
};
struct EpiE {
    static constexpr bool PERM = true, AFTER_DRAIN = false;
    float* E;
    __device__ __forceinline__ void operator()(const f32x4 (&acc)[2][2][4][2], const Unit& u, int wr, int wc, int fr, int fq) const {
        const int row0 = u.pm * BM + wr * 64 + fr, colt = wc * 32 + 8 * fq;
#pragma unroll
        for (int ai = 0; ai < 2; ++ai)
#pragma unroll
            for (int m = 0; m < 4; ++m) {
                float* rp = E + ((size_t)u.bz * NCHUNK_TOT + row0 + ai * HALF + m * 16) * 256 + colt;
#pragma unroll
                for (int bj = 0; bj < 2; ++bj) { *(f32x4*)(rp + bj * HALF) = acc[ai][bj][m][0]; *(f32x4*)(rp + bj * HALF + 4) = acc[ai][bj][m][1]; }
                asm volatile("" ::: "memory");
            }
    }
};
struct EpiY {
    static constexpr bool PERM = true, AFTER_DRAIN = false;
    bf16_t* G;
    __device__ __forceinline__ static float gelu(float y) {
        const float a = 0.7978845608028654f * (y + 0.044715f * y * y * y);
        return y * __builtin_amdgcn_rcpf(1.0f + __builtin_amdgcn_exp2f(-2.885390081777927f * a));
    }
    __device__ __forceinline__ void operator()(const f32x4 (&acc)[2][2][4][2], const Unit& u, int wr, int wc, int fr, int fq) const {
        const int row0 = u.pm * BM + wr * 64 + fr, colt = wc * 32 + 8 * fq;
#pragma unroll
        for (int ai = 0; ai < 2; ++ai)
#pragma unroll
            for (int m = 0; m < 4; ++m) {
                const int n = row0 + ai * HALF + m * 16;
#pragma unroll
                for (int bj = 0; bj < 2; ++bj) {
                    const int col = colt + bj * HALF, t = col >> 4, c0 = col & 15;
                    f32x4 v0 = acc[ai][bj][m][0], v1 = acc[ai][bj][m][1];
#pragma unroll
                    for (int e = 0; e < 4; ++e) { v0[e] = gelu(v0[e]); v1[e] = gelu(v1[e]); }
                    *(u32x4*)(G + ((size_t)n * 16 + t) * 512 + u.bz * 16 + c0) = pack8(v0, v1);
                }
                asm volatile("" ::: "memory");
            }
    }
};
struct EpiGlu {
    static constexpr bool PERM = true, AFTER_DRAIN = false;
    const bf16_t* G; const float* bias; bf16_t* proj; int dry;
    __device__ __forceinline__ static float sig(float v) { return __builtin_amdgcn_rcpf(1.0f + __builtin_amdgcn_exp2f(-1.4426950408889634f * v)); }
    __device__ __forceinline__ void operator()(const f32x4 (&acc)[2][2][4][2], const Unit& u, int wr, int wc, int fr, int fq) const {
        const int row0 = u.pm * BM + wr * 64 + fr, colt = u.pn * BM + wc * 32 + 8 * fq;
#pragma unroll
        for (int bj = 0; bj < 2; ++bj) {
            const int col = colt + bj * HALF;
            const f32x4 b0 = *(const f32x4*)(bias + col), b1 = *(const f32x4*)(bias + col + 4);
#pragma unroll
            for (int ai = 0; ai < 2; ++ai)
#pragma unroll
                for (int m = 0; m < 4; ++m) {
                    const int row = row0 + ai * HALF + m * 16;
                    const u32x4 gg = *(const u32x4*)(G + (size_t)row * 512 + col);
                    bf16_t* zp = proj + (size_t)row * PLD + PC_ZA + col;
                    const u32x4 zz = *(const u32x4*)zp;
                    const f32x4 a0 = acc[ai][bj][m][0] + b0, a1 = acc[ai][bj][m][1] + b1;
                    f32x4 o0, o1;
#pragma unroll
                    for (int e = 0; e < 4; ++e) {
                        const unsigned gw0 = gg[e >> 1], zw0 = zz[e >> 1], gw1 = gg[2 + (e >> 1)], zw1 = zz[2 + (e >> 1)];
                        const float g0 = (e & 1) ? bfh(gw0) : bfl(gw0), z0 = (e & 1) ? bfh(zw0) : bfl(zw0);
                        const float g1 = (e & 1) ? bfh(gw1) : bfl(gw1), z1 = (e & 1) ? bfh(zw1) : bfl(zw1);
                        o0[e] = g0 * sig(a0[e]) * (z0 * sig(z0)); o1[e] = g1 * sig(a1[e]) * (z1 * sig(z1));
                    }
                    if (!dry) *(u32x4*)zp = pack8(o0, o1); else asm volatile("" :: "v"(o0), "v"(o1));
                    asm volatile("" ::: "memory");
                }
        }
    }
};
struct EpiOutProj {
    static constexpr bool PERM = true, AFTER_DRAIN = false;
    const float* xold; float* xout; bf16_t* xb; float* sspart; int write_xb; int dry;
    __device__ __forceinline__ void operator()(const f32x4 (&acc)[2][2][4][2], const Unit& u, int wr, int wc, int fr, int fq) const {
        const int row0 = u.pm * BM + wr * 64 + fr, colt = u.pn * BM + wc * 32 + 8 * fq;
#pragma unroll
        for (int ai = 0; ai < 2; ++ai)
#pragma unroll
            for (int m = 0; m < 4; ++m) {
                const int row = row0 + ai * HALF + m * 16;
                float ssl = 0.f;
#pragma unroll
                for (int bj = 0; bj < 2; ++bj) {
                    const size_t off = (size_t)row * DM + colt + bj * HALF;
                    const f32x4 n0 = *(const f32x4*)(xold + off) + acc[ai][bj][m][0], n1 = *(const f32x4*)(xold + off + 4) + acc[ai][bj][m][1];
                    if (!dry) { *(f32x4*)(xout + off) = n0; *(f32x4*)(xout + off + 4) = n1;
                    if (write_xb) *(u32x4*)(xb + off) = pack8(n0, n1); }
                    ssl += ((n0[0] * n0[0] + n0[1] * n0[1]) + (n0[2] * n0[2] + n0[3] * n0[3])) + ((n1[0] * n1[0] + n1[1] * n1[1]) + (n1[2] * n1[2] + n1[3] * n1[3]));
                }
                ssl += __shfl_xor(ssl, 16); ssl += __shfl_xor(ssl, 32);
                if (fq == 0 && !dry) sspart[(size_t)row * 16 + u.pn * 4 + wc] = ssl; else asm volatile("" :: "v"(ssl));
                asm volatile("" ::: "memory");
            }
    }
};

template <class Epi, class Sched, bool ALIGN_EPI = true>
__device__ __forceinline__ void gemm_phase(PG8_LAS unsigned char* lds, const Gemm g, const Sched& S, const Epi& E, int wave_s) {
    int tid = wave_s * 64 + hw_lane(); asm volatile("" : "+v"(tid));
    const int wid = __builtin_amdgcn_readfirstlane(tid >> 6), lane = tid & 63, wr = wid >> 2, wc = wid & 3, fr = lane & 15, fq = lane >> 4;
    int K = g.K; asm volatile("" : "+s"(K));
    const int nt = K / BK;
    unsigned voffA[2], voffB[2];
#pragma unroll
    for (int i = 0; i < 2; ++i) { int R, C; stage_rc(tid * 16 + i * 8192, R, C); const int Rb = Epi::PERM ? ((R & ~31) + perm32(R & 31)) : R;
        voffA[i] = (unsigned)(R * g.lda + C) * 2u; voffB[i] = (unsigned)(Rb * g.ldb + C) * 2u; }
    const size_t kstep = (size_t)(BK * 2);
    const size_t hstepA = (size_t)HALF * g.lda * 2, hstepB = (size_t)HALF * g.ldb * 2;
    const unsigned ldsw = (unsigned)wid * 1024u;
    const int aoff = lds_byte(wr * 64 + fr, fq * 8), boff = lds_byte(wc * 32 + fr, fq * 8);
#define PG8_SA(b, h) (((b) * 2 + (h)) * HTB)
#define PG8_SB(b, h) ((4 + (b) * 2 + (h)) * HTB)
#define PG8_STAGE(bufoff, gbase, voff) do { _Pragma("unroll") for (int _i = 0; _i < 2; ++_i) \
        __builtin_amdgcn_global_load_lds((const unsigned*)((const char*)(gbase) + (voff)[_i]), (PG8_LAS unsigned*)(lds + (bufoff) + ldsw + _i * 8192), 16, 0, 0); } while (0)
#define PG8_LDA(dst, b, h) do { _Pragma("unroll") for (int m = 0; m < 4; ++m) _Pragma("unroll") for (int k = 0; k < 2; ++k) dst[m][k] = *(const PG8_LAS bf16x8*)(lds + PG8_SA(b, h) + aoff + m * 2048 + k * 1024); } while (0)
#define PG8_LDB(dst, b, h) do { _Pragma("unroll") for (int n = 0; n < 2; ++n) _Pragma("unroll") for (int k = 0; k < 2; ++k) dst[n][k] = *(const PG8_LAS bf16x8*)(lds + PG8_SB(b, h) + boff + n * 2048 + k * 1024); } while (0)
#define PG8_MMA(ai, bj, At, Bt) do { __builtin_amdgcn_s_setprio(1); _Pragma("unroll") for (int m = 0; m < 4; ++m) _Pragma("unroll") for (int n = 0; n < 2; ++n) _Pragma("unroll") for (int k = 0; k < 2; ++k) \
        acc[ai][bj][m][n] = __builtin_amdgcn_mfma_f32_16x16x32_bf16(Bt[n][k], At[m][k], acc[ai][bj][m][n], 0, 0, 0); __builtin_amdgcn_s_setprio(0); } while (0)
#define PG8_WAIT_V(n) asm volatile("s_waitcnt vmcnt(" #n ")" ::: "memory")
#define PG8_WAIT_L(n) asm volatile("s_waitcnt lgkmcnt(" #n ")" ::: "memory")
#define PG8_BAR __builtin_amdgcn_s_barrier()
#define PG8_SCHED __builtin_amdgcn_sched_barrier(0)
#define PG8_ABASE(u) ((const char*)g.A + ((size_t)(u).bz * g.a_bz + (size_t)(u).pm * BM * g.lda) * 2)
#define PG8_BBASE(u) ((const char*)g.Bt + ((size_t)(u).bz * g.b_bz + (size_t)(u).pn * BM * g.ldb) * 2)
    Unit cur, nxt; int ui = 0;
    if (!S.next(0, cur)) return;
    f32x4 acc[2][2][4][2];
#pragma unroll
    for (int a = 0; a < 2; ++a)
#pragma unroll
        for (int b = 0; b < 2; ++b)
#pragma unroll
            for (int m = 0; m < 4; ++m)
#pragma unroll
                for (int n = 0; n < 2; ++n) acc[a][b][m][n] = (f32x4){0.f, 0.f, 0.f, 0.f};
    bf16x8 At[4][2], B0[2][2], B1[2][2];
    const char* cA = PG8_ABASE(cur); const char* cB = PG8_BBASE(cur);
    PG8_STAGE(PG8_SB(0, 0), cB, voffB); PG8_STAGE(PG8_SB(0, 1), cB + hstepB, voffB); PG8_STAGE(PG8_SA(0, 0), cA, voffA); PG8_STAGE(PG8_SA(0, 1), cA + hstepA, voffA);
    if (wr == 1) PG8_BAR;
    PG8_WAIT_V(2); PG8_BAR;
    PG8_STAGE(PG8_SB(1, 0), cB + kstep, voffB); PG8_STAGE(PG8_SA(1, 0), cA + kstep, voffA); PG8_STAGE(PG8_SB(1, 1), cB + hstepB + kstep, voffB);
    PG8_WAIT_V(6); PG8_BAR;
    for (;;) {
        const bool has_next = S.next(ui + 1, nxt);
        const char* nA = has_next ? PG8_ABASE(nxt) : cA; const char* nB = has_next ? PG8_BBASE(nxt) : cB;
        for (int t = 0; t < nt; t += 2) {
            const bool last = (t == nt - 2);
            const char* a1 = cA + (size_t)(t + 1) * kstep;
            const char* a2 = last ? nA : cA + (size_t)(t + 2) * kstep; const char* b2 = last ? nB : cB + (size_t)(t + 2) * kstep;
            const char* a3 = a2 + kstep; const char* b3 = b2 + kstep;
            PG8_LDB(B0, 0, 0); PG8_LDB(B1, 0, 1); PG8_SCHED; PG8_LDA(At, 0, 0); PG8_STAGE(PG8_SA(1, 1), a1 + hstepA, voffA);
            PG8_WAIT_V(8); PG8_WAIT_L(0); PG8_BAR; PG8_MMA(0, 0, At, B0); PG8_MMA(0, 1, At, B1); PG8_BAR; PG8_SCHED;
            PG8_LDA(At, 0, 1); PG8_STAGE(PG8_SB(0, 0), b2, voffB); PG8_STAGE(PG8_SB(0, 1), b2 + hstepB, voffB); PG8_STAGE(PG8_SA(0, 0), a2, voffA);
            PG8_WAIT_V(8); PG8_WAIT_L(0); PG8_BAR; PG8_MMA(1, 0, At, B0); PG8_MMA(1, 1, At, B1); PG8_BAR; PG8_SCHED;
            PG8_LDB(B0, 1, 0); PG8_LDB(B1, 1, 1); PG8_SCHED; PG8_LDA(At, 1, 0); PG8_STAGE(PG8_SA(0, 1), a2 + hstepA, voffA);
            PG8_WAIT_V(8); PG8_WAIT_L(0); PG8_BAR; PG8_MMA(0, 0, At, B0); PG8_MMA(0, 1, At, B1); PG8_BAR; PG8_SCHED;
            PG8_LDA(At, 1, 1); PG8_STAGE(PG8_SB(1, 0), b3, voffB); PG8_STAGE(PG8_SB(1, 1), b3 + hstepB, voffB); PG8_STAGE(PG8_SA(1, 0), a3, voffA);
            PG8_WAIT_V(8); PG8_WAIT_L(0); PG8_BAR; PG8_MMA(1, 0, At, B0); PG8_MMA(1, 1, At, B1); PG8_BAR; PG8_SCHED;
        }
        if constexpr (ALIGN_EPI) { if (wr == 0) PG8_BAR; }
        E(acc, cur, wr, wc, fr, fq);
        if (!has_next) break;
#pragma unroll
        for (int a = 0; a < 2; ++a)
#pragma unroll
            for (int b = 0; b < 2; ++b)
#pragma unroll
                for (int m = 0; m < 4; ++m)
#pragma unroll
                    for (int n = 0; n < 2; ++n) acc[a][b][m][n] = (f32x4){0.f, 0.f, 0.f, 0.f};
        cur = nxt; cA = nA; cB = nB; ++ui;
        if constexpr (ALIGN_EPI) { if (wr == 1) PG8_BAR; }
    }
    PG8_WAIT_V(0);
    if constexpr (!ALIGN_EPI) { if (wr == 0) PG8_BAR; }
    PG8_BAR;
#undef PG8_SA
#undef PG8_SB
#undef PG8_STAGE
#undef PG8_LDA
#undef PG8_LDB
#undef PG8_MMA
#undef PG8_WAIT_V
#undef PG8_WAIT_L
#undef PG8_BAR
#undef PG8_SCHED
#undef PG8_ABASE
#undef PG8_BBASE
}
}
namespace att {
#define LAS __attribute__((address_space(3)))
typedef short bf16x8 __attribute__((ext_vector_type(8)));
typedef short s16x4 __attribute__((ext_vector_type(4)));
typedef float f32x4 __attribute__((ext_vector_type(4)));
typedef unsigned u32x4 __attribute__((ext_vector_type(4)));
typedef unsigned u32x2 __attribute__((ext_vector_type(2)));
typedef float f32x2_t __attribute__((ext_vector_type(2)));
typedef __bf16 bf16x2_t __attribute__((ext_vector_type(2)));
constexpr int VROW = 160;
constexpr int VTILE = 32 * VROW;
constexpr int WAVE_LDS = 2 * VTILE;
constexpr float C2 = 0.125f * 1.4426950408889634f;
constexpr float NEG = -1e30f, MFLOOR = -1e20f, THR = 8.0f;
constexpr int TBW = 640, TBOFF = 240;
constexpr int T5TB_F = 8 * 3 * TBW, T5S_F = 8 * 4 * TBW, RPBS_F = 2 * 4 * 8 * 15 * 64;

__device__ __forceinline__ unsigned cvtpk(float lo, float hi) { f32x2_t v = {lo, hi}; bf16x2_t b = __builtin_convertvector(v, bf16x2_t); return __builtin_bit_cast(unsigned, b); }
__device__ __forceinline__ s16x4 vtr(LAS const char* p) { typedef short v4i16_t __attribute__((ext_vector_type(4))); return __builtin_bit_cast(s16x4, __builtin_amdgcn_ds_read_tr16_b64_v4i16((LAS v4i16_t*)p)); }

__device__ __forceinline__ float max3f(float a, float b, float c) { float r; asm("v_max3_f32 %0, %1, %2, %3" : "=v"(r) : "v"(a), "v"(b), "v"(c)); return r; }
__device__ __forceinline__ float max2f(float a, float b) { float r; asm("v_max_f32_e32 %0, %1, %2" : "=v"(r) : "v"(a), "v"(b)); return r; }
struct State { float m, l; f32x4 acc[4]; };
struct Stage { bf16x8 k00, k01, k10, k11; u32x4 v0, v1, v2, v3; };
struct Bias { f32x4 b0, b1; };

__device__ __forceinline__ void softmax_pv(State& st, f32x4 t0, f32x4 t1, LAS const char* vt, int lane) {
    const float mloc = max2f(max3f(max3f(t0[0], t0[1], t0[2]), t0[3], t1[0]), max3f(t1[1], t1[2], t1[3]));
    if (__builtin_amdgcn_ballot_w64(mloc > st.m + THR) != 0ull) {
        float mx = max2f(mloc, __shfl_xor(mloc, 16)); mx = max2f(mx, __shfl_xor(mx, 32));
        const float mn = max2f(st.m, mx);
        const float alpha = __builtin_amdgcn_exp2f(st.m - mn);
        st.m = mn; st.l *= alpha;
#pragma unroll
        for (int mt = 0; mt < 4; ++mt) st.acc[mt] = st.acc[mt] * alpha;
    }
    const float mn = st.m;
    f32x4 p0, p1;
#pragma unroll
    for (int e = 0; e < 4; ++e) { p0[e] = __builtin_amdgcn_exp2f(t0[e] - mn); p1[e] = __builtin_amdgcn_exp2f(t1[e] - mn); }
    st.l += (((p0[0] + p0[1]) + (p0[2] + p0[3])) + ((p1[0] + p1[1]) + (p1[2] + p1[3])));
    u32x4 pw; pw.x = cvtpk(p0[0], p0[1]); pw.y = cvtpk(p0[2], p0[3]); pw.z = cvtpk(p1[0], p1[1]); pw.w = cvtpk(p1[2], p1[3]);
    const bf16x8 pb = __builtin_bit_cast(bf16x8, pw);
    const int g = lane >> 4, qq = (lane & 15) >> 2, pp = lane & 3;
    LAS const char* vb = vt + (4 * g + qq) * VROW + pp * 8;
#pragma unroll
    for (int mt = 0; mt < 4; ++mt) {
        const s16x4 lo = vtr(vb + mt * 32), hi = vtr(vb + 16 * VROW + mt * 32);
        const bf16x8 av = (bf16x8){lo[0], lo[1], lo[2], lo[3], hi[0], hi[1], hi[2], hi[3]};
        st.acc[mt] = __builtin_amdgcn_mfma_f32_16x16x32_bf16(av, pb, st.acc[mt], 0, 0, 0);
    }
}
__device__ __forceinline__ void write_v(const Stage& s, LAS char* vt, int lane) {
    LAS char* vw = vt + (lane >> 1) * VROW + (lane & 1) * 64;
    *(LAS u32x4*)vw = s.v0; *(LAS u32x4*)(vw + 16) = s.v1; *(LAS u32x4*)(vw + 32) = s.v2; *(LAS u32x4*)(vw + 48) = s.v3;
}
__device__ __forceinline__ void qk(const Stage& s, const Bias& bs, bf16x8 bq0, bf16x8 bq1, f32x4& t0, f32x4& t1) {
    f32x4 s0 = (f32x4){0.f, 0.f, 0.f, 0.f}, s1 = s0;
    s0 = __builtin_amdgcn_mfma_f32_16x16x32_bf16(s.k00, bq0, s0, 0, 0, 0); s0 = __builtin_amdgcn_mfma_f32_16x16x32_bf16(s.k01, bq1, s0, 0, 0, 0);
    s1 = __builtin_amdgcn_mfma_f32_16x16x32_bf16(s.k10, bq0, s1, 0, 0, 0); s1 = __builtin_amdgcn_mfma_f32_16x16x32_bf16(s.k11, bq1, s1, 0, 0, 0);
    t0 = s0 * C2 + bs.b0; t1 = s1 * C2 + bs.b1;
}

__device__ __forceinline__ void finish(State& st, bf16_t* outp  , const bf16_t* zp, int lane) {
    float l = st.l; l += __shfl_xor(l, 16); l += __shfl_xor(l, 32);
    const float rl = 1.0f / l;
    const int g = lane >> 4;
#pragma unroll
    for (int mt = 0; mt < 4; ++mt) {
        const u32x2 zz = *(const u32x2*)(zp + mt * 16 + 4 * g);
        float o[4];
#pragma unroll
        for (int e = 0; e < 4; ++e) {
            const unsigned zw = zz[e >> 1]; const float z = (e & 1) ? __builtin_bit_cast(float, zw & 0xffff0000u) : __builtin_bit_cast(float, zw << 16);
            const float sz = z * __builtin_amdgcn_rcpf(1.0f + __builtin_amdgcn_exp2f(-1.4426950408889634f * z));
            o[e] = st.acc[mt][e] * rl * sz;
        }
        u32x2 w; w.x = cvtpk(o[0], o[1]); w.y = cvtpk(o[2], o[3]);
        *(u32x2*)(outp + mt * 16 + 4 * g) = w;
    }
}

template <int V = 0>
__device__ __forceinline__ void dil_task(bf16_t* proj, const float* tbl, int task, LAS char* vbuf, int lane, bf16_t* dry = nullptr) {
    const int r = task & 15, qb = (task >> 4) & 15, h = (task >> 8) & 7, b = task >> 11;
    const int q = lane & 15, g = lane >> 4;
    const int qr = qb * 256 + r;
    bf16_t* pb_ = proj + (size_t)b * SEQ * PLD;
    const bf16_t* qp = pb_ + (size_t)(qr + 16 * q) * PLD + PC_QC + h * 64 + g * 8;
    const bf16x8 bq0 = *(const bf16x8*)qp, bq1 = *(const bf16x8*)(qp + 32);
    const char* kbase = (const char*)(pb_ + PC_KC + h * 64);
    const char* vbase = (const char*)(pb_ + PC_VC + h * 64);
    const unsigned klane = (unsigned)g * 16u, vlane = (unsigned)(lane & 1) * 64u;
    const int sv = lane >> 1;
    State st; st.m = MFLOOR; st.l = 0.f;
#pragma unroll
    for (int mt = 0; mt < 4; ++mt) st.acc[mt] = (f32x4){0.f, 0.f, 0.f, 0.f};
    const float* tb0 = tbl + T5TB_F + ((size_t)h * 4 + (q & 3)) * TBW + TBOFF + 4 * g - (q & ~3);
    const float* tb1 = tbl + ((size_t)h * 3 + 1) * TBW + TBOFF + 4 * g - 4 * q;
    const float* tb2 = tbl + ((size_t)h * 3 + 2) * TBW + TBOFF + 4 * g - 16 * q;

#define DIL_PARAMS(ks, d, pat, ul0) const int pat = ((ks) >= 5) + ((ks) >= 11), d = 16 >> (2 * pat), ul0 = ((ks) - (5 * pat + (pat >> 1))) * 32;
    auto issue = [&](int ks, Stage& s) {
        if (V == 1 && ks > 2) return;
        DIL_PARAMS(ks, d, pat, ul0);
        const int pbase = qr + d * (ul0 - 64);
        int p0 = pbase + d * q, p1 = p0 + 16 * d, pv = pbase + d * sv;
        p0 = p0 < 0 ? 0 : (p0 > SEQ - 1 ? SEQ - 1 : p0); p1 = p1 < 0 ? 0 : (p1 > SEQ - 1 ? SEQ - 1 : p1); pv = pv < 0 ? 0 : (pv > SEQ - 1 ? SEQ - 1 : pv);
        const char* ka = kbase + ((unsigned)p0 * (unsigned)(PLD * 2) + klane); const char* kb = kbase + ((unsigned)p1 * (unsigned)(PLD * 2) + klane);
        const char* va = vbase + ((unsigned)pv * (unsigned)(PLD * 2) + vlane);
        if (V != 4 && V != 5) { s.k00 = *(const bf16x8*)ka; s.k01 = *(const bf16x8*)(ka + 64); s.k10 = *(const bf16x8*)kb; s.k11 = *(const bf16x8*)(kb + 64); }
        if (V != 3 && V != 5) { s.v0 = *(const u32x4*)va; s.v1 = *(const u32x4*)(va + 16); s.v2 = *(const u32x4*)(va + 32); s.v3 = *(const u32x4*)(va + 48); }
    };
    auto issue_b = [&](int ks, Bias& bs) {
        if (V == 1 && ks > 1) return;
        if (V == 3 || V == 4) return;
        DIL_PARAMS(ks, d, pat, ul0); (void)d;
        const float* tp = (pat == 0 ? tb0 : (pat == 1 ? tb1 : tb2)) + ul0;
        bs.b0 = *(const f32x4*)tp; bs.b1 = *(const f32x4*)(tp + 16);
    };
    auto compute = [&](int ks, const Stage& s, const Bias& bs) {
        if (V == 3) { asm volatile("" :: "v"(s.k00), "v"(s.k01), "v"(s.k10), "v"(s.k11)); return; }
        if (V == 4) { asm volatile("" :: "v"(s.v0), "v"(s.v1), "v"(s.v2), "v"(s.v3)); return; }
        if (V == 5) { asm volatile("" :: "v"(bs.b0), "v"(bs.b1)); return; }
        if (V == 2) { asm volatile("" :: "v"(s.k00), "v"(s.k01), "v"(s.k10), "v"(s.k11), "v"(s.v0), "v"(s.v1), "v"(s.v2), "v"(s.v3), "v"(bs.b0), "v"(bs.b1)); return; }
        LAS char* vt = vbuf + (ks & 1) * VTILE;
        write_v(s, vt, lane);
        f32x4 t0, t1; qk(s, bs, bq0, bq1, t0, t1);
        {
            DIL_PARAMS(ks, d, pat, ul0); (void)pat;
            const int pbase = qr + d * (ul0 - 64);
            if (pbase < 0 || pbase + 31 * d > SEQ - 1) {
                const int pk = pbase + d * 4 * g;
#pragma unroll
                for (int x = 0; x < 4; ++x) { if ((unsigned)(pk + d * x) >= (unsigned)SEQ) t0[x] = NEG; if ((unsigned)(pk + d * (16 + x)) >= (unsigned)SEQ) t1[x] = NEG; }
            }
        }
        softmax_pv(st, t0, t1, vt, lane);
    };
    Stage A, B, C, D;
    Bias X, Y;
    issue(0, A); issue(1, B); issue(2, C); issue_b(0, X);
#pragma unroll 1
    for (int ks = 0; ks < 20; ks += 4) {
        issue(ks + 3, D); issue_b(ks + 1, Y); compute(ks, A, X);
        issue(ks + 4, A); issue_b(ks + 2, X); compute(ks + 1, B, Y);
        issue(ks + 5, B); issue_b(ks + 3, Y); compute(ks + 2, C, X);
        issue(ks + 6, C); issue_b(ks + 4, X); compute(ks + 3, D, Y);
    }
    issue_b(21, Y); compute(20, A, X); issue_b(22, X); compute(21, B, Y); compute(22, C, X);
#undef DIL_PARAMS
    bf16_t* outp = dry ? dry + ((size_t)task * 16 + q) * 64 : pb_ + (size_t)(qr + 16 * q) * PLD + PC_QC + h * 64;
    finish(st, outp, pb_ + (size_t)(qr + 16 * q) * PLD + PC_ZC + h * 64, lane);
}

__device__ __forceinline__ void na_task(bf16_t* proj, const float* rpbs, int task, LAS char* vbuf, int lane, bf16_t* dry = nullptr) {
    const int jt = task & 3, r = (task >> 2) & 63, h = (task >> 8) & 7, b = task >> 11;
    const int q = lane & 15, g = lane >> 4;
    const int j0 = 16 * jt, j = j0 + q;
    int w0 = j0 - 8; w0 = w0 < 0 ? 0 : (w0 > 32 ? 32 : w0);
    int rs = r - 4; rs = rs < 0 ? 0 : (rs > 56 ? 56 : rs);
    int cs = j - 8; cs = cs < 0 ? 0 : (cs > 48 ? 48 : cs);
    bf16_t* pb_ = proj + (size_t)b * SEQ * PLD;
    const size_t tq = (size_t)(r * 64 + j);
    const bf16_t* qp = pb_ + tq * PLD + PC_QB + h * 64 + g * 8;
    const bf16x8 bq0 = *(const bf16x8*)qp, bq1 = *(const bf16x8*)(qp + 32);
    const char* kbase = (const char*)(pb_ + (size_t)(rs * 64 + w0) * PLD + PC_KB + h * 64);
    const char* vbase = (const char*)(pb_ + (size_t)(rs * 64 + w0) * PLD + PC_VB + h * 64);
    const int sv = lane >> 1;
    const unsigned koff = (unsigned)q * (unsigned)(PLD * 2) + (unsigned)g * 16u, voff = (unsigned)sv * (unsigned)(PLD * 2) + (unsigned)(lane & 1) * 64u;
    const int col = w0 - j + 32, c4 = col & 3;
    const float* tb = rpbs + (((size_t)c4 * 8 + h) * 15 + (rs - r + 7)) * 64 + (col - c4) + 4 * g;
    State st; st.m = MFLOOR; st.l = 0.f;
#pragma unroll
    for (int mt = 0; mt < 4; ++mt) st.acc[mt] = (f32x4){0.f, 0.f, 0.f, 0.f};
    const int kc0 = w0 + 4 * g - cs;
    auto issue = [&](int ks, Stage& s) {
        const char* ka = kbase + (size_t)ks * (64 * PLD * 2) + koff; const char* kb = ka + 16 * PLD * 2; const char* va = vbase + (size_t)ks * (64 * PLD * 2) + voff;
        s.k00 = *(const bf16x8*)ka; s.k01 = *(const bf16x8*)(ka + 64); s.k10 = *(const bf16x8*)kb; s.k11 = *(const bf16x8*)(kb + 64);
        s.v0 = *(const u32x4*)va; s.v1 = *(const u32x4*)(va + 16); s.v2 = *(const u32x4*)(va + 32); s.v3 = *(const u32x4*)(va + 48);
    };
    auto issue_b = [&](int ks, Bias& bs) { const float* tp = tb + ks * 64; bs.b0 = *(const f32x4*)tp; bs.b1 = *(const f32x4*)(tp + 16); };
    auto compute = [&](int ks, const Stage& s, const Bias& bs) {
        LAS char* vt = vbuf + (ks & 1) * VTILE;
        write_v(s, vt, lane);
        f32x4 t0, t1; qk(s, bs, bq0, bq1, t0, t1);
#pragma unroll
        for (int x = 0; x < 4; ++x) { if ((unsigned)(kc0 + x) >= 16u) t0[x] = NEG; if ((unsigned)(kc0 + 16 + x) >= 16u) t1[x] = NEG; }
        softmax_pv(st, t0, t1, vt, lane);
    };
    Stage A, B, C, D;
    Bias X, Y;
    issue(0, A); issue(1, B); issue(2, C); issue_b(0, X);
    issue(3, D); issue_b(1, Y); compute(0, A, X);
    issue(4, A); issue_b(2, X); compute(1, B, Y);
    issue(5, B); issue_b(3, Y); compute(2, C, X);
    issue(6, C); issue_b(4, X); compute(3, D, Y);
    issue(7, D); issue_b(5, Y); compute(4, A, X);
    issue_b(6, X); compute(5, B, Y); issue_b(7, Y); compute(6, C, X); compute(7, D, Y);
    finish(st, dry ? dry + ((size_t)task * 16 + q) * 64 : pb_ + tq * PLD + PC_QB + h * 64, pb_ + tq * PLD + PC_ZB + h * 64, lane);
}

constexpr int NA_IMG = 480 * 128;
__device__ __forceinline__ int fK(int kidx) { return (kidx >> 1) & 7; }
__device__ __forceinline__ int fV(int kidx) { return ((kidx >> 1) & 3) * 2; }
constexpr int DIL_IMG = 400 * 128;
struct QF { bf16x8 q0, q1; };
struct LdsBases { LAS const char* ka; LAS const char* kb; LAS const char* v[4]; };
__device__ __forceinline__ LdsBases lds_bases(LAS const char* Kimg, LAS const char* Vimg, int k0  , int v0k  , int lane) {
    const int g = lane >> 4, pp = lane & 3, ch = pp >> 1; LdsBases b;
    b.ka = Kimg + k0 * 128 + ((g ^ fK(k0)) * 16); b.kb = Kimg + k0 * 128 + (((4 + g) ^ fK(k0)) * 16);
    const int f0 = fV(v0k);
#pragma unroll
    for (int mt = 0; mt < 4; ++mt) b.v[mt] = Vimg + v0k * 128 + (pp & 1) * 8 + (((mt * 2 + ch) ^ f0) * 16);
    return b;
}
template <class MF>
__device__ __forceinline__ void lds_step(State& st, const QF& qf, const LdsBases& B, int so, const Bias& bs, MF maskfn) {
    const bf16x8 a00 = *(LAS const bf16x8*)(B.ka + so), a01 = *(LAS const bf16x8*)(B.kb + so);
    const bf16x8 a10 = *(LAS const bf16x8*)(B.ka + so + 2048), a11 = *(LAS const bf16x8*)(B.kb + so + 2048);
    f32x4 s0 = (f32x4){0.f, 0.f, 0.f, 0.f}, s1 = s0;
    s0 = __builtin_amdgcn_mfma_f32_16x16x32_bf16(a00, qf.q0, s0, 0, 0, 0); s0 = __builtin_amdgcn_mfma_f32_16x16x32_bf16(a01, qf.q1, s0, 0, 0, 0);
    s1 = __builtin_amdgcn_mfma_f32_16x16x32_bf16(a10, qf.q0, s1, 0, 0, 0); s1 = __builtin_amdgcn_mfma_f32_16x16x32_bf16(a11, qf.q1, s1, 0, 0, 0);
    f32x4 t0 = s0 * C2 + bs.b0, t1 = s1 * C2 + bs.b1;
    maskfn(t0, t1);
    const float mloc = max2f(max3f(max3f(t0[0], t0[1], t0[2]), t0[3], t1[0]), max3f(t1[1], t1[2], t1[3]));
    if (__builtin_amdgcn_ballot_w64(mloc > st.m + THR) != 0ull) {
        float mx = max2f(mloc, __shfl_xor(mloc, 16)); mx = max2f(mx, __shfl_xor(mx, 32));
        const float mn = max2f(st.m, mx); const float alpha = __builtin_amdgcn_exp2f(st.m - mn);
        st.m = mn; st.l *= alpha;
#pragma unroll
        for (int mt = 0; mt < 4; ++mt) st.acc[mt] = st.acc[mt] * alpha;
    }
    const float mn = st.m; f32x4 p0, p1;
#pragma unroll
    for (int e = 0; e < 4; ++e) { p0[e] = __builtin_amdgcn_exp2f(t0[e] - mn); p1[e] = __builtin_amdgcn_exp2f(t1[e] - mn); }
    st.l += (((p0[0] + p0[1]) + (p0[2] + p0[3])) + ((p1[0] + p1[1]) + (p1[2] + p1[3])));
    u32x4 pw; pw.x = cvtpk(p0[0], p0[1]); pw.y = cvtpk(p0[2], p0[3]); pw.z = cvtpk(p1[0], p1[1]); pw.w = cvtpk(p1[2], p1[3]);
    const bf16x8 pb = __builtin_bit_cast(bf16x8, pw);
#pragma unroll
    for (int mt = 0; mt < 4; ++mt) {
        const s16x4 lo = vtr(B.v[mt] + so), hi = vtr(B.v[mt] + so + 2048);
        const bf16x8 av = (bf16x8){lo[0], lo[1], lo[2], lo[3], hi[0], hi[1], hi[2], hi[3]};
        st.acc[mt] = __builtin_amdgcn_mfma_f32_16x16x32_bf16(av, pb, st.acc[mt], 0, 0, 0);
    }
}
__device__ __forceinline__ void na_block_task(bf16_t* proj, const float* rpbs, int bt, LAS char* lds, int wave, bf16_t* dry) {
    int lane = hw_lane();
    const int jt = bt & 3, rb = (bt >> 2) & 7, h = (bt >> 5) & 7, b = bt >> 8;
    const int r0 = 8 * rb, j0 = 16 * jt;
    int w0 = j0 - 8; w0 = w0 < 0 ? 0 : (w0 > 32 ? 32 : w0);
    int Rb = r0 - 4; Rb = Rb < 0 ? 0 : Rb;
    int Re = r0 + 3; Re = Re > 56 ? 56 : Re; Re += 8;
    const int nins = (Re - Rb) * 4;
    bf16_t* pb_ = proj + (size_t)b * SEQ * PLD;
    LAS char* Kimg = lds; LAS char* Vimg = lds + NA_IMG;
    {
        const int kl = lane >> 3, c = lane & 7;
        for (int ii = wave; ii < nins; ii += 8) {
            const int key = 8 * ii + kl, rl = key >> 5, col = key & 31;
            const bf16_t* row = pb_ + (size_t)((Rb + rl) * 64 + w0 + col) * PLD + h * 64;
            __builtin_amdgcn_global_load_lds((const unsigned*)(row + PC_KB + ((c ^ fK(key)) * 8)), (LAS unsigned*)(Kimg + ii * 1024), 16, 0, 0);
            __builtin_amdgcn_global_load_lds((const unsigned*)(row + PC_VB + ((c ^ fV(key)) * 8)), (LAS unsigned*)(Vimg + ii * 1024), 16, 0, 0);
        }
    }
    const int q = lane & 15, g = lane >> 4, qq = q >> 2, pp = lane & 3;
    const int r = r0 + wave, j = j0 + q;
    int rs = r - 4; rs = rs < 0 ? 0 : (rs > 56 ? 56 : rs);
    int cs = j - 8; cs = cs < 0 ? 0 : (cs > 48 ? 48 : cs);
    const size_t tq = (size_t)(r * 64 + j);
    const bf16_t* qp = pb_ + tq * PLD + PC_QB + h * 64 + g * 8;
    const bf16x8 bq0 = *(const bf16x8*)qp, bq1 = *(const bf16x8*)(qp + 32);
    const int col = w0 - j + 32, c4 = col & 3;
    const float* tb = rpbs + (((size_t)c4 * 8 + h) * 15 + (rs - r + 7)) * 64 + (col - c4) + 4 * g;
    const int kc0 = w0 + 4 * g - cs;
    State st; st.m = MFLOOR; st.l = 0.f;
#pragma unroll
    for (int mt = 0; mt < 4; ++mt) st.acc[mt] = (f32x4){0.f, 0.f, 0.f, 0.f};
    Bias bs; bs.b0 = *(const f32x4*)tb; bs.b1 = *(const f32x4*)(tb + 16);
    __syncthreads();
    const int kbase = (rs - Rb) * 32;
    const LdsBases Bn = lds_bases(Kimg, Vimg, kbase + q, kbase + 4 * g + qq, lane);
    QF qf; qf.q0 = bq0; qf.q1 = bq1;
    auto mk = [=](f32x4& t0, f32x4& t1) {
#pragma unroll
        for (int x = 0; x < 4; ++x) { if ((unsigned)(kc0 + x) >= 16u) t0[x] = NEG; if ((unsigned)(kc0 + 16 + x) >= 16u) t1[x] = NEG; } };
#pragma unroll 2
    for (int ks = 0; ks < 8; ++ks) {
        Bias nb = bs; if (ks + 1 < 8) { const float* tp = tb + (ks + 1) * 64; nb.b0 = *(const f32x4*)tp; nb.b1 = *(const f32x4*)(tp + 16); }
        lds_step(st, qf, Bn, ks * 4096, bs, mk);
        bs = nb;
    }
    finish(st, dry ? dry + (((size_t)bt * 8 + wave) * 16 + q) * 64 : pb_ + tq * PLD + PC_QB + h * 64, pb_ + tq * PLD + PC_ZB + h * 64, lane);
    __syncthreads();
}

template <class PF>
__device__ __forceinline__ void stage_keys(bf16_t* pb_, int h, int kcol, int vcol, int nkeys, PF posfn, LAS char* Kimg, LAS char* Vimg, int lane, int wave) {
    const int kl = lane >> 3, c = lane & 7;
    for (int ii = wave; ii < nkeys / 8; ii += 8) {
        const int key = 8 * ii + kl; int pos = posfn(key); pos = pos < 0 ? 0 : (pos > SEQ - 1 ? SEQ - 1 : pos);
        const bf16_t* row = pb_ + (size_t)pos * PLD + h * 64;
        __builtin_amdgcn_global_load_lds((const unsigned*)(row + kcol + ((c ^ fK(key)) * 8)), (LAS unsigned*)(Kimg + ii * 1024), 16, 0, 0);
        __builtin_amdgcn_global_load_lds((const unsigned*)(row + vcol + ((c ^ fV(key)) * 8)), (LAS unsigned*)(Vimg + ii * 1024), 16, 0, 0);
    }
}
template <int VAR = 0>
__device__ __forceinline__ void dil_block_task(bf16_t* proj, const float* tbl, int bt, LAS char* lds, int wave, bf16_t* dry) {
    int lane = hw_lane();
    const int qb = bt & 15, h = (bt >> 4) & 7, b = bt >> 7;
    const int q = lane & 15, g = lane >> 4, qq = q >> 2;
    const int q0 = qb * 256;
    const int ra = 4 * (wave >> 1) + (wave & 1), rb = ra + 2;
    bf16_t* pb_ = proj + (size_t)b * SEQ * PLD;
    LAS char* Kimg = lds; LAS char* Vimg = lds + DIL_IMG;
    if (VAR != 4) stage_keys(pb_, h, PC_KC, PC_VC, 400, [&](int k) { return q0 - 64 + k; }, Kimg, Vimg, lane, wave);
    QF qa, qbf;
    { const bf16_t* qp = pb_ + (size_t)(q0 + ra + 16 * q) * PLD + PC_QC + h * 64 + g * 8; qa.q0 = *(const bf16x8*)qp; qa.q1 = *(const bf16x8*)(qp + 32);
      qp += 2 * PLD; qbf.q0 = *(const bf16x8*)qp; qbf.q1 = *(const bf16x8*)(qp + 32); }
    State sa, sb; sa.m = MFLOOR; sa.l = 0.f; sb.m = MFLOOR; sb.l = 0.f;
#pragma unroll
    for (int mt = 0; mt < 4; ++mt) { sa.acc[mt] = (f32x4){0.f, 0.f, 0.f, 0.f}; sb.acc[mt] = (f32x4){0.f, 0.f, 0.f, 0.f}; }
    const unsigned to2 = (unsigned)((h * 3 + 2) * TBW + TBOFF + 4 * g - 16 * q);
    __syncthreads();
    {
        const bool needm = (q0 - 64 < 0) || (q0 + 15 + 383 - 64 > SEQ - 1);
        const LdsBases Ba = lds_bases(Kimg, Vimg, ra + q, ra + 4 * g + qq, lane), Bb = lds_bases(Kimg, Vimg, rb + q, rb + 4 * g + qq, lane);
#pragma unroll 2
        for (int ks = 0; ks < (VAR == 3 ? 0 : 12); ++ks) {
            Bias bs; bs.b0 = *(const f32x4*)(tbl + (to2 + (unsigned)(ks * 32))); bs.b1 = *(const f32x4*)(tbl + (to2 + (unsigned)(ks * 32 + 16)));
            const int u0 = ks * 32;
            auto mk = [&](int pk) { return [=](f32x4& t0, f32x4& t1) { if (needm) {
#pragma unroll
                for (int x = 0; x < 4; ++x) { if ((unsigned)(pk + x) >= (unsigned)SEQ) t0[x] = NEG; if ((unsigned)(pk + 16 + x) >= (unsigned)SEQ) t1[x] = NEG; } } }; };
            lds_step(sa, qa, Ba, ks * 4096, bs, mk(q0 + ra + u0 - 64 + 4 * g));
            lds_step(sb, qbf, Bb, ks * 4096, bs, mk(q0 + rb + u0 - 64 + 4 * g));
        }
    }
    __syncthreads();
    asm volatile("" : "+v"(lane));
#pragma unroll 1
    for (int t = 0; t < (VAR == 2 ? 0 : 2); ++t) {
        const int q = lane & 15, g = lane >> 4, qq = q >> 2;
        const unsigned to1 = (unsigned)((h * 3 + 1) * TBW + TBOFF + 4 * g - 4 * q);
        const int c0 = 2 * t;
        if (VAR != 4) stage_keys(pb_, h, PC_KC, PC_VC, 392, [&](int k) { const int cl = k >= 196 ? 1 : 0; return q0 - 256 + c0 + cl + 4 * (k - 196 * cl); }, Kimg, Vimg, lane, wave);
        const int r = t == 0 ? ra : rb, cl = r & 1, kb = cl * 196 + (r >> 2);
        const bool needm = (q0 - 256 < 0) || (q0 + 15 + 4 * 127 > SEQ - 1);
        const LdsBases Bc = lds_bases(Kimg, Vimg, kb + q, kb + 4 * g + qq, lane);
        __syncthreads();
#pragma unroll 2
        for (int ks = 0; ks < 6; ++ks) {
            Bias bs; bs.b0 = *(const f32x4*)(tbl + (to1 + (unsigned)(ks * 32))); bs.b1 = *(const f32x4*)(tbl + (to1 + (unsigned)(ks * 32 + 16)));
            const int u0 = ks * 32;
            const int pk = q0 + r + 4 * (u0 - 64 + 4 * g);
            auto mk = [=](f32x4& t0, f32x4& t1) { if (needm) {
#pragma unroll
                for (int x = 0; x < 4; ++x) { if ((unsigned)(pk + 4 * x) >= (unsigned)SEQ) t0[x] = NEG; if ((unsigned)(pk + 4 * (16 + x)) >= (unsigned)SEQ) t1[x] = NEG; } } };
            if (t == 0) lds_step(sa, qa, Bc, ks * 4096, bs, mk);
            else        lds_step(sb, qbf, Bc, ks * 4096, bs, mk);
        }
        __syncthreads();
    }
    lane = hw_lane();
    {
    const int q = lane & 15, g = lane >> 4, qq = q >> 2;
    LAS char* wbuf = lds + wave * 16384;
    const char* kbase = (const char*)(pb_ + PC_KC + h * 64); const char* vbase = (const char*)(pb_ + PC_VC + h * 64);
    const int kl = lane >> 3, c = lane & 7;
    const unsigned to0 = (unsigned)(T5TB_F + (h * 4 + (q & 3)) * TBW + TBOFF + 4 * g - (q & ~3));
    struct RowStage { u32x4 k[4], v[4]; };
#pragma unroll 1
    for (int t = 0; t < (VAR == 1 ? 0 : 2); ++t) {
        const int qr = q0 + (t == 0 ? ra : rb);
        auto issue = [&](int ks, RowStage& s, Bias& bsn) {
            const int pbase = qr + 16 * (ks * 32 - 64);
#pragma unroll
            for (int i = 0; i < 4; ++i) { int pos = pbase + 16 * (8 * i + kl); pos = pos < 0 ? 0 : (pos > SEQ - 1 ? SEQ - 1 : pos);
                const unsigned off = (unsigned)pos * (unsigned)(PLD * 2) + (unsigned)c * 16u;
                s.k[i] = *(const u32x4*)(kbase + off); s.v[i] = *(const u32x4*)(vbase + off); }
            bsn.b0 = *(const f32x4*)(tbl + (to0 + (unsigned)(ks * 32))); bsn.b1 = *(const f32x4*)(tbl + (to0 + (unsigned)(ks * 32 + 16)));
        };
        auto compute = [&](int ks, const RowStage& s, const Bias& bsn, State& st, const QF& qf) {
            LAS char* Kw = wbuf + (ks & 1) * 8192; LAS char* Vw = Kw + 4096;
#pragma unroll
            for (int i = 0; i < 4; ++i) { const int key = 8 * i + kl;
                *(LAS u32x4*)(Kw + key * 128 + ((c ^ fK(key)) * 16)) = s.k[i]; *(LAS u32x4*)(Vw + key * 128 + ((c ^ fV(key)) * 16)) = s.v[i]; }
            const LdsBases Bw = lds_bases(Kw, Vw, q, 4 * g + qq, lane);
            const int pbase = qr + 16 * (ks * 32 - 64); const bool needm = pbase < 0 || pbase + 31 * 16 > SEQ - 1; const int pk = pbase + 64 * g;
            lds_step(st, qf, Bw, 0, bsn, [=](f32x4& t0, f32x4& t1) { if (needm) {
#pragma unroll
                for (int x = 0; x < 4; ++x) { if ((unsigned)(pk + 16 * x) >= (unsigned)SEQ) t0[x] = NEG; if ((unsigned)(pk + 16 * (16 + x)) >= (unsigned)SEQ) t1[x] = NEG; } } });
        };
        RowStage A, B; Bias X, Y;
        issue(0, A, X); issue(1, B, Y);
        compute(0, A, X, sa, qa); issue(2, A, X); compute(1, B, Y, sa, qa); issue(3, B, Y); compute(2, A, X, sa, qa); issue(4, A, X); compute(3, B, Y, sa, qa); compute(4, A, X, sa, qa);
        { const State ts = sa; sa = sb; sb = ts; const QF tq = qa; qa = qbf; qbf = tq; }
    }
    }
    asm volatile("" : "+v"(lane));
    { const int q = lane & 15;
    finish(sa, dry ? dry + (((size_t)bt * 16 + ra) * 16 + q) * 64 : pb_ + (size_t)(q0 + ra + 16 * q) * PLD + PC_QC + h * 64, pb_ + (size_t)(q0 + ra + 16 * q) * PLD + PC_ZC + h * 64, lane);
    finish(sb, dry ? dry + (((size_t)bt * 16 + rb) * 16 + q) * 64 : pb_ + (size_t)(q0 + rb + 16 * q) * PLD + PC_QC + h * 64, pb_ + (size_t)(q0 + rb + 16 * q) * PLD + PC_ZC + h * 64, lane); }
    __syncthreads();
}
#undef LAS
}
constexpr int NWAVES = 8;
#define GAS __attribute__((address_space(1)))
#define LAS __attribute__((address_space(3)))
typedef unsigned v4u __attribute__((ext_vector_type(4)));
typedef float f32x4 __attribute__((ext_vector_type(4)));
typedef GAS unsigned gu32;
#define RLX_AGENT __ATOMIC_RELAXED, __HIP_MEMORY_SCOPE_AGENT

constexpr size_t SZ_WINT = (size_t)IN_COLS * DM * 2, SZ_WOUTT = (size_t)DM * MIXW * 2, SZ_GLUT = 512 * 512 * 2, SZ_TM = (size_t)32 * 256 * 512 * 2, SZ_MS = (size_t)32 * 256 * 256 * 2;
constexpr size_t OFF_WOUTT0 = OFF_W, OFF_WOUTT1 = OFF_WOUTT0 + SZ_WOUTT, OFF_WINT1 = OFF_WOUTT1 + SZ_WOUTT, OFF_GLUT1 = OFF_WINT1 + SZ_WINT, OFF_TM1 = OFF_GLUT1 + SZ_GLUT, OFF_MS1 = OFF_TM1 + SZ_TM;
constexpr size_t WS_NEED = OFF_MS1 + SZ_MS;
constexpr size_t DO_WINT0 = 0, DO_GLUT0 = DO_WINT0 + SZ_WINT, DO_TM0 = DO_GLUT0 + SZ_GLUT, DO_MS0 = DO_TM0 + SZ_TM;
static_assert(DO_MS0 + SZ_MS <= (size_t)NTOK * DM * 4, "layer-0 tables fit in d_out");
static_assert(WS_NEED <= (size_t)256 * 1024 * 1024, "workspace map fits 256 MiB");
constexpr size_t CTL_ZERO_BYTES = 262144;
constexpr int CW_BAR = 1024;
constexpr int CW_WORK = 256;
constexpr int CW_YDONE = 512;
constexpr size_t OFF_T5TB = 524288;
constexpr size_t OFF_RPBS = OFF_T5TB + (size_t)(att::T5TB_F + att::T5S_F) * 4;
static_assert(OFF_RPBS + (size_t)att::RPBS_F * 4 <= OFF_SS, "small tables fit in the control MiB");

constexpr int RING_BYTES = 131072;
constexpr int MISC_OFF = RING_BYTES;
constexpr int LDS_BYTES = 147456;
static_assert(NWAVES * att::WAVE_LDS <= RING_BYTES && 2 * att::NA_IMG <= RING_BYTES && 2 * att::DIL_IMG <= RING_BYTES, "attention LDS");

#define XB_TMO      128
#define XB_XCNT(j)  (256  + 64 * (j))
#define XB_XSUB(j)  (1280 + 64 * (j))
#define XB_XGEN(j)  (2304 + 64 * (j))
#define XB_TOP      3328
#define XB_TOPGEN   3392
#define XCD_BAR_WORDS 3456
#define XB_SPIN_CAP (1u << 18)
__device__ __forceinline__ unsigned xb_ld(unsigned* p)              { return __hip_atomic_load(p, __ATOMIC_RELAXED, __HIP_MEMORY_SCOPE_AGENT); }
__device__ __forceinline__ unsigned xb_add(unsigned* p, unsigned v) { return __hip_atomic_fetch_add(p, v, __ATOMIC_RELAXED, __HIP_MEMORY_SCOPE_AGENT); }
__device__ __forceinline__ unsigned xb_xcc_id() { return (unsigned)__builtin_amdgcn_s_getreg((3 << 11) | 20) & 0xFu; }
#define XB_SPIN(cond, bar) do { unsigned _sp = 0; while (cond) { __builtin_amdgcn_s_sleep(1); \
    if ((++_sp & 255u) == 0u) { if (xb_ld(&(bar)[XB_TMO])) break; if (_sp > XB_SPIN_CAP) { atomicAdd(&(bar)[XB_TMO], 1u); break; } } } } while (0)
struct XcdBarrier { unsigned* bar; unsigned x; volatile LAS unsigned* st; };
__device__ __forceinline__ XcdBarrier xcd_barrier_post(unsigned* bar, volatile LAS unsigned* st, int wave_s) {
    XcdBarrier b; b.bar = bar; b.x = xb_xcc_id(); b.st = st;
    if (wave_s == 0 && hw_lane() == 0) (void)xb_add(&bar[XB_XCNT(b.x)], 1u);
    return b;
}
__device__ __forceinline__ void xcd_barrier_complete(unsigned* bar, unsigned x, unsigned& nloc, unsigned& nx) {
    const unsigned G = gridDim.x * gridDim.y * gridDim.z;
    unsigned sum, cnt, mine, sp = 0u;
    for (;;) {
        sum = 0u; cnt = 0u; mine = 0u;
#pragma unroll
        for (unsigned j = 0; j < 16; ++j) { const unsigned c = xb_ld(&bar[XB_XCNT(j)]); sum += c; cnt += (c > 0u) ? 1u : 0u; mine = (j == x) ? c : mine; }
        if (sum == G) break;
        __builtin_amdgcn_s_sleep(1);
        if ((++sp & 255u) == 0u) { if (xb_ld(&bar[XB_TMO])) break; if (sp > XB_SPIN_CAP) { atomicAdd(&bar[XB_TMO], 1u); break; } }
    }
    nloc = mine > 0u ? mine : 1u; nx = cnt > 0u ? cnt : 1u;
}
__device__ __forceinline__ void xcd_barrier(const XcdBarrier& b, int wave_s) {
    asm volatile("s_waitcnt vmcnt(0)" ::: "memory");
    __syncthreads();
    if (wave_s == 0 && hw_lane() == 0) {
        unsigned* bar = b.bar;
        __builtin_amdgcn_s_waitcnt(0);
        unsigned nloc = b.st[0], nx = b.st[1];
        if (nloc == 0u) { xcd_barrier_complete(bar, b.x, nloc, nx); b.st[0] = nloc; b.st[1] = nx; }
        const unsigned old = xb_add(&bar[XB_XSUB(b.x)], 1u);
        const unsigned gen = old / nloc;
        if (old + 1u == (gen + 1u) * nloc) {
            __builtin_amdgcn_fence(__ATOMIC_RELEASE, "agent");
            asm volatile("s_waitcnt vmcnt(0)" ::: "memory");
            const unsigned og = xb_add(&bar[XB_TOP], 1u);
            const unsigned tg = og / nx;
            if (og + 1u == (tg + 1u) * nx) xb_add(&bar[XB_TOPGEN], 1u);
            else XB_SPIN(xb_ld(&bar[XB_TOPGEN]) == tg, bar);
            __builtin_amdgcn_fence(__ATOMIC_ACQUIRE, "agent");
            xb_add(&bar[XB_XGEN(b.x)], 1u);
            asm volatile("s_waitcnt vmcnt(0)" ::: "memory");
        } else {
            XB_SPIN(xb_ld(&bar[XB_XGEN(b.x)]) == gen, bar);
            __builtin_amdgcn_fence(__ATOMIC_ACQUIRE, "agent");
            asm volatile("s_waitcnt vmcnt(0)" ::: "memory");
        }
    }
    __syncthreads();
}

struct Args { const float* in[17]; float* out; unsigned char* ws; int ph_lo, ph_hi; int li, skip; };

__device__ __forceinline__ float wave_sum(float v) {
#pragma unroll
    for (int o = 1; o < 64; o <<= 1) v += __shfl_xor(v, o);
    return v;
}
__device__ __forceinline__ unsigned pk2(float lo, float hi) { return f2bf(lo) | (f2bf(hi) << 16); }

__device__ __forceinline__ void p0_transpose_item(const float* W, int K, int Nsrc, bf16_t* WT, int k0, int n0s, int n0d, const float* kscale, LAS float* scr, int lane) {
    float tv[32];
#pragma unroll
    for (int i = 0; i < 32; ++i) { const int kk = 2 * i + (lane >> 5); tv[i] = W[(size_t)(k0 + kk) * Nsrc + n0s + (lane & 31)]; }
    const float ksc = kscale ? kscale[k0 + lane] : 1.f;
#pragma unroll
    for (int i = 0; i < 32; ++i) { const int kk = 2 * i + (lane >> 5); scr[kk * 33 + (lane & 31)] = tv[i] * __shfl(ksc, kk); }
    asm volatile("s_waitcnt lgkmcnt(0)" ::: "memory");
    const int c = lane & 7;
#pragma unroll
    for (int j = 0; j < 4; ++j) { const int n = (lane >> 3) + 8 * j; const LAS float* s = scr + (8 * c) * 33 + n;
        v4u o; o.x = pk2(s[0 * 33], s[1 * 33]); o.y = pk2(s[2 * 33], s[3 * 33]); o.z = pk2(s[4 * 33], s[5 * 33]); o.w = pk2(s[6 * 33], s[7 * 33]);
        *(v4u*)(WT + (size_t)(n0d + n) * K + k0 + 8 * c) = o; }
    asm volatile("s_waitcnt lgkmcnt(0)" ::: "memory");
}
__device__ __forceinline__ void p0_xrow(const float* xrow, bf16_t* orow, float* ssrow, int lane) {
    const f32x4* xr = (const f32x4*)xrow + lane;
    f32x4 v[4]; float s = 0.f;
#pragma unroll
    for (int j = 0; j < 4; ++j) { v[j] = xr[64 * j]; s += (v[j].x * v[j].x + v[j].y * v[j].y) + (v[j].z * v[j].z + v[j].w * v[j].w); }
    s = wave_sum(s);
    unsigned long long* o8 = (unsigned long long*)orow + lane;
#pragma unroll
    for (int j = 0; j < 4; ++j) o8[64 * j] = (unsigned long long)pk2(v[j].x, v[j].y) | ((unsigned long long)pk2(v[j].z, v[j].w) << 32);
    if (lane < 16) ssrow[lane] = lane == 0 ? s : 0.f;
}
__device__ __forceinline__ int t5_bucket_dev(int rel) {
    const int n = rel < 0 ? -rel : rel;
    const int large = 8 + (n >= 15) + (n >= 27) + (n >= 50) + (n >= 91) + (n >= 166) + (n >= 305) + (n >= 559);
    return (rel > 0 ? 16 : 0) + (n < 8 ? n : large);
}
__device__ __forceinline__ void p0_ssm_tables(const Args& a, int l, int g, int d, bf16_t* TM, bf16_t* Ms, LAS float* scr, int wave_s) {
    int tid = wave_s * 64 + hw_lane(); asm volatile("" : "+v"(tid));
    LAS float* pw = scr;
    LAS float* fc = pw + 64 * 17 * 2;
    LAS float* Cc = fc + 2 * 64 * 2;
    LAS float* Bb = Cc + 2048;
    LAS float* C2 = Bb + 2048;
    LAS float* B2 = C2 + 2048;
    LAS float* Kt = B2 + 2048;
    const float* lam_re = a.in[4]; const float* lam_im = a.in[5]; const float* log_dt = a.in[6];
    const float* b_re = a.in[7]; const float* b_im = a.in[8]; const float* c_re = a.in[9]; const float* c_im = a.in[10]; const float* dskip = a.in[11];
    const int pg = (l * 2 + d) * 32 + g, pg2 = (l * 2 + (1 - d)) * 32 + g;
    if (tid < 128) {
        const int o = tid >> 6, p = tid & 63, pgx = o == 0 ? pg : pg2;
        const float lre = lam_re[pgx * 64 + p], lim = lam_im[pgx * 64 + p], dt = expf(log_dt[pgx]);
        const float er = expf(lre * dt), lbr = er * cosf(lim * dt), lbi = er * sinf(lim * dt);
        const float nr = lbr - 1.f, ni = lbi, den = lre * lre + lim * lim;
        fc[(o * 64 + p) * 2] = (nr * lre + ni * lim) / den; fc[(o * 64 + p) * 2 + 1] = (ni * lre - nr * lim) / den;
        if (o == 0) { float wr = 1.f, wi = 0.f;
            for (int k = 0; k <= 16; ++k) { pw[(p * 17 + k) * 2] = wr; pw[(p * 17 + k) * 2 + 1] = wi; const float t = wr * lbr - wi * lbi; wi = wr * lbi + wi * lbr; wr = t; } }
    }
    __syncthreads();
    for (int i = tid; i < 1024; i += NWAVES * 64) {
        Cc[i * 2] = c_re[(size_t)pg * 1024 + i]; Cc[i * 2 + 1] = c_im[(size_t)pg * 1024 + i];
        { const int p = i >> 4; const float br = b_re[(size_t)pg * 1024 + i], bi = b_im[(size_t)pg * 1024 + i], fr = fc[p * 2], fi = fc[p * 2 + 1];
          Bb[i * 2] = fr * br - fi * bi; Bb[i * 2 + 1] = fr * bi + fi * br; }
        if (d == 0) {
            C2[i * 2] = c_re[(size_t)pg2 * 1024 + i]; C2[i * 2 + 1] = c_im[(size_t)pg2 * 1024 + i];
            const int p = i >> 4; const float br = b_re[(size_t)pg2 * 1024 + i], bi = b_im[(size_t)pg2 * 1024 + i], fr = fc[(64 + p) * 2], fi = fc[(64 + p) * 2 + 1];
            B2[i * 2] = fr * br - fi * bi; B2[i * 2 + 1] = fr * bi + fi * br; }
    }
    __syncthreads();
    {
        const int kh = tid >> 8, c = (tid >> 4) & 15, cp = tid & 15;
        float Kk[8];
#pragma unroll
        for (int k = 0; k < 8; ++k) Kk[k] = 0.f;
        float k0o = 0.f;
#pragma unroll 2
        for (int p = 0; p < 64; ++p) {
            const float Cr = Cc[(c * 64 + p) * 2], Ci = Cc[(c * 64 + p) * 2 + 1], br = Bb[(p * 16 + cp) * 2], bi = Bb[(p * 16 + cp) * 2 + 1];
            const LAS float* pwp = pw + (p * 17 + kh * 8) * 2;
#pragma unroll
            for (int k = 0; k < 8; ++k) { const float pr = pwp[2 * k], pi = pwp[2 * k + 1]; const float wr = Cr * pr - Ci * pi, wi = Cr * pi + Ci * pr; Kk[k] += wr * br - wi * bi; }
            if (d == 0 && kh == 0) k0o += C2[(c * 64 + p) * 2] * B2[(p * 16 + cp) * 2] - C2[(c * 64 + p) * 2 + 1] * B2[(p * 16 + cp) * 2 + 1];
        }
#pragma unroll
        for (int k = 0; k < 8; ++k) Kt[(kh * 8 + k) * 256 + c * 16 + cp] = Kk[k];
        if (d == 0 && kh == 0) Kt[16 * 256 + c * 16 + cp] = k0o;
    }
    __syncthreads();
    for (int idx = tid; idx < 256 * 128; idx += NWAVES * 64) {
        const int row = idx >> 7, col = (idx & 127) * 2, t = row >> 4, cc = row & 15, s_ = col >> 4, c2 = col & 15;
        const int k = d == 0 ? t - s_ : s_ - t;
        if (k < 0 || (d == 1 && k == 0)) continue;
        float v0 = Kt[k * 256 + cc * 16 + c2], v1 = Kt[k * 256 + cc * 16 + c2 + 1];
        if (k == 0) { v0 += Kt[16 * 256 + cc * 16 + c2]; v1 += Kt[16 * 256 + cc * 16 + c2 + 1];
            const float dd = dskip[l * 512 + g * 16 + cc]; if (c2 == cc) v0 += dd; if (c2 + 1 == cc) v1 += dd; }
        *(unsigned*)(TM + (size_t)row * 512 + col) = pk2(v0, v1);
    }
    {
        const int p = tid & 63, cq = tid >> 6;
#pragma unroll
        for (int h2 = 0; h2 < 2; ++h2) { const int c = cq + 8 * h2; const float Cr = Cc[(c * 64 + p) * 2], Ci = Cc[(c * 64 + p) * 2 + 1];
#pragma unroll 4
            for (int e = 1; e <= 16; ++e) { const float pr = pw[(p * 17 + e) * 2], pi = pw[(p * 17 + e) * 2 + 1]; const float wr = Cr * pr - Ci * pi, wi = Cr * pi + Ci * pr;
                const int t = d == 0 ? e - 1 : 16 - e; bf16_t* rowp = TM + (size_t)(t * 16 + c) * 512 + 256 + d * 128 + p;
                rowp[0] = (bf16_t)f2bf(wr); rowp[64] = (bf16_t)f2bf(-wi); } }
    }
    {
        const int sc = tid & 255, e = sc >> 4, cp = sc & 15, ph = tid >> 8, s_ = d == 0 ? 15 - e : e;
#pragma unroll 4
        for (int it = 0; it < 32; ++it) { const int p = ph + 2 * it; const float pr = pw[(p * 17 + e) * 2], pi = pw[(p * 17 + e) * 2 + 1], br = Bb[(p * 16 + cp) * 2], bi = Bb[(p * 16 + cp) * 2 + 1];
            Ms[(size_t)(d * 128 + p) * 256 + s_ * 16 + cp] = (bf16_t)f2bf(pr * br - pi * bi); Ms[(size_t)(d * 128 + 64 + p) * 256 + s_ * 16 + cp] = (bf16_t)f2bf(pr * bi + pi * br); }
    }
    __syncthreads();
}

constexpr int N_PHASES = 8;
__global__ void __launch_bounds__(NWAVES * 64, 2) mega_fwd(Args args) {
    extern __shared__ __attribute__((aligned(16))) unsigned char lds_raw[];
    LAS unsigned char* lds = (LAS unsigned char*)lds_raw;
    volatile LAS unsigned* MISC = (volatile LAS unsigned*)(lds + MISC_OFF);
    const int wave_s = __builtin_amdgcn_readfirstlane((int)threadIdx.x >> 6);
#define PHASE_LANES int lane = hw_lane(); asm volatile("" : "+v"(lane)); const int wave = wave_s; const int ptid = wave * 64 + lane; (void)ptid;
    const int G = gridDim.x; int vcu; { const int bx = blockIdx.x; vcu = (G % 8 == 0) ? (bx % 8) * (G / 8) + bx / 8 : bx; }
    unsigned char* ws = args.ws; unsigned char* dout = (unsigned char*)args.out;
    unsigned* ctl = (unsigned*)(ws + OFF_CTL);
    if (wave_s == 0) { const int l0 = hw_lane(); if (l0 < 32) MISC[l0] = 0u; }
    __syncthreads();
    XcdBarrier bar = xcd_barrier_post(ctl + CW_BAR + args.li * XCD_BAR_WORDS, MISC + 8, wave_s);
    const int lo = args.ph_lo, hi = args.ph_hi;
#ifndef REP_P0
#define REP_P0 1
#endif
#ifndef REP_INPROJ
#define REP_INPROJ 1
#endif
#ifndef REP_EG
#define REP_EG 1
#endif
#ifndef DRY_NA
#define DRY_NA 0
#endif
#ifndef DRY_DIL
#define DRY_DIL 0
#endif
#ifndef REP_SCAN
#define REP_SCAN 1
#endif
#ifndef REP_Y
#define REP_Y 1
#endif
#ifndef DRYVAR
#define DRYVAR 0
#endif
#ifndef CT_SKIP
#define CT_SKIP 0
#endif
#ifndef PHASE_MASK
#define PHASE_MASK 0xff
#endif
#define INR(k) (lo <= (k) && (k) < hi)
#define IN(k) (((PHASE_MASK >> ((k) == 7 ? 4 : (k))) & 1) && INR(k))
#define INL(j) (((PHASE_MASK >> ((j) + 1)) & 1) && INR(pb + (j)))
#define SEAM(k) do { if (INR(k) && INR((k) + 1)) xcd_barrier(bar, wave_s); } while (0)

    bf16_t* proj = (bf16_t*)(ws + OFF_PROJ); bf16_t* xag = (bf16_t*)(ws + OFF_XAG); bf16_t* xb = (bf16_t*)(ws + OFF_XB); float* Ebuf = (float*)(ws + OFF_XB);
    bf16_t* Gb = (bf16_t*)(ws + OFF_G); float* sspart = (float*)(ws + OFF_SS);
    float* rpbs = (float*)(ws + OFF_RPBS); float* t5tb = (float*)(ws + OFF_T5TB);
    const int dry = (args.skip >> 8) & 1; bf16_t* dryp = dry ? Gb : nullptr;

    if (IN(0)) for (int rep_ = 0; rep_ < REP_P0; ++rep_) {
        PHASE_LANES
        const int NTB = 128;
        for (int ti = vcu; ti < NTB; ti += G) {
            const int l = ti >> 6, g = (ti >> 1) & 31, d = ti & 1;
            bf16_t* TM = (bf16_t*)(l == 0 ? dout + DO_TM0 : ws + OFF_TM1) + (size_t)g * 256 * 512;
            bf16_t* Ms = (bf16_t*)(l == 0 ? dout + DO_MS0 : ws + OFF_MS1) + (size_t)g * 256 * 256;
            p0_ssm_tables(args, l, g, d, TM, Ms, (LAS float*)lds, wave_s);
        }
        {
            const float* rpb = args.in[14]; const float* t5 = args.in[15];
            for (int i = vcu * NWAVES * 64 + ptid; i < att::RPBS_F; i += G * NWAVES * 64) {
                const int ii = i & 63, rr = (i >> 6) % 15, h = (i / (64 * 15)) & 7, c = (i / (64 * 15 * 8)) & 3, l = i / (64 * 15 * 8 * 4); const int cr = ii + c - 17;
                rpbs[i] = (ii + c < 64 && cr >= 0 && cr <= 30) ? rpb[(((size_t)l * 8 + h) * 15 + rr) * 31 + cr] * 1.4426950408889634f : 0.f; }
            for (int i = vcu * NWAVES * 64 + ptid; i < att::T5TB_F + att::T5S_F; i += G * NWAVES * 64) {
                int h, pat, idx;
                if (i < att::T5TB_F) { idx = i % att::TBW; pat = (i / att::TBW) % 3; h = i / (3 * att::TBW); }
                else { const int i2 = i - att::T5TB_F; const int c = (i2 / att::TBW) & 3; h = i2 / (4 * att::TBW); pat = 0; idx = i2 % att::TBW - c; }
                const int w = idx - att::TBOFF; const int d = pat == 0 ? 16 : (pat == 1 ? 4 : 1);
                t5tb[i] = (idx >= 0 && w >= 0 && w <= 128) ? t5[t5_bucket_dev(d * (w - 64)) * 8 + h] * 1.4426950408889634f : att::NEG; }
        }
        {
            LAS float* scr = (LAS float*)(lds + wave * 16384);
            constexpr int I_IN = (DM / 64) * (IN_COLS / 32), I_OUT = (MIXW / 64) * (DM / 32), I_GLU = (512 / 64) * (512 / 32), I_L = I_IN + I_OUT + I_GLU, I_TOT = 2 * I_L + NTOK;
            const int NW_ALL = G * NWAVES, gw = vcu * NWAVES + wave; const bool tblk = vcu < NTB && G > NTB;
            const int NW2 = tblk ? 0 : (G - NTB) * NWAVES, gw2 = (vcu - NTB) * NWAVES + wave;
            const int P1N = G > NTB ? 9 : (I_TOT + NW_ALL - 1) / NW_ALL, I_P1 = P1N * NW_ALL < I_TOT ? P1N * NW_ALL : I_TOT;
            for (int pass = 0; pass < 2; ++pass) {
                const int i0 = pass == 0 ? gw : I_P1 + gw2, i1 = pass == 0 ? I_P1 : I_TOT, st = pass == 0 ? NW_ALL : NW2;
                if (pass == 1 && NW2 == 0) break;
                for (int it = i0; it < i1; it += st) {
                    if (it >= 2 * I_L) { const int mrow = it - 2 * I_L; p0_xrow(args.in[0] + (size_t)mrow * DM, xb + (size_t)mrow * DM, sspart + (size_t)mrow * 16, lane); continue; }
                    const int l = it / I_L; int r = it % I_L;
                    if (r < I_IN) { const int nblk = IN_COLS / 32, kb = r / nblk, nb = r % nblk;
                        p0_transpose_item(args.in[2] + (size_t)l * DM * IN_COLS, DM, IN_COLS, (bf16_t*)(l == 0 ? dout + DO_WINT0 : ws + OFF_WINT1), 64 * kb, inproj_src_col(32 * nb), 32 * nb, args.in[1] + l * DM, scr, lane); continue; }
                    r -= I_IN;
                    if (r < I_OUT) { const int nblk = DM / 32, kb = r / nblk, nb = r % nblk;
                        p0_transpose_item(args.in[3] + (size_t)l * MIXW * DM, MIXW, DM, (bf16_t*)(ws + (l == 0 ? OFF_WOUTT0 : OFF_WOUTT1)), 64 * kb, 32 * nb, 32 * nb, nullptr, scr, lane); continue; }
                    r -= I_OUT;
                    { const int nblk = 512 / 32, kb = r / nblk, nb = r % nblk;
                        p0_transpose_item(args.in[12] + (size_t)l * 512 * 512, 512, 512, (bf16_t*)(l == 0 ? dout + DO_GLUT0 : ws + OFF_GLUT1), 64 * kb, 32 * nb, 32 * nb, nullptr, scr, lane); }
                }
            }
        }
    }
    SEAM(0);

    for (int l = 0; l < DEPTH; ++l) {
        const int pb = 1 + 3 * l;
        const bf16_t* WinT = (const bf16_t*)(l == 0 ? dout + DO_WINT0 : ws + OFF_WINT1);
        const bf16_t* WoutT = (const bf16_t*)(ws + (l == 0 ? OFF_WOUTT0 : OFF_WOUTT1));
        const bf16_t* GluT = (const bf16_t*)(l == 0 ? dout + DO_GLUT0 : ws + OFF_GLUT1);
        const bf16_t* TM = (const bf16_t*)(l == 0 ? dout + DO_TM0 : ws + OFF_TM1);
        const bf16_t* Ms = (const bf16_t*)(l == 0 ? dout + DO_MS0 : ws + OFF_MS1);
        if (INL(0)) for (int rep_ = 0; rep_ < REP_INPROJ; ++rep_) {
            pg8::Gemm gm{xb, WinT, DM, DM, DM, 0, 0}; pg8::StaticOrder S; S.init(NTOK, IN_COLS, G, (int)blockIdx.x);
            pg8::EpiInProj E{sspart, proj, xag};
            pg8::gemm_phase<pg8::EpiInProj, pg8::StaticOrder>(lds, gm, S, E, wave_s);
        }
        SEAM(pb + 0);
        if (INL(1)) {
            constexpr int NCHAIN = 128;
            if (!(args.skip & 1)) for (int cid = vcu; cid < NCHAIN; cid += G) {
                const int g = cid >> 2, b = cid & 3;
                { pg8::Gemm gm{xag, Ms, 512, 256, 256, (size_t)NCHUNK_TOT * 512, (size_t)256 * 256}; pg8::OneUnit S; S.u = pg8::Unit{b, 0, g};
                  pg8::EpiE E{Ebuf};
                  pg8::gemm_phase<pg8::EpiE, pg8::OneUnit>(lds, gm, S, E, wave_s); }
                asm volatile("s_waitcnt vmcnt(0)" ::: "memory"); __syncthreads();
                {
                    PHASE_LANES
                    const float* lam_re = args.in[4]; const float* lam_im = args.in[5]; const float* log_dt = args.in[6];
                    LAS float* sx = (LAS float*)lds;
#pragma unroll 1
                    for (int d = 0; d < 2; ++d) {
                        const int p = lane, pg = (l * 2 + d) * 32 + g;
                        const float lre = lam_re[pg * 64 + p], lim = lam_im[pg * 64 + p], dt = expf(log_dt[pg]);
                        const float er = expf(lre * dt); float ar = er * cosf(lim * dt), ai = er * sinf(lim * dt);
#pragma unroll
                        for (int i = 0; i < 4; ++i) { const float t = ar * ar - ai * ai; ai = 2.f * ar * ai; ar = t; }
                        const float* Ep = Ebuf + ((size_t)g * NCHUNK_TOT + b * NCHUNK) * 256 + d * 128 + p;
                        bf16_t* Cp = xag + ((size_t)g * NCHUNK_TOT + b * NCHUNK) * 512 + 256 + d * 128 + p;
                        float er_[32], ei_[32];
#pragma unroll
                        for (int i = 0; i < 32; ++i) { const int s = wave * 32 + i, k = d == 0 ? s : NCHUNK - 1 - s; er_[i] = Ep[(size_t)k * 256]; ei_[i] = Ep[(size_t)k * 256 + 64]; }
                        float cr = 0.f, ci = 0.f;
#pragma unroll
                        for (int i = 0; i < 32; ++i) { const float xr = er_[i], xi = ei_[i]; er_[i] = cr; ei_[i] = ci; const float t = ar * cr - ai * ci + xr; ci = ar * ci + ai * cr + xi; cr = t; }
                        sx[(wave * 64 + lane) * 2] = cr; sx[(wave * 64 + lane) * 2 + 1] = ci;
                        float a32r = ar, a32i = ai;
#pragma unroll
                        for (int i = 0; i < 5; ++i) { const float t = a32r * a32r - a32i * a32i; a32i = 2.f * a32r * a32i; a32r = t; }
                        __syncthreads();
                        float inr = 0.f, ini = 0.f;
                        for (int j = 0; j < wave; ++j) { const float tr = sx[(j * 64 + lane) * 2], ti = sx[(j * 64 + lane) * 2 + 1]; const float t = a32r * inr - a32i * ini + tr; ini = a32r * ini + a32i * inr + ti; inr = t; }
                        float pr = inr, pi = ini;
#pragma unroll
                        for (int i = 0; i < 32; ++i) { const int s = wave * 32 + i, k = d == 0 ? s : NCHUNK - 1 - s;
                            Cp[(size_t)k * 512] = (bf16_t)f2bf(er_[i] + pr); Cp[(size_t)k * 512 + 64] = (bf16_t)f2bf(ei_[i] + pi);
                            const float t = ar * pr - ai * pi; pi = ar * pi + ai * pr; pr = t; }
                        __syncthreads();
                    }
                }
                asm volatile("s_waitcnt vmcnt(0)" ::: "memory"); __syncthreads();
                { pg8::Gemm gm{xag, TM, 512, 512, 512, (size_t)NCHUNK_TOT * 512, (size_t)256 * 512}; pg8::OneUnit S; S.u = pg8::Unit{b, 0, g};
                  pg8::EpiY E{Gb};
                  pg8::gemm_phase<pg8::EpiY, pg8::OneUnit>(lds, gm, S, E, wave_s); }
                asm volatile("s_waitcnt vmcnt(0)" ::: "memory"); __syncthreads();
                if (wave_s == 0 && hw_lane() == 0) {
                    __builtin_amdgcn_fence(__ATOMIC_RELEASE, "agent"); asm volatile("s_waitcnt vmcnt(0)" ::: "memory");
                    __hip_atomic_fetch_add(ctl + CW_YDONE + (l * 4 + b) * 64, 1u, __ATOMIC_RELAXED, __HIP_MEMORY_SCOPE_AGENT);
                }
            }
            {
                const float* rp = rpbs + (size_t)l * 4 * 8 * 15 * 64;
                int nNA, naB, naS, nDI, diB, diS, nGL, glB, glS;
                if (G == 2 * NCHAIN) {
                    const int x = (vcu & (NCHAIN - 1)) >> 5, j = vcu & 31;
                    if (vcu < NCHAIN) { nNA = 7; naB = x * 224 + j; naS = 32; nDI = 1; diB = x * 32 + j; diS = 32; nGL = 0; glB = 0; glS = 1; }
                    else { nNA = 1; naB = 896 + x * 32 + j; naS = 32; nDI = 3; diB = NCHAIN + x * 96 + j; diS = 32; nGL = 1; glB = vcu - NCHAIN; glS = 1; }
                } else { nNA = (1024 - vcu + G - 1) / G; naB = vcu; naS = G; nDI = (512 - vcu + G - 1) / G; diB = vcu; diS = G; nGL = (128 - vcu + G - 1) / G; glB = vcu; glS = G; }
#pragma unroll 1
                for (int i = 0; i < ((args.skip & 2) ? 0 : nNA); ++i) att::na_block_task(proj, rp, naB + i * naS, (LAS char*)lds, wave_s, dryp);
#ifdef DILVAR
                if (dry) { for (int i = 0; i < ((args.skip & 4) ? 0 : nDI); ++i) att::dil_block_task<DILVAR>(proj, t5tb, diB + i * diS, (LAS char*)lds, wave_s, dryp); } else
#endif
#pragma unroll 1
                for (int i = 0; i < ((args.skip & 4) ? 0 : nDI); ++i) att::dil_block_task(proj, t5tb, diB + i * diS, (LAS char*)lds, wave_s, dryp);
#pragma unroll 1
                for (int i = 0; i < ((args.skip & 8) ? 0 : nGL); ++i) {
                    const int u = glB + i * glS, bq = u >> 5;
                    if (wave_s == 0) {
                        unsigned* cw = ctl + CW_YDONE + (l * 4 + bq) * 64; unsigned sp = 0;
                        while (__builtin_amdgcn_readfirstlane(__hip_atomic_load(cw, __ATOMIC_RELAXED, __HIP_MEMORY_SCOPE_AGENT)) < 32u) { __builtin_amdgcn_s_sleep(2); if (++sp > (1u << 22)) break; }
                        __builtin_amdgcn_fence(__ATOMIC_ACQUIRE, "agent"); asm volatile("s_waitcnt vmcnt(0)" ::: "memory");
                    }
                    __syncthreads();
                    pg8::Gemm gm{Gb, GluT, 512, 512, 512, 0, 0}; pg8::OneUnit S; S.u = pg8::Unit{u >> 1, u & 1, 0};
                    pg8::EpiGlu E{Gb, args.in[13] + l * 512, proj, dry};
                    pg8::gemm_phase<pg8::EpiGlu, pg8::OneUnit>(lds, gm, S, E, wave_s);
                    __syncthreads();
                }
            }
        }
        SEAM(pb + 1);
        if (INL(2)) {
            pg8::Gemm gm{proj, WoutT, PLD, MIXW, MIXW, 0, 0}; pg8::StaticOrder S; S.init(NTOK, DM, G, (int)blockIdx.x);
            pg8::EpiOutProj E{l == 0 ? args.in[0] : args.out, args.out, xb, sspart, l == 0 ? 1 : 0, dry};
            pg8::gemm_phase<pg8::EpiOutProj, pg8::StaticOrder>(lds, gm, S, E, wave_s);
        }
        SEAM(pb + 2);
    }
    if (IN(7)) {
        PHASE_LANES
        const float* fg = args.in[16];
        const int gw = vcu * NWAVES + wave, NGW = G * NWAVES;
        for (int m = gw; m < NTOK; m += NGW) {
            const f32x4* sp = (const f32x4*)(sspart + (size_t)m * 16);
            const f32x4 s0 = sp[0], s1 = sp[1], s2 = sp[2], s3 = sp[3];
            const float ss = (((s0[0] + s0[1]) + (s0[2] + s0[3])) + ((s1[0] + s1[1]) + (s1[2] + s1[3]))) + (((s2[0] + s2[1]) + (s2[2] + s2[3])) + ((s3[0] + s3[1]) + (s3[2] + s3[3])));
            const float rinv = rsqrtf(ss * (1.0f / DM) + RMS_EPS);
            f32x4* xr = (f32x4*)(args.out + (size_t)m * DM) + lane;
#pragma unroll
            for (int j = 0; j < 4; ++j) { const f32x4 gv = *((const f32x4*)fg + lane + 64 * j); const f32x4 ov = xr[64 * j] * rinv * gv; if (!dry) xr[64 * j] = ov; else asm volatile("" :: "v"(ov)); }
        }
    }
#undef IN
#undef INL
#undef INR
#undef SEAM
}
#ifndef EXTRA_PLAN
#define EXTRA_PLAN
#endif
#define HOST_PLAN launch_mega(d_in, d_out, d_ws, stream, 0, N_PHASES, 0, 0); EXTRA_PLAN
static int g_grid = 0;
static void launch_mega(void* const* d_in, void* d_out, void* d_ws, hipStream_t stream, int lo, int hi, int li, int skip) {
    Args a{};
    for (int i = 0; i < 17; ++i) a.in[i] = (const float*)d_in[i];
    a.out = (float*)d_out; a.ws = (unsigned char*)d_ws; a.ph_lo = lo; a.ph_hi = hi; a.li = li; a.skip = skip;
    hipLaunchKernelGGL(mega_fwd, dim3(g_grid), dim3(NWAVES * 64), LDS_BYTES, stream, a);
    const hipError_t le = hipPeekAtLastError();
    if (le != hipSuccess) fprintf(stderr, "kernel_launch: launch failed: %s (grid %d)\n", hipGetErrorName(le), g_grid);
}
extern "C" void kernel_launch(void* const* d_in, const int* in_sizes, int n_in, void* d_out, int out_size, void* d_ws, size_t ws_size, hipStream_t stream) {
    if (g_grid == 0) {
        if (n_in != 17 || in_sizes[0] != NTOK * DM || out_size != NTOK * DM || ws_size < WS_NEED) { fprintf(stderr, "kernel_launch: unexpected shapes (n_in %d in0 %d out %d ws %zu need %zu)\n", n_in, n_in > 0 ? in_sizes[0] : -1, out_size, ws_size, (size_t)WS_NEED); g_grid = -1; return; }
        int dev = 0, cus = 0, per_cu = 0;
        if (hipGetDevice(&dev) != hipSuccess || hipDeviceGetAttribute(&cus, hipDeviceAttributeMultiprocessorCount, dev) != hipSuccess) { g_grid = -1; return; }
        if (hipFuncSetAttribute((const void*)mega_fwd, hipFuncAttributeMaxDynamicSharedMemorySize, LDS_BYTES) != hipSuccess) { fprintf(stderr, "kernel_launch: hipFuncSetAttribute failed\n"); g_grid = -1; return; }
        if (hipOccupancyMaxActiveBlocksPerMultiprocessor(&per_cu, (const void*)mega_fwd, NWAVES * 64, LDS_BYTES) != hipSuccess || per_cu < 1) { fprintf(stderr, "kernel_launch: occupancy query says %d\n", per_cu); per_cu = 1; }
        (void)hipGetLastError();
        g_grid = cus * 1;
    }
    if (g_grid < 0) return;
    (void)hipMemsetAsync((char*)d_ws + OFF_CTL, 0, CTL_ZERO_BYTES, stream);
    HOST_PLAN
}
```

```cpp
#include <hip/hip_runtime.h>
#include <cstdio>
#include <cstdint>
#include <cmath>

typedef unsigned short bf16_t;

constexpr int NB = 4, SEQ = 4096, DM = 1024, NTOK = NB * SEQ, DEPTH = 2;
constexpr int IN_COLS = 5120, MIXW = 1536;
constexpr float RMS_EPS = 1e-6f;
constexpr int LCH = 16;
constexpr int NCHUNK = SEQ / LCH;
constexpr int NCHUNK_TOT = NB * NCHUNK;
constexpr int PLD = 4608;
constexpr int PC_ZA = 0, PC_QB = 512, PC_QC = 1024, PC_KB = 1536, PC_VB = 2048, PC_ZB = 2560, PC_KC = 3072, PC_VC = 3584, PC_ZC = 4096;
__host__ __device__ __forceinline__ int inproj_src_col(int n) {
    if (n < 512) return n;
    const int pc = n - 512, s = pc >> 9;
    const int seg = (s == 0) ? 1 : (s == 1) ? 2 : (s == 2) ? 6 : (s == 3) ? 3 : (s == 4) ? 4 : (s == 5) ? 5 : (s == 6) ? 7 : (s == 7) ? 8 : 9;
    return seg * 512 + (pc & 511);
}

constexpr size_t OFF_CTL = 0;
constexpr size_t OFF_SS = 1u << 20;
constexpr size_t OFF_PROJ = 2u << 20;
constexpr size_t SZ_PROJ = (size_t)NTOK * PLD * 2;
constexpr size_t OFF_XAG = OFF_PROJ + SZ_PROJ;
constexpr size_t SZ_XAG = (size_t)32 * NCHUNK_TOT * 512 * 2;
constexpr size_t OFF_XB = OFF_XAG + SZ_XAG;
constexpr size_t SZ_XB = (size_t)NTOK * DM * 2;
constexpr size_t OFF_G = OFF_XB + SZ_XB;
constexpr size_t SZ_G = (size_t)NTOK * 512 * 2;
constexpr size_t OFF_W = OFF_G + SZ_G;
constexpr size_t WS_NEED_NAIVE = OFF_W;

__host__ __device__ __forceinline__ unsigned f2bf(float f) { unsigned u = __builtin_bit_cast(unsigned, f); return (u + 0x7fffu + ((u >> 16) & 1u)) >> 16; }
__host__ __device__ __forceinline__ float bf2f(bf16_t b) { return __builtin_bit_cast(float, (unsigned)b << 16); }

__device__ __forceinline__ int hw_lane() { int r; asm volatile("v_mbcnt_lo_u32_b32 %0, -1, 0\n\tv_mbcnt_hi_u32_b32 %0, -1, %0" : "=v"(r)); return r; }
namespace pg8 {
#define PG8_LAS __attribute__((address_space(3)))
typedef short bf16x8 __attribute__((ext_vector_type(8)));
typedef float f32x4 __attribute__((ext_vector_type(4)));
typedef unsigned u32x4 __attribute__((ext_vector_type(4)));
typedef unsigned u32x2 __attribute__((ext_vector_type(2)));
constexpr int BM = 256, BK = 64, HALF = 128, HTB = HALF * BK * 2  , STAGE_BYTES = 8 * HTB, NXCD = 8, WGM = 8;

__host__ __device__ __forceinline__ int lds_byte(int r, int c) { const int st = (r >> 4) * 2 + (c >> 5), rr = r & 15, cc = c & 31, ob = rr * 64 + cc * 2; return st * 1024 + (ob ^ (((ob >> 9) & 1) << 5)); }
__host__ __device__ __forceinline__ void stage_rc(int b, int& R, int& C) { const int st = b / 1024, sb = b % 1024, swz = sb ^ (((sb >> 9) & 1) << 5); R = (st >> 1) * 16 + swz / 64; C = (st & 1) * 32 + (swz % 64) / 2; }
__host__ __device__ __forceinline__ int perm32(int rho) { const int n = rho >> 4, i = rho & 15; return 8 * (i >> 2) + 4 * n + (i & 3); }

struct Unit { int pm, pn, bz; };
struct Gemm { const bf16_t* A; const bf16_t* Bt; int lda, ldb, K; size_t a_bz, b_bz; };

struct StaticOrder {
    int nM, nN, nwg, G, c;
    __host__ __device__ void init(int M, int N, int G_, int c_) { nM = M / BM; nN = N / BM; nwg = nM * nN; G = G_; c = c_; }
    __host__ __device__ bool next(int i, Unit& u) const {
        const long L = (long)i * G + c; if (L >= nwg) return false;
        int wgid = (int)L; { const int q = nwg / NXCD, r = nwg % NXCD, xcd = wgid % NXCD, off = wgid / NXCD; wgid = (xcd < r ? xcd * (q + 1) : r * (q + 1) + (xcd - r) * q) + off; }
        const int nig = WGM * nN, gid = wgid / nig, fm = gid * WGM, gsz = (nM - fm) < WGM ? (nM - fm) : WGM;
        u.pm = fm + ((wgid % nig) % gsz); u.pn = (wgid % nig) / gsz; u.bz = 0; return true;
    }
};
struct BatchOrder {
    int nM, nwg, G, c;
    __host__ __device__ void init(int nM_, int nBatch, int G_, int c_) { nM = nM_; nwg = nM_ * nBatch; G = G_; c = c_; }
    __host__ __device__ bool next(int i, Unit& u) const {
        const long L = (long)i * G + c; if (L >= nwg) return false;
        u.bz = (int)L >> 2; u.pm = (int)L & 3; u.pn = 0; return true;
    }
};

struct OneUnit { Unit u; __host__ __device__ bool next(int i, Unit& o) const { if (i != 0) return false; o = u; return true; } };

__device__ __forceinline__ unsigned cvt_pk_bf16(float lo, float hi) { unsigned r; asm volatile("v_cvt_pk_bf16_f32 %0, %1, %2" : "=v"(r) : "v"(lo), "v"(hi)); return r; }
__device__ __forceinline__ u32x4 pack8(const f32x4 v0, const f32x4 v1) { u32x4 w; w.x = cvt_pk_bf16(v0[0], v0[1]); w.y = cvt_pk_bf16(v0[2], v0[3]); w.z = cvt_pk_bf16(v1[0], v1[1]); w.w = cvt_pk_bf16(v1[2], v1[3]); return w; }
__device__ __forceinline__ float bfl(unsigned w) { return __builtin_bit_cast(float, w << 16); }
__device__ __forceinline__ float bfh(unsigned w) { return __builtin_bit_cast(float, w & 0xffff0000u); }


struct EpiInProj {
    static constexpr bool PERM = true, AFTER_DRAIN = false;
    const float* sspart; bf16_t* proj; bf16_t* xag;
    __device__ __forceinline__ void operator()(const f32x4 (&acc)[2][2][4][2], const Unit& u, int wr, int wc, int fr, int fq) const {
        const int row0 = u.pm * BM + wr * 64 + fr, colt = u.pn * BM + wc * 32 + 8 * fq;
#pragma unroll
        for (int ai = 0; ai < 2; ++ai) {
            f32x4 sp[4][4];
#pragma unroll
            for (int m = 0; m < 4; ++m) { const f32x4* p = (const f32x4*)(sspart + (size_t)(row0 + ai * HALF + m * 16) * 16);
#pragma unroll
                for (int j = 0; j < 4; ++j) sp[m][j] = p[j]; }
#pragma unroll
            for (int m = 0; m < 4; ++m) {
                const int row = row0 + ai * HALF + m * 16;
                const f32x4 s0 = sp[m][0], s1 = sp[m][1], s2 = sp[m][2], s3 = sp[m][3];
                const float ss = (((s0[0] + s0[1]) + (s0[2] + s0[3])) + ((s1[0] + s1[1]) + (s1[2] + s1[3]))) + (((s2[0] + s2[1]) + (s2[2] + s2[3])) + ((s3[0] + s3[1]) + (s3[2] + s3[3])));
                const float rinv = rsqrtf(ss * (1.0f / DM) + RMS_EPS);
#pragma unroll
                for (int bj = 0; bj < 2; ++bj) {
                    const int col = colt + bj * HALF;
                    const u32x4 w = pack8(acc[ai][bj][m][0] * rinv, acc[ai][bj][m][1] * rinv);
                    bf16_t* dst = (u.pn < 2) ? xag + ((size_t)(col >> 4) * NCHUNK_TOT + (row >> 4)) * 512 + (row & 15) * 16 + (col & 15)
                                             : proj + (size_t)row * PLD + (col - 512);
                    *(u32x4*)dst = w;
                }
            }
            asm volatile("" ::: "memory");
        }
    }
};
struct EpiE {
    static constexpr bool PERM = true, AFTER_DRAIN = false;
    float* E;
    __device__ __forceinline__ void operator()(const f32x4 (&acc)[2][2][4][2], const Unit& u, int wr, int wc, int fr, int fq) const {
        const int row0 = u.pm * BM + wr * 64 + fr, colt = wc * 32 + 8 * fq;
#pragma unroll
        for (int ai = 0; ai < 2; ++ai)
#pragma unroll
            for (int m = 0; m < 4; ++m) {
                float* rp = E + ((size_t)u.bz * NCHUNK_TOT + row0 + ai * HALF + m * 16) * 256 + colt;
#pragma unroll
                for (int bj = 0; bj < 2; ++bj) { *(f32x4*)(rp + bj * HALF) = acc[ai][bj][m][0]; *(f32x4*)(rp + bj * HALF + 4) = acc[ai][bj][m][1]; }
                asm volatile("" ::: "memory");
            }
    }
};
struct EpiY {
    static constexpr bool PERM = true, AFTER_DRAIN = false;
    bf16_t* G;
    __device__ __forceinline__ static float gelu(float y) {
        const float a = 0.7978845608028654f * (y + 0.044715f * y * y * y);
        return y * __builtin_amdgcn_rcpf(1.0f + __builtin_amdgcn_exp2f(-2.885390081777927f * a));
    }
    __device__ __forceinline__ void operator()(const f32x4 (&acc)[2][2][4][2], const Unit& u, int wr, int wc, int fr, int fq) const {
        const int row0 = u.pm * BM + wr * 64 + fr, colt = wc * 32 + 8 * fq;
        const __amdgpu_buffer_rsrc_t grs = __builtin_amdgcn_make_buffer_rsrc(G, 0, NTOK * 512 * 2, 0x00020000);
#pragma unroll
        for (int ai = 0; ai < 2; ++ai)
#pragma unroll
            for (int m = 0; m < 4; ++m) {
                const int n = row0 + ai * HALF + m * 16;
#pragma unroll
                for (int bj = 0; bj < 2; ++bj) {
                    const int col = colt + bj * HALF, t = col >> 4, c0 = col & 15;
                    f32x4 v0 = acc[ai][bj][m][0], v1 = acc[ai][bj][m][1];
#pragma unroll
                    for (int e = 0; e < 4; ++e) { v0[e] = gelu(v0[e]); v1[e] = gelu(v1[e]); }
                    __builtin_amdgcn_raw_buffer_store_b128(pack8(v0, v1), grs, (unsigned)(((n * 16 + t) * 512 + u.bz * 16 + c0) * 2), 0,   16);
                }
                asm volatile("" ::: "memory");
            }
    }
};
struct EpiGlu {
    static constexpr bool PERM = true, AFTER_DRAIN = false;
    const bf16_t* G; const float* bias; bf16_t* proj; int dry;
    __device__ __forceinline__ static float sig(float v) { return __builtin_amdgcn_rcpf(1.0f + __builtin_amdgcn_exp2f(-1.4426950408889634f * v)); }
    __device__ __forceinline__ void operator()(const f32x4 (&acc)[2][2][4][2], const Unit& u, int wr, int wc, int fr, int fq) const {
        const int row0 = u.pm * BM + wr * 64 + fr, colt = u.pn * BM + wc * 32 + 8 * fq;
#pragma unroll
        for (int bj = 0; bj < 2; ++bj) {
            const int col = colt + bj * HALF;
            const f32x4 b0 = *(const f32x4*)(bias + col), b1 = *(const f32x4*)(bias + col + 4);
#pragma unroll
            for (int ai = 0; ai < 2; ++ai) {
                u32x4 gg[4], zz[4];
#pragma unroll
                for (int m = 0; m < 4; ++m) { const int row = row0 + ai * HALF + m * 16; gg[m] = *(const u32x4*)(G + (size_t)row * 512 + col); zz[m] = *(const u32x4*)(proj + (size_t)row * PLD + PC_ZA + col); }
#pragma unroll
                for (int m = 0; m < 4; ++m) {
                    const int row = row0 + ai * HALF + m * 16;
                    bf16_t* zp = proj + (size_t)row * PLD + PC_ZA + col;
                    const f32x4 a0 = acc[ai][bj][m][0] + b0, a1 = acc[ai][bj][m][1] + b1;
                    f32x4 o0, o1;
#pragma unroll
                    for (int e = 0; e < 4; ++e) {
                        const unsigned gw0 = gg[m][e >> 1], zw0 = zz[m][e >> 1], gw1 = gg[m][2 + (e >> 1)], zw1 = zz[m][2 + (e >> 1)];
                        const float g0 = (e & 1) ? bfh(gw0) : bfl(gw0), z0 = (e & 1) ? bfh(zw0) : bfl(zw0);
                        const float g1 = (e & 1) ? bfh(gw1) : bfl(gw1), z1 = (e & 1) ? bfh(zw1) : bfl(zw1);
                        o0[e] = g0 * sig(a0[e]) * (z0 * sig(z0)); o1[e] = g1 * sig(a1[e]) * (z1 * sig(z1));
                    }
                    if (!dry) *(u32x4*)zp = pack8(o0, o1); else asm volatile("" :: "v"(o0), "v"(o1));
                }
                asm volatile("" ::: "memory");
            }
        }
    }
};
struct EpiOutProj {
    static constexpr bool PERM = true, AFTER_DRAIN = false;
    const float* xold; float* xout; bf16_t* xb; float* sspart; int write_xb; int dry;
    __device__ __forceinline__ void operator()(const f32x4 (&acc)[2][2][4][2], const Unit& u, int wr, int wc, int fr, int fq) const {
        const int row0 = u.pm * BM + wr * 64 + fr, colt = u.pn * BM + wc * 32 + 8 * fq;
#pragma unroll
        for (int ai = 0; ai < 2; ++ai) {
            f32x4 xo[4][2][2];
#pragma unroll
            for (int m = 0; m < 4; ++m)
#pragma unroll
                for (int bj = 0; bj < 2; ++bj) { const size_t off = (size_t)(row0 + ai * HALF + m * 16) * DM + colt + bj * HALF; xo[m][bj][0] = *(const f32x4*)(xold + off); xo[m][bj][1] = *(const f32x4*)(xold + off + 4); }
#pragma unroll
            for (int m = 0; m < 4; ++m) {
                const int row = row0 + ai * HALF + m * 16;
                float ssl = 0.f;
#pragma unroll
                for (int bj = 0; bj < 2; ++bj) {
                    const size_t off = (size_t)row * DM + colt + bj * HALF;
                    const f32x4 n0 = xo[m][bj][0] + acc[ai][bj][m][0], n1 = xo[m][bj][1] + acc[ai][bj][m][1];
                    if (!dry) { *(f32x4*)(xout + off) = n0; *(f32x4*)(xout + off + 4) = n1;
                    if (write_xb) *(u32x4*)(xb + off) = pack8(n0, n1); }
                    ssl += ((n0[0] * n0[0] + n0[1] * n0[1]) + (n0[2] * n0[2] + n0[3] * n0[3])) + ((n1[0] * n1[0] + n1[1] * n1[1]) + (n1[2] * n1[2] + n1[3] * n1[3]));
                }
                ssl += __shfl_xor(ssl, 16); ssl += __shfl_xor(ssl, 32);
                if (fq == 0 && !dry) sspart[(size_t)row * 16 + u.pn * 4 + wc] = ssl; else asm volatile("" :: "v"(ssl));
            }
            asm volatile("" ::: "memory");
        }
    }
};

template <class Epi, class Sched, bool ALIGN_EPI = true>
__device__ __forceinline__ void gemm_phase(PG8_LAS unsigned char* lds, const Gemm g, const Sched& S, const Epi& E, int wave_s) {
    int tid = wave_s * 64 + hw_lane(); asm volatile("" : "+v"(tid));
    const int wid = __builtin_amdgcn_readfirstlane(tid >> 6), lane = tid & 63, wr = wid >> 2, wc = wid & 3, fr = lane & 15, fq = lane >> 4;
    int K = g.K; asm volatile("" : "+s"(K));
    const int nt = K / BK;
    unsigned voffA[2], voffB[2];
#pragma unroll
    for (int i = 0; i < 2; ++i) { int R, C; stage_rc(tid * 16 + i * 8192, R, C); const int Rb = Epi::PERM ? ((R & ~31) + perm32(R & 31)) : R;
        voffA[i] = (unsigned)(R * g.lda + C) * 2u; voffB[i] = (unsigned)(Rb * g.ldb + C) * 2u; }
    const size_t kstep = (size_t)(BK * 2);
    const size_t hstepA = (size_t)HALF * g.lda * 2, hstepB = (size_t)HALF * g.ldb * 2;
    const unsigned ldsw = (unsigned)wid * 1024u;
    const int aoff = lds_byte(wr * 64 + fr, fq * 8), boff = lds_byte(wc * 32 + fr, fq * 8);
#define PG8_SA(b, h) (((b) * 2 + (h)) * HTB)
#define PG8_SB(b, h) ((4 + (b) * 2 + (h)) * HTB)
#define PG8_STAGE(bufoff, gbase, voff) do { _Pragma("unroll") for (int _i = 0; _i < 2; ++_i) \
        __builtin_amdgcn_global_load_lds((const unsigned*)((const char*)(gbase) + (voff)[_i]), (PG8_LAS unsigned*)(lds + (bufoff) + ldsw + _i * 8192), 16, 0, 0); } while (0)
#define PG8_LDA(dst, b, h) do { _Pragma("unroll") for (int m = 0; m < 4; ++m) _Pragma("unroll") for (int k = 0; k < 2; ++k) dst[m][k] = *(const PG8_LAS bf16x8*)(lds + PG8_SA(b, h) + aoff + m * 2048 + k * 1024); } while (0)
#define PG8_LDB(dst, b, h) do { _Pragma("unroll") for (int n = 0; n < 2; ++n) _Pragma("unroll") for (int k = 0; k < 2; ++k) dst[n][k] = *(const PG8_LAS bf16x8*)(lds + PG8_SB(b, h) + boff + n * 2048 + k * 1024); } while (0)
#define PG8_MMA(ai, bj, At, Bt) do { __builtin_amdgcn_s_setprio(1); _Pragma("unroll") for (int m = 0; m < 4; ++m) _Pragma("unroll") for (int n = 0; n < 2; ++n) _Pragma("unroll") for (int k = 0; k < 2; ++k) \
        acc[ai][bj][m][n] = __builtin_amdgcn_mfma_f32_16x16x32_bf16(Bt[n][k], At[m][k], acc[ai][bj][m][n], 0, 0, 0); __builtin_amdgcn_s_setprio(0); } while (0)
#define PG8_WAIT_V(n) asm volatile("s_waitcnt vmcnt(" #n ")" ::: "memory")
#define PG8_WAIT_L(n) asm volatile("s_waitcnt lgkmcnt(" #n ")" ::: "memory")
#define PG8_BAR __builtin_amdgcn_s_barrier()
#define PG8_SCHED __builtin_amdgcn_sched_barrier(0)
#define PG8_ABASE(u) ((const char*)g.A + ((size_t)(u).bz * g.a_bz + (size_t)(u).pm * BM * g.lda) * 2)
#define PG8_BBASE(u) ((const char*)g.Bt + ((size_t)(u).bz * g.b_bz + (size_t)(u).pn * BM * g.ldb) * 2)
    Unit cur, nxt; int ui = 0;
    if (!S.next(0, cur)) return;
    f32x4 acc[2][2][4][2];
#pragma unroll
    for (int a = 0; a < 2; ++a)
#pragma unroll
        for (int b = 0; b < 2; ++b)
#pragma unroll
            for (int m = 0; m < 4; ++m)
#pragma unroll
                for (int n = 0; n < 2; ++n) acc[a][b][m][n] = (f32x4){0.f, 0.f, 0.f, 0.f};
    bf16x8 At[4][2], B0[2][2], B1[2][2];
    const char* cA = PG8_ABASE(cur); const char* cB = PG8_BBASE(cur);
    PG8_STAGE(PG8_SB(0, 0), cB, voffB); PG8_STAGE(PG8_SB(0, 1), cB + hstepB, voffB); PG8_STAGE(PG8_SA(0, 0), cA, voffA); PG8_STAGE(PG8_SA(0, 1), cA + hstepA, voffA);
    if (wr == 1) PG8_BAR;
    PG8_WAIT_V(2); PG8_BAR;
    PG8_STAGE(PG8_SB(1, 0), cB + kstep, voffB); PG8_STAGE(PG8_SA(1, 0), cA + kstep, voffA); PG8_STAGE(PG8_SB(1, 1), cB + hstepB + kstep, voffB);
    PG8_WAIT_V(6); PG8_BAR;
    for (;;) {
        const bool has_next = S.next(ui + 1, nxt);
        const char* nA = has_next ? PG8_ABASE(nxt) : cA; const char* nB = has_next ? PG8_BBASE(nxt) : cB;
        for (int t = 0; t < nt; t += 2) {
            const bool last = (t == nt - 2);
            const char* a1 = cA + (size_t)(t + 1) * kstep;
            const char* a2 = last ? nA : cA + (size_t)(t + 2) * kstep; const char* b2 = last ? nB : cB + (size_t)(t + 2) * kstep;
            const char* a3 = a2 + kstep; const char* b3 = b2 + kstep;
            PG8_LDB(B0, 0, 0); PG8_LDB(B1, 0, 1); PG8_SCHED; PG8_LDA(At, 0, 0); PG8_STAGE(PG8_SA(1, 1), a1 + hstepA, voffA);
            PG8_WAIT_V(8); PG8_WAIT_L(0); PG8_BAR; PG8_MMA(0, 0, At, B0); PG8_MMA(0, 1, At, B1); PG8_BAR; PG8_SCHED;
            PG8_LDA(At, 0, 1); PG8_STAGE(PG8_SB(0, 0), b2, voffB); PG8_STAGE(PG8_SB(0, 1), b2 + hstepB, voffB); PG8_STAGE(PG8_SA(0, 0), a2, voffA);
            PG8_WAIT_V(8); PG8_WAIT_L(0); PG8_BAR; PG8_MMA(1, 0, At, B0); PG8_MMA(1, 1, At, B1); PG8_BAR; PG8_SCHED;
            PG8_LDB(B0, 1, 0); PG8_LDB(B1, 1, 1); PG8_SCHED; PG8_LDA(At, 1, 0); PG8_STAGE(PG8_SA(0, 1), a2 + hstepA, voffA);
            PG8_WAIT_V(8); PG8_WAIT_L(0); PG8_BAR; PG8_MMA(0, 0, At, B0); PG8_MMA(0, 1, At, B1); PG8_BAR; PG8_SCHED;
            PG8_LDA(At, 1, 1); PG8_STAGE(PG8_SB(1, 0), b3, voffB); PG8_STAGE(PG8_SB(1, 1), b3 + hstepB, voffB); PG8_STAGE(PG8_SA(1, 0), a3, voffA);
            PG8_WAIT_V(8); PG8_WAIT_L(0); PG8_BAR; PG8_MMA(1, 0, At, B0); PG8_MMA(1, 1, At, B1); PG8_BAR; PG8_SCHED;
        }
        if constexpr (ALIGN_EPI) { if (wr == 0) PG8_BAR; }
        E(acc, cur, wr, wc, fr, fq);
        if (!has_next) break;
#pragma unroll
        for (int a = 0; a < 2; ++a)
#pragma unroll
            for (int b = 0; b < 2; ++b)
#pragma unroll
                for (int m = 0; m < 4; ++m)
#pragma unroll
                    for (int n = 0; n < 2; ++n) acc[a][b][m][n] = (f32x4){0.f, 0.f, 0.f, 0.f};
        cur = nxt; cA = nA; cB = nB; ++ui;
        if constexpr (ALIGN_EPI) { if (wr == 1) PG8_BAR; }
    }
    PG8_WAIT_V(0);
    if constexpr (!ALIGN_EPI) { if (wr == 0) PG8_BAR; }
    PG8_BAR;
#undef PG8_SA
#undef PG8_SB
#undef PG8_STAGE
#undef PG8_LDA
#undef PG8_LDB
#undef PG8_MMA
#undef PG8_WAIT_V
#undef PG8_WAIT_L
#undef PG8_BAR
#undef PG8_SCHED
#undef PG8_ABASE
#undef PG8_BBASE
}
}
namespace att {
#define LAS __attribute__((address_space(3)))
typedef short bf16x8 __attribute__((ext_vector_type(8)));
typedef short s16x4 __attribute__((ext_vector_type(4)));
typedef float f32x4 __attribute__((ext_vector_type(4)));
typedef unsigned u32x4 __attribute__((ext_vector_type(4)));
typedef unsigned u32x2 __attribute__((ext_vector_type(2)));
typedef float f32x2_t __attribute__((ext_vector_type(2)));
typedef __bf16 bf16x2_t __attribute__((ext_vector_type(2)));
constexpr int VROW = 160;
constexpr int VTILE = 32 * VROW;
constexpr int WAVE_LDS = 2 * VTILE;
constexpr float C2 = 0.125f * 1.4426950408889634f;
constexpr float NEG = -1e30f, MFLOOR = -1e20f, THR = 8.0f;
constexpr int TBW = 640, TBOFF = 240;
constexpr int T5TB_F = 8 * 3 * TBW, T5S_F = 8 * 4 * TBW, RPBS_F = 2 * 4 * 8 * 15 * 64;

__device__ __forceinline__ unsigned cvtpk(float lo, float hi) { f32x2_t v = {lo, hi}; bf16x2_t b = __builtin_convertvector(v, bf16x2_t); return __builtin_bit_cast(unsigned, b); }
__device__ __forceinline__ s16x4 vtr(LAS const char* p) { typedef short v4i16_t __attribute__((ext_vector_type(4))); return __builtin_bit_cast(s16x4, __builtin_amdgcn_ds_read_tr16_b64_v4i16((LAS v4i16_t*)p)); }

__device__ __forceinline__ float max3f(float a, float b, float c) { float r; asm("v_max3_f32 %0, %1, %2, %3" : "=v"(r) : "v"(a), "v"(b), "v"(c)); return r; }
__device__ __forceinline__ float max2f(float a, float b) { float r; asm("v_max_f32_e32 %0, %1, %2" : "=v"(r) : "v"(a), "v"(b)); return r; }
__device__ __forceinline__ void lds_barrier() { asm volatile("s_waitcnt lgkmcnt(0)" ::: "memory"); __builtin_amdgcn_s_barrier(); asm volatile("" ::: "memory"); }
struct State { float m, l; f32x4 acc[4]; };
struct Stage { bf16x8 k00, k01, k10, k11; u32x4 v0, v1, v2, v3; };
struct Bias { f32x4 b0, b1; };

__device__ __forceinline__ void softmax_pv(State& st, f32x4 t0, f32x4 t1, LAS const char* vt, int lane) {
    const float mloc = max2f(max3f(max3f(t0[0], t0[1], t0[2]), t0[3], t1[0]), max3f(t1[1], t1[2], t1[3]));
    if (__builtin_amdgcn_ballot_w64(mloc > st.m + THR) != 0ull) {
        float mx = max2f(mloc, __shfl_xor(mloc, 16)); mx = max2f(mx, __shfl_xor(mx, 32));
        const float mn = max2f(st.m, mx);
        const float alpha = __builtin_amdgcn_exp2f(st.m - mn);
        st.m = mn; st.l *= alpha;
#pragma unroll
        for (int mt = 0; mt < 4; ++mt) st.acc[mt] = st.acc[mt] * alpha;
    }
    const float mn = st.m;
    f32x4 p0, p1;
#pragma unroll
    for (int e = 0; e < 4; ++e) { p0[e] = __builtin_amdgcn_exp2f(t0[e] - mn); p1[e] = __builtin_amdgcn_exp2f(t1[e] - mn); }
    st.l += (((p0[0] + p0[1]) + (p0[2] + p0[3])) + ((p1[0] + p1[1]) + (p1[2] + p1[3])));
    u32x4 pw; pw.x = cvtpk(p0[0], p0[1]); pw.y = cvtpk(p0[2], p0[3]); pw.z = cvtpk(p1[0], p1[1]); pw.w = cvtpk(p1[2], p1[3]);
    const bf16x8 pb = __builtin_bit_cast(bf16x8, pw);
    const int g = lane >> 4, qq = (lane & 15) >> 2, pp = lane & 3;
    LAS const char* vb = vt + (4 * g + qq) * VROW + pp * 8;
#pragma unroll
    for (int mt = 0; mt < 4; ++mt) {
        const s16x4 lo = vtr(vb + mt * 32), hi = vtr(vb + 16 * VROW + mt * 32);
        const bf16x8 av = (bf16x8){lo[0], lo[1], lo[2], lo[3], hi[0], hi[1], hi[2], hi[3]};
        st.acc[mt] = __builtin_amdgcn_mfma_f32_16x16x32_bf16(av, pb, st.acc[mt], 0, 0, 0);
    }
}
__device__ __forceinline__ void write_v(const Stage& s, LAS char* vt, int lane) {
    LAS char* vw = vt + (lane >> 1) * VROW + (lane & 1) * 64;
    *(LAS u32x4*)vw = s.v0; *(LAS u32x4*)(vw + 16) = s.v1; *(LAS u32x4*)(vw + 32) = s.v2; *(LAS u32x4*)(vw + 48) = s.v3;
}
__device__ __forceinline__ void qk(const Stage& s, const Bias& bs, bf16x8 bq0, bf16x8 bq1, f32x4& t0, f32x4& t1) {
    f32x4 s0 = (f32x4){0.f, 0.f, 0.f, 0.f}, s1 = s0;
    s0 = __builtin_amdgcn_mfma_f32_16x16x32_bf16(s.k00, bq0, s0, 0, 0, 0); s0 = __builtin_amdgcn_mfma_f32_16x16x32_bf16(s.k01, bq1, s0, 0, 0, 0);
    s1 = __builtin_amdgcn_mfma_f32_16x16x32_bf16(s.k10, bq0, s1, 0, 0, 0); s1 = __builtin_amdgcn_mfma_f32_16x16x32_bf16(s.k11, bq1, s1, 0, 0, 0);
    t0 = s0 * C2 + bs.b0; t1 = s1 * C2 + bs.b1;
}

struct ZF { u32x2 z[4]; };
__device__ __forceinline__ ZF load_z(const bf16_t* zp, int lane) { ZF r; const int g = lane >> 4;
#pragma unroll
    for (int mt = 0; mt < 4; ++mt) r.z[mt] = *(const u32x2*)(zp + mt * 16 + 4 * g);
    return r; }
__device__ __forceinline__ void finish(State& st, bf16_t* outp  , const ZF& zf, int lane) {
    float l = st.l; l += __shfl_xor(l, 16); l += __shfl_xor(l, 32);
    const float rl = 1.0f / l;
    const int g = lane >> 4;
#pragma unroll
    for (int mt = 0; mt < 4; ++mt) {
        const u32x2 zz = zf.z[mt];
        float o[4];
#pragma unroll
        for (int e = 0; e < 4; ++e) {
            const unsigned zw = zz[e >> 1]; const float z = (e & 1) ? __builtin_bit_cast(float, zw & 0xffff0000u) : __builtin_bit_cast(float, zw << 16);
            const float sz = z * __builtin_amdgcn_rcpf(1.0f + __builtin_amdgcn_exp2f(-1.4426950408889634f * z));
            o[e] = st.acc[mt][e] * rl * sz;
        }
        u32x2 w; w.x = cvtpk(o[0], o[1]); w.y = cvtpk(o[2], o[3]);
        *(u32x2*)(outp + mt * 16 + 4 * g) = w;
    }
}

template <int V = 0>
__device__ __forceinline__ void dil_task(bf16_t* proj, const float* tbl, int task, LAS char* vbuf, int lane, bf16_t* dry = nullptr) {
    const int r = task & 15, qb = (task >> 4) & 15, h = (task >> 8) & 7, b = task >> 11;
    const int q = lane & 15, g = lane >> 4;
    const int qr = qb * 256 + r;
    bf16_t* pb_ = proj + (size_t)b * SEQ * PLD;
    const bf16_t* qp = pb_ + (size_t)(qr + 16 * q) * PLD + PC_QC + h * 64 + g * 8;
    const bf16x8 bq0 = *(const bf16x8*)qp, bq1 = *(const bf16x8*)(qp + 32);
    const char* kbase = (const char*)(pb_ + PC_KC + h * 64);
    const char* vbase = (const char*)(pb_ + PC_VC + h * 64);
    const unsigned klane = (unsigned)g * 16u, vlane = (unsigned)(lane & 1) * 64u;
    const int sv = lane >> 1;
    State st; st.m = MFLOOR; st.l = 0.f;
#pragma unroll
    for (int mt = 0; mt < 4; ++mt) st.acc[mt] = (f32x4){0.f, 0.f, 0.f, 0.f};
    const float* tb0 = tbl + T5TB_F + ((size_t)h * 4 + (q & 3)) * TBW + TBOFF + 4 * g - (q & ~3);
    const float* tb1 = tbl + ((size_t)h * 3 + 1) * TBW + TBOFF + 4 * g - 4 * q;
    const float* tb2 = tbl + ((size_t)h * 3 + 2) * TBW + TBOFF + 4 * g - 16 * q;

#define DIL_PARAMS(ks, d, pat, ul0) const int pat = ((ks) >= 5) + ((ks) >= 11), d = 16 >> (2 * pat), ul0 = ((ks) - (5 * pat + (pat >> 1))) * 32;
    auto issue = [&](int ks, Stage& s) {
        if (V == 1 && ks > 2) return;
        DIL_PARAMS(ks, d, pat, ul0);
        const int pbase = qr + d * (ul0 - 64);
        int p0 = pbase + d * q, p1 = p0 + 16 * d, pv = pbase + d * sv;
        p0 = p0 < 0 ? 0 : (p0 > SEQ - 1 ? SEQ - 1 : p0); p1 = p1 < 0 ? 0 : (p1 > SEQ - 1 ? SEQ - 1 : p1); pv = pv < 0 ? 0 : (pv > SEQ - 1 ? SEQ - 1 : pv);
        const char* ka = kbase + ((unsigned)p0 * (unsigned)(PLD * 2) + klane); const char* kb = kbase + ((unsigned)p1 * (unsigned)(PLD * 2) + klane);
        const char* va = vbase + ((unsigned)pv * (unsigned)(PLD * 2) + vlane);
        if (V != 4 && V != 5) { s.k00 = *(const bf16x8*)ka; s.k01 = *(const bf16x8*)(ka + 64); s.k10 = *(const bf16x8*)kb; s.k11 = *(const bf16x8*)(kb + 64); }
        if (V != 3 && V != 5) { s.v0 = *(const u32x4*)va; s.v1 = *(const u32x4*)(va + 16); s.v2 = *(const u32x4*)(va + 32); s.v3 = *(const u32x4*)(va + 48); }
    };
    auto issue_b = [&](int ks, Bias& bs) {
        if (V == 1 && ks > 1) return;
        if (V == 3 || V == 4) return;
        DIL_PARAMS(ks, d, pat, ul0); (void)d;
        const float* tp = (pat == 0 ? tb0 : (pat == 1 ? tb1 : tb2)) + ul0;
        bs.b0 = *(const f32x4*)tp; bs.b1 = *(const f32x4*)(tp + 16);
    };
    auto compute = [&](int ks, const Stage& s, const Bias& bs) {
        if (V == 3) { asm volatile("" :: "v"(s.k00), "v"(s.k01), "v"(s.k10), "v"(s.k11)); return; }
        if (V == 4) { asm volatile("" :: "v"(s.v0), "v"(s.v1), "v"(s.v2), "v"(s.v3)); return; }
        if (V == 5) { asm volatile("" :: "v"(bs.b0), "v"(bs.b1)); return; }
        if (V == 2) { asm volatile("" :: "v"(s.k00), "v"(s.k01), "v"(s.k10), "v"(s.k11), "v"(s.v0), "v"(s.v1), "v"(s.v2), "v"(s.v3), "v"(bs.b0), "v"(bs.b1)); return; }
        LAS char* vt = vbuf + (ks & 1) * VTILE;
        write_v(s, vt, lane);
        f32x4 t0, t1; qk(s, bs, bq0, bq1, t0, t1);
        {
            DIL_PARAMS(ks, d, pat, ul0); (void)pat;
            const int pbase = qr + d * (ul0 - 64);
            if (pbase < 0 || pbase + 31 * d > SEQ - 1) {
                const int pk = pbase + d * 4 * g;
#pragma unroll
                for (int x = 0; x < 4; ++x) { if ((unsigned)(pk + d * x) >= (unsigned)SEQ) t0[x] = NEG; if ((unsigned)(pk + d * (16 + x)) >= (unsigned)SEQ) t1[x] = NEG; }
            }
        }
        softmax_pv(st, t0, t1, vt, lane);
    };
    Stage A, B, C, D;
    Bias X, Y;
    issue(0, A); issue(1, B); issue(2, C); issue_b(0, X);
#pragma unroll 1
    for (int ks = 0; ks < 20; ks += 4) {
        issue(ks + 3, D); issue_b(ks + 1, Y); compute(ks, A, X);
        issue(ks + 4, A); issue_b(ks + 2, X); compute(ks + 1, B, Y);
        issue(ks + 5, B); issue_b(ks + 3, Y); compute(ks + 2, C, X);
        issue(ks + 6, C); issue_b(ks + 4, X); compute(ks + 3, D, Y);
    }
    issue_b(21, Y); compute(20, A, X); issue_b(22, X); compute(21, B, Y); compute(22, C, X);
#undef DIL_PARAMS
    bf16_t* outp = dry ? dry + ((size_t)task * 16 + q) * 64 : pb_ + (size_t)(qr + 16 * q) * PLD + PC_QC + h * 64;
    finish(st, outp, load_z(pb_ + (size_t)(qr + 16 * q) * PLD + PC_ZC + h * 64, lane), lane);
}

__device__ __forceinline__ void na_task(bf16_t* proj, const float* rpbs, int task, LAS char* vbuf, int lane, bf16_t* dry = nullptr) {
    const int jt = task & 3, r = (task >> 2) & 63, h = (task >> 8) & 7, b = task >> 11;
    const int q = lane & 15, g = lane >> 4;
    const int j0 = 16 * jt, j = j0 + q;
    int w0 = j0 - 8; w0 = w0 < 0 ? 0 : (w0 > 32 ? 32 : w0);
    int rs = r - 4; rs = rs < 0 ? 0 : (rs > 56 ? 56 : rs);
    int cs = j - 8; cs = cs < 0 ? 0 : (cs > 48 ? 48 : cs);
    bf16_t* pb_ = proj + (size_t)b * SEQ * PLD;
    const size_t tq = (size_t)(r * 64 + j);
    const bf16_t* qp = pb_ + tq * PLD + PC_QB + h * 64 + g * 8;
    const bf16x8 bq0 = *(const bf16x8*)qp, bq1 = *(const bf16x8*)(qp + 32);
    const char* kbase = (const char*)(pb_ + (size_t)(rs * 64 + w0) * PLD + PC_KB + h * 64);
    const char* vbase = (const char*)(pb_ + (size_t)(rs * 64 + w0) * PLD + PC_VB + h * 64);
    const int sv = lane >> 1;
    const unsigned koff = (unsigned)q * (unsigned)(PLD * 2) + (unsigned)g * 16u, voff = (unsigned)sv * (unsigned)(PLD * 2) + (unsigned)(lane & 1) * 64u;
    const int col = w0 - j + 32, c4 = col & 3;
    const float* tb = rpbs + (((size_t)c4 * 8 + h) * 15 + (rs - r + 7)) * 64 + (col - c4) + 4 * g;
    State st; st.m = MFLOOR; st.l = 0.f;
#pragma unroll
    for (int mt = 0; mt < 4; ++mt) st.acc[mt] = (f32x4){0.f, 0.f, 0.f, 0.f};
    const int kc0 = w0 + 4 * g - cs;
    auto issue = [&](int ks, Stage& s) {
        const char* ka = kbase + (size_t)ks * (64 * PLD * 2) + koff; const char* kb = ka + 16 * PLD * 2; const char* va = vbase + (size_t)ks * (64 * PLD * 2) + voff;
        s.k00 = *(const bf16x8*)ka; s.k01 = *(const bf16x8*)(ka + 64); s.k10 = *(const bf16x8*)kb; s.k11 = *(const bf16x8*)(kb + 64);
        s.v0 = *(const u32x4*)va; s.v1 = *(const u32x4*)(va + 16); s.v2 = *(const u32x4*)(va + 32); s.v3 = *(const u32x4*)(va + 48);
    };
    auto issue_b = [&](int ks, Bias& bs) { const float* tp = tb + ks * 64; bs.b0 = *(const f32x4*)tp; bs.b1 = *(const f32x4*)(tp + 16); };
    auto compute = [&](int ks, const Stage& s, const Bias& bs) {
        LAS char* vt = vbuf + (ks & 1) * VTILE;
        write_v(s, vt, lane);
        f32x4 t0, t1; qk(s, bs, bq0, bq1, t0, t1);
#pragma unroll
        for (int x = 0; x < 4; ++x) { if ((unsigned)(kc0 + x) >= 16u) t0[x] = NEG; if ((unsigned)(kc0 + 16 + x) >= 16u) t1[x] = NEG; }
        softmax_pv(st, t0, t1, vt, lane);
    };
    Stage A, B, C, D;
    Bias X, Y;
    issue(0, A); issue(1, B); issue(2, C); issue_b(0, X);
    issue(3, D); issue_b(1, Y); compute(0, A, X);
    issue(4, A); issue_b(2, X); compute(1, B, Y);
    issue(5, B); issue_b(3, Y); compute(2, C, X);
    issue(6, C); issue_b(4, X); compute(3, D, Y);
    issue(7, D); issue_b(5, Y); compute(4, A, X);
    issue_b(6, X); compute(5, B, Y); issue_b(7, Y); compute(6, C, X); compute(7, D, Y);
    finish(st, dry ? dry + ((size_t)task * 16 + q) * 64 : pb_ + tq * PLD + PC_QB + h * 64, load_z(pb_ + tq * PLD + PC_ZB + h * 64, lane), lane);
}

constexpr int NA_IMG = 480 * 128;
__device__ __forceinline__ int fK(int kidx) { return (kidx >> 1) & 7; }
__device__ __forceinline__ int fV(int kidx) { return ((kidx >> 1) & 3) * 2; }
constexpr int DIL_IMG = 400 * 128;
struct QF { bf16x8 q0, q1; };
struct LdsBases { LAS const char* ka; LAS const char* kb; LAS const char* v[4]; };
__device__ __forceinline__ LdsBases lds_bases(LAS const char* Kimg, LAS const char* Vimg, int k0  , int v0k  , int lane) {
    const int g = lane >> 4, pp = lane & 3, ch = pp >> 1; LdsBases b;
    b.ka = Kimg + k0 * 128 + ((g ^ fK(k0)) * 16); b.kb = Kimg + k0 * 128 + (((4 + g) ^ fK(k0)) * 16);
    const int f0 = fV(v0k);
#pragma unroll
    for (int mt = 0; mt < 4; ++mt) b.v[mt] = Vimg + v0k * 128 + (pp & 1) * 8 + (((mt * 2 + ch) ^ f0) * 16);
    return b;
}
struct RState { float m, l; f32x4 acc[4]; f32x4 c0, c1; };
__device__ __forceinline__ void rstate_init(RState& st, f32x4 mk0, f32x4 mk1) {
    st.m = 0.f; st.l = 0.f; st.c0 = mk0 * (1.0f / C2); st.c1 = mk1 * (1.0f / C2);
#pragma unroll
    for (int mt = 0; mt < 4; ++mt) st.acc[mt] = (f32x4){0.f, 0.f, 0.f, 0.f};
}
template <int NT>
__device__ __forceinline__ void rescale_up(RState& st, float mloc, f32x4 (&t)[NT]) {
    float mx = max2f(mloc, __shfl_xor(mloc, 16)); mx = max2f(mx, __shfl_xor(mx, 32));
    const float delta = max2f(mx, 0.f), alpha = __builtin_amdgcn_exp2f(-delta), dc = delta * (1.0f / C2);
    st.m += delta; st.l *= alpha; st.c0 = st.c0 - dc; st.c1 = st.c1 - dc;
#pragma unroll
    for (int mt = 0; mt < 4; ++mt) st.acc[mt] = st.acc[mt] * alpha;
#pragma unroll
    for (int j = 0; j < NT; ++j) t[j] = t[j] - delta;
}
template <class MF>
__device__ __forceinline__ void lds_step(RState& st, const QF& qf, const LdsBases& B, int so, const Bias& bs, MF dynmask) {
    const bf16x8 a00 = *(LAS const bf16x8*)(B.ka + so), a01 = *(LAS const bf16x8*)(B.kb + so);
    const bf16x8 a10 = *(LAS const bf16x8*)(B.ka + so + 2048), a11 = *(LAS const bf16x8*)(B.kb + so + 2048);
    s16x4 vlo[4], vhi[4];
#pragma unroll
    for (int mt = 0; mt < 4; ++mt) { vlo[mt] = vtr(B.v[mt] + so); vhi[mt] = vtr(B.v[mt] + so + 2048); }
    f32x4 s0 = st.c0, s1 = st.c1;
    s0 = __builtin_amdgcn_mfma_f32_16x16x32_bf16(a00, qf.q0, s0, 0, 0, 0); s0 = __builtin_amdgcn_mfma_f32_16x16x32_bf16(a01, qf.q1, s0, 0, 0, 0);
    s1 = __builtin_amdgcn_mfma_f32_16x16x32_bf16(a10, qf.q0, s1, 0, 0, 0); s1 = __builtin_amdgcn_mfma_f32_16x16x32_bf16(a11, qf.q1, s1, 0, 0, 0);
    f32x4 t[2]; t[0] = s0 * C2 + bs.b0; t[1] = s1 * C2 + bs.b1;
    dynmask(t[0], t[1]);
    const float mloc = max2f(max3f(max3f(t[0][0], t[0][1], t[0][2]), t[0][3], t[1][0]), max3f(t[1][1], t[1][2], t[1][3]));
    if (__builtin_amdgcn_ballot_w64(mloc > THR) != 0ull) rescale_up<2>(st, mloc, t);
    f32x4 p0, p1;
#pragma unroll
    for (int e = 0; e < 4; ++e) { p0[e] = __builtin_amdgcn_exp2f(t[0][e]); p1[e] = __builtin_amdgcn_exp2f(t[1][e]); }
    st.l += (((p0[0] + p0[1]) + (p0[2] + p0[3])) + ((p1[0] + p1[1]) + (p1[2] + p1[3])));
    u32x4 pw; pw.x = cvtpk(p0[0], p0[1]); pw.y = cvtpk(p0[2], p0[3]); pw.z = cvtpk(p1[0], p1[1]); pw.w = cvtpk(p1[2], p1[3]);
    const bf16x8 pb = __builtin_bit_cast(bf16x8, pw);
#pragma unroll
    for (int mt = 0; mt < 4; ++mt) {
        const bf16x8 av = (bf16x8){vlo[mt][0], vlo[mt][1], vlo[mt][2], vlo[mt][3], vhi[mt][0], vhi[mt][1], vhi[mt][2], vhi[mt][3]};
        st.acc[mt] = __builtin_amdgcn_mfma_f32_16x16x32_bf16(av, pb, st.acc[mt], 0, 0, 0);
    }
}
template <class MF>
__device__ __forceinline__ void lds_step2(RState& st, const QF& qf, const LdsBases& B, int so, const Bias& bs0, const Bias& bs1, MF dynmask) {
    bf16x8 ka[4], kb[4];
#pragma unroll
    for (int j = 0; j < 4; ++j) { ka[j] = *(LAS const bf16x8*)(B.ka + so + j * 2048); kb[j] = *(LAS const bf16x8*)(B.kb + so + j * 2048); }
    s16x4 vv[4][4];
#pragma unroll
    for (int mt = 0; mt < 4; ++mt)
#pragma unroll
        for (int j = 0; j < 4; ++j) vv[mt][j] = vtr(B.v[mt] + so + j * 2048);
    f32x4 sc[4];
#pragma unroll
    for (int j = 0; j < 4; ++j) sc[j] = __builtin_amdgcn_mfma_f32_16x16x32_bf16(ka[j], qf.q0, (j & 1) ? st.c1 : st.c0, 0, 0, 0);
#pragma unroll
    for (int j = 0; j < 4; ++j) sc[j] = __builtin_amdgcn_mfma_f32_16x16x32_bf16(kb[j], qf.q1, sc[j], 0, 0, 0);
    f32x4 t[4]; t[0] = sc[0] * C2 + bs0.b0; t[1] = sc[1] * C2 + bs0.b1; t[2] = sc[2] * C2 + bs1.b0; t[3] = sc[3] * C2 + bs1.b1;
    dynmask(t[0], t[1]); dynmask(t[2], t[3]);
    const float mloc = max2f(max2f(max3f(max3f(t[0][0], t[0][1], t[0][2]), t[0][3], t[1][0]), max3f(t[1][1], t[1][2], t[1][3])), max2f(max3f(max3f(t[2][0], t[2][1], t[2][2]), t[2][3], t[3][0]), max3f(t[3][1], t[3][2], t[3][3])));
    if (__builtin_amdgcn_ballot_w64(mloc > THR) != 0ull) rescale_up<4>(st, mloc, t);
    f32x4 p[4];
#pragma unroll
    for (int j = 0; j < 4; ++j)
#pragma unroll
        for (int e = 0; e < 4; ++e) p[j][e] = __builtin_amdgcn_exp2f(t[j][e]);
    st.l += ((((p[0][0] + p[0][1]) + (p[0][2] + p[0][3])) + ((p[1][0] + p[1][1]) + (p[1][2] + p[1][3]))) + (((p[2][0] + p[2][1]) + (p[2][2] + p[2][3])) + ((p[3][0] + p[3][1]) + (p[3][2] + p[3][3]))));
    u32x4 pw, pz; pw.x = cvtpk(p[0][0], p[0][1]); pw.y = cvtpk(p[0][2], p[0][3]); pw.z = cvtpk(p[1][0], p[1][1]); pw.w = cvtpk(p[1][2], p[1][3]);
    pz.x = cvtpk(p[2][0], p[2][1]); pz.y = cvtpk(p[2][2], p[2][3]); pz.z = cvtpk(p[3][0], p[3][1]); pz.w = cvtpk(p[3][2], p[3][3]);
    const bf16x8 pb0 = __builtin_bit_cast(bf16x8, pw), pb1 = __builtin_bit_cast(bf16x8, pz);
#pragma unroll
    for (int mt = 0; mt < 4; ++mt) {
        const bf16x8 av0 = (bf16x8){vv[mt][0][0], vv[mt][0][1], vv[mt][0][2], vv[mt][0][3], vv[mt][1][0], vv[mt][1][1], vv[mt][1][2], vv[mt][1][3]};
        const bf16x8 av1 = (bf16x8){vv[mt][2][0], vv[mt][2][1], vv[mt][2][2], vv[mt][2][3], vv[mt][3][0], vv[mt][3][1], vv[mt][3][2], vv[mt][3][3]};
        st.acc[mt] = __builtin_amdgcn_mfma_f32_16x16x32_bf16(av0, pb0, st.acc[mt], 0, 0, 0);
        st.acc[mt] = __builtin_amdgcn_mfma_f32_16x16x32_bf16(av1, pb1, st.acc[mt], 0, 0, 0);
    }
}
__device__ __forceinline__ void finish_r(RState& st, bf16_t* outp, const ZF& zf, int lane) {
    State s2; s2.m = st.m; s2.l = st.l;
#pragma unroll
    for (int mt = 0; mt < 4; ++mt) s2.acc[mt] = st.acc[mt];
    finish(s2, outp, zf, lane);
}
template <int VAR = 0>
__device__ __forceinline__ void na_block_task(bf16_t* proj, const float* rpbs, int bt, LAS char* lds, int wave, bf16_t* dry) {
    int lane = hw_lane();
    const int jt = bt & 3, rb = (bt >> 2) & 7, h = (bt >> 5) & 7, b = bt >> 8;
    const int r0 = 8 * rb, j0 = 16 * jt;
    int w0 = j0 - 8; w0 = w0 < 0 ? 0 : (w0 > 32 ? 32 : w0);
    int Rb = r0 - 4; Rb = Rb < 0 ? 0 : Rb;
    int Re = r0 + 3; Re = Re > 56 ? 56 : Re; Re += 8;
    const int nins = (Re - Rb) * 4;
    bf16_t* pb_ = proj + (size_t)b * SEQ * PLD;
    LAS char* Kimg = lds; LAS char* Vimg = lds + NA_IMG;
    {
        const int kl = lane >> 3, c = lane & 7;
        for (int ii = wave; ii < (VAR == 1 ? 0 : nins); ii += 8) {
            const int key = 8 * ii + kl, rl = key >> 5, col = key & 31;
            const bf16_t* row = pb_ + (size_t)((Rb + rl) * 64 + w0 + col) * PLD + h * 64;
            __builtin_amdgcn_global_load_lds((const unsigned*)(row + PC_KB + ((c ^ fK(key)) * 8)), (LAS unsigned*)(Kimg + ii * 1024), 16, 0, 0);
            __builtin_amdgcn_global_load_lds((const unsigned*)(row + PC_VB + ((c ^ fV(key)) * 8)), (LAS unsigned*)(Vimg + ii * 1024), 16, 0, 0);
        }
    }
    const int q = lane & 15, g = lane >> 4, qq = q >> 2, pp = lane & 3;
    const int r = r0 + wave, j = j0 + q;
    int rs = r - 4; rs = rs < 0 ? 0 : (rs > 56 ? 56 : rs);
    int cs = j - 8; cs = cs < 0 ? 0 : (cs > 48 ? 48 : cs);
    const size_t tq = (size_t)(r * 64 + j);
    const bf16_t* qp = pb_ + tq * PLD + PC_QB + h * 64 + g * 8;
    const bf16x8 bq0 = *(const bf16x8*)qp, bq1 = *(const bf16x8*)(qp + 32);
    const ZF zf = load_z(pb_ + tq * PLD + PC_ZB + h * 64, lane);
    const int col = w0 - j + 32, c4 = col & 3;
    const float* tb = rpbs + (((size_t)c4 * 8 + h) * 15 + (rs - r + 7)) * 64 + (col - c4) + 4 * g;
    const int kc0 = w0 + 4 * g - cs;
    RState st;
    { f32x4 mk0, mk1;
#pragma unroll
      for (int x = 0; x < 4; ++x) { mk0[x] = (unsigned)(kc0 + x) >= 16u ? NEG : 0.f; mk1[x] = (unsigned)(kc0 + 16 + x) >= 16u ? NEG : 0.f; }
      rstate_init(st, mk0, mk1); }
    Bias bs; bs.b0 = *(const f32x4*)tb; bs.b1 = *(const f32x4*)(tb + 16);
    __syncthreads();
    const int kbase = (rs - Rb) * 32;
    const LdsBases Bn = lds_bases(Kimg, Vimg, kbase + q, kbase + 4 * g + qq, lane);
    QF qf; qf.q0 = bq0; qf.q1 = bq1;
    auto mk = [](f32x4&, f32x4&) {};
    Bias b1; b1.b0 = *(const f32x4*)(tb + 64); b1.b1 = *(const f32x4*)(tb + 64 + 16);
#pragma unroll 1
    for (int ks = 0; ks < (VAR == 2 ? 0 : 8); ks += 2) {
        Bias n0 = bs, n1 = b1; if (VAR != 5 && ks + 2 < 8) { const float* tp = tb + (ks + 2) * 64; n0.b0 = *(const f32x4*)tp; n0.b1 = *(const f32x4*)(tp + 16); n1.b0 = *(const f32x4*)(tp + 64); n1.b1 = *(const f32x4*)(tp + 64 + 16); }
        lds_step2(st, qf, Bn, ks * 4096, bs, b1, mk);
        bs = n0; b1 = n1;
    }
    if (VAR != 3) finish_r(st, dry ? dry + (((size_t)bt * 8 + wave) * 16 + q) * 64 : pb_ + tq * PLD + PC_QB + h * 64, zf, lane);
    lds_barrier();
}

template <class PF>
__device__ __forceinline__ void stage_keys(bf16_t* pb_, int h, int kcol, int vcol, int nkeys, PF posfn, LAS char* Kimg, LAS char* Vimg, int lane, int wave) {
    const int kl = lane >> 3, c = lane & 7;
    for (int ii = wave; ii < nkeys / 8; ii += 8) {
        const int key = 8 * ii + kl; int pos = posfn(key); pos = pos < 0 ? 0 : (pos > SEQ - 1 ? SEQ - 1 : pos);
        const bf16_t* row = pb_ + (size_t)pos * PLD + h * 64;
        __builtin_amdgcn_global_load_lds((const unsigned*)(row + kcol + ((c ^ fK(key)) * 8)), (LAS unsigned*)(Kimg + ii * 1024), 16, 0, 0);
        __builtin_amdgcn_global_load_lds((const unsigned*)(row + vcol + ((c ^ fV(key)) * 8)), (LAS unsigned*)(Vimg + ii * 1024), 16, 0, 0);
    }
}
template <int VAR = 0>
__device__ __forceinline__ void dil_block_task(bf16_t* proj, const float* tbl, int bt, LAS char* lds, int wave, bf16_t* dry) {
    int lane = hw_lane();
    const int qb = bt & 15, h = (bt >> 4) & 7, b = bt >> 7;
    const int q = lane & 15, g = lane >> 4, qq = q >> 2;
    const int q0 = qb * 256;
    const int ra = 4 * (wave >> 1) + (wave & 1), rb = ra + 2;
    bf16_t* pb_ = proj + (size_t)b * SEQ * PLD;
    LAS char* Kimg = lds; LAS char* Vimg = lds + DIL_IMG;
    if (VAR != 4) stage_keys(pb_, h, PC_KC, PC_VC, 400, [&](int k) { return q0 - 64 + k; }, Kimg, Vimg, lane, wave);
    QF qa, qbf;
    { const bf16_t* qp = pb_ + (size_t)(q0 + ra + 16 * q) * PLD + PC_QC + h * 64 + g * 8; qa.q0 = *(const bf16x8*)qp; qa.q1 = *(const bf16x8*)(qp + 32);
      qp += 2 * PLD; qbf.q0 = *(const bf16x8*)qp; qbf.q1 = *(const bf16x8*)(qp + 32); }
    const ZF za_ = load_z(pb_ + (size_t)(q0 + ra + 16 * q) * PLD + PC_ZC + h * 64, lane), zb_ = load_z(pb_ + (size_t)(q0 + rb + 16 * q) * PLD + PC_ZC + h * 64, lane);
    RState sa, sb; { const f32x4 z4 = (f32x4){0.f, 0.f, 0.f, 0.f}; rstate_init(sa, z4, z4); rstate_init(sb, z4, z4); }
    LAS float* tbs = (LAS float*)(lds + 2 * DIL_IMG);
    for (int i = wave * 64 + lane; i < 2 * TBW; i += 512) tbs[i] = tbl[(h * 3 + 1) * TBW + i];
    const LAS float* tl2 = tbs + TBW + TBOFF + 4 * g - 16 * q;
    __syncthreads();
    {
        const bool needm = (q0 - 64 < 0) || (q0 + 15 + 383 - 64 > SEQ - 1);
        const LdsBases Ba = lds_bases(Kimg, Vimg, ra + q, ra + 4 * g + qq, lane), Bb = lds_bases(Kimg, Vimg, rb + q, rb + 4 * g + qq, lane);
#pragma unroll 2
        for (int ks = 0; ks < (VAR == 3 ? 0 : 12); ++ks) {
            Bias bs; bs.b0 = *(LAS const f32x4*)(tl2 + ks * 32); bs.b1 = *(LAS const f32x4*)(tl2 + ks * 32 + 16);
            const int u0 = ks * 32;
            auto mk = [&](int pk) { return [=](f32x4& t0, f32x4& t1) { if (needm) {
#pragma unroll
                for (int x = 0; x < 4; ++x) { if ((unsigned)(pk + x) >= (unsigned)SEQ) t0[x] = NEG; if ((unsigned)(pk + 16 + x) >= (unsigned)SEQ) t1[x] = NEG; } } }; };
            lds_step(sa, qa, Ba, ks * 4096, bs, mk(q0 + ra + u0 - 64 + 4 * g));
            lds_step(sb, qbf, Bb, ks * 4096, bs, mk(q0 + rb + u0 - 64 + 4 * g));
        }
    }
    lds_barrier();
    asm volatile("" : "+v"(lane));
#pragma unroll 1
    for (int t = 0; t < (VAR == 2 ? 0 : 2); ++t) {
        const int q = lane & 15, g = lane >> 4, qq = q >> 2;
        const LAS float* tl1 = (LAS const float*)(lds + 2 * DIL_IMG) + TBOFF + 4 * g - 4 * q;
        const int c0 = 2 * t;
        if (VAR != 4) stage_keys(pb_, h, PC_KC, PC_VC, 392, [&](int k) { const int cl = k >= 196 ? 1 : 0; return q0 - 256 + c0 + cl + 4 * (k - 196 * cl); }, Kimg, Vimg, lane, wave);
        const int r = t == 0 ? ra : rb, cl = r & 1, kb = cl * 196 + (r >> 2);
        const bool needm = (q0 - 256 < 0) || (q0 + 15 + 4 * 127 > SEQ - 1);
        const LdsBases Bc = lds_bases(Kimg, Vimg, kb + q, kb + 4 * g + qq, lane);
        __syncthreads();
#pragma unroll 2
        for (int ks = 0; ks < 6; ++ks) {
            Bias bs; bs.b0 = *(LAS const f32x4*)(tl1 + ks * 32); bs.b1 = *(LAS const f32x4*)(tl1 + ks * 32 + 16);
            const int u0 = ks * 32;
            const int pk = q0 + r + 4 * (u0 - 64 + 4 * g);
            auto mk = [=](f32x4& t0, f32x4& t1) { if (needm) {
#pragma unroll
                for (int x = 0; x < 4; ++x) { if ((unsigned)(pk + 4 * x) >= (unsigned)SEQ) t0[x] = NEG; if ((unsigned)(pk + 4 * (16 + x)) >= (unsigned)SEQ) t1[x] = NEG; } } };
            if (t == 0) lds_step(sa, qa, Bc, ks * 4096, bs, mk);
            else        lds_step(sb, qbf, Bc, ks * 4096, bs, mk);
        }
        lds_barrier();
    }
    lane = hw_lane();
    {
    const int q = lane & 15, g = lane >> 4, qq = q >> 2;
    LAS char* wbuf = lds + wave * 16384;
    const char* kbase = (const char*)(pb_ + PC_KC + h * 64); const char* vbase = (const char*)(pb_ + PC_VC + h * 64);
    const int kl = lane >> 3, c = lane & 7;
    const unsigned to0 = (unsigned)(T5TB_F + (h * 4 + (q & 3)) * TBW + TBOFF + 4 * g - (q & ~3));
    struct RowStage { u32x4 k[4], v[4]; };
#pragma unroll 1
    for (int t = 0; t < (VAR == 1 ? 0 : 2); ++t) {
        const int qr = q0 + (t == 0 ? ra : rb);
        auto issue = [&](int ks, RowStage& s, Bias& bsn) {
            const int pbase = qr + 16 * (ks * 32 - 64);
#pragma unroll
            for (int i = 0; i < 4; ++i) { int pos = pbase + 16 * (8 * i + kl); pos = pos < 0 ? 0 : (pos > SEQ - 1 ? SEQ - 1 : pos);
                const unsigned off = (unsigned)pos * (unsigned)(PLD * 2) + (unsigned)c * 16u;
                s.k[i] = *(const u32x4*)(kbase + off); s.v[i] = *(const u32x4*)(vbase + off); }
            bsn.b0 = *(const f32x4*)(tbl + (to0 + (unsigned)(ks * 32))); bsn.b1 = *(const f32x4*)(tbl + (to0 + (unsigned)(ks * 32 + 16)));
        };
        auto compute = [&](int ks, const RowStage& s, const Bias& bsn, RState& st, const QF& qf) {
            LAS char* Kw = wbuf + (ks & 1) * 8192; LAS char* Vw = Kw + 4096;
#pragma unroll
            for (int i = 0; i < 4; ++i) { const int key = 8 * i + kl;
                *(LAS u32x4*)(Kw + key * 128 + ((c ^ fK(key)) * 16)) = s.k[i]; *(LAS u32x4*)(Vw + key * 128 + ((c ^ fV(key)) * 16)) = s.v[i]; }
            const LdsBases Bw = lds_bases(Kw, Vw, q, 4 * g + qq, lane);
            const int pbase = qr + 16 * (ks * 32 - 64); const bool needm = pbase < 0 || pbase + 31 * 16 > SEQ - 1; const int pk = pbase + 64 * g;
            lds_step(st, qf, Bw, 0, bsn, [=](f32x4& t0, f32x4& t1) { if (needm) {
#pragma unroll
                for (int x = 0; x < 4; ++x) { if ((unsigned)(pk + 16 * x) >= (unsigned)SEQ) t0[x] = NEG; if ((unsigned)(pk + 16 * (16 + x)) >= (unsigned)SEQ) t1[x] = NEG; } } });
        };
        RowStage A, B; Bias X, Y;
        issue(0, A, X); issue(1, B, Y);
        compute(0, A, X, sa, qa); issue(2, A, X); compute(1, B, Y, sa, qa); issue(3, B, Y); compute(2, A, X, sa, qa); issue(4, A, X); compute(3, B, Y, sa, qa); compute(4, A, X, sa, qa);
        { const RState ts = sa; sa = sb; sb = ts; const QF tq = qa; qa = qbf; qbf = tq; }
    }
    }
    asm volatile("" : "+v"(lane));
    { const int q = lane & 15;
    finish_r(sa, dry ? dry + (((size_t)bt * 16 + ra) * 16 + q) * 64 : pb_ + (size_t)(q0 + ra + 16 * q) * PLD + PC_QC + h * 64, za_, lane);
    finish_r(sb, dry ? dry + (((size_t)bt * 16 + rb) * 16 + q) * 64 : pb_ + (size_t)(q0 + rb + 16 * q) * PLD + PC_QC + h * 64, zb_, lane); }
    lds_barrier();
}
#undef LAS
}
constexpr int NWAVES = 8;
#define GAS __attribute__((address_space(1)))
#define LAS __attribute__((address_space(3)))
typedef unsigned v4u __attribute__((ext_vector_type(4)));
typedef float f32x4 __attribute__((ext_vector_type(4)));
typedef GAS unsigned gu32;
#define RLX_AGENT __ATOMIC_RELAXED, __HIP_MEMORY_SCOPE_AGENT

constexpr size_t SZ_WINT = (size_t)IN_COLS * DM * 2, SZ_WOUTT = (size_t)DM * MIXW * 2, SZ_GLUT = 512 * 512 * 2, SZ_TM = (size_t)32 * 256 * 512 * 2, SZ_MS = (size_t)32 * 256 * 256 * 2;
constexpr size_t OFF_WOUTT0 = OFF_W, OFF_WOUTT1 = OFF_WOUTT0 + SZ_WOUTT, OFF_WINT1 = OFF_WOUTT1 + SZ_WOUTT, OFF_GLUT1 = OFF_WINT1 + SZ_WINT, OFF_TM1 = OFF_GLUT1 + SZ_GLUT, OFF_MS1 = OFF_TM1 + SZ_TM;
constexpr size_t WS_NEED = OFF_MS1 + SZ_MS;
constexpr size_t DO_WINT0 = 0, DO_GLUT0 = DO_WINT0 + SZ_WINT, DO_TM0 = DO_GLUT0 + SZ_GLUT, DO_MS0 = DO_TM0 + SZ_TM;
static_assert(DO_MS0 + SZ_MS <= (size_t)NTOK * DM * 4, "layer-0 tables fit in d_out");
static_assert(WS_NEED <= (size_t)256 * 1024 * 1024, "workspace map fits 256 MiB");
constexpr size_t CTL_ZERO_BYTES = 262144;
constexpr int CW_BAR = 1024;
constexpr int CW_WORK = 256;
constexpr int CW_YDONE = 512;
constexpr size_t OFF_T5TB = 524288;
constexpr size_t OFF_RPBS = OFF_T5TB + (size_t)(att::T5TB_F + att::T5S_F) * 4;
static_assert(OFF_RPBS + (size_t)att::RPBS_F * 4 <= OFF_SS, "small tables fit in the control MiB");

constexpr int RING_BYTES = 131072;
constexpr int MISC_OFF = RING_BYTES;
constexpr int LDS_BYTES = 147456;
static_assert(NWAVES * att::WAVE_LDS <= RING_BYTES && 2 * att::NA_IMG <= RING_BYTES && 2 * att::DIL_IMG + 2 * att::TBW * 4 <= RING_BYTES, "attention LDS");

#define XB_TMO      128
#define XB_XCNT(j)  (256  + 64 * (j))
#define XB_XSUB(j)  (1280 + 64 * (j))
#define XB_XGEN(j)  (2304 + 64 * (j))
#define XB_TOP      3328
#define XB_TOPGEN   3392
#define XCD_BAR_WORDS 3456
#define XB_SPIN_CAP (1u << 18)
__device__ __forceinline__ unsigned xb_ld(unsigned* p)              { return __hip_atomic_load(p, __ATOMIC_RELAXED, __HIP_MEMORY_SCOPE_AGENT); }
__device__ __forceinline__ unsigned xb_add(unsigned* p, unsigned v) { return __hip_atomic_fetch_add(p, v, __ATOMIC_RELAXED, __HIP_MEMORY_SCOPE_AGENT); }
__device__ __forceinline__ unsigned xb_xcc_id() { return (unsigned)__builtin_amdgcn_s_getreg((3 << 11) | 20) & 0xFu; }
#define XB_SPIN(cond, bar) do { unsigned _sp = 0; while (cond) { __builtin_amdgcn_s_sleep(1); \
    if ((++_sp & 255u) == 0u) { if (xb_ld(&(bar)[XB_TMO])) break; if (_sp > XB_SPIN_CAP) { atomicAdd(&(bar)[XB_TMO], 1u); break; } } } } while (0)
struct XcdBarrier { unsigned* bar; unsigned x; volatile LAS unsigned* st; };
__device__ __forceinline__ XcdBarrier xcd_barrier_post(unsigned* bar, volatile LAS unsigned* st, int wave_s) {
    XcdBarrier b; b.bar = bar; b.x = xb_xcc_id(); b.st = st;
    if (wave_s == 0 && hw_lane() == 0) (void)xb_add(&bar[XB_XCNT(b.x)], 1u);
    return b;
}
__device__ __forceinline__ void xcd_barrier_complete(unsigned* bar, unsigned x, unsigned& nloc, unsigned& nx) {
    const unsigned G = gridDim.x * gridDim.y * gridDim.z;
    unsigned sum, cnt, mine, sp = 0u;
    for (;;) {
        sum = 0u; cnt = 0u; mine = 0u;
#pragma unroll
        for (unsigned j = 0; j < 16; ++j) { const unsigned c = xb_ld(&bar[XB_XCNT(j)]); sum += c; cnt += (c > 0u) ? 1u : 0u; mine = (j == x) ? c : mine; }
        if (sum == G) break;
        __builtin_amdgcn_s_sleep(1);
        if ((++sp & 255u) == 0u) { if (xb_ld(&bar[XB_TMO])) break; if (sp > XB_SPIN_CAP) { atomicAdd(&bar[XB_TMO], 1u); break; } }
    }
    nloc = mine > 0u ? mine : 1u; nx = cnt > 0u ? cnt : 1u;
}
__device__ __forceinline__ void xcd_barrier(const XcdBarrier& b, int wave_s) {
    asm volatile("s_waitcnt vmcnt(0)" ::: "memory");
    __syncthreads();
    if (wave_s == 0 && hw_lane() == 0) {
        unsigned* bar = b.bar;
        __builtin_amdgcn_s_waitcnt(0);
        unsigned nloc = b.st[0], nx = b.st[1];
        if (nloc == 0u) { xcd_barrier_complete(bar, b.x, nloc, nx); b.st[0] = nloc; b.st[1] = nx; }
        const unsigned old = xb_add(&bar[XB_XSUB(b.x)], 1u);
        const unsigned gen = old / nloc;
        if (old + 1u == (gen + 1u) * nloc) {
            __builtin_amdgcn_fence(__ATOMIC_RELEASE, "agent");
            asm volatile("s_waitcnt vmcnt(0)" ::: "memory");
            const unsigned og = xb_add(&bar[XB_TOP], 1u);
            const unsigned tg = og / nx;
            if (og + 1u == (tg + 1u) * nx) xb_add(&bar[XB_TOPGEN], 1u);
            else XB_SPIN(xb_ld(&bar[XB_TOPGEN]) == tg, bar);
            __builtin_amdgcn_fence(__ATOMIC_ACQUIRE, "agent");
            xb_add(&bar[XB_XGEN(b.x)], 1u);
            asm volatile("s_waitcnt vmcnt(0)" ::: "memory");
        } else {
            XB_SPIN(xb_ld(&bar[XB_XGEN(b.x)]) == gen, bar);
            __builtin_amdgcn_fence(__ATOMIC_ACQUIRE, "agent");
            asm volatile("s_waitcnt vmcnt(0)" ::: "memory");
        }
    }
    __syncthreads();
}

struct Args { const float* in[17]; float* out; unsigned char* ws; int ph_lo, ph_hi; int li, skip; };

__device__ __forceinline__ float wave_sum(float v) {
#pragma unroll
    for (int o = 1; o < 64; o <<= 1) v += __shfl_xor(v, o);
    return v;
}
__device__ __forceinline__ unsigned pk2(float lo, float hi) { return f2bf(lo) | (f2bf(hi) << 16); }

__device__ __forceinline__ void p0_transpose_item(const float* W, int K, int Nsrc, bf16_t* WT, int k0, int n0s, int n0d, const float* kscale, LAS float* scr, int lane) {
    float tv[32];
#pragma unroll
    for (int i = 0; i < 32; ++i) { const int kk = 2 * i + (lane >> 5); tv[i] = W[(size_t)(k0 + kk) * Nsrc + n0s + (lane & 31)]; }
    const float ksc = kscale ? kscale[k0 + lane] : 1.f;
#pragma unroll
    for (int i = 0; i < 32; ++i) { const int kk = 2 * i + (lane >> 5); scr[kk * 33 + (lane & 31)] = tv[i] * __shfl(ksc, kk); }
    asm volatile("s_waitcnt lgkmcnt(0)" ::: "memory");
    const int c = lane & 7;
#pragma unroll
    for (int j = 0; j < 4; ++j) { const int n = (lane >> 3) + 8 * j; const LAS float* s = scr + (8 * c) * 33 + n;
        v4u o; o.x = pk2(s[0 * 33], s[1 * 33]); o.y = pk2(s[2 * 33], s[3 * 33]); o.z = pk2(s[4 * 33], s[5 * 33]); o.w = pk2(s[6 * 33], s[7 * 33]);
        *(v4u*)(WT + (size_t)(n0d + n) * K + k0 + 8 * c) = o; }
    asm volatile("s_waitcnt lgkmcnt(0)" ::: "memory");
}
__device__ __forceinline__ void p0_xrow(const float* xrow, bf16_t* orow, float* ssrow, int lane) {
    const f32x4* xr = (const f32x4*)xrow + lane;
    f32x4 v[4]; float s = 0.f;
#pragma unroll
    for (int j = 0; j < 4; ++j) { v[j] = xr[64 * j]; s += (v[j].x * v[j].x + v[j].y * v[j].y) + (v[j].z * v[j].z + v[j].w * v[j].w); }
    s = wave_sum(s);
    unsigned long long* o8 = (unsigned long long*)orow + lane;
#pragma unroll
    for (int j = 0; j < 4; ++j) o8[64 * j] = (unsigned long long)pk2(v[j].x, v[j].y) | ((unsigned long long)pk2(v[j].z, v[j].w) << 32);
    if (lane < 16) ssrow[lane] = lane == 0 ? s : 0.f;
}
__device__ __forceinline__ int t5_bucket_dev(int rel) {
    const int n = rel < 0 ? -rel : rel;
    const int large = 8 + (n >= 15) + (n >= 27) + (n >= 50) + (n >= 91) + (n >= 166) + (n >= 305) + (n >= 559);
    return (rel > 0 ? 16 : 0) + (n < 8 ? n : large);
}
__device__ __forceinline__ void p0_ssm_tables(const Args& a, int l, int g, int d, bf16_t* TM, bf16_t* Ms, LAS float* scr, int wave_s) {
    int tid = wave_s * 64 + hw_lane(); asm volatile("" : "+v"(tid));
    LAS float* pw = scr;
    LAS float* fc = pw + 64 * 17 * 2;
    LAS float* Cc = fc + 2 * 64 * 2;
    LAS float* Bb = Cc + 2048;
    LAS float* C2 = Bb + 2048;
    LAS float* B2 = C2 + 2048;
    LAS float* Kt = B2 + 2048;
    const float* lam_re = a.in[4]; const float* lam_im = a.in[5]; const float* log_dt = a.in[6];
    const float* b_re = a.in[7]; const float* b_im = a.in[8]; const float* c_re = a.in[9]; const float* c_im = a.in[10]; const float* dskip = a.in[11];
    const int pg = (l * 2 + d) * 32 + g, pg2 = (l * 2 + (1 - d)) * 32 + g;
    if (tid < 128) {
        const int o = tid >> 6, p = tid & 63, pgx = o == 0 ? pg : pg2;
        const float lre = lam_re[pgx * 64 + p], lim = lam_im[pgx * 64 + p], dt = expf(log_dt[pgx]);
        const float er = expf(lre * dt), lbr = er * cosf(lim * dt), lbi = er * sinf(lim * dt);
        const float nr = lbr - 1.f, ni = lbi, den = lre * lre + lim * lim;
        fc[(o * 64 + p) * 2] = (nr * lre + ni * lim) / den; fc[(o * 64 + p) * 2 + 1] = (ni * lre - nr * lim) / den;
        if (o == 0) { float wr = 1.f, wi = 0.f;
            for (int k = 0; k <= 16; ++k) { pw[(p * 17 + k) * 2] = wr; pw[(p * 17 + k) * 2 + 1] = wi; const float t = wr * lbr - wi * lbi; wi = wr * lbi + wi * lbr; wr = t; } }
    }
    __syncthreads();
    for (int i = tid; i < 1024; i += NWAVES * 64) {
        Cc[i * 2] = c_re[(size_t)pg * 1024 + i]; Cc[i * 2 + 1] = c_im[(size_t)pg * 1024 + i];
        { const int p = i >> 4; const float br = b_re[(size_t)pg * 1024 + i], bi = b_im[(size_t)pg * 1024 + i], fr = fc[p * 2], fi = fc[p * 2 + 1];
          Bb[i * 2] = fr * br - fi * bi; Bb[i * 2 + 1] = fr * bi + fi * br; }
        if (d == 0) {
            C2[i * 2] = c_re[(size_t)pg2 * 1024 + i]; C2[i * 2 + 1] = c_im[(size_t)pg2 * 1024 + i];
            const int p = i >> 4; const float br = b_re[(size_t)pg2 * 1024 + i], bi = b_im[(size_t)pg2 * 1024 + i], fr = fc[(64 + p) * 2], fi = fc[(64 + p) * 2 + 1];
            B2[i * 2] = fr * br - fi * bi; B2[i * 2 + 1] = fr * bi + fi * br; }
    }
    __syncthreads();
    {
        const int kh = tid >> 8, c = (tid >> 4) & 15, cp = tid & 15;
        float Kk[8];
#pragma unroll
        for (int k = 0; k < 8; ++k) Kk[k] = 0.f;
        float k0o = 0.f;
#pragma unroll 2
        for (int p = 0; p < 64; ++p) {
            const float Cr = Cc[(c * 64 + p) * 2], Ci = Cc[(c * 64 + p) * 2 + 1], br = Bb[(p * 16 + cp) * 2], bi = Bb[(p * 16 + cp) * 2 + 1];
            const LAS float* pwp = pw + (p * 17 + kh * 8) * 2;
#pragma unroll
            for (int k = 0; k < 8; ++k) { const float pr = pwp[2 * k], pi = pwp[2 * k + 1]; const float wr = Cr * pr - Ci * pi, wi = Cr * pi + Ci * pr; Kk[k] += wr * br - wi * bi; }
            if (d == 0 && kh == 0) k0o += C2[(c * 64 + p) * 2] * B2[(p * 16 + cp) * 2] - C2[(c * 64 + p) * 2 + 1] * B2[(p * 16 + cp) * 2 + 1];
        }
#pragma unroll
        for (int k = 0; k < 8; ++k) Kt[(kh * 8 + k) * 256 + c * 16 + cp] = Kk[k];
        if (d == 0 && kh == 0) Kt[16 * 256 + c * 16 + cp] = k0o;
    }
    __syncthreads();
    for (int idx = tid; idx < 256 * 128; idx += NWAVES * 64) {
        const int row = idx >> 7, col = (idx & 127) * 2, t = row >> 4, cc = row & 15, s_ = col >> 4, c2 = col & 15;
        const int k = d == 0 ? t - s_ : s_ - t;
        if (k < 0 || (d == 1 && k == 0)) continue;
        float v0 = Kt[k * 256 + cc * 16 + c2], v1 = Kt[k * 256 + cc * 16 + c2 + 1];
        if (k == 0) { v0 += Kt[16 * 256 + cc * 16 + c2]; v1 += Kt[16 * 256 + cc * 16 + c2 + 1];
            const float dd = dskip[l * 512 + g * 16 + cc]; if (c2 == cc) v0 += dd; if (c2 + 1 == cc) v1 += dd; }
        *(unsigned*)(TM + (size_t)row * 512 + col) = pk2(v0, v1);
    }
    {
        const int p = tid & 63, cq = tid >> 6;
#pragma unroll
        for (int h2 = 0; h2 < 2; ++h2) { const int c = cq + 8 * h2; const float Cr = Cc[(c * 64 + p) * 2], Ci = Cc[(c * 64 + p) * 2 + 1];
#pragma unroll 4
            for (int e = 1; e <= 16; ++e) { const float pr = pw[(p * 17 + e) * 2], pi = pw[(p * 17 + e) * 2 + 1]; const float wr = Cr * pr - Ci * pi, wi = Cr * pi + Ci * pr;
                const int t = d == 0 ? e - 1 : 16 - e; bf16_t* rowp = TM + (size_t)(t * 16 + c) * 512 + 256 + d * 128 + p;
                rowp[0] = (bf16_t)f2bf(wr); rowp[64] = (bf16_t)f2bf(-wi); } }
    }
    {
        const int sc = tid & 255, e = sc >> 4, cp = sc & 15, ph = tid >> 8, s_ = d == 0 ? 15 - e : e;
#pragma unroll 4
        for (int it = 0; it < 32; ++it) { const int p = ph + 2 * it; const float pr = pw[(p * 17 + e) * 2], pi = pw[(p * 17 + e) * 2 + 1], br = Bb[(p * 16 + cp) * 2], bi = Bb[(p * 16 + cp) * 2 + 1];
            Ms[(size_t)(d * 128 + p) * 256 + s_ * 16 + cp] = (bf16_t)f2bf(pr * br - pi * bi); Ms[(size_t)(d * 128 + 64 + p) * 256 + s_ * 16 + cp] = (bf16_t)f2bf(pr * bi + pi * br); }
    }
    __syncthreads();
}

constexpr int N_PHASES = 8;
__global__ void __launch_bounds__(NWAVES * 64, 2) mega_fwd(Args args) {
    extern __shared__ __attribute__((aligned(16))) unsigned char lds_raw[];
    LAS unsigned char* lds = (LAS unsigned char*)lds_raw;
    volatile LAS unsigned* MISC = (volatile LAS unsigned*)(lds + MISC_OFF);
    const int wave_s = __builtin_amdgcn_readfirstlane((int)threadIdx.x >> 6);
#define PHASE_LANES int lane = hw_lane(); asm volatile("" : "+v"(lane)); const int wave = wave_s; const int ptid = wave * 64 + lane; (void)ptid;
    const int G = gridDim.x; int vcu; { const int bx = blockIdx.x; vcu = (G % 8 == 0) ? (bx % 8) * (G / 8) + bx / 8 : bx; }
    unsigned char* ws = args.ws; unsigned char* dout = (unsigned char*)args.out;
    unsigned* ctl = (unsigned*)(ws + OFF_CTL);
    if (wave_s == 0) { const int l0 = hw_lane(); if (l0 < 32) MISC[l0] = 0u; }
    __syncthreads();
    XcdBarrier bar = xcd_barrier_post(ctl + CW_BAR + args.li * XCD_BAR_WORDS, MISC + 8, wave_s);
    const int lo = args.ph_lo, hi = args.ph_hi;
#ifndef REP_P0
#define REP_P0 1
#endif
#ifndef REP_INPROJ
#define REP_INPROJ 1
#endif
#ifndef REP_EG
#define REP_EG 1
#endif
#ifndef DRY_NA
#define DRY_NA 0
#endif
#ifndef DRY_DIL
#define DRY_DIL 0
#endif
#ifndef REP_SCAN
#define REP_SCAN 1
#endif
#ifndef REP_Y
#define REP_Y 1
#endif
#ifndef DRYVAR
#define DRYVAR 0
#endif
#ifndef CT_SKIP
#define CT_SKIP 0
#endif
#ifndef PHASE_MASK
#define PHASE_MASK 0xff
#endif
#define INR(k) (lo <= (k) && (k) < hi)
#define IN(k) (((PHASE_MASK >> ((k) == 7 ? 4 : (k))) & 1) && INR(k))
#define INL(j) (((PHASE_MASK >> ((j) + 1)) & 1) && INR(pb + (j)))
#ifndef REP_BAR
#define REP_BAR 1
#endif
#define SEAM(k) do { if (INR(k) && INR((k) + 1)) for (int rb_ = 0; rb_ < REP_BAR; ++rb_) xcd_barrier(bar, wave_s); } while (0)

    bf16_t* proj = (bf16_t*)(ws + OFF_PROJ); bf16_t* xag = (bf16_t*)(ws + OFF_XAG); bf16_t* xb = (bf16_t*)(ws + OFF_XB); float* Ebuf = (float*)(ws + OFF_XB);
    bf16_t* Gb = (bf16_t*)(ws + OFF_G); float* sspart = (float*)(ws + OFF_SS);
    float* rpbs = (float*)(ws + OFF_RPBS); float* t5tb = (float*)(ws + OFF_T5TB);
    const int dry = (args.skip >> 8) & 1; bf16_t* dryp = dry ? Gb : nullptr;

    if (IN(0)) for (int rep_ = 0; rep_ < REP_P0; ++rep_) {
        PHASE_LANES
        const int NTB = 128;
        for (int ti = vcu; ti < NTB; ti += G) {
            const int l = ti >> 6, g = (ti >> 1) & 31, d = ti & 1;
            bf16_t* TM = (bf16_t*)(l == 0 ? dout + DO_TM0 : ws + OFF_TM1) + (size_t)g * 256 * 512;
            bf16_t* Ms = (bf16_t*)(l == 0 ? dout + DO_MS0 : ws + OFF_MS1) + (size_t)g * 256 * 256;
            p0_ssm_tables(args, l, g, d, TM, Ms, (LAS float*)lds, wave_s);
        }
        {
            const float* rpb = args.in[14]; const float* t5 = args.in[15];
            for (int i = vcu * NWAVES * 64 + ptid; i < att::RPBS_F; i += G * NWAVES * 64) {
                const int ii = i & 63, rr = (i >> 6) % 15, h = (i / (64 * 15)) & 7, c = (i / (64 * 15 * 8)) & 3, l = i / (64 * 15 * 8 * 4); const int cr = ii + c - 17;
                rpbs[i] = (ii + c < 64 && cr >= 0 && cr <= 30) ? rpb[(((size_t)l * 8 + h) * 15 + rr) * 31 + cr] * 1.4426950408889634f : 0.f; }
            for (int i = vcu * NWAVES * 64 + ptid; i < att::T5TB_F + att::T5S_F; i += G * NWAVES * 64) {
                int h, pat, idx;
                if (i < att::T5TB_F) { idx = i % att::TBW; pat = (i / att::TBW) % 3; h = i / (3 * att::TBW); }
                else { const int i2 = i - att::T5TB_F; const int c = (i2 / att::TBW) & 3; h = i2 / (4 * att::TBW); pat = 0; idx = i2 % att::TBW - c; }
                const int w = idx - att::TBOFF; const int d = pat == 0 ? 16 : (pat == 1 ? 4 : 1);
                t5tb[i] = (idx >= 0 && w >= 0 && w <= 128) ? t5[t5_bucket_dev(d * (w - 64)) * 8 + h] * 1.4426950408889634f : att::NEG; }
        }
        {
            LAS float* scr = (LAS float*)(lds + wave * 16384);
            constexpr int I_IN = (DM / 64) * (IN_COLS / 32), I_OUT = (MIXW / 64) * (DM / 32), I_GLU = (512 / 64) * (512 / 32), I_L = I_IN + I_OUT + I_GLU, I_TOT = 2 * I_L + NTOK;
            const int NW_ALL = G * NWAVES, gw = vcu * NWAVES + wave; const bool tblk = vcu < NTB && G > NTB;
            const int NW2 = tblk ? 0 : (G - NTB) * NWAVES, gw2 = (vcu - NTB) * NWAVES + wave;
            const int P1N = G > NTB ? 9 : (I_TOT + NW_ALL - 1) / NW_ALL, I_P1 = P1N * NW_ALL < I_TOT ? P1N * NW_ALL : I_TOT;
            for (int pass = 0; pass < 2; ++pass) {
                const int i0 = pass == 0 ? gw : I_P1 + gw2, i1 = pass == 0 ? I_P1 : I_TOT, st = pass == 0 ? NW_ALL : NW2;
                if (pass == 1 && NW2 == 0) break;
                for (int it = i0; it < i1; it += st) {
                    if (it >= 2 * I_L) { const int mrow = it - 2 * I_L; p0_xrow(args.in[0] + (size_t)mrow * DM, xb + (size_t)mrow * DM, sspart + (size_t)mrow * 16, lane); continue; }
                    const int l = it / I_L; int r = it % I_L;
                    if (r < I_IN) { const int nblk = IN_COLS / 32, kb = r / nblk, nb = r % nblk;
                        p0_transpose_item(args.in[2] + (size_t)l * DM * IN_COLS, DM, IN_COLS, (bf16_t*)(l == 0 ? dout + DO_WINT0 : ws + OFF_WINT1), 64 * kb, inproj_src_col(32 * nb), 32 * nb, args.in[1] + l * DM, scr, lane); continue; }
                    r -= I_IN;
                    if (r < I_OUT) { const int nblk = DM / 32, kb = r / nblk, nb = r % nblk;
                        p0_transpose_item(args.in[3] + (size_t)l * MIXW * DM, MIXW, DM, (bf16_t*)(ws + (l == 0 ? OFF_WOUTT0 : OFF_WOUTT1)), 64 * kb, 32 * nb, 32 * nb, nullptr, scr, lane); continue; }
                    r -= I_OUT;
                    { const int nblk = 512 / 32, kb = r / nblk, nb = r % nblk;
                        p0_transpose_item(args.in[12] + (size_t)l * 512 * 512, 512, 512, (bf16_t*)(l == 0 ? dout + DO_GLUT0 : ws + OFF_GLUT1), 64 * kb, 32 * nb, 32 * nb, nullptr, scr, lane); }
                }
            }
        }
    }
    SEAM(0);

    for (int l = 0; l < DEPTH; ++l) {
        const int pb = 1 + 3 * l;
        const bf16_t* WinT = (const bf16_t*)(l == 0 ? dout + DO_WINT0 : ws + OFF_WINT1);
        const bf16_t* WoutT = (const bf16_t*)(ws + (l == 0 ? OFF_WOUTT0 : OFF_WOUTT1));
        const bf16_t* GluT = (const bf16_t*)(l == 0 ? dout + DO_GLUT0 : ws + OFF_GLUT1);
        const bf16_t* TM = (const bf16_t*)(l == 0 ? dout + DO_TM0 : ws + OFF_TM1);
        const bf16_t* Ms = (const bf16_t*)(l == 0 ? dout + DO_MS0 : ws + OFF_MS1);
        if (INL(0)) for (int rep_ = 0; rep_ < REP_INPROJ; ++rep_) {
            pg8::Gemm gm{xb, WinT, DM, DM, DM, 0, 0}; pg8::StaticOrder S; S.init(NTOK, IN_COLS, G, (int)blockIdx.x);
            pg8::EpiInProj E{sspart, proj, xag};
            pg8::gemm_phase<pg8::EpiInProj, pg8::StaticOrder>(lds, gm, S, E, wave_s);
        }
        SEAM(pb + 0);
        if (INL(1)) {
            constexpr int NCHAIN = 128;
            if (!(args.skip & 1)) for (int cid = vcu; cid < NCHAIN; cid += G) {
                const int g = cid >> 2, b = cid & 3;
                { pg8::Gemm gm{xag, Ms, 512, 256, 256, (size_t)NCHUNK_TOT * 512, (size_t)256 * 256}; pg8::OneUnit S; S.u = pg8::Unit{b, 0, g};
                  pg8::EpiE E{Ebuf};
                  pg8::gemm_phase<pg8::EpiE, pg8::OneUnit>(lds, gm, S, E, wave_s); }
                asm volatile("s_waitcnt vmcnt(0)" ::: "memory"); __syncthreads();
                if (!(args.skip & 0x10)) {
                    PHASE_LANES
                    const float* lam_re = args.in[4]; const float* lam_im = args.in[5]; const float* log_dt = args.in[6];
                    LAS float* sx = (LAS float*)lds;
#pragma unroll 1
                    for (int d = 0; d < 2; ++d) {
                        const int p = lane, pg = (l * 2 + d) * 32 + g;
                        const float lre = lam_re[pg * 64 + p], lim = lam_im[pg * 64 + p], dt = expf(log_dt[pg]);
                        const float er = expf(lre * dt); float ar = er * cosf(lim * dt), ai = er * sinf(lim * dt);
#pragma unroll
                        for (int i = 0; i < 4; ++i) { const float t = ar * ar - ai * ai; ai = 2.f * ar * ai; ar = t; }
                        const float* Ep = Ebuf + ((size_t)g * NCHUNK_TOT + b * NCHUNK) * 256 + d * 128 + p;
                        bf16_t* Cp = xag + ((size_t)g * NCHUNK_TOT + b * NCHUNK) * 512 + 256 + d * 128 + p;
                        float er_[32], ei_[32];
#pragma unroll
                        for (int i = 0; i < 32; ++i) { const int s = wave * 32 + i, k = d == 0 ? s : NCHUNK - 1 - s; er_[i] = Ep[(size_t)k * 256]; ei_[i] = Ep[(size_t)k * 256 + 64]; }
                        float cr = 0.f, ci = 0.f;
#pragma unroll
                        for (int i = 0; i < 32; ++i) { const float xr = er_[i], xi = ei_[i]; er_[i] = cr; ei_[i] = ci; const float t = ar * cr - ai * ci + xr; ci = ar * ci + ai * cr + xi; cr = t; }
                        sx[(wave * 64 + lane) * 2] = cr; sx[(wave * 64 + lane) * 2 + 1] = ci;
                        float a32r = ar, a32i = ai;
#pragma unroll
                        for (int i = 0; i < 5; ++i) { const float t = a32r * a32r - a32i * a32i; a32i = 2.f * a32r * a32i; a32r = t; }
                        __syncthreads();
                        float inr = 0.f, ini = 0.f;
                        for (int j = 0; j < wave; ++j) { const float tr = sx[(j * 64 + lane) * 2], ti = sx[(j * 64 + lane) * 2 + 1]; const float t = a32r * inr - a32i * ini + tr; ini = a32r * ini + a32i * inr + ti; inr = t; }
                        float pr = inr, pi = ini;
#pragma unroll
                        for (int i = 0; i < 32; ++i) { const int s = wave * 32 + i, k = d == 0 ? s : NCHUNK - 1 - s;
                            Cp[(size_t)k * 512] = (bf16_t)f2bf(er_[i] + pr); Cp[(size_t)k * 512 + 64] = (bf16_t)f2bf(ei_[i] + pi);
                            const float t = ar * pr - ai * pi; pi = ar * pi + ai * pr; pr = t; }
                        __syncthreads();
                    }
                }
                asm volatile("s_waitcnt vmcnt(0)" ::: "memory"); __syncthreads();
                if (!(args.skip & 0x20)) { pg8::Gemm gm{xag, TM, 512, 512, 512, (size_t)NCHUNK_TOT * 512, (size_t)256 * 512}; pg8::OneUnit S; S.u = pg8::Unit{b, 0, g};
                  pg8::EpiY E{Gb};
                  pg8::gemm_phase<pg8::EpiY, pg8::OneUnit>(lds, gm, S, E, wave_s); }
                asm volatile("s_waitcnt vmcnt(0)" ::: "memory"); __syncthreads();
                if (wave_s == 0 && hw_lane() == 0) {
                    __hip_atomic_fetch_add(ctl + CW_YDONE + (l * 4 + b) * 64, 1u, __ATOMIC_RELAXED, __HIP_MEMORY_SCOPE_AGENT);
                }
            }
            {
                const float* rp = rpbs + (size_t)l * 4 * 8 * 15 * 64;
                int nNA, naB, naS, nDI, diB, diS, nGL, glB, glS;
                if (G == 2 * NCHAIN) {
                    const int x = (vcu & (NCHAIN - 1)) >> 5, j = vcu & 31;
                    if (vcu < NCHAIN) { nNA = 7; naB = x * 224 + j; naS = 32; nDI = 1; diB = x * 32 + j; diS = 32; nGL = 0; glB = 0; glS = 1; }
                    else { nNA = 1; naB = 896 + x * 32 + j; naS = 32; nDI = 3; diB = NCHAIN + x * 96 + j; diS = 32; nGL = 1; glB = vcu - NCHAIN; glS = 1; }
                } else { nNA = (1024 - vcu + G - 1) / G; naB = vcu; naS = G; nDI = (512 - vcu + G - 1) / G; diB = vcu; diS = G; nGL = (128 - vcu + G - 1) / G; glB = vcu; glS = G; }
#ifdef NAVAR
                if (dry) { for (int i = 0; i < ((args.skip & 2) ? 0 : nNA); ++i) att::na_block_task<NAVAR>(proj, rp, naB + i * naS, (LAS char*)lds, wave_s, dryp); } else
#endif
#pragma unroll 1
                for (int i = 0; i < ((args.skip & 2) ? 0 : nNA); ++i) att::na_block_task(proj, rp, naB + i * naS, (LAS char*)lds, wave_s, dryp);
#ifdef DILVAR
                if (dry) { for (int i = 0; i < ((args.skip & 4) ? 0 : nDI); ++i) att::dil_block_task<DILVAR>(proj, t5tb, diB + i * diS, (LAS char*)lds, wave_s, dryp); } else
#endif
#pragma unroll 1
                for (int i = 0; i < ((args.skip & 4) ? 0 : nDI); ++i) att::dil_block_task(proj, t5tb, diB + i * diS, (LAS char*)lds, wave_s, dryp);
#pragma unroll 1
                for (int i = 0; i < ((args.skip & 8) ? 0 : nGL); ++i) {
                    const int u = glB + i * glS, bq = u >> 5;
                    if (wave_s == 0) {
                        unsigned* cw = ctl + CW_YDONE + (l * 4 + bq) * 64; unsigned sp = 0;
                        while (__builtin_amdgcn_readfirstlane(__hip_atomic_load(cw, __ATOMIC_RELAXED, __HIP_MEMORY_SCOPE_AGENT)) < 32u) { __builtin_amdgcn_s_sleep(2); if (++sp > (1u << 22)) break; }
                    }
                    __syncthreads();
                    pg8::Gemm gm{Gb, GluT, 512, 512, 512, 0, 0}; pg8::OneUnit S; S.u = pg8::Unit{u >> 1, u & 1, 0};
                    pg8::EpiGlu E{Gb, args.in[13] + l * 512, proj, dry};
                    pg8::gemm_phase<pg8::EpiGlu, pg8::OneUnit>(lds, gm, S, E, wave_s);
                    __syncthreads();
                }
            }
        }
        SEAM(pb + 1);
        if (INL(2)) {
            pg8::Gemm gm{proj, WoutT, PLD, MIXW, MIXW, 0, 0}; pg8::StaticOrder S; S.init(NTOK, DM, G, (int)blockIdx.x);
            pg8::EpiOutProj E{l == 0 ? args.in[0] : args.out, args.out, xb, sspart, l == 0 ? 1 : 0, dry};
            pg8::gemm_phase<pg8::EpiOutProj, pg8::StaticOrder>(lds, gm, S, E, wave_s);
        }
        SEAM(pb + 2);
    }
    if (IN(7)) {
        PHASE_LANES
        const float* fg = args.in[16];
        const int gw = vcu * NWAVES + wave, NGW = G * NWAVES;
        for (int m = gw; m < NTOK; m += NGW) {
            const f32x4* sp = (const f32x4*)(sspart + (size_t)m * 16);
            const f32x4 s0 = sp[0], s1 = sp[1], s2 = sp[2], s3 = sp[3];
            const float ss = (((s0[0] + s0[1]) + (s0[2] + s0[3])) + ((s1[0] + s1[1]) + (s1[2] + s1[3]))) + (((s2[0] + s2[1]) + (s2[2] + s2[3])) + ((s3[0] + s3[1]) + (s3[2] + s3[3])));
            const float rinv = rsqrtf(ss * (1.0f / DM) + RMS_EPS);
            f32x4* xr = (f32x4*)(args.out + (size_t)m * DM) + lane;
#pragma unroll
            for (int j = 0; j < 4; ++j) { const f32x4 gv = *((const f32x4*)fg + lane + 64 * j); const f32x4 ov = xr[64 * j] * rinv * gv; if (!dry) xr[64 * j] = ov; else asm volatile("" :: "v"(ov)); }
        }
    }
#undef IN
#undef INL
#undef INR
#undef SEAM
}
#ifndef EXTRA_PLAN
#define EXTRA_PLAN
#endif
#define HOST_PLAN launch_mega(d_in, d_out, d_ws, stream, 0, N_PHASES, 0, 0); EXTRA_PLAN
static int g_grid = 0;
static void launch_mega(void* const* d_in, void* d_out, void* d_ws, hipStream_t stream, int lo, int hi, int li, int skip) {
    Args a{};
    for (int i = 0; i < 17; ++i) a.in[i] = (const float*)d_in[i];
    a.out = (float*)d_out; a.ws = (unsigned char*)d_ws; a.ph_lo = lo; a.ph_hi = hi; a.li = li; a.skip = skip;
    hipLaunchKernelGGL(mega_fwd, dim3(g_grid), dim3(NWAVES * 64), LDS_BYTES, stream, a);
    const hipError_t le = hipPeekAtLastError();
    if (le != hipSuccess) fprintf(stderr, "kernel_launch: launch failed: %s (grid %d)\n", hipGetErrorName(le), g_grid);
}
extern "C" void kernel_launch(void* const* d_in, const int* in_sizes, int n_in, void* d_out, int out_size, void* d_ws, size_t ws_size, hipStream_t stream) {
    if (g_grid == 0) {
        if (n_in != 17 || in_sizes[0] != NTOK * DM || out_size != NTOK * DM || ws_size < WS_NEED) { fprintf(stderr, "kernel_launch: unexpected shapes (n_in %d in0 %d out %d ws %zu need %zu)\n", n_in, n_in > 0 ? in_sizes[0] : -1, out_size, ws_size, (size_t)WS_NEED); g_grid = -1; return; }
        int dev = 0, cus = 0, per_cu = 0;
        if (hipGetDevice(&dev) != hipSuccess || hipDeviceGetAttribute(&cus, hipDeviceAttributeMultiprocessorCount, dev) != hipSuccess) { g_grid = -1; return; }
        if (hipFuncSetAttribute((const void*)mega_fwd, hipFuncAttributeMaxDynamicSharedMemorySize, LDS_BYTES) != hipSuccess) { fprintf(stderr, "kernel_launch: hipFuncSetAttribute failed\n"); g_grid = -1; return; }
        if (hipOccupancyMaxActiveBlocksPerMultiprocessor(&per_cu, (const void*)mega_fwd, NWAVES * 64, LDS_BYTES) != hipSuccess || per_cu < 1) { fprintf(stderr, "kernel_launch: occupancy query says %d\n", per_cu); per_cu = 1; }
        (void)hipGetLastError();
        g_grid = cus * 1;
    }
    if (g_grid < 0) return;
    (void)hipMemsetAsync((char*)d_ws + OFF_CTL, 0, CTL_ZERO_BYTES, stream);
    HOST_PLAN
}
```

```cpp
#include <hip/hip_runtime.h>
#include <cstdio>
#include <cstdint>
#include <cmath>

typedef unsigned short bf16_t;

constexpr int NB = 4, SEQ = 4096, DM = 1024, NTOK = NB * SEQ, DEPTH = 2;
constexpr int IN_COLS = 5120, MIXW = 1536;
constexpr float RMS_EPS = 1e-6f;
constexpr int LCH = 16;
constexpr int NCHUNK = SEQ / LCH;
constexpr int NCHUNK_TOT = NB * NCHUNK;
constexpr int PLD = 4608;
constexpr int PC_ZA = 0, PC_QB = 512, PC_QC = 1024, PC_KB = 1536, PC_VB = 2048, PC_ZB = 2560, PC_KC = 3072, PC_VC = 3584, PC_ZC = 4096;
__host__ __device__ __forceinline__ int inproj_src_col(int n) {
    if (n < 512) return n;
    const int pc = n - 512, s = pc >> 9;
    const int seg = (s == 0) ? 1 : (s == 1) ? 2 : (s == 2) ? 6 : (s == 3) ? 3 : (s == 4) ? 4 : (s == 5) ? 5 : (s == 6) ? 7 : (s == 7) ? 8 : 9;
    return seg * 512 + (pc & 511);
}

constexpr size_t OFF_CTL = 0;
constexpr size_t OFF_SS = 1u << 20;
constexpr size_t OFF_PROJ = 2u << 20;
constexpr size_t SZ_PROJ = (size_t)NTOK * PLD * 2;
constexpr size_t OFF_XAG = OFF_PROJ + SZ_PROJ;
constexpr size_t SZ_XAG = (size_t)32 * NCHUNK_TOT * 512 * 2;
constexpr size_t OFF_XB = OFF_XAG + SZ_XAG;
constexpr size_t SZ_XB = (size_t)NTOK * DM * 2;
constexpr size_t OFF_G = OFF_XB + SZ_XB;
constexpr size_t SZ_G = (size_t)NTOK * 512 * 2;
constexpr size_t OFF_W = OFF_G + SZ_G;
constexpr size_t WS_NEED_NAIVE = OFF_W;

__host__ __device__ __forceinline__ unsigned f2bf(float f) { unsigned u = __builtin_bit_cast(unsigned, f); return (u + 0x7fffu + ((u >> 16) & 1u)) >> 16; }
__host__ __device__ __forceinline__ float bf2f(bf16_t b) { return __builtin_bit_cast(float, (unsigned)b << 16); }

__device__ __forceinline__ int hw_lane() { int r; asm volatile("v_mbcnt_lo_u32_b32 %0, -1, 0\n\tv_mbcnt_hi_u32_b32 %0, -1, %0" : "=v"(r)); return r; }
namespace pg8 {
#define PG8_LAS __attribute__((address_space(3)))
typedef short bf16x8 __attribute__((ext_vector_type(8)));
typedef float f32x4 __attribute__((ext_vector_type(4)));
typedef unsigned u32x4 __attribute__((ext_vector_type(4)));
typedef unsigned u32x2 __attribute__((ext_vector_type(2)));
constexpr int BM = 256, BK = 64, HALF = 128, HTB = HALF * BK * 2  , STAGE_BYTES = 8 * HTB, NXCD = 8, WGM = 8;

__host__ __device__ __forceinline__ int lds_byte(int r, int c) { const int st = (r >> 4) * 2 + (c >> 5), rr = r & 15, cc = c & 31, ob = rr * 64 + cc * 2; return st * 1024 + (ob ^ (((ob >> 9) & 1) << 5)); }
__host__ __device__ __forceinline__ void stage_rc(int b, int& R, int& C) { const int st = b / 1024, sb = b % 1024, swz = sb ^ (((sb >> 9) & 1) << 5); R = (st >> 1) * 16 + swz / 64; C = (st & 1) * 32 + (swz % 64) / 2; }
__host__ __device__ __forceinline__ int perm32(int rho) { const int n = rho >> 4, i = rho & 15; return 8 * (i >> 2) + 4 * n + (i & 3); }

struct Unit { int pm, pn, bz; };
struct Gemm { const bf16_t* A; const bf16_t* Bt; int lda, ldb, K; size_t a_bz, b_bz; };

struct StaticOrder {
    int nM, nN, nwg, G, c;
    __host__ __device__ void init(int M, int N, int G_, int c_) { nM = M / BM; nN = N / BM; nwg = nM * nN; G = G_; c = c_; }
    __host__ __device__ bool next(int i, Unit& u) const {
        const long L = (long)i * G + c; if (L >= nwg) return false;
        int wgid = (int)L; { const int q = nwg / NXCD, r = nwg % NXCD, xcd = wgid % NXCD, off = wgid / NXCD; wgid = (xcd < r ? xcd * (q + 1) : r * (q + 1) + (xcd - r) * q) + off; }
        const int nig = WGM * nN, gid = wgid / nig, fm = gid * WGM, gsz = (nM - fm) < WGM ? (nM - fm) : WGM;
        u.pm = fm + ((wgid % nig) % gsz); u.pn = (wgid % nig) / gsz; u.bz = 0; return true;
    }
};
struct BatchOrder {
    int nM, nwg, G, c;
    __host__ __device__ void init(int nM_, int nBatch, int G_, int c_) { nM = nM_; nwg = nM_ * nBatch; G = G_; c = c_; }
    __host__ __device__ bool next(int i, Unit& u) const {
        const long L = (long)i * G + c; if (L >= nwg) return false;
        u.bz = (int)L >> 2; u.pm = (int)L & 3; u.pn = 0; return true;
    }
};

struct OneUnit { Unit u; __host__ __device__ bool next(int i, Unit& o) const { if (i != 0) return false; o = u; return true; } };

__device__ __forceinline__ unsigned cvt_pk_bf16(float lo, float hi) { unsigned r; asm volatile("v_cvt_pk_bf16_f32 %0, %1, %2" : "=v"(r) : "v"(lo), "v"(hi)); return r; }
__device__ __forceinline__ u32x4 pack8(const f32x4 v0, const f32x4 v1) { u32x4 w; w.x = cvt_pk_bf16(v0[0], v0[1]); w.y = cvt_pk_bf16(v0[2], v0[3]); w.z = cvt_pk_bf16(v1[0], v1[1]); w.w = cvt_pk_bf16(v1[2], v1[3]); return w; }
__device__ __forceinline__ float bfl(unsigned w) { return __builtin_bit_cast(float, w << 16); }
__device__ __forceinline__ float bfh(unsigned w) { return __builtin_bit_cast(float, w & 0xffff0000u); }


struct EpiInProj {
    static constexpr bool PERM = true, AFTER_DRAIN = false;
    const float* sspart; bf16_t* proj; bf16_t* xag;
    __device__ __forceinline__ void operator()(const f32x4 (&acc)[2][2][4][2], const Unit& u, int wr, int wc, int fr, int fq) const {
        const int row0 = u.pm * BM + wr * 64 + fr, colt = u.pn * BM + wc * 32 + 8 * fq;
#pragma unroll
        for (int ai = 0; ai < 2; ++ai) {
            f32x4 sp[4][4];
#pragma unroll
            for (int m = 0; m < 4; ++m) { const f32x4* p = (const f32x4*)(sspart + (size_t)(row0 + ai * HALF + m * 16) * 16);
#pragma unroll
                for (int j = 0; j < 4; ++j) sp[m][j] = p[j]; }
#pragma unroll
            for (int m = 0; m < 4; ++m) {
                const int row = row0 + ai * HALF + m * 16;
                const f32x4 s0 = sp[m][0], s1 = sp[m][1], s2 = sp[m][2], s3 = sp[m][3];
                const float ss = (((s0[0] + s0[1]) + (s0[2] + s0[3])) + ((s1[0] + s1[1]) + (s1[2] + s1[3]))) + (((s2[0] + s2[1]) + (s2[2] + s2[3])) + ((s3[0] + s3[1]) + (s3[2] + s3[3])));
                const float rinv = rsqrtf(ss * (1.0f / DM) + RMS_EPS);
#pragma unroll
                for (int bj = 0; bj < 2; ++bj) {
                    const int col = colt + bj * HALF;
                    const u32x4 w = pack8(acc[ai][bj][m][0] * rinv, acc[ai][bj][m][1] * rinv);
                    bf16_t* dst = (u.pn < 2) ? xag + ((size_t)(col >> 4) * NCHUNK_TOT + (row >> 4)) * 512 + (row & 15) * 16 + (col & 15)
                                             : proj + (size_t)row * PLD + (col - 512);
                    *(u32x4*)dst = w;
                }
            }
            asm volatile("" ::: "memory");
        }
    }
};
struct EpiE {
    static constexpr bool PERM = true, AFTER_DRAIN = false;
    float* E;
    __device__ __forceinline__ void operator()(const f32x4 (&acc)[2][2][4][2], const Unit& u, int wr, int wc, int fr, int fq) const {
        const int row0 = u.pm * BM + wr * 64 + fr, colt = wc * 32 + 8 * fq;
#pragma unroll
        for (int ai = 0; ai < 2; ++ai)
#pragma unroll
            for (int m = 0; m < 4; ++m) {
                float* rp = E + ((size_t)u.bz * NCHUNK_TOT + row0 + ai * HALF + m * 16) * 256 + colt;
#pragma unroll
                for (int bj = 0; bj < 2; ++bj) { *(f32x4*)(rp + bj * HALF) = acc[ai][bj][m][0]; *(f32x4*)(rp + bj * HALF + 4) = acc[ai][bj][m][1]; }
                asm volatile("" ::: "memory");
            }
    }
};
struct EpiY {
    static constexpr bool PERM = true, AFTER_DRAIN = false;
    bf16_t* G;
    __device__ __forceinline__ static float gelu(float y) {
        const float a = 0.7978845608028654f * (y + 0.044715f * y * y * y);
        return y * __builtin_amdgcn_rcpf(1.0f + __builtin_amdgcn_exp2f(-2.885390081777927f * a));
    }
    __device__ __forceinline__ void operator()(const f32x4 (&acc)[2][2][4][2], const Unit& u, int wr, int wc, int fr, int fq) const {
        const int row0 = u.pm * BM + wr * 64 + fr, colt = wc * 32 + 8 * fq;
        const __amdgpu_buffer_rsrc_t grs = __builtin_amdgcn_make_buffer_rsrc(G, 0, NTOK * 512 * 2, 0x00020000);
#pragma unroll
        for (int ai = 0; ai < 2; ++ai)
#pragma unroll
            for (int m = 0; m < 4; ++m) {
                const int n = row0 + ai * HALF + m * 16;
#pragma unroll
                for (int bj = 0; bj < 2; ++bj) {
                    const int col = colt + bj * HALF, t = col >> 4, c0 = col & 15;
                    f32x4 v0 = acc[ai][bj][m][0], v1 = acc[ai][bj][m][1];
#pragma unroll
                    for (int e = 0; e < 4; ++e) { v0[e] = gelu(v0[e]); v1[e] = gelu(v1[e]); }
                    __builtin_amdgcn_raw_buffer_store_b128(pack8(v0, v1), grs, (unsigned)(((n * 16 + t) * 512 + u.bz * 16 + c0) * 2), 0,   16);
                }
                asm volatile("" ::: "memory");
            }
    }
};
struct EpiGlu {
    static constexpr bool PERM = true, AFTER_DRAIN = false;
    const bf16_t* G; const float* bias; bf16_t* proj; int dry;
    __device__ __forceinline__ static float sig(float v) { return __builtin_amdgcn_rcpf(1.0f + __builtin_amdgcn_exp2f(-1.4426950408889634f * v)); }
    __device__ __forceinline__ void operator()(const f32x4 (&acc)[2][2][4][2], const Unit& u, int wr, int wc, int fr, int fq) const {
        const int row0 = u.pm * BM + wr * 64 + fr, colt = u.pn * BM + wc * 32 + 8 * fq;
#pragma unroll
        for (int bj = 0; bj < 2; ++bj) {
            const int col = colt + bj * HALF;
            const f32x4 b0 = *(const f32x4*)(bias + col), b1 = *(const f32x4*)(bias + col + 4);
#pragma unroll
            for (int ai = 0; ai < 2; ++ai) {
                u32x4 gg[4], zz[4];
#pragma unroll
                for (int m = 0; m < 4; ++m) { const int row = row0 + ai * HALF + m * 16; gg[m] = *(const u32x4*)(G + (size_t)row * 512 + col); zz[m] = *(const u32x4*)(proj + (size_t)row * PLD + PC_ZA + col); }
#pragma unroll
                for (int m = 0; m < 4; ++m) {
                    const int row = row0 + ai * HALF + m * 16;
                    bf16_t* zp = proj + (size_t)row * PLD + PC_ZA + col;
                    const f32x4 a0 = acc[ai][bj][m][0] + b0, a1 = acc[ai][bj][m][1] + b1;
                    f32x4 o0, o1;
#pragma unroll
                    for (int e = 0; e < 4; ++e) {
                        const unsigned gw0 = gg[m][e >> 1], zw0 = zz[m][e >> 1], gw1 = gg[m][2 + (e >> 1)], zw1 = zz[m][2 + (e >> 1)];
                        const float g0 = (e & 1) ? bfh(gw0) : bfl(gw0), z0 = (e & 1) ? bfh(zw0) : bfl(zw0);
                        const float g1 = (e & 1) ? bfh(gw1) : bfl(gw1), z1 = (e & 1) ? bfh(zw1) : bfl(zw1);
                        o0[e] = g0 * sig(a0[e]) * (z0 * sig(z0)); o1[e] = g1 * sig(a1[e]) * (z1 * sig(z1));
                    }
                    if (!dry) *(u32x4*)zp = pack8(o0, o1); else asm volatile("" :: "v"(o0), "v"(o1));
                }
                asm volatile("" ::: "memory");
            }
        }
    }
};
struct EpiOutProj {
    static constexpr bool PERM = true, AFTER_DRAIN = false;
    const float* xold; float* xout; bf16_t* xb; float* sspart; int write_xb; int dry;
    __device__ __forceinline__ void operator()(const f32x4 (&acc)[2][2][4][2], const Unit& u, int wr, int wc, int fr, int fq) const {
        const int row0 = u.pm * BM + wr * 64 + fr, colt = u.pn * BM + wc * 32 + 8 * fq;
#pragma unroll
        for (int ai = 0; ai < 2; ++ai) {
            f32x4 xo[4][2][2];
#pragma unroll
            for (int m = 0; m < 4; ++m)
#pragma unroll
                for (int bj = 0; bj < 2; ++bj) { const size_t off = (size_t)(row0 + ai * HALF + m * 16) * DM + colt + bj * HALF; xo[m][bj][0] = *(const f32x4*)(xold + off); xo[m][bj][1] = *(const f32x4*)(xold + off + 4); }
#pragma unroll
            for (int m = 0; m < 4; ++m) {
                const int row = row0 + ai * HALF + m * 16;
                float ssl = 0.f;
#pragma unroll
                for (int bj = 0; bj < 2; ++bj) {
                    const size_t off = (size_t)row * DM + colt + bj * HALF;
                    const f32x4 n0 = xo[m][bj][0] + acc[ai][bj][m][0], n1 = xo[m][bj][1] + acc[ai][bj][m][1];
                    if (!dry) { *(f32x4*)(xout + off) = n0; *(f32x4*)(xout + off + 4) = n1;
                    if (write_xb) *(u32x4*)(xb + off) = pack8(n0, n1); }
                    ssl += ((n0[0] * n0[0] + n0[1] * n0[1]) + (n0[2] * n0[2] + n0[3] * n0[3])) + ((n1[0] * n1[0] + n1[1] * n1[1]) + (n1[2] * n1[2] + n1[3] * n1[3]));
                }
                ssl += __shfl_xor(ssl, 16); ssl += __shfl_xor(ssl, 32);
                if (fq == 0 && !dry) sspart[(size_t)row * 16 + u.pn * 4 + wc] = ssl; else asm volatile("" :: "v"(ssl));
            }
            asm volatile("" ::: "memory");
        }
    }
};

template <class Epi, class Sched, bool ALIGN_EPI = true>
__device__ __forceinline__ void gemm_phase(PG8_LAS unsigned char* lds, const Gemm g, const Sched& S, const Epi& E, int wave_s) {
    int tid = wave_s * 64 + hw_lane(); asm volatile("" : "+v"(tid));
    const int wid = __builtin_amdgcn_readfirstlane(tid >> 6), lane = tid & 63, wr = wid >> 2, wc = wid & 3, fr = lane & 15, fq = lane >> 4;
    int K = g.K; asm volatile("" : "+s"(K));
    const int nt = K / BK;
    unsigned voffA[2], voffB[2];
#pragma unroll
    for (int i = 0; i < 2; ++i) { int R, C; stage_rc(tid * 16 + i * 8192, R, C); const int Rb = Epi::PERM ? ((R & ~31) + perm32(R & 31)) : R;
        voffA[i] = (unsigned)(R * g.lda + C) * 2u; voffB[i] = (unsigned)(Rb * g.ldb + C) * 2u; }
    const size_t kstep = (size_t)(BK * 2);
    const size_t hstepA = (size_t)HALF * g.lda * 2, hstepB = (size_t)HALF * g.ldb * 2;
    const unsigned ldsw = (unsigned)wid * 1024u;
    const int aoff = lds_byte(wr * 64 + fr, fq * 8), boff = lds_byte(wc * 32 + fr, fq * 8);
#define PG8_SA(b, h) (((b) * 2 + (h)) * HTB)
#define PG8_SB(b, h) ((4 + (b) * 2 + (h)) * HTB)
#define PG8_STAGE(bufoff, gbase, voff) do { _Pragma("unroll") for (int _i = 0; _i < 2; ++_i) \
        __builtin_amdgcn_global_load_lds((const unsigned*)((const char*)(gbase) + (voff)[_i]), (PG8_LAS unsigned*)(lds + (bufoff) + ldsw + _i * 8192), 16, 0, 0); } while (0)
#define PG8_LDA(dst, b, h) do { _Pragma("unroll") for (int m = 0; m < 4; ++m) _Pragma("unroll") for (int k = 0; k < 2; ++k) dst[m][k] = *(const PG8_LAS bf16x8*)(lds + PG8_SA(b, h) + aoff + m * 2048 + k * 1024); } while (0)
#define PG8_LDB(dst, b, h) do { _Pragma("unroll") for (int n = 0; n < 2; ++n) _Pragma("unroll") for (int k = 0; k < 2; ++k) dst[n][k] = *(const PG8_LAS bf16x8*)(lds + PG8_SB(b, h) + boff + n * 2048 + k * 1024); } while (0)
#define PG8_MMA(ai, bj, At, Bt) do { __builtin_amdgcn_s_setprio(1); _Pragma("unroll") for (int m = 0; m < 4; ++m) _Pragma("unroll") for (int n = 0; n < 2; ++n) _Pragma("unroll") for (int k = 0; k < 2; ++k) \
        acc[ai][bj][m][n] = __builtin_amdgcn_mfma_f32_16x16x32_bf16(Bt[n][k], At[m][k], acc[ai][bj][m][n], 0, 0, 0); __builtin_amdgcn_s_setprio(0); } while (0)
#define PG8_WAIT_V(n) asm volatile("s_waitcnt vmcnt(" #n ")" ::: "memory")
#define PG8_WAIT_L(n) asm volatile("s_waitcnt lgkmcnt(" #n ")" ::: "memory")
#define PG8_BAR __builtin_amdgcn_s_barrier()
#define PG8_SCHED __builtin_amdgcn_sched_barrier(0)
#define PG8_ABASE(u) ((const char*)g.A + ((size_t)(u).bz * g.a_bz + (size_t)(u).pm * BM * g.lda) * 2)
#define PG8_BBASE(u) ((const char*)g.Bt + ((size_t)(u).bz * g.b_bz + (size_t)(u).pn * BM * g.ldb) * 2)
    Unit cur, nxt; int ui = 0;
    if (!S.next(0, cur)) return;
    f32x4 acc[2][2][4][2];
#pragma unroll
    for (int a = 0; a < 2; ++a)
#pragma unroll
        for (int b = 0; b < 2; ++b)
#pragma unroll
            for (int m = 0; m < 4; ++m)
#pragma unroll
                for (int n = 0; n < 2; ++n) acc[a][b][m][n] = (f32x4){0.f, 0.f, 0.f, 0.f};
    bf16x8 At[4][2], B0[2][2], B1[2][2];
    const char* cA = PG8_ABASE(cur); const char* cB = PG8_BBASE(cur);
    PG8_STAGE(PG8_SB(0, 0), cB, voffB); PG8_STAGE(PG8_SB(0, 1), cB + hstepB, voffB); PG8_STAGE(PG8_SA(0, 0), cA, voffA); PG8_STAGE(PG8_SA(0, 1), cA + hstepA, voffA);
    if (wr == 1) PG8_BAR;
    PG8_WAIT_V(2); PG8_BAR;
    PG8_STAGE(PG8_SB(1, 0), cB + kstep, voffB); PG8_STAGE(PG8_SA(1, 0), cA + kstep, voffA); PG8_STAGE(PG8_SB(1, 1), cB + hstepB + kstep, voffB);
    PG8_WAIT_V(6); PG8_BAR;
    for (;;) {
        const bool has_next = S.next(ui + 1, nxt);
        const char* nA = has_next ? PG8_ABASE(nxt) : cA; const char* nB = has_next ? PG8_BBASE(nxt) : cB;
        for (int t = 0; t < nt; t += 2) {
            const bool last = (t == nt - 2);
            const char* a1 = cA + (size_t)(t + 1) * kstep;
            const char* a2 = last ? nA : cA + (size_t)(t + 2) * kstep; const char* b2 = last ? nB : cB + (size_t)(t + 2) * kstep;
            const char* a3 = a2 + kstep; const char* b3 = b2 + kstep;
            PG8_LDB(B0, 0, 0); PG8_LDB(B1, 0, 1); PG8_SCHED; PG8_LDA(At, 0, 0); PG8_STAGE(PG8_SA(1, 1), a1 + hstepA, voffA);
            PG8_WAIT_V(8); PG8_WAIT_L(0); PG8_BAR; PG8_MMA(0, 0, At, B0); PG8_MMA(0, 1, At, B1); PG8_BAR; PG8_SCHED;
            PG8_LDA(At, 0, 1); PG8_STAGE(PG8_SB(0, 0), b2, voffB); PG8_STAGE(PG8_SB(0, 1), b2 + hstepB, voffB); PG8_STAGE(PG8_SA(0, 0), a2, voffA);
            PG8_WAIT_V(8); PG8_WAIT_L(0); PG8_BAR; PG8_MMA(1, 0, At, B0); PG8_MMA(1, 1, At, B1); PG8_BAR; PG8_SCHED;
            PG8_LDB(B0, 1, 0); PG8_LDB(B1, 1, 1); PG8_SCHED; PG8_LDA(At, 1, 0); PG8_STAGE(PG8_SA(0, 1), a2 + hstepA, voffA);
            PG8_WAIT_V(8); PG8_WAIT_L(0); PG8_BAR; PG8_MMA(0, 0, At, B0); PG8_MMA(0, 1, At, B1); PG8_BAR; PG8_SCHED;
            PG8_LDA(At, 1, 1); PG8_STAGE(PG8_SB(1, 0), b3, voffB); PG8_STAGE(PG8_SB(1, 1), b3 + hstepB, voffB); PG8_STAGE(PG8_SA(1, 0), a3, voffA);
            PG8_WAIT_V(8); PG8_WAIT_L(0); PG8_BAR; PG8_MMA(1, 0, At, B0); PG8_MMA(1, 1, At, B1); PG8_BAR; PG8_SCHED;
        }
        if constexpr (ALIGN_EPI) { if (wr == 0) PG8_BAR; }
        E(acc, cur, wr, wc, fr, fq);
        if (!has_next) break;
#pragma unroll
        for (int a = 0; a < 2; ++a)
#pragma unroll
            for (int b = 0; b < 2; ++b)
#pragma unroll
                for (int m = 0; m < 4; ++m)
#pragma unroll
                    for (int n = 0; n < 2; ++n) acc[a][b][m][n] = (f32x4){0.f, 0.f, 0.f, 0.f};
        cur = nxt; cA = nA; cB = nB; ++ui;
        if constexpr (ALIGN_EPI) { if (wr == 1) PG8_BAR; }
    }
    PG8_WAIT_V(0);
    if constexpr (!ALIGN_EPI) { if (wr == 0) PG8_BAR; }
    PG8_BAR;
#undef PG8_SA
#undef PG8_SB
#undef PG8_STAGE
#undef PG8_LDA
#undef PG8_LDB
#undef PG8_MMA
#undef PG8_WAIT_V
#undef PG8_WAIT_L
#undef PG8_BAR
#undef PG8_SCHED
#undef PG8_ABASE
#undef PG8_BBASE
}
}
namespace att {
#define LAS __attribute__((address_space(3)))
typedef short bf16x8 __attribute__((ext_vector_type(8)));
typedef short s16x4 __attribute__((ext_vector_type(4)));
typedef float f32x4 __attribute__((ext_vector_type(4)));
typedef unsigned u32x4 __attribute__((ext_vector_type(4)));
typedef unsigned u32x2 __attribute__((ext_vector_type(2)));
typedef float f32x2_t __attribute__((ext_vector_type(2)));
typedef __bf16 bf16x2_t __attribute__((ext_vector_type(2)));
constexpr int VROW = 160;
constexpr int VTILE = 32 * VROW;
constexpr int WAVE_LDS = 2 * VTILE;
constexpr float C2 = 0.125f * 1.4426950408889634f;
constexpr float NEG = -1e30f, MFLOOR = -1e20f, THR = 8.0f;
constexpr int TBW = 640, TBOFF = 240;
constexpr int T5TB_F = 8 * 3 * TBW, T5S_F = 8 * 4 * TBW, RPBS_F = 2 * 4 * 8 * 15 * 64;

__device__ __forceinline__ unsigned cvtpk(float lo, float hi) { f32x2_t v = {lo, hi}; bf16x2_t b = __builtin_convertvector(v, bf16x2_t); return __builtin_bit_cast(unsigned, b); }
__device__ __forceinline__ s16x4 vtr(LAS const char* p) { typedef short v4i16_t __attribute__((ext_vector_type(4))); return __builtin_bit_cast(s16x4, __builtin_amdgcn_ds_read_tr16_b64_v4i16((LAS v4i16_t*)p)); }

__device__ __forceinline__ float max3f(float a, float b, float c) { float r; asm("v_max3_f32 %0, %1, %2, %3" : "=v"(r) : "v"(a), "v"(b), "v"(c)); return r; }
__device__ __forceinline__ float max2f(float a, float b) { float r; asm("v_max_f32_e32 %0, %1, %2" : "=v"(r) : "v"(a), "v"(b)); return r; }
__device__ __forceinline__ void lds_barrier() { asm volatile("s_waitcnt lgkmcnt(0)" ::: "memory"); __builtin_amdgcn_s_barrier(); asm volatile("" ::: "memory"); }
struct State { float m, l; f32x4 acc[4]; };
struct Stage { bf16x8 k00, k01, k10, k11; u32x4 v0, v1, v2, v3; };
struct Bias { f32x4 b0, b1; };

__device__ __forceinline__ void softmax_pv(State& st, f32x4 t0, f32x4 t1, LAS const char* vt, int lane) {
    const float mloc = max2f(max3f(max3f(t0[0], t0[1], t0[2]), t0[3], t1[0]), max3f(t1[1], t1[2], t1[3]));
    if (__builtin_amdgcn_ballot_w64(mloc > st.m + THR) != 0ull) {
        float mx = max2f(mloc, __shfl_xor(mloc, 16)); mx = max2f(mx, __shfl_xor(mx, 32));
        const float mn = max2f(st.m, mx);
        const float alpha = __builtin_amdgcn_exp2f(st.m - mn);
        st.m = mn; st.l *= alpha;
#pragma unroll
        for (int mt = 0; mt < 4; ++mt) st.acc[mt] = st.acc[mt] * alpha;
    }
    const float mn = st.m;
    f32x4 p0, p1;
#pragma unroll
    for (int e = 0; e < 4; ++e) { p0[e] = __builtin_amdgcn_exp2f(t0[e] - mn); p1[e] = __builtin_amdgcn_exp2f(t1[e] - mn); }
    st.l += (((p0[0] + p0[1]) + (p0[2] + p0[3])) + ((p1[0] + p1[1]) + (p1[2] + p1[3])));
    u32x4 pw; pw.x = cvtpk(p0[0], p0[1]); pw.y = cvtpk(p0[2], p0[3]); pw.z = cvtpk(p1[0], p1[1]); pw.w = cvtpk(p1[2], p1[3]);
    const bf16x8 pb = __builtin_bit_cast(bf16x8, pw);
    const int g = lane >> 4, qq = (lane & 15) >> 2, pp = lane & 3;
    LAS const char* vb = vt + (4 * g + qq) * VROW + pp * 8;
#pragma unroll
    for (int mt = 0; mt < 4; ++mt) {
        const s16x4 lo = vtr(vb + mt * 32), hi = vtr(vb + 16 * VROW + mt * 32);
        const bf16x8 av = (bf16x8){lo[0], lo[1], lo[2], lo[3], hi[0], hi[1], hi[2], hi[3]};
        st.acc[mt] = __builtin_amdgcn_mfma_f32_16x16x32_bf16(av, pb, st.acc[mt], 0, 0, 0);
    }
}
__device__ __forceinline__ void write_v(const Stage& s, LAS char* vt, int lane) {
    LAS char* vw = vt + (lane >> 1) * VROW + (lane & 1) * 64;
    *(LAS u32x4*)vw = s.v0; *(LAS u32x4*)(vw + 16) = s.v1; *(LAS u32x4*)(vw + 32) = s.v2; *(LAS u32x4*)(vw + 48) = s.v3;
}
__device__ __forceinline__ void qk(const Stage& s, const Bias& bs, bf16x8 bq0, bf16x8 bq1, f32x4& t0, f32x4& t1) {
    f32x4 s0 = (f32x4){0.f, 0.f, 0.f, 0.f}, s1 = s0;
    s0 = __builtin_amdgcn_mfma_f32_16x16x32_bf16(s.k00, bq0, s0, 0, 0, 0); s0 = __builtin_amdgcn_mfma_f32_16x16x32_bf16(s.k01, bq1, s0, 0, 0, 0);
    s1 = __builtin_amdgcn_mfma_f32_16x16x32_bf16(s.k10, bq0, s1, 0, 0, 0); s1 = __builtin_amdgcn_mfma_f32_16x16x32_bf16(s.k11, bq1, s1, 0, 0, 0);
    t0 = s0 * C2 + bs.b0; t1 = s1 * C2 + bs.b1;
}

struct ZF { u32x2 z[4]; };
__device__ __forceinline__ ZF load_z(const bf16_t* zp, int lane) { ZF r; const int g = lane >> 4;
#pragma unroll
    for (int mt = 0; mt < 4; ++mt) r.z[mt] = *(const u32x2*)(zp + mt * 16 + 4 * g);
    return r; }
__device__ __forceinline__ void finish(State& st, bf16_t* outp  , const ZF& zf, int lane) {
    float l = st.l; l += __shfl_xor(l, 16); l += __shfl_xor(l, 32);
    const float rl = 1.0f / l;
    const int g = lane >> 4;
#pragma unroll
    for (int mt = 0; mt < 4; ++mt) {
        const u32x2 zz = zf.z[mt];
        float o[4];
#pragma unroll
        for (int e = 0; e < 4; ++e) {
            const unsigned zw = zz[e >> 1]; const float z = (e & 1) ? __builtin_bit_cast(float, zw & 0xffff0000u) : __builtin_bit_cast(float, zw << 16);
            const float sz = z * __builtin_amdgcn_rcpf(1.0f + __builtin_amdgcn_exp2f(-1.4426950408889634f * z));
            o[e] = st.acc[mt][e] * rl * sz;
        }
        u32x2 w; w.x = cvtpk(o[0], o[1]); w.y = cvtpk(o[2], o[3]);
        *(u32x2*)(outp + mt * 16 + 4 * g) = w;
    }
}

template <int V = 0>
__device__ __forceinline__ void dil_task(bf16_t* proj, const float* tbl, int task, LAS char* vbuf, int lane, bf16_t* dry = nullptr) {
    const int r = task & 15, qb = (task >> 4) & 15, h = (task >> 8) & 7, b = task >> 11;
    const int q = lane & 15, g = lane >> 4;
    const int qr = qb * 256 + r;
    bf16_t* pb_ = proj + (size_t)b * SEQ * PLD;
    const bf16_t* qp = pb_ + (size_t)(qr + 16 * q) * PLD + PC_QC + h * 64 + g * 8;
    const bf16x8 bq0 = *(const bf16x8*)qp, bq1 = *(const bf16x8*)(qp + 32);
    const char* kbase = (const char*)(pb_ + PC_KC + h * 64);
    const char* vbase = (const char*)(pb_ + PC_VC + h * 64);
    const unsigned klane = (unsigned)g * 16u, vlane = (unsigned)(lane & 1) * 64u;
    const int sv = lane >> 1;
    State st; st.m = MFLOOR; st.l = 0.f;
#pragma unroll
    for (int mt = 0; mt < 4; ++mt) st.acc[mt] = (f32x4){0.f, 0.f, 0.f, 0.f};
    const float* tb0 = tbl + T5TB_F + ((size_t)h * 4 + (q & 3)) * TBW + TBOFF + 4 * g - (q & ~3);
    const float* tb1 = tbl + ((size_t)h * 3 + 1) * TBW + TBOFF + 4 * g - 4 * q;
    const float* tb2 = tbl + ((size_t)h * 3 + 2) * TBW + TBOFF + 4 * g - 16 * q;

#define DIL_PARAMS(ks, d, pat, ul0) const int pat = ((ks) >= 5) + ((ks) >= 11), d = 16 >> (2 * pat), ul0 = ((ks) - (5 * pat + (pat >> 1))) * 32;
    auto issue = [&](int ks, Stage& s) {
        if (V == 1 && ks > 2) return;
        DIL_PARAMS(ks, d, pat, ul0);
        const int pbase = qr + d * (ul0 - 64);
        int p0 = pbase + d * q, p1 = p0 + 16 * d, pv = pbase + d * sv;
        p0 = p0 < 0 ? 0 : (p0 > SEQ - 1 ? SEQ - 1 : p0); p1 = p1 < 0 ? 0 : (p1 > SEQ - 1 ? SEQ - 1 : p1); pv = pv < 0 ? 0 : (pv > SEQ - 1 ? SEQ - 1 : pv);
        const char* ka = kbase + ((unsigned)p0 * (unsigned)(PLD * 2) + klane); const char* kb = kbase + ((unsigned)p1 * (unsigned)(PLD * 2) + klane);
        const char* va = vbase + ((unsigned)pv * (unsigned)(PLD * 2) + vlane);
        if (V != 4 && V != 5) { s.k00 = *(const bf16x8*)ka; s.k01 = *(const bf16x8*)(ka + 64); s.k10 = *(const bf16x8*)kb; s.k11 = *(const bf16x8*)(kb + 64); }
        if (V != 3 && V != 5) { s.v0 = *(const u32x4*)va; s.v1 = *(const u32x4*)(va + 16); s.v2 = *(const u32x4*)(va + 32); s.v3 = *(const u32x4*)(va + 48); }
    };
    auto issue_b = [&](int ks, Bias& bs) {
        if (V == 1 && ks > 1) return;
        if (V == 3 || V == 4) return;
        DIL_PARAMS(ks, d, pat, ul0); (void)d;
        const float* tp = (pat == 0 ? tb0 : (pat == 1 ? tb1 : tb2)) + ul0;
        bs.b0 = *(const f32x4*)tp; bs.b1 = *(const f32x4*)(tp + 16);
    };
    auto compute = [&](int ks, const Stage& s, const Bias& bs) {
        if (V == 3) { asm volatile("" :: "v"(s.k00), "v"(s.k01), "v"(s.k10), "v"(s.k11)); return; }
        if (V == 4) { asm volatile("" :: "v"(s.v0), "v"(s.v1), "v"(s.v2), "v"(s.v3)); return; }
        if (V == 5) { asm volatile("" :: "v"(bs.b0), "v"(bs.b1)); return; }
        if (V == 2) { asm volatile("" :: "v"(s.k00), "v"(s.k01), "v"(s.k10), "v"(s.k11), "v"(s.v0), "v"(s.v1), "v"(s.v2), "v"(s.v3), "v"(bs.b0), "v"(bs.b1)); return; }
        LAS char* vt = vbuf + (ks & 1) * VTILE;
        write_v(s, vt, lane);
        f32x4 t0, t1; qk(s, bs, bq0, bq1, t0, t1);
        {
            DIL_PARAMS(ks, d, pat, ul0); (void)pat;
            const int pbase = qr + d * (ul0 - 64);
            if (pbase < 0 || pbase + 31 * d > SEQ - 1) {
                const int pk = pbase + d * 4 * g;
#pragma unroll
                for (int x = 0; x < 4; ++x) { if ((unsigned)(pk + d * x) >= (unsigned)SEQ) t0[x] = NEG; if ((unsigned)(pk + d * (16 + x)) >= (unsigned)SEQ) t1[x] = NEG; }
            }
        }
        softmax_pv(st, t0, t1, vt, lane);
    };
    Stage A, B, C, D;
    Bias X, Y;
    issue(0, A); issue(1, B); issue(2, C); issue_b(0, X);
#pragma unroll 1
    for (int ks = 0; ks < 20; ks += 4) {
        issue(ks + 3, D); issue_b(ks + 1, Y); compute(ks, A, X);
        issue(ks + 4, A); issue_b(ks + 2, X); compute(ks + 1, B, Y);
        issue(ks + 5, B); issue_b(ks + 3, Y); compute(ks + 2, C, X);
        issue(ks + 6, C); issue_b(ks + 4, X); compute(ks + 3, D, Y);
    }
    issue_b(21, Y); compute(20, A, X); issue_b(22, X); compute(21, B, Y); compute(22, C, X);
#undef DIL_PARAMS
    bf16_t* outp = dry ? dry + ((size_t)task * 16 + q) * 64 : pb_ + (size_t)(qr + 16 * q) * PLD + PC_QC + h * 64;
    finish(st, outp, load_z(pb_ + (size_t)(qr + 16 * q) * PLD + PC_ZC + h * 64, lane), lane);
}

__device__ __forceinline__ void na_task(bf16_t* proj, const float* rpbs, int task, LAS char* vbuf, int lane, bf16_t* dry = nullptr) {
    const int jt = task & 3, r = (task >> 2) & 63, h = (task >> 8) & 7, b = task >> 11;
    const int q = lane & 15, g = lane >> 4;
    const int j0 = 16 * jt, j = j0 + q;
    int w0 = j0 - 8; w0 = w0 < 0 ? 0 : (w0 > 32 ? 32 : w0);
    int rs = r - 4; rs = rs < 0 ? 0 : (rs > 56 ? 56 : rs);
    int cs = j - 8; cs = cs < 0 ? 0 : (cs > 48 ? 48 : cs);
    bf16_t* pb_ = proj + (size_t)b * SEQ * PLD;
    const size_t tq = (size_t)(r * 64 + j);
    const bf16_t* qp = pb_ + tq * PLD + PC_QB + h * 64 + g * 8;
    const bf16x8 bq0 = *(const bf16x8*)qp, bq1 = *(const bf16x8*)(qp + 32);
    const char* kbase = (const char*)(pb_ + (size_t)(rs * 64 + w0) * PLD + PC_KB + h * 64);
    const char* vbase = (const char*)(pb_ + (size_t)(rs * 64 + w0) * PLD + PC_VB + h * 64);
    const int sv = lane >> 1;
    const unsigned koff = (unsigned)q * (unsigned)(PLD * 2) + (unsigned)g * 16u, voff = (unsigned)sv * (unsigned)(PLD * 2) + (unsigned)(lane & 1) * 64u;
    const int col = w0 - j + 32, c4 = col & 3;
    const float* tb = rpbs + (((size_t)c4 * 8 + h) * 15 + (rs - r + 7)) * 64 + (col - c4) + 4 * g;
    State st; st.m = MFLOOR; st.l = 0.f;
#pragma unroll
    for (int mt = 0; mt < 4; ++mt) st.acc[mt] = (f32x4){0.f, 0.f, 0.f, 0.f};
    const int kc0 = w0 + 4 * g - cs;
    auto issue = [&](int ks, Stage& s) {
        const char* ka = kbase + (size_t)ks * (64 * PLD * 2) + koff; const char* kb = ka + 16 * PLD * 2; const char* va = vbase + (size_t)ks * (64 * PLD * 2) + voff;
        s.k00 = *(const bf16x8*)ka; s.k01 = *(const bf16x8*)(ka + 64); s.k10 = *(const bf16x8*)kb; s.k11 = *(const bf16x8*)(kb + 64);
        s.v0 = *(const u32x4*)va; s.v1 = *(const u32x4*)(va + 16); s.v2 = *(const u32x4*)(va + 32); s.v3 = *(const u32x4*)(va + 48);
    };
    auto issue_b = [&](int ks, Bias& bs) { const float* tp = tb + ks * 64; bs.b0 = *(const f32x4*)tp; bs.b1 = *(const f32x4*)(tp + 16); };
    auto compute = [&](int ks, const Stage& s, const Bias& bs) {
        LAS char* vt = vbuf + (ks & 1) * VTILE;
        write_v(s, vt, lane);
        f32x4 t0, t1; qk(s, bs, bq0, bq1, t0, t1);
#pragma unroll
        for (int x = 0; x < 4; ++x) { if ((unsigned)(kc0 + x) >= 16u) t0[x] = NEG; if ((unsigned)(kc0 + 16 + x) >= 16u) t1[x] = NEG; }
        softmax_pv(st, t0, t1, vt, lane);
    };
    Stage A, B, C, D;
    Bias X, Y;
    issue(0, A); issue(1, B); issue(2, C); issue_b(0, X);
    issue(3, D); issue_b(1, Y); compute(0, A, X);
    issue(4, A); issue_b(2, X); compute(1, B, Y);
    issue(5, B); issue_b(3, Y); compute(2, C, X);
    issue(6, C); issue_b(4, X); compute(3, D, Y);
    issue(7, D); issue_b(5, Y); compute(4, A, X);
    issue_b(6, X); compute(5, B, Y); issue_b(7, Y); compute(6, C, X); compute(7, D, Y);
    finish(st, dry ? dry + ((size_t)task * 16 + q) * 64 : pb_ + tq * PLD + PC_QB + h * 64, load_z(pb_ + tq * PLD + PC_ZB + h * 64, lane), lane);
}

constexpr int NA_IMG = 480 * 128;
__device__ __forceinline__ int fK(int kidx) { return (kidx >> 1) & 7; }
__device__ __forceinline__ int fV(int kidx) { return ((kidx >> 1) & 3) * 2; }
constexpr int DIL_IMG = 400 * 128;
struct QF { bf16x8 q0, q1; };
struct LdsBases { LAS const char* ka; LAS const char* kb; LAS const char* v[4]; };
__device__ __forceinline__ LdsBases lds_bases(LAS const char* Kimg, LAS const char* Vimg, int k0  , int v0k  , int lane) {
    const int g = lane >> 4, pp = lane & 3, ch = pp >> 1; LdsBases b;
    b.ka = Kimg + k0 * 128 + ((g ^ fK(k0)) * 16); b.kb = Kimg + k0 * 128 + (((4 + g) ^ fK(k0)) * 16);
    const int f0 = fV(v0k);
#pragma unroll
    for (int mt = 0; mt < 4; ++mt) b.v[mt] = Vimg + v0k * 128 + (pp & 1) * 8 + (((mt * 2 + ch) ^ f0) * 16);
    return b;
}
struct RState { float m, l; f32x4 acc[4]; f32x4 c0, c1; };
__device__ __forceinline__ void rstate_init(RState& st, f32x4 mk0, f32x4 mk1) {
    st.m = 0.f; st.l = 0.f; st.c0 = mk0 * (1.0f / C2); st.c1 = mk1 * (1.0f / C2);
#pragma unroll
    for (int mt = 0; mt < 4; ++mt) st.acc[mt] = (f32x4){0.f, 0.f, 0.f, 0.f};
}
template <int NT>
__device__ __forceinline__ void rescale_up(RState& st, float mloc, f32x4 (&t)[NT]) {
    float mx = max2f(mloc, __shfl_xor(mloc, 16)); mx = max2f(mx, __shfl_xor(mx, 32));
    const float delta = max2f(mx, 0.f), alpha = __builtin_amdgcn_exp2f(-delta), dc = delta * (1.0f / C2);
    st.m += delta; st.l *= alpha; st.c0 = st.c0 - dc; st.c1 = st.c1 - dc;
#pragma unroll
    for (int mt = 0; mt < 4; ++mt) st.acc[mt] = st.acc[mt] * alpha;
#pragma unroll
    for (int j = 0; j < NT; ++j) t[j] = t[j] - delta;
}
template <class MF>
__device__ __forceinline__ void lds_step(RState& st, const QF& qf, const LdsBases& B, int so, const Bias& bs, MF dynmask) {
    const bf16x8 a00 = *(LAS const bf16x8*)(B.ka + so), a01 = *(LAS const bf16x8*)(B.kb + so);
    const bf16x8 a10 = *(LAS const bf16x8*)(B.ka + so + 2048), a11 = *(LAS const bf16x8*)(B.kb + so + 2048);
    s16x4 vlo[4], vhi[4];
#pragma unroll
    for (int mt = 0; mt < 4; ++mt) { vlo[mt] = vtr(B.v[mt] + so); vhi[mt] = vtr(B.v[mt] + so + 2048); }
    f32x4 s0 = st.c0, s1 = st.c1;
    s0 = __builtin_amdgcn_mfma_f32_16x16x32_bf16(a00, qf.q0, s0, 0, 0, 0); s0 = __builtin_amdgcn_mfma_f32_16x16x32_bf16(a01, qf.q1, s0, 0, 0, 0);
    s1 = __builtin_amdgcn_mfma_f32_16x16x32_bf16(a10, qf.q0, s1, 0, 0, 0); s1 = __builtin_amdgcn_mfma_f32_16x16x32_bf16(a11, qf.q1, s1, 0, 0, 0);
    f32x4 t[2]; t[0] = s0 * C2 + bs.b0; t[1] = s1 * C2 + bs.b1;
    dynmask(t[0], t[1]);
    const float mloc = max2f(max3f(max3f(t[0][0], t[0][1], t[0][2]), t[0][3], t[1][0]), max3f(t[1][1], t[1][2], t[1][3]));
    if (__builtin_amdgcn_ballot_w64(mloc > THR) != 0ull) rescale_up<2>(st, mloc, t);
    f32x4 p0, p1;
#pragma unroll
    for (int e = 0; e < 4; ++e) { p0[e] = __builtin_amdgcn_exp2f(t[0][e]); p1[e] = __builtin_amdgcn_exp2f(t[1][e]); }
    st.l += (((p0[0] + p0[1]) + (p0[2] + p0[3])) + ((p1[0] + p1[1]) + (p1[2] + p1[3])));
    u32x4 pw; pw.x = cvtpk(p0[0], p0[1]); pw.y = cvtpk(p0[2], p0[3]); pw.z = cvtpk(p1[0], p1[1]); pw.w = cvtpk(p1[2], p1[3]);
    const bf16x8 pb = __builtin_bit_cast(bf16x8, pw);
#pragma unroll
    for (int mt = 0; mt < 4; ++mt) {
        const bf16x8 av = (bf16x8){vlo[mt][0], vlo[mt][1], vlo[mt][2], vlo[mt][3], vhi[mt][0], vhi[mt][1], vhi[mt][2], vhi[mt][3]};
        st.acc[mt] = __builtin_amdgcn_mfma_f32_16x16x32_bf16(av, pb, st.acc[mt], 0, 0, 0);
    }
}
template <class MF>
__device__ __forceinline__ void lds_step2(RState& st, const QF& qf, const LdsBases& B, int so, const Bias& bs0, const Bias& bs1, MF dynmask) {
    bf16x8 ka[4], kb[4];
#pragma unroll
    for (int j = 0; j < 4; ++j) { ka[j] = *(LAS const bf16x8*)(B.ka + so + j * 2048); kb[j] = *(LAS const bf16x8*)(B.kb + so + j * 2048); }
    s16x4 vv[4][4];
#pragma unroll
    for (int mt = 0; mt < 4; ++mt)
#pragma unroll
        for (int j = 0; j < 4; ++j) vv[mt][j] = vtr(B.v[mt] + so + j * 2048);
    f32x4 sc[4];
#pragma unroll
    for (int j = 0; j < 4; ++j) sc[j] = __builtin_amdgcn_mfma_f32_16x16x32_bf16(ka[j], qf.q0, (j & 1) ? st.c1 : st.c0, 0, 0, 0);
#pragma unroll
    for (int j = 0; j < 4; ++j) sc[j] = __builtin_amdgcn_mfma_f32_16x16x32_bf16(kb[j], qf.q1, sc[j], 0, 0, 0);
    f32x4 t[4]; t[0] = sc[0] * C2 + bs0.b0; t[1] = sc[1] * C2 + bs0.b1; t[2] = sc[2] * C2 + bs1.b0; t[3] = sc[3] * C2 + bs1.b1;
    dynmask(t[0], t[1]); dynmask(t[2], t[3]);
    const float mloc = max2f(max2f(max3f(max3f(t[0][0], t[0][1], t[0][2]), t[0][3], t[1][0]), max3f(t[1][1], t[1][2], t[1][3])), max2f(max3f(max3f(t[2][0], t[2][1], t[2][2]), t[2][3], t[3][0]), max3f(t[3][1], t[3][2], t[3][3])));
    if (__builtin_amdgcn_ballot_w64(mloc > THR) != 0ull) rescale_up<4>(st, mloc, t);
    f32x4 p[4];
#pragma unroll
    for (int j = 0; j < 4; ++j)
#pragma unroll
        for (int e = 0; e < 4; ++e) p[j][e] = __builtin_amdgcn_exp2f(t[j][e]);
    st.l += ((((p[0][0] + p[0][1]) + (p[0][2] + p[0][3])) + ((p[1][0] + p[1][1]) + (p[1][2] + p[1][3]))) + (((p[2][0] + p[2][1]) + (p[2][2] + p[2][3])) + ((p[3][0] + p[3][1]) + (p[3][2] + p[3][3]))));
    u32x4 pw, pz; pw.x = cvtpk(p[0][0], p[0][1]); pw.y = cvtpk(p[0][2], p[0][3]); pw.z = cvtpk(p[1][0], p[1][1]); pw.w = cvtpk(p[1][2], p[1][3]);
    pz.x = cvtpk(p[2][0], p[2][1]); pz.y = cvtpk(p[2][2], p[2][3]); pz.z = cvtpk(p[3][0], p[3][1]); pz.w = cvtpk(p[3][2], p[3][3]);
    const bf16x8 pb0 = __builtin_bit_cast(bf16x8, pw), pb1 = __builtin_bit_cast(bf16x8, pz);
#pragma unroll
    for (int mt = 0; mt < 4; ++mt) {
        const bf16x8 av0 = (bf16x8){vv[mt][0][0], vv[mt][0][1], vv[mt][0][2], vv[mt][0][3], vv[mt][1][0], vv[mt][1][1], vv[mt][1][2], vv[mt][1][3]};
        const bf16x8 av1 = (bf16x8){vv[mt][2][0], vv[mt][2][1], vv[mt][2][2], vv[mt][2][3], vv[mt][3][0], vv[mt][3][1], vv[mt][3][2], vv[mt][3][3]};
        st.acc[mt] = __builtin_amdgcn_mfma_f32_16x16x32_bf16(av0, pb0, st.acc[mt], 0, 0, 0);
        st.acc[mt] = __builtin_amdgcn_mfma_f32_16x16x32_bf16(av1, pb1, st.acc[mt], 0, 0, 0);
    }
}
__device__ __forceinline__ void finish_r(RState& st, bf16_t* outp, const ZF& zf, int lane) {
    State s2; s2.m = st.m; s2.l = st.l;
#pragma unroll
    for (int mt = 0; mt < 4; ++mt) s2.acc[mt] = st.acc[mt];
    finish(s2, outp, zf, lane);
}
template <int VAR = 0>
__device__ __forceinline__ void na_block_task(bf16_t* proj, const float* rpbs, int bt, LAS char* lds, int wave, bf16_t* dry) {
    int lane = hw_lane();
    const int jt = bt & 3, rb = (bt >> 2) & 7, h = (bt >> 5) & 7, b = bt >> 8;
    const int r0 = 8 * rb, j0 = 16 * jt;
    int w0 = j0 - 8; w0 = w0 < 0 ? 0 : (w0 > 32 ? 32 : w0);
    int Rb = r0 - 4; Rb = Rb < 0 ? 0 : Rb;
    int Re = r0 + 3; Re = Re > 56 ? 56 : Re; Re += 8;
    const int nins = (Re - Rb) * 4;
    bf16_t* pb_ = proj + (size_t)b * SEQ * PLD;
    LAS char* Kimg = lds; LAS char* Vimg = lds + NA_IMG;
    {
        const int kl = lane >> 3, c = lane & 7;
        for (int ii = wave; ii < (VAR == 1 ? 0 : nins); ii += 8) {
            const int key = 8 * ii + kl, rl = key >> 5, col = key & 31;
            const bf16_t* row = pb_ + (size_t)((Rb + rl) * 64 + w0 + col) * PLD + h * 64;
            __builtin_amdgcn_global_load_lds((const unsigned*)(row + PC_KB + ((c ^ fK(key)) * 8)), (LAS unsigned*)(Kimg + ii * 1024), 16, 0, 0);
            __builtin_amdgcn_global_load_lds((const unsigned*)(row + PC_VB + ((c ^ fV(key)) * 8)), (LAS unsigned*)(Vimg + ii * 1024), 16, 0, 0);
        }
    }
    const int q = lane & 15, g = lane >> 4, qq = q >> 2, pp = lane & 3;
    const int r = r0 + wave, j = j0 + q;
    int rs = r - 4; rs = rs < 0 ? 0 : (rs > 56 ? 56 : rs);
    int cs = j - 8; cs = cs < 0 ? 0 : (cs > 48 ? 48 : cs);
    const size_t tq = (size_t)(r * 64 + j);
    const bf16_t* qp = pb_ + tq * PLD + PC_QB + h * 64 + g * 8;
    const bf16x8 bq0 = *(const bf16x8*)qp, bq1 = *(const bf16x8*)(qp + 32);
    const ZF zf = load_z(pb_ + tq * PLD + PC_ZB + h * 64, lane);
    const int col = w0 - j + 32, c4 = col & 3;
    const float* tb = rpbs + (((size_t)c4 * 8 + h) * 15 + (rs - r + 7)) * 64 + (col - c4) + 4 * g;
    const int kc0 = w0 + 4 * g - cs;
    RState st;
    { f32x4 mk0, mk1;
#pragma unroll
      for (int x = 0; x < 4; ++x) { mk0[x] = (unsigned)(kc0 + x) >= 16u ? NEG : 0.f; mk1[x] = (unsigned)(kc0 + 16 + x) >= 16u ? NEG : 0.f; }
      rstate_init(st, mk0, mk1); }
    Bias bs; bs.b0 = *(const f32x4*)tb; bs.b1 = *(const f32x4*)(tb + 16);
    __syncthreads();
    const int kbase = (rs - Rb) * 32;
    const LdsBases Bn = lds_bases(Kimg, Vimg, kbase + q, kbase + 4 * g + qq, lane);
    QF qf; qf.q0 = bq0; qf.q1 = bq1;
    auto mk = [](f32x4&, f32x4&) {};
    Bias b1; b1.b0 = *(const f32x4*)(tb + 64); b1.b1 = *(const f32x4*)(tb + 64 + 16);
#pragma unroll 1
    for (int ks = 0; ks < (VAR == 2 ? 0 : 8); ks += 2) {
        Bias n0 = bs, n1 = b1; if (VAR != 5 && ks + 2 < 8) { const float* tp = tb + (ks + 2) * 64; n0.b0 = *(const f32x4*)tp; n0.b1 = *(const f32x4*)(tp + 16); n1.b0 = *(const f32x4*)(tp + 64); n1.b1 = *(const f32x4*)(tp + 64 + 16); }
        lds_step2(st, qf, Bn, ks * 4096, bs, b1, mk);
        bs = n0; b1 = n1;
    }
    if (VAR != 3) finish_r(st, dry ? dry + (((size_t)bt * 8 + wave) * 16 + q) * 64 : pb_ + tq * PLD + PC_QB + h * 64, zf, lane);
    lds_barrier();
}

template <class PF>
__device__ __forceinline__ void stage_keys(bf16_t* pb_, int h, int kcol, int vcol, int nkeys, PF posfn, LAS char* Kimg, LAS char* Vimg, int lane, int wave) {
    const int kl = lane >> 3, c = lane & 7;
    for (int ii = wave; ii < nkeys / 8; ii += 8) {
        const int key = 8 * ii + kl; int pos = posfn(key); pos = pos < 0 ? 0 : (pos > SEQ - 1 ? SEQ - 1 : pos);
        const bf16_t* row = pb_ + (size_t)pos * PLD + h * 64;
        __builtin_amdgcn_global_load_lds((const unsigned*)(row + kcol + ((c ^ fK(key)) * 8)), (LAS unsigned*)(Kimg + ii * 1024), 16, 0, 0);
        __builtin_amdgcn_global_load_lds((const unsigned*)(row + vcol + ((c ^ fV(key)) * 8)), (LAS unsigned*)(Vimg + ii * 1024), 16, 0, 0);
    }
}
template <int VAR = 0>
__device__ __forceinline__ void dil_block_task(bf16_t* proj, const float* tbl, int bt, LAS char* lds, int wave, bf16_t* dry) {
    int lane = hw_lane();
    const int qb = bt & 15, h = (bt >> 4) & 7, b = bt >> 7;
    const int q = lane & 15, g = lane >> 4, qq = q >> 2;
    const int q0 = qb * 256;
    const int ra = 4 * (wave >> 1) + (wave & 1), rb = ra + 2;
    bf16_t* pb_ = proj + (size_t)b * SEQ * PLD;
    LAS char* Kimg = lds; LAS char* Vimg = lds + DIL_IMG;
    if (VAR != 4) stage_keys(pb_, h, PC_KC, PC_VC, 400, [&](int k) { return q0 - 64 + k; }, Kimg, Vimg, lane, wave);
    QF qa, qbf;
    { const bf16_t* qp = pb_ + (size_t)(q0 + ra + 16 * q) * PLD + PC_QC + h * 64 + g * 8; qa.q0 = *(const bf16x8*)qp; qa.q1 = *(const bf16x8*)(qp + 32);
      qp += 2 * PLD; qbf.q0 = *(const bf16x8*)qp; qbf.q1 = *(const bf16x8*)(qp + 32); }
    const ZF za_ = load_z(pb_ + (size_t)(q0 + ra + 16 * q) * PLD + PC_ZC + h * 64, lane), zb_ = load_z(pb_ + (size_t)(q0 + rb + 16 * q) * PLD + PC_ZC + h * 64, lane);
    RState sa, sb; { const f32x4 z4 = (f32x4){0.f, 0.f, 0.f, 0.f}; rstate_init(sa, z4, z4); rstate_init(sb, z4, z4); }
    LAS float* tbs = (LAS float*)(lds + 2 * DIL_IMG);
    for (int i = wave * 64 + lane; i < 2 * TBW; i += 512) tbs[i] = tbl[(h * 3 + 1) * TBW + i];
    const LAS float* tl2 = tbs + TBW + TBOFF + 4 * g - 16 * q;
    __syncthreads();
    {
        const bool needm = (q0 - 64 < 0) || (q0 + 15 + 383 - 64 > SEQ - 1);
        const LdsBases Ba = lds_bases(Kimg, Vimg, ra + q, ra + 4 * g + qq, lane), Bb = lds_bases(Kimg, Vimg, rb + q, rb + 4 * g + qq, lane);
#pragma unroll 2
        for (int ks = 0; ks < (VAR == 3 ? 0 : 12); ++ks) {
            Bias bs; bs.b0 = *(LAS const f32x4*)(tl2 + ks * 32); bs.b1 = *(LAS const f32x4*)(tl2 + ks * 32 + 16);
            const int u0 = ks * 32;
            auto mk = [&](int pk) { return [=](f32x4& t0, f32x4& t1) { if (needm) {
#pragma unroll
                for (int x = 0; x < 4; ++x) { if ((unsigned)(pk + x) >= (unsigned)SEQ) t0[x] = NEG; if ((unsigned)(pk + 16 + x) >= (unsigned)SEQ) t1[x] = NEG; } } }; };
            lds_step(sa, qa, Ba, ks * 4096, bs, mk(q0 + ra + u0 - 64 + 4 * g));
            lds_step(sb, qbf, Bb, ks * 4096, bs, mk(q0 + rb + u0 - 64 + 4 * g));
        }
    }
    lds_barrier();
    asm volatile("" : "+v"(lane));
#pragma unroll 1
    for (int t = 0; t < (VAR == 2 ? 0 : 2); ++t) {
        const int q = lane & 15, g = lane >> 4, qq = q >> 2;
        const LAS float* tl1 = (LAS const float*)(lds + 2 * DIL_IMG) + TBOFF + 4 * g - 4 * q;
        const int c0 = 2 * t;
        if (VAR != 4) stage_keys(pb_, h, PC_KC, PC_VC, 392, [&](int k) { const int cl = k >= 196 ? 1 : 0; return q0 - 256 + c0 + cl + 4 * (k - 196 * cl); }, Kimg, Vimg, lane, wave);
        const int r = t == 0 ? ra : rb, cl = r & 1, kb = cl * 196 + (r >> 2);
        const bool needm = (q0 - 256 < 0) || (q0 + 15 + 4 * 127 > SEQ - 1);
        const LdsBases Bc = lds_bases(Kimg, Vimg, kb + q, kb + 4 * g + qq, lane);
        __syncthreads();
#pragma unroll 2
        for (int ks = 0; ks < 6; ++ks) {
            Bias bs; bs.b0 = *(LAS const f32x4*)(tl1 + ks * 32); bs.b1 = *(LAS const f32x4*)(tl1 + ks * 32 + 16);
            const int u0 = ks * 32;
            const int pk = q0 + r + 4 * (u0 - 64 + 4 * g);
            auto mk = [=](f32x4& t0, f32x4& t1) { if (needm) {
#pragma unroll
                for (int x = 0; x < 4; ++x) { if ((unsigned)(pk + 4 * x) >= (unsigned)SEQ) t0[x] = NEG; if ((unsigned)(pk + 4 * (16 + x)) >= (unsigned)SEQ) t1[x] = NEG; } } };
            if (t == 0) lds_step(sa, qa, Bc, ks * 4096, bs, mk);
            else        lds_step(sb, qbf, Bc, ks * 4096, bs, mk);
        }
        lds_barrier();
    }
    lane = hw_lane();
    {
    const int q = lane & 15, g = lane >> 4, qq = q >> 2;
    LAS char* wbuf = lds + wave * 16384;
    const char* kbase = (const char*)(pb_ + PC_KC + h * 64); const char* vbase = (const char*)(pb_ + PC_VC + h * 64);
    const int kl = lane >> 3, c = lane & 7;
    const unsigned to0 = (unsigned)(T5TB_F + (h * 4 + (q & 3)) * TBW + TBOFF + 4 * g - (q & ~3));
    struct RowStage { u32x4 k[4], v[4]; };
#pragma unroll 1
    for (int t = 0; t < (VAR == 1 ? 0 : 2); ++t) {
        const int qr = q0 + (t == 0 ? ra : rb);
        auto issue = [&](int ks, RowStage& s, Bias& bsn) {
            const int pbase = qr + 16 * (ks * 32 - 64);
#pragma unroll
            for (int i = 0; i < 4; ++i) { int pos = pbase + 16 * (8 * i + kl); pos = pos < 0 ? 0 : (pos > SEQ - 1 ? SEQ - 1 : pos);
                const unsigned off = (unsigned)pos * (unsigned)(PLD * 2) + (unsigned)c * 16u;
                s.k[i] = *(const u32x4*)(kbase + off); s.v[i] = *(const u32x4*)(vbase + off); }
            bsn.b0 = *(const f32x4*)(tbl + (to0 + (unsigned)(ks * 32))); bsn.b1 = *(const f32x4*)(tbl + (to0 + (unsigned)(ks * 32 + 16)));
        };
        auto compute = [&](int ks, const RowStage& s, const Bias& bsn, RState& st, const QF& qf) {
            LAS char* Kw = wbuf + (ks & 1) * 8192; LAS char* Vw = Kw + 4096;
#pragma unroll
            for (int i = 0; i < 4; ++i) { const int key = 8 * i + kl;
                *(LAS u32x4*)(Kw + key * 128 + ((c ^ fK(key)) * 16)) = s.k[i]; *(LAS u32x4*)(Vw + key * 128 + ((c ^ fV(key)) * 16)) = s.v[i]; }
            const LdsBases Bw = lds_bases(Kw, Vw, q, 4 * g + qq, lane);
            const int pbase = qr + 16 * (ks * 32 - 64); const bool needm = pbase < 0 || pbase + 31 * 16 > SEQ - 1; const int pk = pbase + 64 * g;
            lds_step(st, qf, Bw, 0, bsn, [=](f32x4& t0, f32x4& t1) { if (needm) {
#pragma unroll
                for (int x = 0; x < 4; ++x) { if ((unsigned)(pk + 16 * x) >= (unsigned)SEQ) t0[x] = NEG; if ((unsigned)(pk + 16 * (16 + x)) >= (unsigned)SEQ) t1[x] = NEG; } } });
        };
        RowStage A, B; Bias X, Y;
        issue(0, A, X); issue(1, B, Y);
        compute(0, A, X, sa, qa); issue(2, A, X); compute(1, B, Y, sa, qa); issue(3, B, Y); compute(2, A, X, sa, qa); issue(4, A, X); compute(3, B, Y, sa, qa); compute(4, A, X, sa, qa);
        { const RState ts = sa; sa = sb; sb = ts; const QF tq = qa; qa = qbf; qbf = tq; }
    }
    }
    asm volatile("" : "+v"(lane));
    { const int q = lane & 15;
    finish_r(sa, dry ? dry + (((size_t)bt * 16 + ra) * 16 + q) * 64 : pb_ + (size_t)(q0 + ra + 16 * q) * PLD + PC_QC + h * 64, za_, lane);
    finish_r(sb, dry ? dry + (((size_t)bt * 16 + rb) * 16 + q) * 64 : pb_ + (size_t)(q0 + rb + 16 * q) * PLD + PC_QC + h * 64, zb_, lane); }
    lds_barrier();
}
#undef LAS
}
constexpr int NWAVES = 8;
#define GAS __attribute__((address_space(1)))
#define LAS __attribute__((address_space(3)))
typedef unsigned v4u __attribute__((ext_vector_type(4)));
typedef float f32x4 __attribute__((ext_vector_type(4)));
typedef GAS unsigned gu32;
#define RLX_AGENT __ATOMIC_RELAXED, __HIP_MEMORY_SCOPE_AGENT

constexpr size_t SZ_WINT = (size_t)IN_COLS * DM * 2, SZ_WOUTT = (size_t)DM * MIXW * 2, SZ_GLUT = 512 * 512 * 2, SZ_TM = (size_t)32 * 256 * 512 * 2, SZ_MS = (size_t)32 * 256 * 256 * 2;
constexpr size_t OFF_WOUTT0 = OFF_W, OFF_WOUTT1 = OFF_WOUTT0 + SZ_WOUTT, OFF_WINT1 = OFF_WOUTT1 + SZ_WOUTT, OFF_GLUT1 = OFF_WINT1 + SZ_WINT, OFF_TM1 = OFF_GLUT1 + SZ_GLUT, OFF_MS1 = OFF_TM1 + SZ_TM;
constexpr size_t WS_NEED = OFF_MS1 + SZ_MS;
constexpr size_t DO_WINT0 = 0, DO_GLUT0 = DO_WINT0 + SZ_WINT, DO_TM0 = DO_GLUT0 + SZ_GLUT, DO_MS0 = DO_TM0 + SZ_TM;
static_assert(DO_MS0 + SZ_MS <= (size_t)NTOK * DM * 4, "layer-0 tables fit in d_out");
static_assert(WS_NEED <= (size_t)256 * 1024 * 1024, "workspace map fits 256 MiB");
constexpr size_t CTL_ZERO_BYTES = 262144;
constexpr int CW_BAR = 1024;
constexpr int CW_WORK = 256;
constexpr int CW_YDONE = 512;
constexpr size_t OFF_T5TB = 524288;
constexpr size_t OFF_RPBS = OFF_T5TB + (size_t)(att::T5TB_F + att::T5S_F) * 4;
static_assert(OFF_RPBS + (size_t)att::RPBS_F * 4 <= OFF_SS, "small tables fit in the control MiB");

constexpr int RING_BYTES = 131072;
constexpr int MISC_OFF = RING_BYTES;
constexpr int LDS_BYTES = 147456;
static_assert(NWAVES * att::WAVE_LDS <= RING_BYTES && 2 * att::NA_IMG <= RING_BYTES && 2 * att::DIL_IMG + 2 * att::TBW * 4 <= RING_BYTES, "attention LDS");

#define XB_TMO      128
#define XB_XCNT(j)  (256  + 64 * (j))
#define XB_XSUB(j)  (1280 + 64 * (j))
#define XB_XGEN(j)  (2304 + 64 * (j))
#define XB_TOP      3328
#define XB_TOPGEN   3392
#define XCD_BAR_WORDS 3456
#define XB_SPIN_CAP (1u << 18)
__device__ __forceinline__ unsigned xb_ld(unsigned* p)              { return __hip_atomic_load(p, __ATOMIC_RELAXED, __HIP_MEMORY_SCOPE_AGENT); }
__device__ __forceinline__ unsigned xb_add(unsigned* p, unsigned v) { return __hip_atomic_fetch_add(p, v, __ATOMIC_RELAXED, __HIP_MEMORY_SCOPE_AGENT); }
__device__ __forceinline__ unsigned xb_xcc_id() { return (unsigned)__builtin_amdgcn_s_getreg((3 << 11) | 20) & 0xFu; }
#define XB_SPIN(cond, bar) do { unsigned _sp = 0; while (cond) { __builtin_amdgcn_s_sleep(1); \
    if ((++_sp & 255u) == 0u) { if (xb_ld(&(bar)[XB_TMO])) break; if (_sp > XB_SPIN_CAP) { atomicAdd(&(bar)[XB_TMO], 1u); break; } } } } while (0)
struct XcdBarrier { unsigned* bar; unsigned x; volatile LAS unsigned* st; };
__device__ __forceinline__ XcdBarrier xcd_barrier_post(unsigned* bar, volatile LAS unsigned* st, int wave_s) {
    XcdBarrier b; b.bar = bar; b.x = xb_xcc_id(); b.st = st;
    if (wave_s == 0 && hw_lane() == 0) (void)xb_add(&bar[XB_XCNT(b.x)], 1u);
    return b;
}
__device__ __forceinline__ void xcd_barrier_complete(unsigned* bar, unsigned x, unsigned& nloc, unsigned& nx) {
    const unsigned G = gridDim.x * gridDim.y * gridDim.z;
    unsigned sum, cnt, mine, sp = 0u;
    for (;;) {
        sum = 0u; cnt = 0u; mine = 0u;
#pragma unroll
        for (unsigned j = 0; j < 16; ++j) { const unsigned c = xb_ld(&bar[XB_XCNT(j)]); sum += c; cnt += (c > 0u) ? 1u : 0u; mine = (j == x) ? c : mine; }
        if (sum == G) break;
        __builtin_amdgcn_s_sleep(1);
        if ((++sp & 255u) == 0u) { if (xb_ld(&bar[XB_TMO])) break; if (sp > XB_SPIN_CAP) { atomicAdd(&bar[XB_TMO], 1u); break; } }
    }
    nloc = mine > 0u ? mine : 1u; nx = cnt > 0u ? cnt : 1u;
}
__device__ __forceinline__ void xcd_barrier(const XcdBarrier& b, int wave_s) {
    asm volatile("s_waitcnt vmcnt(0)" ::: "memory");
    __syncthreads();
    if (wave_s == 0 && hw_lane() == 0) {
        unsigned* bar = b.bar;
        __builtin_amdgcn_s_waitcnt(0);
        unsigned nloc = b.st[0], nx = b.st[1];
        if (nloc == 0u) { xcd_barrier_complete(bar, b.x, nloc, nx); b.st[0] = nloc; b.st[1] = nx; }
        const unsigned old = xb_add(&bar[XB_XSUB(b.x)], 1u);
        const unsigned gen = old / nloc;
        if (old + 1u == (gen + 1u) * nloc) {
            __builtin_amdgcn_fence(__ATOMIC_RELEASE, "agent");
            asm volatile("s_waitcnt vmcnt(0)" ::: "memory");
            const unsigned og = xb_add(&bar[XB_TOP], 1u);
            const unsigned tg = og / nx;
            if (og + 1u == (tg + 1u) * nx) xb_add(&bar[XB_TOPGEN], 1u);
            else XB_SPIN(xb_ld(&bar[XB_TOPGEN]) == tg, bar);
            __builtin_amdgcn_fence(__ATOMIC_ACQUIRE, "agent");
            xb_add(&bar[XB_XGEN(b.x)], 1u);
            asm volatile("s_waitcnt vmcnt(0)" ::: "memory");
        } else {
            XB_SPIN(xb_ld(&bar[XB_XGEN(b.x)]) == gen, bar);
            __builtin_amdgcn_fence(__ATOMIC_ACQUIRE, "agent");
            asm volatile("s_waitcnt vmcnt(0)" ::: "memory");
        }
    }
    __syncthreads();
}

struct Args { const float* in[17]; float* out; unsigned char* ws; int ph_lo, ph_hi; int li, skip; };

__device__ __forceinline__ float wave_sum(float v) {
#pragma unroll
    for (int o = 1; o < 64; o <<= 1) v += __shfl_xor(v, o);
    return v;
}
__device__ __forceinline__ unsigned pk2(float lo, float hi) { return f2bf(lo) | (f2bf(hi) << 16); }

__device__ __forceinline__ void p0_transpose_item(const float* W, int K, int Nsrc, bf16_t* WT, int k0, int n0s, int n0d, const float* kscale, LAS float* scr, int lane) {
    float tv[32];
#pragma unroll
    for (int i = 0; i < 32; ++i) { const int kk = 2 * i + (lane >> 5); tv[i] = W[(size_t)(k0 + kk) * Nsrc + n0s + (lane & 31)]; }
    const float ksc = kscale ? kscale[k0 + lane] : 1.f;
#pragma unroll
    for (int i = 0; i < 32; ++i) { const int kk = 2 * i + (lane >> 5); scr[kk * 33 + (lane & 31)] = tv[i] * __shfl(ksc, kk); }
    asm volatile("s_waitcnt lgkmcnt(0)" ::: "memory");
    const int c = lane & 7;
#pragma unroll
    for (int j = 0; j < 4; ++j) { const int n = (lane >> 3) + 8 * j; const LAS float* s = scr + (8 * c) * 33 + n;
        v4u o; o.x = pk2(s[0 * 33], s[1 * 33]); o.y = pk2(s[2 * 33], s[3 * 33]); o.z = pk2(s[4 * 33], s[5 * 33]); o.w = pk2(s[6 * 33], s[7 * 33]);
        *(v4u*)(WT + (size_t)(n0d + n) * K + k0 + 8 * c) = o; }
    asm volatile("s_waitcnt lgkmcnt(0)" ::: "memory");
}
template <int NR>
__device__ __forceinline__ void p0_xrows(const float* xrow, bf16_t* orow, float* ssrow, int lane) {
    f32x4 v[NR][4];
#pragma unroll
    for (int r = 0; r < NR; ++r)
#pragma unroll
        for (int j = 0; j < 4; ++j) v[r][j] = *((const f32x4*)(xrow + (size_t)r * DM) + lane + 64 * j);
#pragma unroll
    for (int r = 0; r < NR; ++r) {
        float s = 0.f;
#pragma unroll
        for (int j = 0; j < 4; ++j) s += (v[r][j].x * v[r][j].x + v[r][j].y * v[r][j].y) + (v[r][j].z * v[r][j].z + v[r][j].w * v[r][j].w);
        s = wave_sum(s);
        unsigned long long* o8 = (unsigned long long*)(orow + (size_t)r * DM) + lane;
#pragma unroll
        for (int j = 0; j < 4; ++j) o8[64 * j] = (unsigned long long)pk2(v[r][j].x, v[r][j].y) | ((unsigned long long)pk2(v[r][j].z, v[r][j].w) << 32);
        if (lane < 16) ssrow[r * 16 + lane] = lane == 0 ? s : 0.f;
    }
}
__device__ __forceinline__ int t5_bucket_dev(int rel) {
    const int n = rel < 0 ? -rel : rel;
    const int large = 8 + (n >= 15) + (n >= 27) + (n >= 50) + (n >= 91) + (n >= 166) + (n >= 305) + (n >= 559);
    return (rel > 0 ? 16 : 0) + (n < 8 ? n : large);
}
__device__ __forceinline__ void p0_ssm_tables(const Args& a, int l, int g, int d, bf16_t* TM, bf16_t* Ms, LAS float* scr, int wave_s, int dbg = 0) {
    int tid = wave_s * 64 + hw_lane(); asm volatile("" : "+v"(tid));
    LAS float* pw = scr;
    LAS float* fc = pw + 64 * 17 * 2;
    LAS float* Cc = fc + 2 * 64 * 2;
    LAS float* Bb = Cc + 2048;
    LAS float* C2 = Bb + 2048;
    LAS float* B2 = C2 + 2048;
    LAS float* Kt = B2 + 2048;
    const float* lam_re = a.in[4]; const float* lam_im = a.in[5]; const float* log_dt = a.in[6];
    const float* b_re = a.in[7]; const float* b_im = a.in[8]; const float* c_re = a.in[9]; const float* c_im = a.in[10]; const float* dskip = a.in[11];
    const int pg = (l * 2 + d) * 32 + g, pg2 = (l * 2 + (1 - d)) * 32 + g;
    if (tid < 128) {
        const int o = tid >> 6, p = tid & 63, pgx = o == 0 ? pg : pg2;
        const float lre = lam_re[pgx * 64 + p], lim = lam_im[pgx * 64 + p], dt = expf(log_dt[pgx]);
        const float er = expf(lre * dt), lbr = er * cosf(lim * dt), lbi = er * sinf(lim * dt);
        const float nr = lbr - 1.f, ni = lbi, den = lre * lre + lim * lim;
        fc[(o * 64 + p) * 2] = (nr * lre + ni * lim) / den; fc[(o * 64 + p) * 2 + 1] = (ni * lre - nr * lim) / den;
        if (o == 0) { float wr = 1.f, wi = 0.f;
            for (int k = 0; k <= 16; ++k) { pw[(p * 17 + k) * 2] = wr; pw[(p * 17 + k) * 2 + 1] = wi; const float t = wr * lbr - wi * lbi; wi = wr * lbi + wi * lbr; wr = t; } }
    }
    __syncthreads();
    for (int i = tid; i < 1024; i += NWAVES * 64) {
        Cc[i * 2] = c_re[(size_t)pg * 1024 + i]; Cc[i * 2 + 1] = c_im[(size_t)pg * 1024 + i];
        { const int p = i >> 4; const float br = b_re[(size_t)pg * 1024 + i], bi = b_im[(size_t)pg * 1024 + i], fr = fc[p * 2], fi = fc[p * 2 + 1];
          Bb[i * 2] = fr * br - fi * bi; Bb[i * 2 + 1] = fr * bi + fi * br; }
        if (d == 0) {
            C2[i * 2] = c_re[(size_t)pg2 * 1024 + i]; C2[i * 2 + 1] = c_im[(size_t)pg2 * 1024 + i];
            const int p = i >> 4; const float br = b_re[(size_t)pg2 * 1024 + i], bi = b_im[(size_t)pg2 * 1024 + i], fr = fc[(64 + p) * 2], fi = fc[(64 + p) * 2 + 1];
            B2[i * 2] = fr * br - fi * bi; B2[i * 2 + 1] = fr * bi + fi * br; }
    }
    __syncthreads();
    {
        const int kh = tid >> 8, c = (tid >> 4) & 15, cp = tid & 15;
        float Kk[8];
#pragma unroll
        for (int k = 0; k < 8; ++k) Kk[k] = 0.f;
        float k0o = 0.f;
        typedef float f32x2v __attribute__((ext_vector_type(2)));
#pragma unroll 2
        for (int p = 0; p < ((dbg & 0x20) ? 0 : 64); ++p) {
            const f32x2v Cv = *(const LAS f32x2v*)(Cc + (c * 64 + p) * 2), bv = *(const LAS f32x2v*)(Bb + (p * 16 + cp) * 2);
            const float Cr = Cv.x, Ci = Cv.y, br = bv.x, bi = bv.y;
            const LAS f32x2v* pwp = (const LAS f32x2v*)(pw + (p * 17 + kh * 8) * 2);
            f32x2v pq[8];
#pragma unroll
            for (int k = 0; k < 8; ++k) pq[k] = pwp[k];
            const float zr = Cr * br - Ci * bi, zi = Cr * bi + Ci * br;
#pragma unroll
            for (int k = 0; k < 8; ++k) Kk[k] += zr * pq[k].x - zi * pq[k].y;
            if (d == 0 && kh == 0) { const f32x2v c2 = *(const LAS f32x2v*)(C2 + (c * 64 + p) * 2), b2 = *(const LAS f32x2v*)(B2 + (p * 16 + cp) * 2); k0o += c2.x * b2.x - c2.y * b2.y; }
        }
#pragma unroll
        for (int k = 0; k < 8; ++k) Kt[(kh * 8 + k) * 256 + c * 16 + cp] = Kk[k];
        if (d == 0 && kh == 0) Kt[16 * 256 + c * 16 + cp] = k0o;
        if (tid < 16) Kt[17 * 256 + tid] = dskip[l * 512 + g * 16 + tid];
    }
    __syncthreads();
    for (int idx = tid; idx < ((dbg & 0x40) ? 0 : 256 * 64); idx += NWAVES * 64) {
        const int row = idx >> 6, col = (idx & 63) * 4, t = row >> 4, cc = row & 15, s_ = col >> 4, c2 = col & 15;
        const int k = d == 0 ? t - s_ : s_ - t;
        if (k < 0 || (d == 1 && k == 0)) continue;
        f32x4 v = *(const LAS f32x4*)(Kt + k * 256 + cc * 16 + c2);
        if (k == 0) { v = v + *(const LAS f32x4*)(Kt + 16 * 256 + cc * 16 + c2); const float dd = Kt[17 * 256 + cc];
#pragma unroll
            for (int e = 0; e < 4; ++e) if (c2 + e == cc) v[e] += dd; }
        *(unsigned long long*)(TM + (size_t)row * 512 + col) = (unsigned long long)pk2(v[0], v[1]) | ((unsigned long long)pk2(v[2], v[3]) << 32);
    }
    if (!(dbg & 0x80)) {
        const int p = tid & 63, cq = tid >> 6;
#pragma unroll
        for (int h2 = 0; h2 < 2; ++h2) { const int c = cq + 8 * h2; const float Cr = Cc[(c * 64 + p) * 2], Ci = Cc[(c * 64 + p) * 2 + 1];
#pragma unroll 4
            for (int e = 1; e <= 16; ++e) { const float pr = pw[(p * 17 + e) * 2], pi = pw[(p * 17 + e) * 2 + 1]; const float wr = Cr * pr - Ci * pi, wi = Cr * pi + Ci * pr;
                const int t = d == 0 ? e - 1 : 16 - e; bf16_t* rowp = TM + (size_t)(t * 16 + c) * 512 + 256 + d * 128 + p;
                rowp[0] = (bf16_t)f2bf(wr); rowp[64] = (bf16_t)f2bf(-wi); } }
    }
    if (!(dbg & 0x80)) {
        const int sc = tid & 255, e = sc >> 4, cp = sc & 15, ph = tid >> 8, s_ = d == 0 ? 15 - e : e;
#pragma unroll 4
        for (int it = 0; it < 32; ++it) { const int p = ph + 2 * it; const float pr = pw[(p * 17 + e) * 2], pi = pw[(p * 17 + e) * 2 + 1], br = Bb[(p * 16 + cp) * 2], bi = Bb[(p * 16 + cp) * 2 + 1];
            Ms[(size_t)(d * 128 + p) * 256 + s_ * 16 + cp] = (bf16_t)f2bf(pr * br - pi * bi); Ms[(size_t)(d * 128 + 64 + p) * 256 + s_ * 16 + cp] = (bf16_t)f2bf(pr * bi + pi * br); }
    }
    __syncthreads();
}

constexpr int N_PHASES = 8;
__global__ void __launch_bounds__(NWAVES * 64, 2) mega_fwd(Args args) {
    extern __shared__ __attribute__((aligned(16))) unsigned char lds_raw[];
    LAS unsigned char* lds = (LAS unsigned char*)lds_raw;
    volatile LAS unsigned* MISC = (volatile LAS unsigned*)(lds + MISC_OFF);
    const int wave_s = __builtin_amdgcn_readfirstlane((int)threadIdx.x >> 6);
#define PHASE_LANES int lane = hw_lane(); asm volatile("" : "+v"(lane)); const int wave = wave_s; const int ptid = wave * 64 + lane; (void)ptid;
    const int G = gridDim.x; int vcu; { const int bx = blockIdx.x; vcu = (G % 8 == 0) ? (bx % 8) * (G / 8) + bx / 8 : bx; }
    unsigned char* ws = args.ws; unsigned char* dout = (unsigned char*)args.out;
    unsigned* ctl = (unsigned*)(ws + OFF_CTL);
    if (wave_s == 0) { const int l0 = hw_lane(); if (l0 < 32) MISC[l0] = 0u; }
    __syncthreads();
    XcdBarrier bar = xcd_barrier_post(ctl + CW_BAR + args.li * XCD_BAR_WORDS, MISC + 8, wave_s);
    const int lo = args.ph_lo, hi = args.ph_hi;
    const int dry = (args.skip >> 8) & 1;
#ifndef REP_P0
#define REP_P0 1
#endif
#ifndef REP_INPROJ
#define REP_INPROJ 1
#endif
#ifndef REP_EG
#define REP_EG 1
#endif
#ifndef DRY_NA
#define DRY_NA 0
#endif
#ifndef DRY_DIL
#define DRY_DIL 0
#endif
#ifndef REP_SCAN
#define REP_SCAN 1
#endif
#ifndef REP_Y
#define REP_Y 1
#endif
#ifndef DRYVAR
#define DRYVAR 0
#endif
#ifndef CT_SKIP
#define CT_SKIP 0
#endif
#ifndef PHASE_MASK
#define PHASE_MASK 0xff
#endif
#define INR(k) (lo <= (k) && (k) < hi)
#define IN(k) (((PHASE_MASK >> ((k) == 7 ? 4 : (k))) & 1) && INR(k))
#define INL(j) (((PHASE_MASK >> ((j) + 1)) & 1) && INR(pb + (j)))
#ifndef REP_BAR
#define REP_BAR 1
#endif
#define SEAM(k) do { if (INR(k) && INR((k) + 1)) for (int rb_ = 0; rb_ < REP_BAR; ++rb_) xcd_barrier(bar, wave_s); } while (0)

    bf16_t* proj = (bf16_t*)(ws + OFF_PROJ); bf16_t* xag = (bf16_t*)(ws + OFF_XAG); bf16_t* xb = (bf16_t*)(ws + OFF_XB); float* Ebuf = (float*)(ws + OFF_XB);
    bf16_t* Gb = (bf16_t*)(ws + OFF_G); float* sspart = (float*)(ws + OFF_SS);
    float* rpbs = (float*)(ws + OFF_RPBS); float* t5tb = (float*)(ws + OFF_T5TB);
    bf16_t* dryp = dry ? Gb : nullptr;

    if (IN(0)) for (int rep_ = 0; rep_ < REP_P0; ++rep_) {
        PHASE_LANES
        const int NTB = 128;
        if (!(args.skip & 1)) for (int ti = vcu; ti < NTB; ti += G) {
            const int l = ti >> 6, g = (ti >> 1) & 31, d = ti & 1;
            bf16_t* TM = (bf16_t*)(l == 0 && !dry ? dout + DO_TM0 : ws + OFF_TM1) + (size_t)g * 256 * 512;
            bf16_t* Ms = (bf16_t*)(l == 0 && !dry ? dout + DO_MS0 : ws + OFF_MS1) + (size_t)g * 256 * 256;
            p0_ssm_tables(args, l, g, d, TM, Ms, (LAS float*)lds, wave_s, dry ? args.skip : 0);
        }
        if (!(args.skip & 2)) {
            const float* rpb = args.in[14]; const float* t5 = args.in[15];
            for (int i = vcu * NWAVES * 64 + ptid; i < att::RPBS_F; i += G * NWAVES * 64) {
                const int ii = i & 63, rr = (i >> 6) % 15, h = (i / (64 * 15)) & 7, c = (i / (64 * 15 * 8)) & 3, l = i / (64 * 15 * 8 * 4); const int cr = ii + c - 17;
                rpbs[i] = (ii + c < 64 && cr >= 0 && cr <= 30) ? rpb[(((size_t)l * 8 + h) * 15 + rr) * 31 + cr] * 1.4426950408889634f : 0.f; }
            for (int i = vcu * NWAVES * 64 + ptid; i < att::T5TB_F + att::T5S_F; i += G * NWAVES * 64) {
                int h, pat, idx;
                if (i < att::T5TB_F) { idx = i % att::TBW; pat = (i / att::TBW) % 3; h = i / (3 * att::TBW); }
                else { const int i2 = i - att::T5TB_F; const int c = (i2 / att::TBW) & 3; h = i2 / (4 * att::TBW); pat = 0; idx = i2 % att::TBW - c; }
                const int w = idx - att::TBOFF; const int d = pat == 0 ? 16 : (pat == 1 ? 4 : 1);
                t5tb[i] = (idx >= 0 && w >= 0 && w <= 128) ? t5[t5_bucket_dev(d * (w - 64)) * 8 + h] * 1.4426950408889634f : att::NEG; }
        }
        {
            LAS float* scr = (LAS float*)(lds + wave * 16384);
            constexpr int I_IN = (DM / 64) * (IN_COLS / 32), I_OUT = (MIXW / 64) * (DM / 32), I_GLU = (512 / 64) * (512 / 32), I_L = I_IN + I_OUT + I_GLU, I_TOT = 2 * I_L + NTOK / 4;
            const int NW_ALL = G * NWAVES, gw = vcu * NWAVES + wave; const bool tblk = vcu < NTB && G > NTB;
            const int NW2 = tblk ? 0 : (G - NTB) * NWAVES, gw2 = (vcu - NTB) * NWAVES + wave;
            const int P1N = G > NTB ? 3 : (I_TOT + NW_ALL - 1) / NW_ALL, I_P1 = P1N * NW_ALL < I_TOT ? P1N * NW_ALL : I_TOT;
            for (int pass = 0; pass < 2; ++pass) {
                const int i0 = pass == 0 ? gw : I_P1 + gw2, i1 = pass == 0 ? I_P1 : I_TOT, st = pass == 0 ? NW_ALL : NW2;
                if (pass == 1 && NW2 == 0) break;
                for (int it = i0; it < i1; it += st) {
                    if (it >= 2 * I_L) { if (args.skip & 8) continue; const int mrow = (it - 2 * I_L) * 4; p0_xrows<4>(args.in[0] + (size_t)mrow * DM, xb + (size_t)mrow * DM, sspart + (size_t)mrow * 16, lane); continue; }
                    if (args.skip & 4) continue;
                    const int l = it / I_L; int r = it % I_L;
                    if (r < I_IN) { const int nblk = IN_COLS / 32, kb = r / nblk, nb = r % nblk;
                        p0_transpose_item(args.in[2] + (size_t)l * DM * IN_COLS, DM, IN_COLS, (bf16_t*)(l == 0 && !dry ? dout + DO_WINT0 : ws + OFF_WINT1), 64 * kb, inproj_src_col(32 * nb), 32 * nb, args.in[1] + l * DM, scr, lane); continue; }
                    r -= I_IN;
                    if (r < I_OUT) { const int nblk = DM / 32, kb = r / nblk, nb = r % nblk;
                        p0_transpose_item(args.in[3] + (size_t)l * MIXW * DM, MIXW, DM, (bf16_t*)(ws + (l == 0 ? OFF_WOUTT0 : OFF_WOUTT1)), 64 * kb, 32 * nb, 32 * nb, nullptr, scr, lane); continue; }
                    r -= I_OUT;
                    { const int nblk = 512 / 32, kb = r / nblk, nb = r % nblk;
                        p0_transpose_item(args.in[12] + (size_t)l * 512 * 512, 512, 512, (bf16_t*)(l == 0 && !dry ? dout + DO_GLUT0 : ws + OFF_GLUT1), 64 * kb, 32 * nb, 32 * nb, nullptr, scr, lane); }
                }
            }
        }
    }
    SEAM(0);

    for (int l = 0; l < DEPTH; ++l) {
        const int pb = 1 + 3 * l;
        const bf16_t* WinT = (const bf16_t*)(l == 0 ? dout + DO_WINT0 : ws + OFF_WINT1);
        const bf16_t* WoutT = (const bf16_t*)(ws + (l == 0 ? OFF_WOUTT0 : OFF_WOUTT1));
        const bf16_t* GluT = (const bf16_t*)(l == 0 ? dout + DO_GLUT0 : ws + OFF_GLUT1);
        const bf16_t* TM = (const bf16_t*)(l == 0 ? dout + DO_TM0 : ws + OFF_TM1);
        const bf16_t* Ms = (const bf16_t*)(l == 0 ? dout + DO_MS0 : ws + OFF_MS1);
        if (INL(0)) for (int rep_ = 0; rep_ < REP_INPROJ; ++rep_) {
            pg8::Gemm gm{xb, WinT, DM, DM, DM, 0, 0}; pg8::StaticOrder S; S.init(NTOK, IN_COLS, G, (int)blockIdx.x);
            pg8::EpiInProj E{sspart, proj, xag};
            pg8::gemm_phase<pg8::EpiInProj, pg8::StaticOrder>(lds, gm, S, E, wave_s);
        }
        SEAM(pb + 0);
        if (INL(1)) {
            constexpr int NCHAIN = 128;
            if (!(args.skip & 1)) for (int cid = vcu; cid < NCHAIN; cid += G) {
                const int g = cid >> 2, b = cid & 3;
                { pg8::Gemm gm{xag, Ms, 512, 256, 256, (size_t)NCHUNK_TOT * 512, (size_t)256 * 256}; pg8::OneUnit S; S.u = pg8::Unit{b, 0, g};
                  pg8::EpiE E{Ebuf};
                  pg8::gemm_phase<pg8::EpiE, pg8::OneUnit>(lds, gm, S, E, wave_s); }
                asm volatile("s_waitcnt vmcnt(0)" ::: "memory"); __syncthreads();
                if (!(args.skip & 0x10)) {
                    PHASE_LANES
                    const float* lam_re = args.in[4]; const float* lam_im = args.in[5]; const float* log_dt = args.in[6];
                    LAS float* sx = (LAS float*)lds;
#pragma unroll 1
                    for (int d = 0; d < 2; ++d) {
                        const int p = lane, pg = (l * 2 + d) * 32 + g;
                        const float lre = lam_re[pg * 64 + p], lim = lam_im[pg * 64 + p], dt = expf(log_dt[pg]);
                        const float er = expf(lre * dt); float ar = er * cosf(lim * dt), ai = er * sinf(lim * dt);
#pragma unroll
                        for (int i = 0; i < 4; ++i) { const float t = ar * ar - ai * ai; ai = 2.f * ar * ai; ar = t; }
                        const float* Ep = Ebuf + ((size_t)g * NCHUNK_TOT + b * NCHUNK) * 256 + d * 128 + p;
                        bf16_t* Cp = xag + ((size_t)g * NCHUNK_TOT + b * NCHUNK) * 512 + 256 + d * 128 + p;
                        float er_[32], ei_[32];
#pragma unroll
                        for (int i = 0; i < 32; ++i) { const int s = wave * 32 + i, k = d == 0 ? s : NCHUNK - 1 - s; er_[i] = Ep[(size_t)k * 256]; ei_[i] = Ep[(size_t)k * 256 + 64]; }
                        float cr = 0.f, ci = 0.f;
#pragma unroll
                        for (int i = 0; i < 32; ++i) { const float xr = er_[i], xi = ei_[i]; er_[i] = cr; ei_[i] = ci; const float t = ar * cr - ai * ci + xr; ci = ar * ci + ai * cr + xi; cr = t; }
                        sx[(wave * 64 + lane) * 2] = cr; sx[(wave * 64 + lane) * 2 + 1] = ci;
                        float a32r = ar, a32i = ai;
#pragma unroll
                        for (int i = 0; i < 5; ++i) { const float t = a32r * a32r - a32i * a32i; a32i = 2.f * a32r * a32i; a32r = t; }
                        __syncthreads();
                        float inr = 0.f, ini = 0.f;
                        for (int j = 0; j < wave; ++j) { const float tr = sx[(j * 64 + lane) * 2], ti = sx[(j * 64 + lane) * 2 + 1]; const float t = a32r * inr - a32i * ini + tr; ini = a32r * ini + a32i * inr + ti; inr = t; }
                        float pr = inr, pi = ini;
#pragma unroll
                        for (int i = 0; i < 32; ++i) { const int s = wave * 32 + i, k = d == 0 ? s : NCHUNK - 1 - s;
                            Cp[(size_t)k * 512] = (bf16_t)f2bf(er_[i] + pr); Cp[(size_t)k * 512 + 64] = (bf16_t)f2bf(ei_[i] + pi);
                            const float t = ar * pr - ai * pi; pi = ar * pi + ai * pr; pr = t; }
                        __syncthreads();
                    }
                }
                asm volatile("s_waitcnt vmcnt(0)" ::: "memory"); __syncthreads();
                if (!(args.skip & 0x20)) { pg8::Gemm gm{xag, TM, 512, 512, 512, (size_t)NCHUNK_TOT * 512, (size_t)256 * 512}; pg8::OneUnit S; S.u = pg8::Unit{b, 0, g};
                  pg8::EpiY E{Gb};
                  pg8::gemm_phase<pg8::EpiY, pg8::OneUnit>(lds, gm, S, E, wave_s); }
                asm volatile("s_waitcnt vmcnt(0)" ::: "memory"); __syncthreads();
                if (wave_s == 0 && hw_lane() == 0) {
                    __hip_atomic_fetch_add(ctl + CW_YDONE + (l * 4 + b) * 64, 1u, __ATOMIC_RELAXED, __HIP_MEMORY_SCOPE_AGENT);
                }
            }
            {
                const float* rp = rpbs + (size_t)l * 4 * 8 * 15 * 64;
                int nNA, naB, naS, nDI, diB, diS, nGL, glB, glS;
                if (G == 2 * NCHAIN) {
                    const int x = (vcu & (NCHAIN - 1)) >> 5, j = vcu & 31;
                    if (vcu < NCHAIN) { nNA = 7; naB = x * 224 + j; naS = 32; nDI = 1; diB = x * 32 + j; diS = 32; nGL = 0; glB = 0; glS = 1; }
                    else { nNA = 1; naB = 896 + x * 32 + j; naS = 32; nDI = 3; diB = NCHAIN + x * 96 + j; diS = 32; nGL = 1; glB = vcu - NCHAIN; glS = 1; }
                } else { nNA = (1024 - vcu + G - 1) / G; naB = vcu; naS = G; nDI = (512 - vcu + G - 1) / G; diB = vcu; diS = G; nGL = (128 - vcu + G - 1) / G; glB = vcu; glS = G; }
#ifdef NAVAR
                if (dry) { for (int i = 0; i < ((args.skip & 2) ? 0 : nNA); ++i) att::na_block_task<NAVAR>(proj, rp, naB + i * naS, (LAS char*)lds, wave_s, dryp); } else
#endif
#pragma unroll 1
                for (int i = 0; i < ((args.skip & 2) ? 0 : nNA); ++i) att::na_block_task(proj, rp, naB + i * naS, (LAS char*)lds, wave_s, dryp);
#ifdef DILVAR
                if (dry) { for (int i = 0; i < ((args.skip & 4) ? 0 : nDI); ++i) att::dil_block_task<DILVAR>(proj, t5tb, diB + i * diS, (LAS char*)lds, wave_s, dryp); } else
#endif
#pragma unroll 1
                for (int i = 0; i < ((args.skip & 4) ? 0 : nDI); ++i) att::dil_block_task(proj, t5tb, diB + i * diS, (LAS char*)lds, wave_s, dryp);
#pragma unroll 1
                for (int i = 0; i < ((args.skip & 8) ? 0 : nGL); ++i) {
                    const int u = glB + i * glS, bq = u >> 5;
                    if (wave_s == 0) {
                        unsigned* cw = ctl + CW_YDONE + (l * 4 + bq) * 64; unsigned sp = 0;
                        while (__builtin_amdgcn_readfirstlane(__hip_atomic_load(cw, __ATOMIC_RELAXED, __HIP_MEMORY_SCOPE_AGENT)) < 32u) { __builtin_amdgcn_s_sleep(2); if (++sp > (1u << 22)) break; }
                    }
                    __syncthreads();
                    pg8::Gemm gm{Gb, GluT, 512, 512, 512, 0, 0}; pg8::OneUnit S; S.u = pg8::Unit{u >> 1, u & 1, 0};
                    pg8::EpiGlu E{Gb, args.in[13] + l * 512, proj, dry};
                    pg8::gemm_phase<pg8::EpiGlu, pg8::OneUnit>(lds, gm, S, E, wave_s);
                    __syncthreads();
                }
            }
        }
        SEAM(pb + 1);
        if (INL(2)) {
            pg8::Gemm gm{proj, WoutT, PLD, MIXW, MIXW, 0, 0}; pg8::StaticOrder S; S.init(NTOK, DM, G, (int)blockIdx.x);
            pg8::EpiOutProj E{l == 0 ? args.in[0] : args.out, args.out, xb, sspart, l == 0 ? 1 : 0, dry};
            pg8::gemm_phase<pg8::EpiOutProj, pg8::StaticOrder>(lds, gm, S, E, wave_s);
        }
        SEAM(pb + 2);
    }
    if (IN(7)) {
        PHASE_LANES
        const float* fg = args.in[16];
        const int gw = vcu * NWAVES + wave, NGW = G * NWAVES;
        for (int m = gw; m < NTOK; m += NGW) {
            const f32x4* sp = (const f32x4*)(sspart + (size_t)m * 16);
            const f32x4 s0 = sp[0], s1 = sp[1], s2 = sp[2], s3 = sp[3];
            const float ss = (((s0[0] + s0[1]) + (s0[2] + s0[3])) + ((s1[0] + s1[1]) + (s1[2] + s1[3]))) + (((s2[0] + s2[1]) + (s2[2] + s2[3])) + ((s3[0] + s3[1]) + (s3[2] + s3[3])));
            const float rinv = rsqrtf(ss * (1.0f / DM) + RMS_EPS);
            f32x4* xr = (f32x4*)(args.out + (size_t)m * DM) + lane;
#pragma unroll
            for (int j = 0; j < 4; ++j) { const f32x4 gv = *((const f32x4*)fg + lane + 64 * j); const f32x4 ov = xr[64 * j] * rinv * gv; if (!dry) xr[64 * j] = ov; else asm volatile("" :: "v"(ov)); }
        }
    }
#undef IN
#undef INL
#undef INR
#undef SEAM
}
#ifndef EXTRA_PLAN
#define EXTRA_PLAN
#endif
#define HOST_PLAN launch_mega(d_in, d_out, d_ws, stream, 0, N_PHASES, 0, 0); EXTRA_PLAN
static int g_grid = 0;
static void launch_mega(void* const* d_in, void* d_out, void* d_ws, hipStream_t stream, int lo, int hi, int li, int skip) {
    Args a{};
    for (int i = 0; i < 17; ++i) a.in[i] = (const float*)d_in[i];
    a.out = (float*)d_out; a.ws = (unsigned char*)d_ws; a.ph_lo = lo; a.ph_hi = hi; a.li = li; a.skip = skip;
    hipLaunchKernelGGL(mega_fwd, dim3(g_grid), dim3(NWAVES * 64), LDS_BYTES, stream, a);
    const hipError_t le = hipPeekAtLastError();
    if (le != hipSuccess) fprintf(stderr, "kernel_launch: launch failed: %s (grid %d)\n", hipGetErrorName(le), g_grid);
}
extern "C" void kernel_launch(void* const* d_in, const int* in_sizes, int n_in, void* d_out, int out_size, void* d_ws, size_t ws_size, hipStream_t stream) {
    if (g_grid == 0) {
        if (n_in != 17 || in_sizes[0] != NTOK * DM || out_size != NTOK * DM || ws_size < WS_NEED) { fprintf(stderr, "kernel_launch: unexpected shapes (n_in %d in0 %d out %d ws %zu need %zu)\n", n_in, n_in > 0 ? in_sizes[0] : -1, out_size, ws_size, (size_t)WS_NEED); g_grid = -1; return; }
        int dev = 0, cus = 0, per_cu = 0;
        if (hipGetDevice(&dev) != hipSuccess || hipDeviceGetAttribute(&cus, hipDeviceAttributeMultiprocessorCount, dev) != hipSuccess) { g_grid = -1; return; }
        if (hipFuncSetAttribute((const void*)mega_fwd, hipFuncAttributeMaxDynamicSharedMemorySize, LDS_BYTES) != hipSuccess) { fprintf(stderr, "kernel_launch: hipFuncSetAttribute failed\n"); g_grid = -1; return; }
        if (hipOccupancyMaxActiveBlocksPerMultiprocessor(&per_cu, (const void*)mega_fwd, NWAVES * 64, LDS_BYTES) != hipSuccess || per_cu < 1) { fprintf(stderr, "kernel_launch: occupancy query says %d\n", per_cu); per_cu = 1; }
        (void)hipGetLastError();
        g_grid = cus * 1;
    }
    if (g_grid < 0) return;
    (void)hipMemsetAsync((char*)d_ws + OFF_CTL, 0, CTL_ZERO_BYTES, stream);
    HOST_PLAN
}
```
